# Optimizing an MI355X kernel written in HIP

```python
import math
import jax
import jax.numpy as jnp
from jax import lax
import numpy as np

D_MODEL = 1024
BATCH = 8
SEQ = 2048
DEPTH = 2

MEM_LEN = 256
HEAD_DIM = 64
SWA_Q_HEADS = 8
SWA_KV_HEADS = 2
SWA_GROUP = SWA_Q_HEADS // SWA_KV_HEADS
WINDOW = 128
SWA_BLOCK = WINDOW
MLSTM_HEADS = 8
MLSTM_HEAD_DIM = 64
MLSTM_CHUNK = 64
CONV_WIDTH = 4
X_HEADS = 4
X_HEAD_DIM = 128
N_BRANCH = 3
D_FF = 4 * D_MODEL
REL_BUCKETS = 32
REL_MAX_EXACT = 16
REL_MAX_DIST = 128
EPS = 1e-6
NEG_INF = -1e30

SWA_Q = SWA_Q_HEADS * HEAD_DIM
SWA_KV = SWA_KV_HEADS * HEAD_DIM
MLSTM_W = MLSTM_HEADS * MLSTM_HEAD_DIM
X_W = X_HEADS * X_HEAD_DIM
IN_SIZES = (SWA_Q, SWA_KV, SWA_KV, MLSTM_W, MLSTM_W, MLSTM_W, MLSTM_HEADS, MLSTM_HEADS, MLSTM_W, X_W, N_BRANCH * D_MODEL)
IN_COLS = sum(IN_SIZES)

kernel_name = "hybrid_swa_mlstm_xattn_gated_block"


def rms_norm(x, g):
    xf = x.astype(jnp.float32)
    y = xf * lax.rsqrt(jnp.mean(xf * xf, axis=-1, keepdims=True) + EPS)
    return (y * g.astype(jnp.float32)).astype(x.dtype)


def t5_causal_bucket(dist):
    n = jnp.maximum(dist, 0)
    nf = jnp.maximum(n, 1).astype(jnp.float32)
    scale = (REL_BUCKETS - REL_MAX_EXACT) / math.log(REL_MAX_DIST / REL_MAX_EXACT)
    large = REL_MAX_EXACT + (jnp.log(nf / REL_MAX_EXACT) * scale).astype(jnp.int32)
    large = jnp.minimum(large, REL_BUCKETS - 1)
    return jnp.where(n < REL_MAX_EXACT, n, large)


def swa_band_bias_and_mask(rel_bias, n_blocks):
    qi = jnp.arange(SWA_BLOCK)[:, None]
    kj = jnp.arange(2 * SWA_BLOCK)[None, :]
    dist = qi + SWA_BLOCK - kj
    band = (dist >= 0) & (dist < WINDOW)
    key_pos = (jnp.arange(n_blocks)[:, None, None] - 1) * SWA_BLOCK + kj[None]
    mask = band[None] & (key_pos >= 0)
    bias = rel_bias.astype(jnp.float32)[t5_causal_bucket(dist)]
    bias = jnp.transpose(bias, (2, 0, 1)).reshape(SWA_KV_HEADS, SWA_GROUP, SWA_BLOCK, 2 * SWA_BLOCK)
    return bias, mask


def swa_attention(q, k, v, sinks, bias, mask):
    B, T, _ = q.shape
    nb = T // SWA_BLOCK
    q = q.reshape(B, nb, SWA_BLOCK, SWA_KV_HEADS, SWA_GROUP, HEAD_DIM)
    k = k.reshape(B, nb, SWA_BLOCK, SWA_KV_HEADS, HEAD_DIM)
    v = v.reshape(B, nb, SWA_BLOCK, SWA_KV_HEADS, HEAD_DIM)

    def with_prev(t):
        prev = jnp.pad(t[:, :-1], ((0, 0), (1, 0), (0, 0), (0, 0), (0, 0)))
        return jnp.concatenate([prev, t], axis=2)

    kb, vb = with_prev(k), with_prev(v)
    s = jnp.einsum("bnqhgd,bnkhd->bnhgqk", q, kb).astype(jnp.float32) * HEAD_DIM ** -0.5
    s = s + bias[None, None]
    s = jnp.where(mask[None, :, None, None], s, NEG_INF)
    sink = sinks.astype(jnp.float32).reshape(SWA_KV_HEADS, SWA_GROUP)[:, :, None, None]
    m = jnp.maximum(jnp.max(s, axis=-1, keepdims=True), sink)
    p = jnp.exp(s - m)
    p = p / (jnp.sum(p, axis=-1, keepdims=True) + jnp.exp(sink - m))
    o = jnp.einsum("bnhgqk,bnkhd->bnqhgd", p.astype(v.dtype), vb)
    return o.reshape(B, T, SWA_Q)


def causal_depthwise_conv(x, w):
    C = x.shape[-1]
    return lax.conv_general_dilated(
        x, w[:, None, :].astype(x.dtype), window_strides=(1,),
        padding=[(CONV_WIDTH - 1, 0)], dimension_numbers=("NWC", "WIO", "NWC"),
        feature_group_count=C)


def mlstm_chunkwise(q, k, v, i_pre, f_pre):
    B, T, H, Dh = q.shape
    L = MLSTM_CHUNK
    nc = T // L
    f32 = jnp.float32
    qc = q.astype(f32).reshape(B, nc, L, H, Dh)
    kc = (k.astype(f32) * Dh ** -0.5).reshape(B, nc, L, H, Dh)
    vc = v.astype(f32).reshape(B, nc, L, H, Dh)
    ig = i_pre.reshape(B, nc, L, H)
    b = jnp.cumsum(jax.nn.log_sigmoid(f_pre).reshape(B, nc, L, H), axis=2)
    g = b[:, :, -1]
    w_log = g[:, :, None] - b + ig
    m_loc = jnp.max(w_log, axis=2)
    wk = jnp.exp(w_log - m_loc[:, :, None])[..., None] * kc
    dC = jnp.einsum("bclhk,bclhv->bchkv", wk, vc)
    dn = jnp.sum(wk, axis=2)

    def step(carry, xs):
        C, n, m = carry
        dC_c, dn_c, g_c, ml_c = xs
        m_new = jnp.maximum(g_c + m, ml_c)
        a = jnp.exp(g_c + m - m_new)
        s = jnp.exp(ml_c - m_new)
        C_new = a[..., None, None] * C + s[..., None, None] * dC_c
        n_new = a[..., None] * n + s[..., None] * dn_c
        return (C_new, n_new, m_new), (C, n, m)

    init = (jnp.zeros((B, H, Dh, Dh), f32), jnp.zeros((B, H, Dh), f32), jnp.zeros((B, H), f32))
    xs = tuple(jnp.moveaxis(t, 1, 0) for t in (dC, dn, g, m_loc))
    _, (C_in, n_in, m_in) = lax.scan(step, init, xs)
    C_in = jnp.moveaxis(C_in, 0, 1)
    n_in = jnp.moveaxis(n_in, 0, 1)
    m_in = jnp.moveaxis(m_in, 0, 1)

    causal = jnp.tril(jnp.ones((L, L), dtype=bool))
    d_log = b[:, :, :, None] - b[:, :, None, :] + ig[:, :, None, :]
    d_log = jnp.where(causal[:, :, None], d_log, NEG_INF)
    inter_log = b + m_in[:, :, None]
    m_t = jnp.maximum(jnp.max(d_log, axis=3), inter_log)
    s = jnp.einsum("bcthd,bcshd->bctsh", qc, kc) * jnp.exp(d_log - m_t[:, :, :, None])
    inter_w = jnp.exp(inter_log - m_t)
    num = jnp.einsum("bctsh,bcshd->bcthd", s, vc) + inter_w[..., None] * jnp.einsum("bcthk,bchkv->bcthv", qc, C_in)
    den = jnp.sum(s, axis=3) + inter_w * jnp.einsum("bcthk,bchk->bcth", qc, n_in)
    h = num / jnp.maximum(jnp.abs(den), jnp.exp(-m_t))[..., None]
    return h.reshape(B, T, H, Dh)


def mlstm_branch(mq, mk, mv, mi, mf, mo, conv_w, b_i, b_f, norm_g):
    B, T, _ = mq.shape
    qk = jax.nn.silu(causal_depthwise_conv(jnp.concatenate([mq, mk], axis=-1), conv_w))
    q, k = jnp.split(qk, 2, axis=-1)
    shp = (B, T, MLSTM_HEADS, MLSTM_HEAD_DIM)
    h = mlstm_chunkwise(q.reshape(shp), k.reshape(shp), mv.reshape(shp),
                        (mi + b_i).astype(jnp.float32), (mf + b_f).astype(jnp.float32))
    mu = jnp.mean(h, axis=-1, keepdims=True)
    var = jnp.mean(jnp.square(h - mu), axis=-1, keepdims=True)
    h = ((h - mu) * lax.rsqrt(var + EPS)).reshape(B, T, MLSTM_W) * norm_g.astype(jnp.float32)
    return (jax.nn.sigmoid(mo.astype(jnp.float32)) * h).astype(mq.dtype)


def cross_attention(q, k, v):
    B, T, _ = q.shape
    M = k.shape[1]
    q = q.reshape(B, T, X_HEADS, X_HEAD_DIM)
    k = k.reshape(B, M, X_HEADS, X_HEAD_DIM)
    v = v.reshape(B, M, X_HEADS, X_HEAD_DIM)
    s = jnp.einsum("bthd,bmhd->bhtm", q, k).astype(jnp.float32) * X_HEAD_DIM ** -0.5
    p = jax.nn.softmax(s, axis=-1).astype(v.dtype)
    return jnp.einsum("bhtm,bmhd->bthd", p, v).reshape(B, T, X_W)


def setup_inputs(seed: int = 0) -> dict:
    key = jax.random.key(seed)
    ks = jax.random.split(key, 20)
    f32 = jnp.float32

    def nrm(k, shape, scale):
        return jax.random.normal(k, shape, f32) * scale

    def gain(k, shape):
        return 1.0 + 0.05 * jax.random.normal(k, shape, f32)

    f_bias = jnp.linspace(3.0, 6.0, MLSTM_HEADS, dtype=f32)[None] + 0.1 * jax.random.normal(ks[8], (DEPTH, MLSTM_HEADS), f32)
    return {
        "x": nrm(ks[0], (BATCH, SEQ, D_MODEL), 1.0),
        "mem": nrm(ks[1], (BATCH, MEM_LEN, D_MODEL), 1.0),
        "rel_bias": nrm(ks[2], (REL_BUCKETS, SWA_Q_HEADS), 0.5),
        "g_mix": gain(ks[3], (DEPTH, D_MODEL)),
        "w_in": nrm(ks[4], (DEPTH, D_MODEL, IN_COLS), D_MODEL ** -0.5),
        "conv_w": nrm(ks[5], (DEPTH, CONV_WIDTH, 2 * MLSTM_W), CONV_WIDTH ** -0.5),
        "b_i": nrm(ks[6], (DEPTH, MLSTM_HEADS), 0.1),
        "b_f": f_bias,
        "mlstm_norm_g": gain(ks[7], (DEPTH, MLSTM_W)),
        "sinks": nrm(ks[9], (DEPTH, SWA_Q_HEADS), 0.5),
        "g_mem": gain(ks[10], (DEPTH, D_MODEL)),
        "w_mem_kv": nrm(ks[11], (DEPTH, D_MODEL, 2 * X_W), D_MODEL ** -0.5),
        "w_br_swa": nrm(ks[12], (DEPTH, SWA_Q, D_MODEL), SWA_Q ** -0.5),
        "w_br_mlstm": nrm(ks[13], (DEPTH, MLSTM_W, D_MODEL), MLSTM_W ** -0.5),
        "w_br_x": nrm(ks[14], (DEPTH, X_W, D_MODEL), X_W ** -0.5),
        "w_out": nrm(ks[15], (DEPTH, D_MODEL, D_MODEL), D_MODEL ** -0.5),
        "g_ffn": gain(ks[16], (DEPTH, D_MODEL)),
        "w_ff1": nrm(ks[17], (DEPTH, D_MODEL, D_FF), D_MODEL ** -0.5),
        "w_ff2": nrm(ks[18], (DEPTH, D_FF, D_MODEL), D_FF ** -0.5),
        "g_final": gain(ks[19], (D_MODEL,)),
    }


def reference(x, mem, rel_bias, g_mix, w_in, conv_w, b_i, b_f, mlstm_norm_g, sinks, g_mem, w_mem_kv,
              w_br_swa, w_br_mlstm, w_br_x, w_out, g_ffn, w_ff1, w_ff2, g_final):
    B, T, _ = x.shape
    n_blocks = T // SWA_BLOCK
    band_bias, band_mask = swa_band_bias_and_mask(rel_bias, n_blocks)
    split_at = [int(c) for c in np.cumsum(IN_SIZES)[:-1]]
    for l in range(DEPTH):
        h = rms_norm(x, g_mix[l])
        proj = h @ w_in[l]
        sq, sk, sv, mq, mk, mv, mi, mf, mo, xq, gate_pre = jnp.split(proj, split_at, axis=-1)
        y_swa = swa_attention(sq, sk, sv, sinks[l], band_bias, band_mask)
        y_mlstm = mlstm_branch(mq, mk, mv, mi, mf, mo, conv_w[l], b_i[l], b_f[l], mlstm_norm_g[l])
        mem_kv = rms_norm(mem, g_mem[l]) @ w_mem_kv[l]
        mk_x, mv_x = jnp.split(mem_kv, 2, axis=-1)
        y_x = cross_attention(xq, mk_x, mv_x)
        gates = jax.nn.sigmoid(gate_pre.astype(jnp.float32)).astype(x.dtype).reshape(B, T, N_BRANCH, D_MODEL)
        merged = (gates[:, :, 0] * (y_swa @ w_br_swa[l])
                  + gates[:, :, 1] * (y_mlstm @ w_br_mlstm[l])
                  + gates[:, :, 2] * (y_x @ w_br_x[l]))
        x = x + merged @ w_out[l]
        h = rms_norm(x, g_ffn[l])
        x = x + jnp.square(jax.nn.relu(h @ w_ff1[l])) @ w_ff2[l]
    return rms_norm(x, g_final)
```

```cpp
#include <hip/hip_runtime.h>
#include <cstdio>
#include <cstdint>

namespace {
typedef unsigned short bf16_t;
constexpr int M = 16384, D = 1024, T = 2048, NB = 8, MEMLEN = 256, MM = NB * MEMLEN;
constexpr int INC = 6416, DFF = 4096, NCH = 32, NH = 8;
constexpr float EPS = 1e-6f;
constexpr size_t MiB = 1u << 20;
constexpr size_t WS_ROWSS = 64 * 1024;
constexpr size_t WS_ROWSS_MEM = 384 * 1024;
constexpr size_t WS_G = 400 * 1024, WS_ML = 408 * 1024, WS_MIN = 416 * 1024;
constexpr size_t WS_DN = 512 * 1024;
constexpr size_t WS_WT = 1 * MiB;
constexpr size_t WT_WIN = 0, WT_WMEM = (size_t)INC * D * 2, WT_WBR = WT_WMEM + (size_t)D * D * 2, WT_WOUT = WT_WBR + (size_t)3 * D * 512 * 2,
                 WT_FF1 = WT_WOUT + (size_t)D * D * 2, WT_FF2 = WT_FF1 + (size_t)DFF * D * 2, WT_LAYER = WT_FF2 + (size_t)D * DFF * 2;
constexpr size_t WS_MEMB = 73 * MiB, WS_POOL = 77 * MiB, WS_END = 256 * MiB;
static_assert(WS_WT + 2 * WT_LAYER <= WS_MEMB, "weights fit");

struct P {
    const float *x, *mem, *rel_bias, *g_mix, *w_in, *conv_w, *b_i, *b_f, *norm_g, *sinks, *g_mem, *w_mem_kv, *w_br0, *w_br1, *w_br2, *w_out, *g_ffn, *w_ff1, *w_ff2, *g_final;
    float* out; unsigned char* ws;
};
struct LB {
    bf16_t *xbin, *sq, *mo, *xq, *gates, *skv, *mqk, *mv, *memkv, *merged, *xbmid, *hff, *xbnext;
    float *iff, *state;
    const bf16_t *win, *wmem, *wbr, *wout, *wff1, *wff2;
};
__host__ __device__ inline LB layer_buf(unsigned char* ws, int l) {
    LB b; unsigned char* pool = ws + WS_POOL; const int p = l & 1;
    unsigned char* breg = pool + (p ? 0 : 32 * MiB);
    b.xbin = (bf16_t*)(pool + (p ? 147 * MiB : 0)); b.merged = b.xbin;
    b.xbmid = (bf16_t*)(pool + (p ? 0 : 147 * MiB)); b.xbnext = b.xbmid;
    b.hff = (bf16_t*)(pool + (p ? 32 * MiB : 0));
    b.sq = (bf16_t*)breg; b.mo = (bf16_t*)(breg + 16 * MiB); b.xq = (bf16_t*)(breg + 32 * MiB);
    b.gates = (bf16_t*)(breg + 48 * MiB);
    b.skv = (bf16_t*)(breg + 48 * MiB); b.mqk = (bf16_t*)(breg + 56 * MiB); b.mv = (bf16_t*)(breg + 88 * MiB);
    b.iff = (float*)(breg + 104 * MiB); b.memkv = (bf16_t*)(breg + 105 * MiB); b.state = (float*)(breg + 109 * MiB);
    unsigned char* wt = ws + WS_WT + (size_t)l * WT_LAYER;
    b.win = (const bf16_t*)(wt + WT_WIN); b.wmem = (const bf16_t*)(wt + WT_WMEM); b.wbr = (const bf16_t*)(wt + WT_WBR);
    b.wout = (const bf16_t*)(wt + WT_WOUT); b.wff1 = (const bf16_t*)(wt + WT_FF1); b.wff2 = (const bf16_t*)(wt + WT_FF2);
    return b;
}
__device__ __forceinline__ float* ws_f(unsigned char* ws, size_t off) { return (float*)(ws + off); }

__device__ __forceinline__ float bf2f(bf16_t h) { return __uint_as_float(((unsigned)h) << 16); }
__device__ __forceinline__ bf16_t f2bf(float f) { unsigned u = __float_as_uint(f); u = (u + 0x7fffu + ((u >> 16) & 1u)) >> 16; return (bf16_t)u; }
__device__ __forceinline__ unsigned pk2(float lo, float hi) { return (unsigned)f2bf(lo) | ((unsigned)f2bf(hi) << 16); }
__device__ __forceinline__ float sigmoidf_(float v) { return 1.f / (1.f + expf(-v)); }
__device__ __forceinline__ float wave_sum(float v) {
#pragma unroll
    for (int o = 1; o < 64; o <<= 1) v += __shfl_xor(v, o);
    return v;
}
__device__ __forceinline__ float wave_max(float v) {
#pragma unroll
    for (int o = 1; o < 64; o <<= 1) v = fmaxf(v, __shfl_xor(v, o));
    return v;
}
__device__ const unsigned char T5_BUCKET[128] = {0, 1, 2, 3, 4, 5, 6, 7, 8, 9, 10, 11, 12, 13, 14, 15, 16, 16, 16, 17, 17, 18, 18, 18, 19, 19, 19, 20, 20, 20, 20, 21, 21, 21, 21, 22, 22, 22, 22, 22, 23, 23, 23, 23, 23, 23, 24, 24, 24, 24, 24, 24, 25, 25, 25, 25, 25, 25, 25, 26, 26, 26, 26, 26, 26, 26, 26, 27, 27, 27, 27, 27, 27, 27, 27, 27, 27, 28, 28, 28, 28, 28, 28, 28, 28, 28, 28, 29, 29, 29, 29, 29, 29, 29, 29, 29, 29, 29, 29, 30, 30, 30, 30, 30, 30, 30, 30, 30, 30, 30, 30, 30, 30, 31, 31, 31, 31, 31, 31, 31, 31, 31, 31, 31, 31, 31, 31, 31};

__device__ void convert_tile(const float* src, int ldsrc, int col0, int ncols, int k0, const float* gain, float scale, bf16_t* dst, int K, float* tile) {
    const int tid = threadIdx.x;
#pragma unroll
    for (int j = 0; j < 8; ++j) { const int kk = (tid >> 6) + 8 * j, nn = tid & 63; float v = 0.f;
        if (nn < ncols) v = src[(size_t)(k0 + kk) * ldsrc + col0 + nn] * (gain ? gain[k0 + kk] : 1.f) * scale;
        tile[kk * 65 + nn] = v; }
    __syncthreads();
#pragma unroll
    for (int j = 0; j < 8; ++j) { const int nn = (tid >> 6) + 8 * j, kk = tid & 63; if (nn < ncols) dst[(size_t)nn * K + k0 + kk] = f2bf(tile[kk * 65 + nn]); }
    __syncthreads();
}
__global__ void __launch_bounds__(512) k_convert(const float* src, int ldsrc, int col0, int ncols, const float* gain, float scale, bf16_t* dst, int K) {
    __shared__ float tile[64 * 65];
    const int nb = blockIdx.x, kb = blockIdx.y; const int c0 = nb * 64; const int nc = (ncols - c0) < 64 ? (ncols - c0) : 64;
    convert_tile(src, ldsrc, col0 + c0, nc, kb * 64, gain, scale, dst + (size_t)c0 * K, K, tile);
}

__global__ void __launch_bounds__(512) k_rowstat(const float* src, int rows, bf16_t* xb, float* rowss) {
    const int lane = threadIdx.x & 63, w = (blockIdx.x * 512 + threadIdx.x) >> 6, nw = (gridDim.x * 512) >> 6;
    for (int r = w; r < rows; r += nw) {
        const float4* s4 = (const float4*)(src + (size_t)r * D); float ss = 0.f;
#pragma unroll
        for (int j = 0; j < 4; ++j) { const float4 v = s4[lane + 64 * j]; ss += v.x * v.x + v.y * v.y + v.z * v.z + v.w * v.w;
            if (xb) { uint2 o; o.x = pk2(v.x, v.y); o.y = pk2(v.z, v.w); *(uint2*)(xb + (size_t)r * D + 4 * (lane + 64 * j)) = o; } }
        ss = wave_sum(ss);
        if (lane == 0) rowss[r] = ss;
    }
}
__global__ void __launch_bounds__(512) k_finalnorm(float* x, const float* rowss, const float* g) {
    const int lane = threadIdx.x & 63, w = (blockIdx.x * 512 + threadIdx.x) >> 6, nw = (gridDim.x * 512) >> 6;
    for (int r = w; r < M; r += nw) {
        const float rstd = rsqrtf(rowss[r] * (1.f / D) + EPS);
        float4* s4 = (float4*)(x + (size_t)r * D); const float4* g4 = (const float4*)g;
#pragma unroll
        for (int j = 0; j < 4; ++j) { float4 v = s4[lane + 64 * j]; const float4 gg = g4[lane + 64 * j];
            v.x *= rstd * gg.x; v.y *= rstd * gg.y; v.z *= rstd * gg.z; v.w *= rstd * gg.w; s4[lane + 64 * j] = v; }
    }
}

__device__ __forceinline__ void unpack8(const uint4 a, float (&f)[8]) {
    f[0] = __uint_as_float(a.x << 16); f[1] = __uint_as_float(a.x & 0xffff0000u); f[2] = __uint_as_float(a.y << 16); f[3] = __uint_as_float(a.y & 0xffff0000u);
    f[4] = __uint_as_float(a.z << 16); f[5] = __uint_as_float(a.z & 0xffff0000u); f[6] = __uint_as_float(a.w << 16); f[7] = __uint_as_float(a.w & 0xffff0000u);
}
constexpr int GLD = 132;
__device__ __forceinline__ void gemm_kloop(const bf16_t* A, const bf16_t* Bt, int K, int row0, int col0, float (&acc)[8][4], float* lds) {
    float* As = lds; float* Bs = lds + 32 * GLD;
    const int tid = threadIdx.x, tx = tid & 31, ty = tid >> 5, lr = tid >> 2, lk = (tid & 3) * 8;
    for (int k0 = 0; k0 < K; k0 += 32) {
        const uint4 a = *(const uint4*)(A + (size_t)(row0 + lr) * K + k0 + lk);
        const uint4 b = *(const uint4*)(Bt + (size_t)(col0 + lr) * K + k0 + lk);
        float fa[8], fb[8]; unpack8(a, fa); unpack8(b, fb);
        __syncthreads();
#pragma unroll
        for (int j = 0; j < 8; ++j) { As[(lk + j) * GLD + lr] = fa[j]; Bs[(lk + j) * GLD + lr] = fb[j]; }
        __syncthreads();
#pragma unroll 8
        for (int kk = 0; kk < 32; ++kk) {
            const float4 a0 = *(const float4*)&As[kk * GLD + ty * 8], a1 = *(const float4*)&As[kk * GLD + ty * 8 + 4], b0 = *(const float4*)&Bs[kk * GLD + tx * 4];
            const float av[8] = {a0.x, a0.y, a0.z, a0.w, a1.x, a1.y, a1.z, a1.w}; const float bv[4] = {b0.x, b0.y, b0.z, b0.w};
#pragma unroll
            for (int i = 0; i < 8; ++i)
#pragma unroll
                for (int j = 0; j < 4; ++j) acc[i][j] = fmaf(av[i], bv[j], acc[i][j]);
        }
    }
    __syncthreads();
}

struct EpiProj {
    LB L; const float* rowss;
    __device__ __forceinline__ void st4(bf16_t* dst, float4 v) const { uint2 o; o.x = pk2(v.x, v.y); o.y = pk2(v.z, v.w); *(uint2*)dst = o; }
    __device__ __forceinline__ void operator()(int row, int col, float4 v) const {
        const float rstd = rsqrtf(rowss[row] * (1.f / D) + EPS); v.x *= rstd; v.y *= rstd; v.z *= rstd; v.w *= rstd;
        if (col < 512) st4(L.sq + (size_t)row * 512 + col, v);
        else if (col < 768) st4(L.skv + (size_t)row * 256 + (col - 512), v);
        else if (col < 1792) st4(L.mqk + (size_t)row * 1024 + (col - 768), v);
        else if (col < 2304) st4(L.mv + (size_t)row * 512 + (col - 1792), v);
        else if (col < 2816) { v.x = sigmoidf_(v.x); v.y = sigmoidf_(v.y); v.z = sigmoidf_(v.z); v.w = sigmoidf_(v.w); st4(L.mo + (size_t)row * 512 + (col - 2304), v); }
        else if (col < 3328) st4(L.xq + (size_t)row * 512 + (col - 2816), v);
        else if (col < 6400) { v.x = sigmoidf_(v.x); v.y = sigmoidf_(v.y); v.z = sigmoidf_(v.z); v.w = sigmoidf_(v.w); st4(L.gates + (size_t)row * 3072 + (col - 3328), v); }
        else if (col < 6416) *(float4*)(L.iff + (size_t)row * 16 + (col - 6400)) = v;
    }
};
struct EpiMemKV { bf16_t* dst; const float* rowss;
    __device__ __forceinline__ void operator()(int row, int col, float4 v) const {
        const float rstd = rsqrtf(rowss[row] * (1.f / D) + EPS); uint2 o; o.x = pk2(v.x * rstd, v.y * rstd); o.y = pk2(v.z * rstd, v.w * rstd); *(uint2*)(dst + (size_t)row * 1024 + col) = o; } };
struct EpiResid { const float* xold; float* xnew; bf16_t* xb;
    __device__ __forceinline__ void operator()(int row, int col, float4 v) const {
        const float4 o = *(const float4*)(xold + (size_t)row * D + col); v.x += o.x; v.y += o.y; v.z += o.z; v.w += o.w;
        *(float4*)(xnew + (size_t)row * D + col) = v; uint2 w; w.x = pk2(v.x, v.y); w.y = pk2(v.z, v.w); *(uint2*)(xb + (size_t)row * D + col) = w; } };
struct EpiFF1 { bf16_t* h; const float* rowss;
    __device__ __forceinline__ void operator()(int row, int col, float4 v) const {
        const float rstd = rsqrtf(rowss[row] * (1.f / D) + EPS);
        v.x = fmaxf(v.x * rstd, 0.f); v.y = fmaxf(v.y * rstd, 0.f); v.z = fmaxf(v.z * rstd, 0.f); v.w = fmaxf(v.w * rstd, 0.f);
        uint2 w; w.x = pk2(v.x * v.x, v.y * v.y); w.y = pk2(v.z * v.z, v.w * v.w); *(uint2*)(h + (size_t)row * DFF + col) = w; } };

template <class Epi>
__global__ void __launch_bounds__(512) k_gemm(const bf16_t* A, const bf16_t* Bt, int K, int col_base, Epi epi) {
    __shared__ __attribute__((aligned(16))) float lds[2 * 32 * GLD];
    const int row0 = blockIdx.y * 128, col0 = col_base + blockIdx.x * 128;
    float acc[8][4];
#pragma unroll
    for (int i = 0; i < 8; ++i)
#pragma unroll
        for (int j = 0; j < 4; ++j) acc[i][j] = 0.f;
    gemm_kloop(A, Bt, K, row0, col0, acc, lds);
    const int tx = threadIdx.x & 31, ty = threadIdx.x >> 5;
#pragma unroll
    for (int i = 0; i < 8; ++i) epi(row0 + ty * 8 + i, col0 + tx * 4, make_float4(acc[i][0], acc[i][1], acc[i][2], acc[i][3]));
}
__global__ void __launch_bounds__(512) k_merged(const bf16_t* Y, const bf16_t* wbr, const bf16_t* gates, bf16_t* merged) {
    __shared__ __attribute__((aligned(16))) float lds[2 * 32 * GLD];
    const int row0 = blockIdx.y * 128, col0 = blockIdx.x * 128, tx = threadIdx.x & 31, ty = threadIdx.x >> 5;
    float tot[8][4];
#pragma unroll
    for (int i = 0; i < 8; ++i)
#pragma unroll
        for (int j = 0; j < 4; ++j) tot[i][j] = 0.f;
    for (int s = 0; s < 3; ++s) {
        float acc[8][4];
#pragma unroll
        for (int i = 0; i < 8; ++i)
#pragma unroll
            for (int j = 0; j < 4; ++j) acc[i][j] = 0.f;
        gemm_kloop(Y + (size_t)s * M * 512, wbr + (size_t)s * 1024 * 512, 512, row0, col0, acc, lds);
#pragma unroll
        for (int i = 0; i < 8; ++i) { const bf16_t* gp = gates + (size_t)(row0 + ty * 8 + i) * 3072 + s * 1024 + col0 + tx * 4;
#pragma unroll
            for (int j = 0; j < 4; ++j) tot[i][j] += bf2f(gp[j]) * acc[i][j]; }
    }
#pragma unroll
    for (int i = 0; i < 8; ++i) { uint2 w; w.x = pk2(tot[i][0], tot[i][1]); w.y = pk2(tot[i][2], tot[i][3]); *(uint2*)(merged + (size_t)(row0 + ty * 8 + i) * D + col0 + tx * 4) = w; }
}

__global__ void __launch_bounds__(512) k_swa(P p, int l) {
    const LB L = layer_buf(p.ws, l);
    const int tid = threadIdx.x, hq = tid & 7, row = blockIdx.x * 64 + (tid >> 3), b = row / T, t = row % T, hkv = hq >> 2;
    bf16_t* qp = L.sq + (size_t)row * 512 + hq * 64;
    float q[64], o[64];
#pragma unroll
    for (int c = 0; c < 8; ++c) { float f[8]; unpack8(*(const uint4*)(qp + 8 * c), f);
#pragma unroll
        for (int j = 0; j < 8; ++j) { q[8 * c + j] = f[j]; o[8 * c + j] = 0.f; } }
    float m = -1e30f, lsum = 0.f;
    const int j0 = t - 127 > 0 ? t - 127 : 0;
    for (int j = j0; j <= t; ++j) {
        const bf16_t* kp = L.skv + (size_t)(b * T + j) * 256 + hkv * 64;
        float s = 0.f;
#pragma unroll
        for (int c = 0; c < 8; ++c) { float f[8]; unpack8(*(const uint4*)(kp + 8 * c), f);
#pragma unroll
            for (int jj = 0; jj < 8; ++jj) s = fmaf(q[8 * c + jj], f[jj], s); }
        s += p.rel_bias[(int)T5_BUCKET[t - j] * 8 + hq];
        const float mn = fmaxf(m, s), alpha = expf(m - mn), pj = expf(s - mn);
        lsum = lsum * alpha + pj;
#pragma unroll
        for (int c = 0; c < 8; ++c) { float f[8]; unpack8(*(const uint4*)(kp + 128 + 8 * c), f);
#pragma unroll
            for (int jj = 0; jj < 8; ++jj) o[8 * c + jj] = o[8 * c + jj] * alpha + pj * f[jj]; }
        m = mn;
    }
    const float sink = p.sinks[l * 8 + hq], mf = fmaxf(m, sink), a = expf(m - mf), den = lsum * a + expf(sink - mf), sc = a / den;
#pragma unroll
    for (int c = 0; c < 8; ++c) { uint4 w; w.x = pk2(o[8 * c] * sc, o[8 * c + 1] * sc); w.y = pk2(o[8 * c + 2] * sc, o[8 * c + 3] * sc); w.z = pk2(o[8 * c + 4] * sc, o[8 * c + 5] * sc); w.w = pk2(o[8 * c + 6] * sc, o[8 * c + 7] * sc);
        *(uint4*)(qp + 8 * c) = w; }
}

__global__ void __launch_bounds__(512) k_xattn(P p, int l) {
    __shared__ float pbuf[8][256];
    const LB L = layer_buf(p.ws, l);
    const int lane = threadIdx.x & 63, wv = threadIdx.x >> 6, w = blockIdx.x * 8 + wv, hx = w & 3, row = w >> 2, b = row / T;
    bf16_t* qp = L.xq + (size_t)row * 512 + hx * 128;
    const bf16_t* kbase = L.memkv + (size_t)(b * MEMLEN) * 1024 + hx * 128;
    float s[4] = {0.f, 0.f, 0.f, 0.f};
    for (int c = 0; c < 16; ++c) { float qf[8]; unpack8(*(const uint4*)(qp + 8 * c), qf);
#pragma unroll
        for (int i = 0; i < 4; ++i) { float kf[8]; unpack8(*(const uint4*)(kbase + (size_t)(lane + 64 * i) * 1024 + 8 * c), kf);
#pragma unroll
            for (int j = 0; j < 8; ++j) s[i] = fmaf(qf[j], kf[j], s[i]); } }
    float mx = fmaxf(fmaxf(s[0], s[1]), fmaxf(s[2], s[3])); mx = wave_max(mx);
    float pe[4], ls = 0.f;
#pragma unroll
    for (int i = 0; i < 4; ++i) { pe[i] = expf(s[i] - mx); ls += pe[i]; }
    ls = wave_sum(ls); const float inv = 1.f / ls;
#pragma unroll
    for (int i = 0; i < 4; ++i) pbuf[wv][lane + 64 * i] = pe[i] * inv;
    __syncthreads();
    float o0 = 0.f, o1 = 0.f;
    for (int k = 0; k < 256; ++k) { const unsigned vv = *(const unsigned*)(kbase + (size_t)k * 1024 + 512 + 2 * lane); const float pk = pbuf[wv][k];
        o0 = fmaf(pk, __uint_as_float(vv << 16), o0); o1 = fmaf(pk, __uint_as_float(vv & 0xffff0000u), o1); }
    *(unsigned*)(qp + 2 * lane) = pk2(o0, o1);
}

__device__ __forceinline__ float conv_silu(const bf16_t* mqk, const float* cw, int b, int t, int ch) {
    float acc = 0.f;
#pragma unroll
    for (int j = 0; j < 4; ++j) { const int tt = t - 3 + j; if (tt >= 0) acc = fmaf(cw[j * 1024 + ch], bf2f(mqk[(size_t)(b * T + tt) * 1024 + ch]), acc); }
    return acc / (1.f + expf(-acc));
}
__device__ __forceinline__ void mlstm_gates(const P& p, const LB& L, int l, int b, int c, int h, float* sB, float* sI) {
    const int tid = threadIdx.x;
    if (tid < 64) { const size_t row = (size_t)b * T + c * 64 + tid; const float ip = L.iff[row * 16 + h] + p.b_i[l * 8 + h], fp = L.iff[row * 16 + 8 + h] + p.b_f[l * 8 + h];
        sB[tid] = fp >= 0.f ? -log1pf(expf(-fp)) : fp - log1pf(expf(fp)); sI[tid] = ip; }
    __syncthreads();
    if (tid == 0) { float a = 0.f; for (int s = 0; s < 64; ++s) { a += sB[s]; sB[s] = a; } }
    __syncthreads();
}
__global__ void __launch_bounds__(512) k_mlstm_A(P p, int l) {
    extern __shared__ __attribute__((aligned(16))) float lds[];
    const LB L = layer_buf(p.ws, l);
    const int u = blockIdx.x, tid = threadIdx.x, h = u & 7, c = (u >> 3) & 31, b = u >> 8;
    float *sK = lds, *sV = lds + 64 * 65, *sB = sV + 64 * 65, *sI = sB + 64, *sW = sI + 64;
    const float* cw = p.conv_w + (size_t)l * 4 * 1024;
    mlstm_gates(p, L, l, b, c, h, sB, sI);
    for (int e = tid; e < 4096; e += 512) { const int s = e >> 6, d = e & 63;
        sK[s * 65 + d] = conv_silu(L.mqk, cw, b, c * 64 + s, 512 + h * 64 + d) * 0.125f;
        sV[s * 65 + d] = bf2f(L.mv[(size_t)(b * T + c * 64 + s) * 512 + h * 64 + d]); }
    const float g = sB[63];
    if (tid < 64) sW[tid] = g - sB[tid] + sI[tid];
    __syncthreads();
    float ml = -1e30f; for (int s = 0; s < 64; ++s) ml = fmaxf(ml, sW[s]);
    __syncthreads();
    if (tid < 64) sW[tid] = expf(sW[tid] - ml);
    __syncthreads();
    const int dk = tid >> 3, dv0 = (tid & 7) * 8;
    float acc[8] = {0.f, 0.f, 0.f, 0.f, 0.f, 0.f, 0.f, 0.f};
    for (int s = 0; s < 64; ++s) { const float wk = sW[s] * sK[s * 65 + dk];
#pragma unroll
        for (int j = 0; j < 8; ++j) acc[j] = fmaf(wk, sV[s * 65 + dv0 + j], acc[j]); }
    float* st = L.state + (size_t)u * 4096 + dk * 64 + dv0;
#pragma unroll
    for (int j = 0; j < 8; ++j) st[j] = acc[j];
    if (tid < 64) { float a = 0.f; for (int s = 0; s < 64; ++s) a = fmaf(sW[s], sK[s * 65 + tid], a); ws_f(p.ws, WS_DN)[(size_t)u * 64 + tid] = a; }
    if (tid == 0) { ws_f(p.ws, WS_G)[u] = g; ws_f(p.ws, WS_ML)[u] = ml; }
}
__global__ void __launch_bounds__(512) k_mlstm_scan(P p, int l) {
    const LB L = layer_buf(p.ws, l);
    const int u = blockIdx.x, tid = threadIdx.x, bh = u >> 3, b = bh >> 3, h = bh & 7, e = (u & 7) * 512 + tid;
    const bool first = (u & 7) == 0; const bool do_n = first && tid < 64;
    float m = 0.f, C = 0.f, n = 0.f;
    float *G = ws_f(p.ws, WS_G), *ML = ws_f(p.ws, WS_ML), *MIN = ws_f(p.ws, WS_MIN), *DN = ws_f(p.ws, WS_DN);
    for (int c = 0; c < NCH; ++c) { const int idx = (b * NCH + c) * 8 + h; const float g = G[idx], ml = ML[idx], mn = fmaxf(g + m, ml), a = expf(g + m - mn), s = expf(ml - mn);
        float* sp = L.state + (size_t)idx * 4096 + e; const float d = *sp; *sp = C; C = a * C + s * d;
        if (do_n) { float* np_ = DN + (size_t)idx * 64 + tid; const float dn = *np_; *np_ = n; n = a * n + s * dn; }
        if (first && tid == 0) MIN[idx] = m;
        m = mn; }
}
__global__ void __launch_bounds__(512) k_mlstm_C(P p, int l) {
    extern __shared__ __attribute__((aligned(16))) float lds[];
    const LB L = layer_buf(p.ws, l);
    const int u = blockIdx.x, tid = threadIdx.x, h = u & 7, c = (u >> 3) & 31, b = u >> 8;
    float *sQ = lds, *sK = sQ + 64 * 65, *sV = sK + 64 * 65, *sC = sV + 64 * 65, *sS = sC + 64 * 65, *sH = sS + 64 * 65, *sB = sH + 64 * 65, *sI = sB + 64, *sMt = sI + 64, *sIw = sMt + 64, *sDen = sIw + 64, *sN = sDen + 64;
    const float* cw = p.conv_w + (size_t)l * 4 * 1024;
    mlstm_gates(p, L, l, b, c, h, sB, sI);
    const float m_in = ws_f(p.ws, WS_MIN)[u];
    for (int e = tid; e < 4096; e += 512) { const int s = e >> 6, d = e & 63;
        sQ[s * 65 + d] = conv_silu(L.mqk, cw, b, c * 64 + s, h * 64 + d);
        sK[s * 65 + d] = conv_silu(L.mqk, cw, b, c * 64 + s, 512 + h * 64 + d) * 0.125f;
        sV[s * 65 + d] = bf2f(L.mv[(size_t)(b * T + c * 64 + s) * 512 + h * 64 + d]);
        sC[s * 65 + d] = L.state[(size_t)u * 4096 + e]; }
    if (tid < 64) sN[tid] = ws_f(p.ws, WS_DN)[(size_t)u * 64 + tid];
    __syncthreads();
    if (tid < 64) { const int t = tid; const float bt = sB[t]; float mx = -1e30f; for (int s = 0; s <= t; ++s) mx = fmaxf(mx, bt - sB[s] + sI[s]);
        const float il = bt + m_in, mt = fmaxf(mx, il); sMt[t] = mt; sIw[t] = expf(il - mt); }
    __syncthreads();
    for (int e = tid; e < 4096; e += 512) { const int t = e >> 6, s = e & 63; float v = 0.f;
        if (s <= t) { float dot = 0.f; for (int d = 0; d < 64; ++d) dot = fmaf(sQ[t * 65 + d], sK[s * 65 + d], dot); v = dot * expf(sB[t] - sB[s] + sI[s] - sMt[t]); }
        sS[t * 65 + s] = v; }
    __syncthreads();
    if (tid < 64) { const int t = tid; float d = 0.f; for (int s = 0; s < 64; ++s) d += sS[t * 65 + s]; float qn = 0.f; for (int k = 0; k < 64; ++k) qn = fmaf(sQ[t * 65 + k], sN[k], qn); sDen[t] = d + sIw[t] * qn; }
    __syncthreads();
    for (int e = tid; e < 4096; e += 512) { const int t = e >> 6, dv = e & 63; float num = 0.f, qc = 0.f;
        for (int s = 0; s < 64; ++s) num = fmaf(sS[t * 65 + s], sV[s * 65 + dv], num);
        for (int k = 0; k < 64; ++k) qc = fmaf(sQ[t * 65 + k], sC[k * 65 + dv], qc);
        num += sIw[t] * qc; const float dn = fmaxf(fabsf(sDen[t]), expf(-sMt[t])); sH[t * 65 + dv] = num / dn; }
    __syncthreads();
    if (tid < 64) { const int t = tid; float mu = 0.f; for (int d = 0; d < 64; ++d) mu += sH[t * 65 + d]; mu *= (1.f / 64.f); float var = 0.f; for (int d = 0; d < 64; ++d) { const float x = sH[t * 65 + d] - mu; var += x * x; }
        var *= (1.f / 64.f); sMt[t] = mu; sIw[t] = rsqrtf(var + EPS); }
    __syncthreads();
    for (int e = tid; e < 4096; e += 512) { const int t = e >> 6, dv = e & 63; const size_t idx = (size_t)(b * T + c * 64 + t) * 512 + h * 64 + dv;
        const float y = (sH[t * 65 + dv] - sMt[t]) * sIw[t] * p.norm_g[l * 512 + h * 64 + dv] * bf2f(L.mo[idx]); L.mo[idx] = f2bf(y); }
}
}

extern "C" void kernel_launch(void* const* d_in, const int* in_sizes, int n_in, void* d_out, int out_size, void* d_ws, size_t ws_size, hipStream_t stream) {
    if (n_in != 20 || out_size != M * D || ws_size < WS_END) { fprintf(stderr, "kernel_launch: unexpected shapes (n_in %d out %d ws %zu)\n", n_in, out_size, ws_size); return; }
    P p{};
    const float** pf = (const float**)&p;
    for (int i = 0; i < 20; ++i) pf[i] = (const float*)d_in[i];
    p.out = (float*)d_out; p.ws = (unsigned char*)d_ws;
    unsigned char* ws = p.ws;
    static bool attr = false;
    if (!attr) { hipFuncSetAttribute((const void*)k_mlstm_C, hipFuncAttributeMaxDynamicSharedMemorySize, 110 * 1024); attr = true; }
    float* rowss = (float*)(ws + WS_ROWSS); float* rowss_mem = (float*)(ws + WS_ROWSS_MEM);
    for (int l = 0; l < 2; ++l) {
        const LB L = layer_buf(ws, l);
        const float* win = p.w_in + (size_t)l * D * INC; const float* gm = p.g_mix + l * D;
        struct Seg { int src, n, dst; float sc; } segs[6] = {{0, 512, 0, 0.125f}, {512, 1792, 512, 1.f}, {2320, 512, 2304, 1.f}, {2832, 512, 2816, 0.08838834764831845f}, {3344, 3072, 3328, 1.f}, {2304, 16, 6400, 1.f}};
        for (int s = 0; s < 6; ++s) k_convert<<<dim3((segs[s].n + 63) / 64, D / 64), 512, 0, stream>>>(win, INC, segs[s].src, segs[s].n, gm, segs[s].sc, (bf16_t*)L.win + (size_t)segs[s].dst * D, D);
        k_convert<<<dim3(1024 / 64, D / 64), 512, 0, stream>>>(p.w_mem_kv + (size_t)l * D * 1024, 1024, 0, 1024, p.g_mem + l * D, 1.f, (bf16_t*)L.wmem, D);
        const float* wbr[3] = {p.w_br0, p.w_br1, p.w_br2};
        for (int s = 0; s < 3; ++s) k_convert<<<dim3(1024 / 64, 512 / 64), 512, 0, stream>>>(wbr[s] + (size_t)l * 512 * 1024, 1024, 0, 1024, nullptr, 1.f, (bf16_t*)L.wbr + (size_t)s * 1024 * 512, 512);
        k_convert<<<dim3(1024 / 64, D / 64), 512, 0, stream>>>(p.w_out + (size_t)l * D * D, 1024, 0, 1024, nullptr, 1.f, (bf16_t*)L.wout, D);
        k_convert<<<dim3(DFF / 64, D / 64), 512, 0, stream>>>(p.w_ff1 + (size_t)l * D * DFF, DFF, 0, DFF, p.g_ffn + l * D, 1.f, (bf16_t*)L.wff1, D);
        k_convert<<<dim3(D / 64, DFF / 64), 512, 0, stream>>>(p.w_ff2 + (size_t)l * DFF * D, D, 0, D, nullptr, 1.f, (bf16_t*)L.wff2, DFF);
    }
    bf16_t* memb = (bf16_t*)(ws + WS_MEMB);
    k_rowstat<<<512, 512, 0, stream>>>(p.x, M, layer_buf(ws, 0).xbin, rowss);
    k_rowstat<<<64, 512, 0, stream>>>(p.mem, MM, memb, rowss_mem);
    for (int l = 0; l < 2; ++l) {
        const LB L = layer_buf(ws, l);
        const float* xold = l == 0 ? p.x : p.out;
        EpiProj ep{L, rowss + (size_t)(2 * l) * M};
        k_gemm<EpiProj><<<dim3(3328 / 128, M / 128), 512, 0, stream>>>(L.xbin, L.win, D, 0, ep);
        k_gemm<EpiProj><<<dim3(1, M / 128), 512, 0, stream>>>(L.xbin, L.win, D, 6400, ep);
        EpiMemKV em{L.memkv, rowss_mem};
        k_gemm<EpiMemKV><<<dim3(1024 / 128, MM / 128), 512, 0, stream>>>(memb, L.wmem, D, 0, em);
        k_swa<<<M / 64, 512, 0, stream>>>(p, l);
        k_xattn<<<M * 4 / 8, 512, 0, stream>>>(p, l);
        k_mlstm_A<<<NB * NCH * NH, 512, (2 * 64 * 65 + 256) * 4, stream>>>(p, l);
        k_mlstm_scan<<<512, 512, 0, stream>>>(p, l);
        k_mlstm_C<<<NB * NCH * NH, 512, (6 * 64 * 65 + 6 * 64) * 4, stream>>>(p, l);
        k_gemm<EpiProj><<<dim3(3072 / 128, M / 128), 512, 0, stream>>>(L.xbin, L.win, D, 3328, ep);
        k_merged<<<dim3(D / 128, M / 128), 512, 0, stream>>>(L.sq, L.wbr, L.gates, L.merged);
        EpiResid er1{xold, p.out, L.xbmid};
        k_gemm<EpiResid><<<dim3(D / 128, M / 128), 512, 0, stream>>>(L.merged, L.wout, D, 0, er1);
        k_rowstat<<<512, 512, 0, stream>>>(p.out, M, nullptr, rowss + (size_t)(2 * l + 1) * M);
        EpiFF1 ef{L.hff, rowss + (size_t)(2 * l + 1) * M};
        k_gemm<EpiFF1><<<dim3(DFF / 128, M / 128), 512, 0, stream>>>(L.xbmid, L.wff1, D, 0, ef);
        EpiResid er2{p.out, p.out, L.xbnext};
        k_gemm<EpiResid><<<dim3(D / 128, M / 128), 512, 0, stream>>>(L.hff, L.wff2, DFF, 0, er2);
        k_rowstat<<<512, 512, 0, stream>>>(p.out, M, nullptr, rowss + (size_t)(2 * l + 2) * M);
    }
    k_finalnorm<<<512, 512, 0, stream>>>(p.out, rowss + (size_t)4 * M, p.g_final);
}
```

```cpp
#include <hip/hip_runtime.h>
#include <cstdio>
#include <cstdint>

namespace pg8 {
#define PG8_LAS __attribute__((address_space(3)))
typedef unsigned short bf16_t;
typedef short bf16x8 __attribute__((ext_vector_type(8)));
typedef float f32x4 __attribute__((ext_vector_type(4)));
typedef unsigned u32x4 __attribute__((ext_vector_type(4)));
constexpr int BM = 256, BK = 64, HALF = 128, HTB = HALF * BK * 2  , STAGE_BYTES = 8 * HTB, NXCD = 8, WGM = 8;

__host__ __device__ __forceinline__ int lds_byte(int r, int c) { const int st = (r >> 4) * 2 + (c >> 5), rr = r & 15, cc = c & 31, ob = rr * 64 + cc * 2; return st * 1024 + (ob ^ (((ob >> 9) & 1) << 5)); }
__host__ __device__ __forceinline__ void stage_rc(int b, int& R, int& C) { const int st = b / 1024, sb = b % 1024, swz = sb ^ (((sb >> 9) & 1) << 5); R = (st >> 1) * 16 + swz / 64; C = (st & 1) * 32 + (swz % 64) / 2; }
__host__ __device__ __forceinline__ int perm32(int rho) { const int n = rho >> 4, i = rho & 15; return 8 * (i >> 2) + 4 * n + (i & 3); }
struct Unit { int pm, pn, rm, kind; };
struct Gemm { const bf16_t* A; const bf16_t* Bt; int M, N, K; };
__device__ __forceinline__ unsigned cvt_pk_bf16(float lo, float hi) { unsigned r; asm volatile("v_cvt_pk_bf16_f32 %0, %1, %2" : "=v"(r) : "v"(lo), "v"(hi)); return r; }
template <class Epi, class Sched, bool ALIGN_EPI = false, bool SP2 = false>
__device__ __forceinline__ void gemm_phase(PG8_LAS unsigned char* lds, const Gemm g, const Sched& S, const Epi& E) {
    int tid_l = threadIdx.x; asm volatile("" : "+v"(tid_l));
    const int tid = tid_l, wid = __builtin_amdgcn_readfirstlane(tid >> 6), lane = tid & 63, wr = wid >> 2, wc = wid & 3, fr = lane & 15, fq = lane >> 4;
    const int K = g.K, nt = K / BK;
    unsigned voffA[2], voffB[2];
#pragma unroll
    for (int i = 0; i < 2; ++i) { int R, C; stage_rc(tid * 16 + i * 8192, R, C); const int Rb = Epi::PERM ? ((R & ~31) + perm32(R & 31)) : R;
        voffA[i] = (unsigned)(R * K + C) * 2u; voffB[i] = (unsigned)(Rb * K + C) * 2u; }
    const size_t kstep = (size_t)(BK * 2);
    const size_t hstep = (size_t)HALF * K * 2;
    const size_t tstep = 2 * hstep;
    const unsigned ldsw = (unsigned)wid * 1024u;
    const int aoff = lds_byte(wr * 64 + fr, fq * 8), boff = lds_byte(wc * 32 + fr, fq * 8);
#define PG8_SA(b, h) (((b) * 2 + (h)) * HTB)
#define PG8_SB(b, h) ((4 + (b) * 2 + (h)) * HTB)
#define PG8_STAGE(bufoff, gbase, voff) do { _Pragma("unroll") for (int _i = 0; _i < 2; ++_i) \
        __builtin_amdgcn_global_load_lds((const unsigned*)((const char*)(gbase) + (voff)[_i]), (PG8_LAS unsigned*)(lds + (bufoff) + ldsw + _i * 8192), 16, 0, 0); } while (0)
#define PG8_LDA(dst, b, h) do { _Pragma("unroll") for (int m = 0; m < 4; ++m) _Pragma("unroll") for (int k = 0; k < 2; ++k) dst[m][k] = *(const PG8_LAS bf16x8*)(lds + PG8_SA(b, h) + aoff + m * 2048 + k * 1024); } while (0)
#define PG8_LDB(dst, b, h) do { _Pragma("unroll") for (int n = 0; n < 2; ++n) _Pragma("unroll") for (int k = 0; k < 2; ++k) dst[n][k] = *(const PG8_LAS bf16x8*)(lds + PG8_SB(b, h) + boff + n * 2048 + k * 1024); } while (0)
#define PG8_MMA(ai, bj, At, Bt) do { __builtin_amdgcn_s_setprio(1); _Pragma("unroll") for (int m = 0; m < 4; ++m) _Pragma("unroll") for (int n = 0; n < 2; ++n) _Pragma("unroll") for (int k = 0; k < 2; ++k) \
        acc[ai][bj][m][n] = __builtin_amdgcn_mfma_f32_16x16x32_bf16(Bt[n][k], At[m][k], acc[ai][bj][m][n], 0, 0, 0); __builtin_amdgcn_s_setprio(0); } while (0)
#define PG8_WAIT_V(n) asm volatile("s_waitcnt vmcnt(" #n ")" ::: "memory")
#define PG8_WAIT_L(n) asm volatile("s_waitcnt lgkmcnt(" #n ")" ::: "memory")
#define PG8_BAR __builtin_amdgcn_s_barrier()
#define PG8_SCHED __builtin_amdgcn_sched_barrier(0)
    Unit cur, nxt; int ui = 0;
    if (!S.next(0, cur)) return;
    f32x4 acc[2][2][4][2];
#pragma unroll
    for (int a = 0; a < 2; ++a)
#pragma unroll
        for (int b = 0; b < 2; ++b)
#pragma unroll
            for (int m = 0; m < 4; ++m)
#pragma unroll
                for (int n = 0; n < 2; ++n) acc[a][b][m][n] = (f32x4){0.f, 0.f, 0.f, 0.f};
    bf16x8 At[4][2], B0[2][2], B1[2][2];
    const char* cA = (const char*)g.A + (size_t)cur.pm * tstep; const char* cB = (const char*)g.Bt + (size_t)cur.pn * tstep;
    S.a_ready(cur);
    if constexpr (SP2) {
        PG8_STAGE(PG8_SB(0, 0), cB, voffB); PG8_STAGE(PG8_SB(0, 1), cB + hstep, voffB); PG8_STAGE(PG8_SA(0, 0), cA, voffA); PG8_STAGE(PG8_SA(0, 1), cA + hstep, voffA);
        if (wr == 1) PG8_BAR;
        PG8_WAIT_V(2); PG8_BAR;
        PG8_STAGE(PG8_SB(1, 0), cB + kstep, voffB); PG8_STAGE(PG8_SA(1, 0), cA + kstep, voffA); PG8_STAGE(PG8_SB(1, 1), cB + hstep + kstep, voffB);
        PG8_WAIT_V(6); PG8_BAR;
    } else {
        PG8_STAGE(PG8_SB(0, 0), cB, voffB); PG8_STAGE(PG8_SA(0, 0), cA, voffA); PG8_STAGE(PG8_SB(0, 1), cB + hstep, voffB); PG8_STAGE(PG8_SA(0, 1), cA + hstep, voffA);
        if (wr == 1) PG8_BAR;
        PG8_WAIT_V(4); PG8_BAR;
        PG8_STAGE(PG8_SB(1, 0), cB + kstep, voffB); PG8_STAGE(PG8_SA(1, 0), cA + kstep, voffA); PG8_STAGE(PG8_SB(1, 1), cB + hstep + kstep, voffB);
        PG8_WAIT_V(6); PG8_BAR;
    }
    for (;;) {
        const bool has_next = S.next(ui + 1, nxt);
        const char* nA = has_next ? (const char*)g.A + (size_t)nxt.pm * tstep : cA; const char* nB = has_next ? (const char*)g.Bt + (size_t)nxt.pn * tstep : cB;
        for (int t = 0; t < nt; t += 2) {
            const bool last = (t == nt - 2);
            const char* a1 = cA + (size_t)(t + 1) * kstep;
            const char* a2 = last ? nA : cA + (size_t)(t + 2) * kstep; const char* b2 = last ? nB : cB + (size_t)(t + 2) * kstep;
            const char* a3 = a2 + kstep; const char* b3 = b2 + kstep;
            if (last && has_next) S.a_ready(nxt);
            if constexpr (SP2) {
            PG8_LDB(B0, 0, 0); PG8_LDB(B1, 0, 1); PG8_SCHED; PG8_LDA(At, 0, 0); PG8_STAGE(PG8_SA(1, 1), a1 + hstep, voffA);
            PG8_WAIT_V(8); PG8_WAIT_L(0); PG8_BAR; PG8_MMA(0, 0, At, B0); PG8_MMA(0, 1, At, B1); PG8_BAR; PG8_SCHED;
            PG8_LDA(At, 0, 1); PG8_STAGE(PG8_SB(0, 0), b2, voffB); PG8_STAGE(PG8_SB(0, 1), b2 + hstep, voffB); PG8_STAGE(PG8_SA(0, 0), a2, voffA);
            PG8_WAIT_V(8); PG8_WAIT_L(0); PG8_BAR; PG8_MMA(1, 0, At, B0); PG8_MMA(1, 1, At, B1); PG8_BAR; PG8_SCHED;
            PG8_LDB(B0, 1, 0); PG8_LDB(B1, 1, 1); PG8_SCHED; PG8_LDA(At, 1, 0); PG8_STAGE(PG8_SA(0, 1), a2 + hstep, voffA);
            PG8_WAIT_V(8); PG8_WAIT_L(0); PG8_BAR; PG8_MMA(0, 0, At, B0); PG8_MMA(0, 1, At, B1); PG8_BAR; PG8_SCHED;
            PG8_LDA(At, 1, 1); PG8_STAGE(PG8_SB(1, 0), b3, voffB); PG8_STAGE(PG8_SB(1, 1), b3 + hstep, voffB); PG8_STAGE(PG8_SA(1, 0), a3, voffA);
            PG8_WAIT_V(8); PG8_WAIT_L(0); PG8_BAR; PG8_MMA(1, 0, At, B0); PG8_MMA(1, 1, At, B1); PG8_BAR; PG8_SCHED;
            } else {
            PG8_LDB(B0, 0, 0); PG8_SCHED; PG8_LDA(At, 0, 0); PG8_STAGE(PG8_SA(1, 1), a1 + hstep, voffA);
            PG8_WAIT_L(8); PG8_BAR; PG8_WAIT_L(0); PG8_MMA(0, 0, At, B0); PG8_BAR; PG8_SCHED;
            PG8_LDB(B1, 0, 1); PG8_STAGE(PG8_SB(0, 0), b2, voffB);
            PG8_BAR; PG8_WAIT_L(0); PG8_MMA(0, 1, At, B1); PG8_BAR;
            PG8_LDA(At, 0, 1); PG8_STAGE(PG8_SA(0, 0), a2, voffA);
            PG8_BAR; PG8_WAIT_L(0); PG8_MMA(1, 0, At, B0); PG8_BAR; PG8_SCHED;
            PG8_STAGE(PG8_SB(0, 1), b2 + hstep, voffB);
            PG8_WAIT_V(6); PG8_BAR; PG8_MMA(1, 1, At, B1); PG8_BAR;
            PG8_LDB(B0, 1, 0); PG8_SCHED; PG8_LDA(At, 1, 0); PG8_STAGE(PG8_SA(0, 1), a2 + hstep, voffA);
            PG8_WAIT_L(8); PG8_BAR; PG8_WAIT_L(0); PG8_MMA(0, 0, At, B0); PG8_BAR; PG8_SCHED;
            PG8_LDB(B1, 1, 1); PG8_STAGE(PG8_SB(1, 0), b3, voffB);
            PG8_BAR; PG8_WAIT_L(0); PG8_MMA(0, 1, At, B1); PG8_BAR;
            PG8_LDA(At, 1, 1); PG8_STAGE(PG8_SA(1, 0), a3, voffA);
            PG8_BAR; PG8_WAIT_L(0); PG8_MMA(1, 0, At, B0); PG8_BAR; PG8_SCHED;
            PG8_STAGE(PG8_SB(1, 1), b3 + hstep, voffB);
            PG8_WAIT_V(6); PG8_BAR; PG8_MMA(1, 1, At, B1); PG8_BAR;
            }
        }
        if constexpr (ALIGN_EPI) { if (wr == 0) PG8_BAR; }
        if constexpr (!Epi::AFTER_DRAIN) { E(acc, cur, wr, wc, fr, fq); S.done(cur); }
        const bool keep_acc = E.keep(cur);
        if (!has_next) break;
        if (!keep_acc) {
#pragma unroll
        for (int a = 0; a < 2; ++a)
#pragma unroll
            for (int b = 0; b < 2; ++b)
#pragma unroll
                for (int m = 0; m < 4; ++m)
#pragma unroll
                    for (int n = 0; n < 2; ++n) acc[a][b][m][n] = (f32x4){0.f, 0.f, 0.f, 0.f};
        }
        cur = nxt; cA = nA; cB = nB; ++ui;
        if constexpr (ALIGN_EPI) { if (wr == 1) PG8_BAR; }
    }
    PG8_WAIT_V(0);
    if constexpr (!ALIGN_EPI) { if (wr == 0) PG8_BAR; }
    PG8_BAR;
    if constexpr (Epi::AFTER_DRAIN) { E.fused(acc, cur, wr, wc, fr, fq, lds, wid, lane); S.done(cur); }
#undef PG8_SA
#undef PG8_SB
#undef PG8_STAGE
#undef PG8_LDA
#undef PG8_LDB
#undef PG8_MMA
#undef PG8_WAIT_V
#undef PG8_WAIT_L
#undef PG8_BAR
#undef PG8_SCHED
}
}

namespace {
using pg8::bf16_t; using pg8::f32x4; using pg8::u32x4; using pg8::Unit;
#define LAS __attribute__((address_space(3)))
constexpr int M = 16384, D = 1024, T = 2048, NB = 8, MEMLEN = 256, MM = NB * MEMLEN;
constexpr int INC = 6416, DFF = 4096, NCH = 32, NH = 8;
constexpr float EPS = 1e-6f;
constexpr size_t MiB = 1u << 20;
constexpr size_t WS_BAR = 0;
constexpr size_t WS_ROWSS = 64 * 1024;
constexpr size_t WS_ZERO_BYTES = 384 * 1024;
constexpr size_t WS_ROWSS_MEM = 384 * 1024;
constexpr size_t WS_G = 400 * 1024, WS_ML = 408 * 1024, WS_MIN = 416 * 1024;
constexpr size_t WS_DN = 512 * 1024;
constexpr size_t WS_WT = 1 * MiB;
constexpr size_t WT_WIN = 0, WT_WMEM = (size_t)6656 * D * 2, WT_WBR = WT_WMEM + (size_t)D * D * 2, WT_WOUT = WT_WBR + (size_t)3 * D * 512 * 2,
                 WT_FF1 = WT_WOUT + (size_t)D * D * 2, WT_FF2 = WT_FF1 + (size_t)DFF * D * 2, WT_LAYER = WT_FF2 + (size_t)D * DFF * 2;
constexpr size_t WS_MEMB = 73 * MiB, WS_POOL = 77 * MiB, WS_END = 256 * MiB;
static_assert(WS_WT + 2 * WT_LAYER <= WS_MEMB, "weights fit");
constexpr int LDS_RING = 131072, LDS_BYTES = 147456;

struct P {
    const float *x, *mem, *rel_bias, *g_mix, *w_in, *conv_w, *b_i, *b_f, *norm_g, *sinks, *g_mem, *w_mem_kv, *w_br0, *w_br1, *w_br2, *w_out, *g_ffn, *w_ff1, *w_ff2, *g_final;
    float* out; unsigned char* ws;
};
struct LB {
    bf16_t *xbin, *sq, *mo, *xq, *gates, *skv, *mqk, *mv, *memkv, *merged, *xbmid, *hff, *xbnext;
    float *iff, *state;
    const bf16_t *win, *wmem, *wbr, *wout, *wff1, *wff2;
};
__host__ __device__ inline LB layer_buf(unsigned char* ws, int l) {
    LB b; unsigned char* pool = ws + WS_POOL; const int p = l & 1;
    unsigned char* breg = pool + (p ? 0 : 32 * MiB);
    b.xbin = (bf16_t*)(pool + (p ? 147 * MiB : 0)); b.merged = b.xbin;
    b.xbmid = (bf16_t*)(pool + (p ? 0 : 147 * MiB)); b.xbnext = b.xbmid;
    b.hff = (bf16_t*)(pool + (p ? 32 * MiB : 0));
    b.sq = (bf16_t*)breg; b.mo = (bf16_t*)(breg + 16 * MiB); b.xq = (bf16_t*)(breg + 32 * MiB);
    b.gates = (bf16_t*)(breg + 48 * MiB);
    b.skv = (bf16_t*)(breg + 48 * MiB); b.mqk = (bf16_t*)(breg + 56 * MiB); b.mv = (bf16_t*)(breg + 88 * MiB);
    b.iff = (float*)(breg + 104 * MiB); b.memkv = (bf16_t*)(breg + 105 * MiB); b.state = (float*)(breg + 109 * MiB);
    unsigned char* wt = ws + WS_WT + (size_t)l * WT_LAYER;
    b.win = (const bf16_t*)(wt + WT_WIN); b.wmem = (const bf16_t*)(wt + WT_WMEM); b.wbr = (const bf16_t*)(wt + WT_WBR);
    b.wout = (const bf16_t*)(wt + WT_WOUT); b.wff1 = (const bf16_t*)(wt + WT_FF1); b.wff2 = (const bf16_t*)(wt + WT_FF2);
    return b;
}
__device__ __forceinline__ float* ws_f(unsigned char* ws, size_t off) { return (float*)(ws + off); }

__device__ __forceinline__ float bf2f(bf16_t h) { return __uint_as_float(((unsigned)h) << 16); }
__device__ __forceinline__ bf16_t f2bf(float f) { unsigned u = __float_as_uint(f); u = (u + 0x7fffu + ((u >> 16) & 1u)) >> 16; return (bf16_t)u; }
__device__ __forceinline__ unsigned pk2(float lo, float hi) { return (unsigned)f2bf(lo) | ((unsigned)f2bf(hi) << 16); }
__device__ __forceinline__ float sigmoidf_(float v) { return 1.f / (1.f + expf(-v)); }
__device__ __forceinline__ float fsigmoid(float v) { return __builtin_amdgcn_rcpf(1.f + __expf(-v)); }
__device__ __forceinline__ float wave_sum(float v) {
#pragma unroll
    for (int o = 1; o < 64; o <<= 1) v += __shfl_xor(v, o);
    return v;
}
__device__ __forceinline__ float wave_max(float v) {
#pragma unroll
    for (int o = 1; o < 64; o <<= 1) v = fmaxf(v, __shfl_xor(v, o));
    return v;
}
__device__ __forceinline__ void unpack8(const uint4 a, float (&f)[8]) {
    f[0] = __uint_as_float(a.x << 16); f[1] = __uint_as_float(a.x & 0xffff0000u); f[2] = __uint_as_float(a.y << 16); f[3] = __uint_as_float(a.y & 0xffff0000u);
    f[4] = __uint_as_float(a.z << 16); f[5] = __uint_as_float(a.z & 0xffff0000u); f[6] = __uint_as_float(a.w << 16); f[7] = __uint_as_float(a.w & 0xffff0000u);
}
__device__ const unsigned char T5_BUCKET[128] = {0, 1, 2, 3, 4, 5, 6, 7, 8, 9, 10, 11, 12, 13, 14, 15, 16, 16, 16, 17, 17, 18, 18, 18, 19, 19, 19, 20, 20, 20, 20, 21, 21, 21, 21, 22, 22, 22, 22, 22, 23, 23, 23, 23, 23, 23, 24, 24, 24, 24, 24, 24, 25, 25, 25, 25, 25, 25, 25, 26, 26, 26, 26, 26, 26, 26, 26, 27, 27, 27, 27, 27, 27, 27, 27, 27, 27, 28, 28, 28, 28, 28, 28, 28, 28, 28, 28, 29, 29, 29, 29, 29, 29, 29, 29, 29, 29, 29, 29, 30, 30, 30, 30, 30, 30, 30, 30, 30, 30, 30, 30, 30, 30, 31, 31, 31, 31, 31, 31, 31, 31, 31, 31, 31, 31, 31, 31, 31};

struct SchedRounds {
    int G, c, nfull, pn_base, tail, memA;
    __device__ __forceinline__ bool next(int i, Unit& u) const {
        const int L = i * G + c;
        if (L < nfull * 256) { const int r = L >> 8, w = L & 255, x = w & 7, j = w >> 3; u.pm = u.rm = 8 * x + (j & 7); u.pn = pn_base + 4 * r + (j >> 3); u.kind = 0; return true; }
        if (!tail) return false;
        const int t = L - nfull * 256;
        if (t < 64) { u.pm = u.rm = t; u.pn = 12; u.kind = 0; return true; }
        if (t < 128) { u.pm = u.rm = t - 64; u.pn = 25; u.kind = 0; return true; }
        if (t < 160) { const int q = t - 128; u.rm = q >> 2; u.pm = memA + (q >> 2); u.pn = 26 + (q & 3); u.kind = 1; return true; }
        return false;
    }
    __device__ __forceinline__ void a_ready(const Unit&) const {}
    __device__ __forceinline__ void done(const Unit&) const {}
};
struct SchedMerged {
    int G, c;
    __device__ __forceinline__ bool next(int i, Unit& u) const {
        const int tt = (i / 3) * G + c, seg = i % 3; if (tt >= 256) return false;
        const int x = tt & 7, j = tt >> 3; u.rm = 8 * x + (j & 7); u.pm = seg * 64 + u.rm; u.pn = seg * 4 + (j >> 3); u.kind = seg; return true;
    }
    __device__ __forceinline__ void a_ready(const Unit&) const {}
    __device__ __forceinline__ void done(const Unit&) const {}
};

__device__ __forceinline__ u32x4 pack8(f32x4 a, f32x4 b) { u32x4 w; w.x = pg8::cvt_pk_bf16(a[0], a[1]); w.y = pg8::cvt_pk_bf16(a[2], a[3]); w.z = pg8::cvt_pk_bf16(b[0], b[1]); w.w = pg8::cvt_pk_bf16(b[2], b[3]); return w; }
__device__ __forceinline__ f32x4 sig4(f32x4 v) { f32x4 r; r[0] = fsigmoid(v[0]); r[1] = fsigmoid(v[1]); r[2] = fsigmoid(v[2]); r[3] = fsigmoid(v[3]); return r; }
struct EpiProjMK {
    static constexpr bool PERM = true, AFTER_DRAIN = false;
    LB L; const float* rowss; const float* rowss_mem;
    __device__ __forceinline__ bool keep(const Unit&) const { return false; }
    __device__ __forceinline__ void operator()(f32x4 (&acc)[2][2][4][2], const Unit& u, int wr, int wc, int fr, int fq) const {
        const int rbase = u.rm * 256 + wr * 64 + fr, cin = wc * 32 + 8 * fq;
        const float* rs = rowss; bf16_t* dst; int ld, coff; bool sig = false; const int tile = u.pn;
        if (u.kind == 1) { rs = rowss_mem; dst = L.memkv; ld = 1024; coff = (tile - 26) * 256; }
        else if (tile < 2) { dst = L.sq; ld = 512; coff = tile * 256; }
        else if (tile < 3) { dst = L.skv; ld = 256; coff = 0; }
        else if (tile < 7) { dst = L.mqk; ld = 1024; coff = (tile - 3) * 256; }
        else if (tile < 9) { dst = L.mv; ld = 512; coff = (tile - 7) * 256; }
        else if (tile < 11) { dst = L.mo; ld = 512; coff = (tile - 9) * 256; sig = true; }
        else if (tile < 13) { dst = L.xq; ld = 512; coff = (tile - 11) * 256; }
        else if (tile < 25) { dst = L.gates; ld = 3072; coff = (tile - 13) * 256; sig = true; }
        else { dst = nullptr; ld = 0; coff = 0; }
#pragma unroll
        for (int ai = 0; ai < 2; ++ai)
#pragma unroll
            for (int m = 0; m < 4; ++m) {
                const int row = rbase + ai * 128 + m * 16; const float rstd = rsqrtf(rs[row] * (1.f / D) + EPS);
#pragma unroll
                for (int bj = 0; bj < 2; ++bj) {
                    f32x4 v0 = acc[ai][bj][m][0] * rstd, v1 = acc[ai][bj][m][1] * rstd;
                    if (dst) { if (sig) { v0 = sig4(v0); v1 = sig4(v1); }
                        *(u32x4*)(dst + (size_t)row * ld + coff + bj * 128 + cin) = pack8(v0, v1); }
                    else if (bj == 0 && cin < 16) { *(f32x4*)(L.iff + (size_t)row * 16 + cin) = v0; *(f32x4*)(L.iff + (size_t)row * 16 + cin + 4) = v1; }
                }
            }
    }
};
struct EpiMergedMK {
    static constexpr bool PERM = true, AFTER_DRAIN = false;
    const bf16_t* gates; bf16_t* merged;
    __device__ __forceinline__ bool keep(const Unit& u) const { return u.kind < 2; }
    __device__ __forceinline__ void operator()(f32x4 (&acc)[2][2][4][2], const Unit& u, int wr, int wc, int fr, int fq) const {
        const int rbase = u.rm * 256 + wr * 64 + fr, col0 = (u.pn & 3) * 256 + wc * 32 + 8 * fq, seg = u.kind;
#pragma unroll
        for (int ai = 0; ai < 2; ++ai)
#pragma unroll
            for (int m = 0; m < 4; ++m) {
                const int row = rbase + ai * 128 + m * 16;
#pragma unroll
                for (int bj = 0; bj < 2; ++bj) {
                    const int col = col0 + bj * 128;
                    float g[8]; unpack8(*(const uint4*)(gates + (size_t)row * 3072 + seg * 1024 + col), g);
                    if (seg < 2) { float gn[8]; unpack8(*(const uint4*)(gates + (size_t)row * 3072 + (seg + 1) * 1024 + col), gn);
#pragma unroll
                        for (int j = 0; j < 8; ++j) g[j] = g[j] * __builtin_amdgcn_rcpf(fmaxf(gn[j], 1e-30f)); }
                    f32x4 v0 = acc[ai][bj][m][0], v1 = acc[ai][bj][m][1];
                    v0[0] *= g[0]; v0[1] *= g[1]; v0[2] *= g[2]; v0[3] *= g[3]; v1[0] *= g[4]; v1[1] *= g[5]; v1[2] *= g[6]; v1[3] *= g[7];
                    acc[ai][bj][m][0] = v0; acc[ai][bj][m][1] = v1;
                    if (seg == 2) *(u32x4*)(merged + (size_t)row * D + col) = pack8(v0, v1);
                }
            }
    }
};
struct EpiResidMK {
    static constexpr bool PERM = false, AFTER_DRAIN = false;
    const float* xold; float* xnew; bf16_t* xb; float* rowss;
    __device__ __forceinline__ bool keep(const Unit&) const { return false; }
    __device__ __forceinline__ void operator()(f32x4 (&acc)[2][2][4][2], const Unit& u, int wr, int wc, int fr, int fq) const {
        const int rbase = u.rm * 256 + wr * 64 + fr, col0 = u.pn * 256 + wc * 32 + 4 * fq;
#pragma unroll
        for (int ai = 0; ai < 2; ++ai)
#pragma unroll
            for (int m = 0; m < 4; ++m) {
                const int row = rbase + ai * 128 + m * 16; const size_t off = (size_t)row * D + col0; float ss = 0.f;
#pragma unroll
                for (int bj = 0; bj < 2; ++bj)
#pragma unroll
                    for (int n = 0; n < 2; ++n) {
                        const f32x4 o = *(const f32x4*)(xold + off + bj * 128 + n * 16); const f32x4 v = acc[ai][bj][m][n] + o;
                        *(f32x4*)(xnew + off + bj * 128 + n * 16) = v;
                        uint2 w; w.x = pg8::cvt_pk_bf16(v[0], v[1]); w.y = pg8::cvt_pk_bf16(v[2], v[3]); *(uint2*)(xb + off + bj * 128 + n * 16) = w;
                        ss += (v[0] * v[0] + v[1] * v[1]) + (v[2] * v[2] + v[3] * v[3]);
                    }
                ss += __shfl_xor(ss, 16); ss += __shfl_xor(ss, 32);
                if (fq == 0) atomicAdd(rowss + row, ss);
                asm volatile("" ::: "memory");
            }
    }
};
struct EpiFF1MK {
    static constexpr bool PERM = true, AFTER_DRAIN = false;
    bf16_t* h; const float* rowss;
    __device__ __forceinline__ bool keep(const Unit&) const { return false; }
    __device__ __forceinline__ void operator()(f32x4 (&acc)[2][2][4][2], const Unit& u, int wr, int wc, int fr, int fq) const {
        const int rbase = u.rm * 256 + wr * 64 + fr, col0 = u.pn * 256 + wc * 32 + 8 * fq;
#pragma unroll
        for (int ai = 0; ai < 2; ++ai)
#pragma unroll
            for (int m = 0; m < 4; ++m) {
                const int row = rbase + ai * 128 + m * 16; const float rstd = rsqrtf(rowss[row] * (1.f / D) + EPS);
#pragma unroll
                for (int bj = 0; bj < 2; ++bj) {
                    f32x4 v0 = acc[ai][bj][m][0] * rstd, v1 = acc[ai][bj][m][1] * rstd;
#pragma unroll
                    for (int j = 0; j < 4; ++j) { v0[j] = fmaxf(v0[j], 0.f); v0[j] *= v0[j]; v1[j] = fmaxf(v1[j], 0.f); v1[j] *= v1[j]; }
                    *(u32x4*)(h + (size_t)row * DFF + col0 + bj * 128) = pack8(v0, v1);
                }
            }
    }
};

__device__ __forceinline__ void convert_tile(const float* src, int ldsrc, int col0, int ncols, int k0, const float* gain, float scale, bf16_t* dst, int K, float* tile) {
    int tid_l = threadIdx.x; asm volatile("" : "+v"(tid_l)); const int tid = tid_l;
#pragma unroll
    for (int j = 0; j < 8; ++j) { const int kk = (tid >> 6) + 8 * j, nn = tid & 63; float v = 0.f;
        if (nn < ncols) v = src[(size_t)(k0 + kk) * ldsrc + col0 + nn] * (gain ? gain[k0 + kk] : 1.f) * scale;
        tile[kk * 65 + nn] = v; }
    __syncthreads();
#pragma unroll
    for (int j = 0; j < 8; ++j) { const int nn = (tid >> 6) + 8 * j, kk = tid & 63; if (nn < ncols) dst[(size_t)nn * K + k0 + kk] = f2bf(tile[kk * 65 + nn]); }
    __syncthreads();
}
constexpr int CV_NJOB = 13, CV_ITEMS_LAYER = 4560;
__device__ __forceinline__ void convert_item(const P& p, int item, float* tile) {
    const int l = item / CV_ITEMS_LAYER; int r = item % CV_ITEMS_LAYER;
    unsigned char* wt = p.ws + WS_WT + (size_t)l * WT_LAYER;
    const float* src; const float* gain = nullptr; int ld, col0, ncols, K; float sc = 1.f; bf16_t* dst;
    if (r < 1616) {
        const float* win = p.w_in + (size_t)l * D * INC; src = win; ld = INC; K = D; gain = p.g_mix + l * D; int dr;
        if (r < 128) { col0 = 0; ncols = 512; dr = 0; sc = 0.125f; }
        else if ((r -= 128) < 448) { col0 = 512; ncols = 1792; dr = 512; }
        else if ((r -= 448) < 128) { col0 = 2320; ncols = 512; dr = 2304; }
        else if ((r -= 128) < 128) { col0 = 2832; ncols = 512; dr = 2816; sc = 0.08838834764831845f; }
        else if ((r -= 128) < 768) { col0 = 3344; ncols = 3072; dr = 3328; }
        else { r -= 768; col0 = 2304; ncols = 16; dr = 6400; }
        dst = (bf16_t*)(wt + WT_WIN) + (size_t)dr * D;
    } else if ((r -= 1616) < 256) { src = p.w_mem_kv + (size_t)l * D * 1024; ld = 1024; col0 = 0; ncols = 1024; K = D; gain = p.g_mem + l * D; dst = (bf16_t*)(wt + WT_WMEM); }
    else if ((r -= 256) < 384) { const int s = r / 128; r -= s * 128; src = (s == 0 ? p.w_br0 : s == 1 ? p.w_br1 : p.w_br2) + (size_t)l * 512 * 1024; ld = 1024; col0 = 0; ncols = 1024; K = 512; dst = (bf16_t*)(wt + WT_WBR) + (size_t)s * 1024 * 512; }
    else if ((r -= 384) < 256) { src = p.w_out + (size_t)l * D * D; ld = 1024; col0 = 0; ncols = 1024; K = D; dst = (bf16_t*)(wt + WT_WOUT); }
    else if ((r -= 256) < 1024) { src = p.w_ff1 + (size_t)l * D * DFF; ld = DFF; col0 = 0; ncols = DFF; K = D; gain = p.g_ffn + l * D; dst = (bf16_t*)(wt + WT_FF1); }
    else { r -= 1024; src = p.w_ff2 + (size_t)l * DFF * D; ld = D; col0 = 0; ncols = D; K = DFF; dst = (bf16_t*)(wt + WT_FF2); }
    const int nkb = K / 64, nb = r / nkb, kb = r % nkb, c0 = nb * 64, nc = (ncols - c0) < 64 ? (ncols - c0) : 64;
    convert_tile(src, ld, col0 + c0, nc, kb * 64, gain, sc, dst + (size_t)c0 * K, K, tile);
}
__device__ __forceinline__ void rowstat_rows(const float* src, int rows, bf16_t* xb, float* rowss, int gw, int ngw, int lane) {
    for (int r = gw; r < rows; r += ngw) {
        const float4* s4 = (const float4*)(src + (size_t)r * D); float ss = 0.f;
#pragma unroll
        for (int j = 0; j < 4; ++j) { const float4 v = s4[lane + 64 * j]; ss += v.x * v.x + v.y * v.y + v.z * v.z + v.w * v.w;
            uint2 o; o.x = pk2(v.x, v.y); o.y = pk2(v.z, v.w); *(uint2*)(xb + (size_t)r * D + 4 * (lane + 64 * j)) = o; }
        ss = wave_sum(ss);
        if (lane == 0) rowss[r] = ss;
    }
}
__device__ __forceinline__ void finalnorm_rows(float* x, const float* rowss, const float* g, int gw, int ngw, int lane) {
    for (int r = gw; r < M; r += ngw) {
        const float rstd = rsqrtf(rowss[r] * (1.f / D) + EPS);
        float4* s4 = (float4*)(x + (size_t)r * D); const float4* g4 = (const float4*)g;
#pragma unroll
        for (int j = 0; j < 4; ++j) { float4 v = s4[lane + 64 * j]; const float4 gg = g4[lane + 64 * j];
            v.x *= rstd * gg.x; v.y *= rstd * gg.y; v.z *= rstd * gg.z; v.w *= rstd * gg.w; s4[lane + 64 * j] = v; }
    }
}

__device__ __forceinline__ void swa_unit(const P& p, const LB& L, int l, int u) {
    int tid_l = threadIdx.x; asm volatile("" : "+v"(tid_l)); const int tid = tid_l, hq = tid & 7, row = u * 64 + (tid >> 3), b = row / T, t = row % T, hkv = hq >> 2;
    bf16_t* qp = L.sq + (size_t)row * 512 + hq * 64;
    float q[64], o[64];
#pragma unroll
    for (int c = 0; c < 8; ++c) { float f[8]; unpack8(*(const uint4*)(qp + 8 * c), f);
#pragma unroll
        for (int j = 0; j < 8; ++j) { q[8 * c + j] = f[j]; o[8 * c + j] = 0.f; } }
    float m = -1e30f, lsum = 0.f;
    const int j0 = t - 127 > 0 ? t - 127 : 0;
    for (int j = j0; j <= t; ++j) {
        const bf16_t* kp = L.skv + (size_t)(b * T + j) * 256 + hkv * 64;
        float s = 0.f;
#pragma unroll
        for (int c = 0; c < 8; ++c) { float f[8]; unpack8(*(const uint4*)(kp + 8 * c), f);
#pragma unroll
            for (int jj = 0; jj < 8; ++jj) s = fmaf(q[8 * c + jj], f[jj], s); }
        s += p.rel_bias[(int)T5_BUCKET[t - j] * 8 + hq];
        const float mn = fmaxf(m, s), alpha = expf(m - mn), pj = expf(s - mn);
        lsum = lsum * alpha + pj;
#pragma unroll
        for (int c = 0; c < 8; ++c) { float f[8]; unpack8(*(const uint4*)(kp + 128 + 8 * c), f);
#pragma unroll
            for (int jj = 0; jj < 8; ++jj) o[8 * c + jj] = o[8 * c + jj] * alpha + pj * f[jj]; }
        m = mn;
    }
    const float sink = p.sinks[l * 8 + hq], mf = fmaxf(m, sink), a = expf(m - mf), den = lsum * a + expf(sink - mf), sc = a / den;
#pragma unroll
    for (int c = 0; c < 8; ++c) { uint4 w; w.x = pk2(o[8 * c] * sc, o[8 * c + 1] * sc); w.y = pk2(o[8 * c + 2] * sc, o[8 * c + 3] * sc); w.z = pk2(o[8 * c + 4] * sc, o[8 * c + 5] * sc); w.w = pk2(o[8 * c + 6] * sc, o[8 * c + 7] * sc);
        *(uint4*)(qp + 8 * c) = w; }
}
__device__ __forceinline__ void xattn_unit(const LB& L, int u, float* pbuf  ) {
    int tid_l = threadIdx.x; asm volatile("" : "+v"(tid_l)); const int lane = tid_l & 63, wv = tid_l >> 6, w = u * 8 + wv, hx = w & 3, row = w >> 2, b = row / T;
    bf16_t* qp = L.xq + (size_t)row * 512 + hx * 128;
    const bf16_t* kbase = L.memkv + (size_t)(b * MEMLEN) * 1024 + hx * 128;
    float s[4] = {0.f, 0.f, 0.f, 0.f};
    for (int c = 0; c < 16; ++c) { float qf[8]; unpack8(*(const uint4*)(qp + 8 * c), qf);
#pragma unroll
        for (int i = 0; i < 4; ++i) { float kf[8]; unpack8(*(const uint4*)(kbase + (size_t)(lane + 64 * i) * 1024 + 8 * c), kf);
#pragma unroll
            for (int j = 0; j < 8; ++j) s[i] = fmaf(qf[j], kf[j], s[i]); } }
    float mx = fmaxf(fmaxf(s[0], s[1]), fmaxf(s[2], s[3])); mx = wave_max(mx);
    float pe[4], ls = 0.f;
#pragma unroll
    for (int i = 0; i < 4; ++i) { pe[i] = expf(s[i] - mx); ls += pe[i]; }
    ls = wave_sum(ls); const float inv = 1.f / ls;
    __syncthreads();
#pragma unroll
    for (int i = 0; i < 4; ++i) pbuf[wv * 256 + lane + 64 * i] = pe[i] * inv;
    __syncthreads();
    float o0 = 0.f, o1 = 0.f;
    for (int k = 0; k < 256; ++k) { const unsigned vv = *(const unsigned*)(kbase + (size_t)k * 1024 + 512 + 2 * lane); const float pk = pbuf[wv * 256 + k];
        o0 = fmaf(pk, __uint_as_float(vv << 16), o0); o1 = fmaf(pk, __uint_as_float(vv & 0xffff0000u), o1); }
    *(unsigned*)(qp + 2 * lane) = pk2(o0, o1);
}
__device__ __forceinline__ float conv_silu(const bf16_t* mqk, const float* cw, int b, int t, int ch) {
    float acc = 0.f;
#pragma unroll
    for (int j = 0; j < 4; ++j) { const int tt = t - 3 + j; if (tt >= 0) acc = fmaf(cw[j * 1024 + ch], bf2f(mqk[(size_t)(b * T + tt) * 1024 + ch]), acc); }
    return acc / (1.f + expf(-acc));
}
__device__ __forceinline__ void mlstm_gates(const P& p, const LB& L, int l, int b, int c, int h, float* sB, float* sI) {
    int tid_l = threadIdx.x; asm volatile("" : "+v"(tid_l)); const int tid = tid_l;
    __syncthreads();
    if (tid < 64) { const size_t row = (size_t)b * T + c * 64 + tid; const float ip = L.iff[row * 16 + h] + p.b_i[l * 8 + h], fp = L.iff[row * 16 + 8 + h] + p.b_f[l * 8 + h];
        sB[tid] = fp >= 0.f ? -log1pf(expf(-fp)) : fp - log1pf(expf(fp)); sI[tid] = ip; }
    __syncthreads();
    if (tid == 0) { float a = 0.f; for (int s = 0; s < 64; ++s) { a += sB[s]; sB[s] = a; } }
    __syncthreads();
}
__device__ __forceinline__ void mlstm_A_unit(const P& p, const LB& L, int l, int u, float* lds) {
    int tid_l = threadIdx.x; asm volatile("" : "+v"(tid_l)); const int tid = tid_l, h = u & 7, c = (u >> 3) & 31, b = u >> 8;
    float *sK = lds, *sV = lds + 64 * 65, *sB = sV + 64 * 65, *sI = sB + 64, *sW = sI + 64;
    const float* cw = p.conv_w + (size_t)l * 4 * 1024;
    mlstm_gates(p, L, l, b, c, h, sB, sI);
    for (int e = tid; e < 4096; e += 512) { const int s = e >> 6, d = e & 63;
        sK[s * 65 + d] = conv_silu(L.mqk, cw, b, c * 64 + s, 512 + h * 64 + d) * 0.125f;
        sV[s * 65 + d] = bf2f(L.mv[(size_t)(b * T + c * 64 + s) * 512 + h * 64 + d]); }
    const float g = sB[63];
    if (tid < 64) sW[tid] = g - sB[tid] + sI[tid];
    __syncthreads();
    float ml = -1e30f; for (int s = 0; s < 64; ++s) ml = fmaxf(ml, sW[s]);
    __syncthreads();
    if (tid < 64) sW[tid] = expf(sW[tid] - ml);
    __syncthreads();
    const int dk = tid >> 3, dv0 = (tid & 7) * 8;
    float acc[8] = {0.f, 0.f, 0.f, 0.f, 0.f, 0.f, 0.f, 0.f};
    for (int s = 0; s < 64; ++s) { const float wk = sW[s] * sK[s * 65 + dk];
#pragma unroll
        for (int j = 0; j < 8; ++j) acc[j] = fmaf(wk, sV[s * 65 + dv0 + j], acc[j]); }
    float* st = L.state + (size_t)u * 4096 + dk * 64 + dv0;
#pragma unroll
    for (int j = 0; j < 8; ++j) st[j] = acc[j];
    if (tid < 64) { float a = 0.f; for (int s = 0; s < 64; ++s) a = fmaf(sW[s], sK[s * 65 + tid], a); ws_f(p.ws, WS_DN)[(size_t)u * 64 + tid] = a; }
    if (tid == 0) { ws_f(p.ws, WS_G)[u] = g; ws_f(p.ws, WS_ML)[u] = ml; }
}
__device__ __forceinline__ void mlstm_scan_unit(const P& p, const LB& L, int u) {
    int tid_l = threadIdx.x; asm volatile("" : "+v"(tid_l)); const int tid = tid_l, bh = u >> 3, b = bh >> 3, h = bh & 7, e = (u & 7) * 512 + tid;
    const bool first = (u & 7) == 0; const bool do_n = first && tid < 64;
    float m = 0.f, C = 0.f, n = 0.f;
    float *G = ws_f(p.ws, WS_G), *ML = ws_f(p.ws, WS_ML), *MIN = ws_f(p.ws, WS_MIN), *DN = ws_f(p.ws, WS_DN);
    for (int c = 0; c < NCH; ++c) { const int idx = (b * NCH + c) * 8 + h; const float g = G[idx], ml = ML[idx], mn = fmaxf(g + m, ml), a = expf(g + m - mn), s = expf(ml - mn);
        float* sp = L.state + (size_t)idx * 4096 + e; const float d = *sp; *sp = C; C = a * C + s * d;
        if (do_n) { float* np_ = DN + (size_t)idx * 64 + tid; const float dn = *np_; *np_ = n; n = a * n + s * dn; }
        if (first && tid == 0) MIN[idx] = m;
        m = mn; }
}
__device__ __forceinline__ void mlstm_C_unit(const P& p, const LB& L, int l, int u, float* lds) {
    int tid_l = threadIdx.x; asm volatile("" : "+v"(tid_l)); const int tid = tid_l, h = u & 7, c = (u >> 3) & 31, b = u >> 8;
    float *sQ = lds, *sK = sQ + 64 * 65, *sV = sK + 64 * 65, *sC = sV + 64 * 65, *sS = sC + 64 * 65, *sH = sS + 64 * 65, *sB = sH + 64 * 65, *sI = sB + 64, *sMt = sI + 64, *sIw = sMt + 64, *sDen = sIw + 64, *sN = sDen + 64;
    const float* cw = p.conv_w + (size_t)l * 4 * 1024;
    mlstm_gates(p, L, l, b, c, h, sB, sI);
    const float m_in = ws_f(p.ws, WS_MIN)[u];
    for (int e = tid; e < 4096; e += 512) { const int s = e >> 6, d = e & 63;
        sQ[s * 65 + d] = conv_silu(L.mqk, cw, b, c * 64 + s, h * 64 + d);
        sK[s * 65 + d] = conv_silu(L.mqk, cw, b, c * 64 + s, 512 + h * 64 + d) * 0.125f;
        sV[s * 65 + d] = bf2f(L.mv[(size_t)(b * T + c * 64 + s) * 512 + h * 64 + d]);
        sC[s * 65 + d] = L.state[(size_t)u * 4096 + e]; }
    if (tid < 64) sN[tid] = ws_f(p.ws, WS_DN)[(size_t)u * 64 + tid];
    __syncthreads();
    if (tid < 64) { const int t = tid; const float bt = sB[t]; float mx = -1e30f; for (int s = 0; s <= t; ++s) mx = fmaxf(mx, bt - sB[s] + sI[s]);
        const float il = bt + m_in, mt = fmaxf(mx, il); sMt[t] = mt; sIw[t] = expf(il - mt); }
    __syncthreads();
    for (int e = tid; e < 4096; e += 512) { const int t = e >> 6, s = e & 63; float v = 0.f;
        if (s <= t) { float dot = 0.f; for (int d = 0; d < 64; ++d) dot = fmaf(sQ[t * 65 + d], sK[s * 65 + d], dot); v = dot * expf(sB[t] - sB[s] + sI[s] - sMt[t]); }
        sS[t * 65 + s] = v; }
    __syncthreads();
    if (tid < 64) { const int t = tid; float d = 0.f; for (int s = 0; s < 64; ++s) d += sS[t * 65 + s]; float qn = 0.f; for (int k = 0; k < 64; ++k) qn = fmaf(sQ[t * 65 + k], sN[k], qn); sDen[t] = d + sIw[t] * qn; }
    __syncthreads();
    for (int e = tid; e < 4096; e += 512) { const int t = e >> 6, dv = e & 63; float num = 0.f, qc = 0.f;
        for (int s = 0; s < 64; ++s) num = fmaf(sS[t * 65 + s], sV[s * 65 + dv], num);
        for (int k = 0; k < 64; ++k) qc = fmaf(sQ[t * 65 + k], sC[k * 65 + dv], qc);
        num += sIw[t] * qc; const float dn = fmaxf(fabsf(sDen[t]), expf(-sMt[t])); sH[t * 65 + dv] = num / dn; }
    __syncthreads();
    if (tid < 64) { const int t = tid; float mu = 0.f; for (int d = 0; d < 64; ++d) mu += sH[t * 65 + d]; mu *= (1.f / 64.f); float var = 0.f; for (int d = 0; d < 64; ++d) { const float x = sH[t * 65 + d] - mu; var += x * x; }
        var *= (1.f / 64.f); sMt[t] = mu; sIw[t] = rsqrtf(var + EPS); }
    __syncthreads();
    for (int e = tid; e < 4096; e += 512) { const int t = e >> 6, dv = e & 63; const size_t idx = (size_t)(b * T + c * 64 + t) * 512 + h * 64 + dv;
        const float y = (sH[t * 65 + dv] - sMt[t]) * sIw[t] * p.norm_g[l * 512 + h * 64 + dv] * bf2f(L.mo[idx]); L.mo[idx] = f2bf(y); }
}

#define XB_TMO      128
#define XB_XCNT(j)  (256  + 64 * (j))
#define XB_XSUB(j)  (1280 + 64 * (j))
#define XB_XGEN(j)  (2304 + 64 * (j))
#define XB_TOP      3328
#define XB_TOPGEN   3392
#define XCD_BAR_WORDS 3456
#define XB_SPIN_CAP (1u << 18)

__device__ __forceinline__ unsigned xb_ld(unsigned* p)              { return __hip_atomic_load(p, __ATOMIC_RELAXED, __HIP_MEMORY_SCOPE_AGENT); }
__device__ __forceinline__ unsigned xb_add(unsigned* p, unsigned v) { return __hip_atomic_fetch_add(p, v, __ATOMIC_RELAXED, __HIP_MEMORY_SCOPE_AGENT); }
__device__ __forceinline__ unsigned xb_xcc_id() { return (unsigned)__builtin_amdgcn_s_getreg((3 << 11) | 20) & 0xFu; }
#define XB_SPIN(cond, bar) do { unsigned _sp = 0; while (cond) { __builtin_amdgcn_s_sleep(1); \
    if ((++_sp & 255u) == 0u) { if (xb_ld(&(bar)[XB_TMO])) break; if (_sp > XB_SPIN_CAP) { atomicAdd(&(bar)[XB_TMO], 1u); break; } } } } while (0)

struct XcdBarrier {
    unsigned* bar; unsigned x;
    volatile LAS unsigned* st;
};

__device__ __forceinline__ XcdBarrier xcd_barrier_post(unsigned* bar, volatile LAS unsigned* st) {
    XcdBarrier b; b.bar = bar; b.x = xb_xcc_id(); b.st = st;
    if (threadIdx.x == 0) (void)xb_add(&bar[XB_XCNT(b.x)], 1u);
    return b;
}
__device__ __forceinline__ void xcd_barrier_complete(unsigned* bar, unsigned x, unsigned& nloc, unsigned& nx) {
    const unsigned G = gridDim.x * gridDim.y * gridDim.z;
    unsigned sum, cnt, mine, sp = 0u;
    for (;;) {
        sum = 0u; cnt = 0u; mine = 0u;
#pragma unroll
        for (unsigned j = 0; j < 16; ++j) { const unsigned c = xb_ld(&bar[XB_XCNT(j)]); sum += c; cnt += (c > 0u) ? 1u : 0u; mine = (j == x) ? c : mine; }
        if (sum == G) break;
        __builtin_amdgcn_s_sleep(1);
        if ((++sp & 255u) == 0u) { if (xb_ld(&bar[XB_TMO])) break; if (sp > XB_SPIN_CAP) { atomicAdd(&bar[XB_TMO], 1u); break; } }
    }
    nloc = mine > 0u ? mine : 1u; nx = cnt > 0u ? cnt : 1u;
}

__device__ __forceinline__ void xcd_barrier(const XcdBarrier& b) {
    asm volatile("s_waitcnt vmcnt(0)" ::: "memory");
    __syncthreads();
    if (threadIdx.x == 0) {
        unsigned* bar = b.bar;
        __builtin_amdgcn_s_waitcnt(0);
        unsigned nloc = b.st[0], nx = b.st[1];
        if (nloc == 0u) { xcd_barrier_complete(bar, b.x, nloc, nx); b.st[0] = nloc; b.st[1] = nx; }
        const unsigned old = xb_add(&bar[XB_XSUB(b.x)], 1u);
        const unsigned gen = old / nloc;
        if (old + 1u == (gen + 1u) * nloc) {
            __builtin_amdgcn_fence(__ATOMIC_RELEASE, "agent");
            asm volatile("s_waitcnt vmcnt(0)" ::: "memory");
            const unsigned og = xb_add(&bar[XB_TOP], 1u);
            const unsigned tg = og / nx;
            if (og + 1u == (tg + 1u) * nx) xb_add(&bar[XB_TOPGEN], 1u);
            else XB_SPIN(xb_ld(&bar[XB_TOPGEN]) == tg, bar);
            __builtin_amdgcn_fence(__ATOMIC_ACQUIRE, "agent");
            xb_add(&bar[XB_XGEN(b.x)], 1u);
            asm volatile("s_waitcnt vmcnt(0)" ::: "memory");
        } else {
            XB_SPIN(xb_ld(&bar[XB_XGEN(b.x)]) == gen, bar);
            __builtin_amdgcn_fence(__ATOMIC_ACQUIRE, "agent");
            asm volatile("s_waitcnt vmcnt(0)" ::: "memory");
        }
    }
    __syncthreads();
}

__global__ void __launch_bounds__(512, 2) mk_fwd(P p) {
    extern __shared__ __attribute__((aligned(16))) unsigned char lds[];
    LAS unsigned char* l3 = (LAS unsigned char*)lds;
    float* fl = (float*)lds;
    const int G = gridDim.x, bx = blockIdx.x;
    if (threadIdx.x < 64) ((LAS unsigned*)(l3 + LDS_RING))[threadIdx.x] = 0u;
    __syncthreads();
    (void)xcd_barrier_post((unsigned*)(p.ws + WS_BAR), (volatile LAS unsigned*)(l3 + LDS_RING + 32));
#define GRID_BAR() do { XcdBarrier b_; b_.bar = (unsigned*)(p.ws + WS_BAR); b_.x = xb_xcc_id(); b_.st = (volatile LAS unsigned*)(l3 + LDS_RING + 32); xcd_barrier(b_); } while (0)
#define WAVE_IDS() int tid_w = threadIdx.x; asm volatile("" : "+v"(tid_w)); const int lane = tid_w & 63, gw = bx * 8 + (tid_w >> 6), ngw = G * 8

    {
        for (int it = bx; it < 2 * CV_ITEMS_LAYER; it += G) convert_item(p, it, fl);
        WAVE_IDS();
        rowstat_rows(p.x, M, layer_buf(p.ws, 0).xbin, ws_f(p.ws, WS_ROWSS), gw, ngw, lane);
        rowstat_rows(p.mem, MM, (bf16_t*)(p.ws + WS_MEMB), ws_f(p.ws, WS_ROWSS_MEM), gw, ngw, lane);
    }
    GRID_BAR();

#pragma unroll 1
    for (int l = 0; l < 2; ++l) {
        {
            const LB L = layer_buf(p.ws, l);
            pg8::Gemm g{L.xbin, L.win, M, 6656, D};
            const int memA = (int)(((long long)(p.ws + WS_MEMB) - (long long)L.xbin) / (long long)(256 * D * 2));
            SchedRounds S{G, bx, 3, 0, 1, memA};
            EpiProjMK E{L, ws_f(p.ws, WS_ROWSS) + (size_t)(2 * l) * M, ws_f(p.ws, WS_ROWSS_MEM)};
            pg8::gemm_phase<EpiProjMK, SchedRounds, true, true>(l3, g, S, E);
        }
        GRID_BAR();
        {
            const LB L = layer_buf(p.ws, l);
            for (int u = bx; u < M / 64; u += G) swa_unit(p, L, l, u);
            for (int u = bx; u < M * 4 / 8; u += G) xattn_unit(L, u, fl);
            for (int u = bx; u < NB * NCH * NH; u += G) mlstm_A_unit(p, L, l, u, fl);
        }
        GRID_BAR();
        {
            const LB L = layer_buf(p.ws, l);
            for (int u = bx; u < 512; u += G) mlstm_scan_unit(p, L, u);
        }
        GRID_BAR();
        {
            const LB L = layer_buf(p.ws, l);
            for (int u = bx; u < NB * NCH * NH; u += G) mlstm_C_unit(p, L, l, u, fl);
        }
        GRID_BAR();
        {
            const LB L = layer_buf(p.ws, l);
            pg8::Gemm g{L.xbin, L.win, M, 6656, D};
            SchedRounds S{G, bx, 3, 13, 0, 0};
            EpiProjMK E{L, ws_f(p.ws, WS_ROWSS) + (size_t)(2 * l) * M, ws_f(p.ws, WS_ROWSS_MEM)};
            pg8::gemm_phase<EpiProjMK, SchedRounds, true, true>(l3, g, S, E);
        }
        GRID_BAR();
        {
            const LB L = layer_buf(p.ws, l);
            pg8::Gemm g{L.sq, L.wbr, 3 * M, 3 * D, 512};
            SchedMerged S{G, bx};
            EpiMergedMK E{L.gates, L.merged};
            pg8::gemm_phase<EpiMergedMK, SchedMerged, false, true>(l3, g, S, E);
        }
        GRID_BAR();
        {
            const LB L = layer_buf(p.ws, l);
            pg8::Gemm g{L.merged, L.wout, M, D, D};
            SchedRounds S{G, bx, 1, 0, 0, 0};
            EpiResidMK E{l == 0 ? p.x : p.out, p.out, L.xbmid, ws_f(p.ws, WS_ROWSS) + (size_t)(2 * l + 1) * M};
            pg8::gemm_phase<EpiResidMK, SchedRounds, false, true>(l3, g, S, E);
        }
        GRID_BAR();
        {
            const LB L = layer_buf(p.ws, l);
            pg8::Gemm g{L.xbmid, L.wff1, M, DFF, D};
            SchedRounds S{G, bx, 4, 0, 0, 0};
            EpiFF1MK E{L.hff, ws_f(p.ws, WS_ROWSS) + (size_t)(2 * l + 1) * M};
            pg8::gemm_phase<EpiFF1MK, SchedRounds, true, true>(l3, g, S, E);
        }
        GRID_BAR();
        {
            const LB L = layer_buf(p.ws, l);
            pg8::Gemm g{L.hff, L.wff2, M, D, DFF};
            SchedRounds S{G, bx, 1, 0, 0, 0};
            EpiResidMK E{p.out, p.out, L.xbnext, ws_f(p.ws, WS_ROWSS) + (size_t)(2 * l + 2) * M};
            pg8::gemm_phase<EpiResidMK, SchedRounds, false, true>(l3, g, S, E);
        }
        GRID_BAR();
    }
    {
        WAVE_IDS();
        finalnorm_rows(p.out, ws_f(p.ws, WS_ROWSS) + (size_t)4 * M, p.g_final, gw, ngw, lane);
    }
}
}

extern "C" void kernel_launch(void* const* d_in, const int* in_sizes, int n_in, void* d_out, int out_size, void* d_ws, size_t ws_size, hipStream_t stream) {
    static int grid = 0;
    if (grid == 0) {
        if (n_in != 20 || out_size != M * D || ws_size < WS_END) { fprintf(stderr, "kernel_launch: unexpected shapes (n_in %d out %d ws %zu)\n", n_in, out_size, ws_size); grid = -1; return; }
        int dev = 0, cus = 0, per_cu = 0;
        if (hipGetDevice(&dev) != hipSuccess || hipDeviceGetAttribute(&cus, hipDeviceAttributeMultiprocessorCount, dev) != hipSuccess) { fprintf(stderr, "kernel_launch: device query failed\n"); grid = -1; return; }
        if (hipFuncSetAttribute((const void*)mk_fwd, hipFuncAttributeMaxDynamicSharedMemorySize, LDS_BYTES) != hipSuccess) { fprintf(stderr, "kernel_launch: hipFuncSetAttribute failed\n"); grid = -1; return; }
        if (hipOccupancyMaxActiveBlocksPerMultiprocessor(&per_cu, (const void*)mk_fwd, 512, LDS_BYTES) != hipSuccess || per_cu < 1) { fprintf(stderr, "kernel_launch: occupancy query says %d blocks per CU\n", per_cu); grid = -1; return; }
        grid = cus;
    }
    if (grid < 0) return;
    P p{};
    const float** pf = (const float**)&p;
    for (int i = 0; i < 20; ++i) pf[i] = (const float*)d_in[i];
    p.out = (float*)d_out; p.ws = (unsigned char*)d_ws;
    if (hipMemsetAsync(d_ws, 0, WS_ZERO_BYTES, stream) != hipSuccess) { fprintf(stderr, "kernel_launch: memset failed\n"); return; }
    void* args[] = {&p};
    const hipError_t e = hipLaunchCooperativeKernel((const void*)mk_fwd, dim3(grid), dim3(512), args, LDS_BYTES, stream);
    if (e != hipSuccess) fprintf(stderr, "kernel_launch: cooperative launch failed: %s (grid %d)\n", hipGetErrorString(e), grid);
}
```

```cpp
#include <hip/hip_runtime.h>
#include <cstdio>
#include <cstdint>

namespace pg8 {
#define PG8_LAS __attribute__((address_space(3)))
typedef unsigned short bf16_t;
typedef short bf16x8 __attribute__((ext_vector_type(8)));
typedef float f32x4 __attribute__((ext_vector_type(4)));
typedef unsigned u32x4 __attribute__((ext_vector_type(4)));
constexpr int BM = 256, BK = 64, HALF = 128, HTB = HALF * BK * 2  , STAGE_BYTES = 8 * HTB, NXCD = 8, WGM = 8;

__host__ __device__ __forceinline__ int lds_byte(int r, int c) { const int st = (r >> 4) * 2 + (c >> 5), rr = r & 15, cc = c & 31, ob = rr * 64 + cc * 2; return st * 1024 + (ob ^ (((ob >> 9) & 1) << 5)); }
__host__ __device__ __forceinline__ void stage_rc(int b, int& R, int& C) { const int st = b / 1024, sb = b % 1024, swz = sb ^ (((sb >> 9) & 1) << 5); R = (st >> 1) * 16 + swz / 64; C = (st & 1) * 32 + (swz % 64) / 2; }
__host__ __device__ __forceinline__ int perm32(int rho) { const int n = rho >> 4, i = rho & 15; return 8 * (i >> 2) + 4 * n + (i & 3); }
struct Unit { int pm, pn, rm, kind; };
struct Gemm { const bf16_t* A; const bf16_t* Bt; int M, N, K; };
__device__ __forceinline__ unsigned cvt_pk_bf16(float lo, float hi) { unsigned r; asm volatile("v_cvt_pk_bf16_f32 %0, %1, %2" : "=v"(r) : "v"(lo), "v"(hi)); return r; }
template <class Epi, class Sched, bool ALIGN_EPI = false, bool SP2 = false>
__device__ __forceinline__ void gemm_phase(PG8_LAS unsigned char* lds, const Gemm g, const Sched& S, const Epi& E) {
    int tid_l = threadIdx.x; asm volatile("" : "+v"(tid_l));
    const int tid = tid_l, wid = __builtin_amdgcn_readfirstlane(tid >> 6), lane = tid & 63, wr = wid >> 2, wc = wid & 3, fr = lane & 15, fq = lane >> 4;
    const int K = g.K, nt = K / BK;
    unsigned voffA[2], voffB[2];
#pragma unroll
    for (int i = 0; i < 2; ++i) { int R, C; stage_rc(tid * 16 + i * 8192, R, C); const int Rb = Epi::PERM ? ((R & ~31) + perm32(R & 31)) : R;
        voffA[i] = (unsigned)(R * K + C) * 2u; voffB[i] = (unsigned)(Rb * K + C) * 2u; }
    const size_t kstep = (size_t)(BK * 2);
    const size_t hstep = (size_t)HALF * K * 2;
    const size_t tstep = 2 * hstep;
    const unsigned ldsw = (unsigned)wid * 1024u;
    const int aoff = lds_byte(wr * 64 + fr, fq * 8), boff = lds_byte(wc * 32 + fr, fq * 8);
#define PG8_SA(b, h) (((b) * 2 + (h)) * HTB)
#define PG8_SB(b, h) ((4 + (b) * 2 + (h)) * HTB)
#define PG8_STAGE(bufoff, gbase, voff) do { _Pragma("unroll") for (int _i = 0; _i < 2; ++_i) \
        __builtin_amdgcn_global_load_lds((const unsigned*)((const char*)(gbase) + (voff)[_i]), (PG8_LAS unsigned*)(lds + (bufoff) + ldsw + _i * 8192), 16, 0, 0); } while (0)
#define PG8_LDA(dst, b, h) do { _Pragma("unroll") for (int m = 0; m < 4; ++m) _Pragma("unroll") for (int k = 0; k < 2; ++k) dst[m][k] = *(const PG8_LAS bf16x8*)(lds + PG8_SA(b, h) + aoff + m * 2048 + k * 1024); } while (0)
#define PG8_LDB(dst, b, h) do { _Pragma("unroll") for (int n = 0; n < 2; ++n) _Pragma("unroll") for (int k = 0; k < 2; ++k) dst[n][k] = *(const PG8_LAS bf16x8*)(lds + PG8_SB(b, h) + boff + n * 2048 + k * 1024); } while (0)
#define PG8_MMA(ai, bj, At, Bt) do { __builtin_amdgcn_s_setprio(1); _Pragma("unroll") for (int m = 0; m < 4; ++m) _Pragma("unroll") for (int n = 0; n < 2; ++n) _Pragma("unroll") for (int k = 0; k < 2; ++k) \
        acc[ai][bj][m][n] = __builtin_amdgcn_mfma_f32_16x16x32_bf16(Bt[n][k], At[m][k], acc[ai][bj][m][n], 0, 0, 0); __builtin_amdgcn_s_setprio(0); } while (0)
#define PG8_WAIT_V(n) asm volatile("s_waitcnt vmcnt(" #n ")" ::: "memory")
#define PG8_WAIT_L(n) asm volatile("s_waitcnt lgkmcnt(" #n ")" ::: "memory")
#define PG8_BAR __builtin_amdgcn_s_barrier()
#define PG8_SCHED __builtin_amdgcn_sched_barrier(0)
    Unit cur, nxt; int ui = 0;
    if (!S.next(0, cur)) return;
    f32x4 acc[2][2][4][2];
#pragma unroll
    for (int a = 0; a < 2; ++a)
#pragma unroll
        for (int b = 0; b < 2; ++b)
#pragma unroll
            for (int m = 0; m < 4; ++m)
#pragma unroll
                for (int n = 0; n < 2; ++n) acc[a][b][m][n] = (f32x4){0.f, 0.f, 0.f, 0.f};
    bf16x8 At[4][2], B0[2][2], B1[2][2];
    const char* cA = (const char*)g.A + (size_t)cur.pm * tstep; const char* cB = (const char*)g.Bt + (size_t)cur.pn * tstep;
    S.a_ready(cur);
    if constexpr (SP2) {
        PG8_STAGE(PG8_SB(0, 0), cB, voffB); PG8_STAGE(PG8_SB(0, 1), cB + hstep, voffB); PG8_STAGE(PG8_SA(0, 0), cA, voffA); PG8_STAGE(PG8_SA(0, 1), cA + hstep, voffA);
        if (wr == 1) PG8_BAR;
        PG8_WAIT_V(2); PG8_BAR;
        PG8_STAGE(PG8_SB(1, 0), cB + kstep, voffB); PG8_STAGE(PG8_SA(1, 0), cA + kstep, voffA); PG8_STAGE(PG8_SB(1, 1), cB + hstep + kstep, voffB);
        PG8_WAIT_V(6); PG8_BAR;
    } else {
        PG8_STAGE(PG8_SB(0, 0), cB, voffB); PG8_STAGE(PG8_SA(0, 0), cA, voffA); PG8_STAGE(PG8_SB(0, 1), cB + hstep, voffB); PG8_STAGE(PG8_SA(0, 1), cA + hstep, voffA);
        if (wr == 1) PG8_BAR;
        PG8_WAIT_V(4); PG8_BAR;
        PG8_STAGE(PG8_SB(1, 0), cB + kstep, voffB); PG8_STAGE(PG8_SA(1, 0), cA + kstep, voffA); PG8_STAGE(PG8_SB(1, 1), cB + hstep + kstep, voffB);
        PG8_WAIT_V(6); PG8_BAR;
    }
    for (;;) {
        const bool has_next = S.next(ui + 1, nxt);
        const char* nA = has_next ? (const char*)g.A + (size_t)nxt.pm * tstep : cA; const char* nB = has_next ? (const char*)g.Bt + (size_t)nxt.pn * tstep : cB;
        for (int t = 0; t < nt; t += 2) {
            const bool last = (t == nt - 2);
            const char* a1 = cA + (size_t)(t + 1) * kstep;
            const char* a2 = last ? nA : cA + (size_t)(t + 2) * kstep; const char* b2 = last ? nB : cB + (size_t)(t + 2) * kstep;
            const char* a3 = a2 + kstep; const char* b3 = b2 + kstep;
            if (last && has_next) S.a_ready(nxt);
            if constexpr (SP2) {
            PG8_LDB(B0, 0, 0); PG8_LDB(B1, 0, 1); PG8_SCHED; PG8_LDA(At, 0, 0); PG8_STAGE(PG8_SA(1, 1), a1 + hstep, voffA);
            PG8_WAIT_V(8); PG8_WAIT_L(0); PG8_BAR; PG8_MMA(0, 0, At, B0); PG8_MMA(0, 1, At, B1); PG8_BAR; PG8_SCHED;
            PG8_LDA(At, 0, 1); PG8_STAGE(PG8_SB(0, 0), b2, voffB); PG8_STAGE(PG8_SB(0, 1), b2 + hstep, voffB); PG8_STAGE(PG8_SA(0, 0), a2, voffA);
            PG8_WAIT_V(8); PG8_WAIT_L(0); PG8_BAR; PG8_MMA(1, 0, At, B0); PG8_MMA(1, 1, At, B1); PG8_BAR; PG8_SCHED;
            PG8_LDB(B0, 1, 0); PG8_LDB(B1, 1, 1); PG8_SCHED; PG8_LDA(At, 1, 0); PG8_STAGE(PG8_SA(0, 1), a2 + hstep, voffA);
            PG8_WAIT_V(8); PG8_WAIT_L(0); PG8_BAR; PG8_MMA(0, 0, At, B0); PG8_MMA(0, 1, At, B1); PG8_BAR; PG8_SCHED;
            PG8_LDA(At, 1, 1); PG8_STAGE(PG8_SB(1, 0), b3, voffB); PG8_STAGE(PG8_SB(1, 1), b3 + hstep, voffB); PG8_STAGE(PG8_SA(1, 0), a3, voffA);
            PG8_WAIT_V(8); PG8_WAIT_L(0); PG8_BAR; PG8_MMA(1, 0, At, B0); PG8_MMA(1, 1, At, B1); PG8_BAR; PG8_SCHED;
            } else {
            PG8_LDB(B0, 0, 0); PG8_SCHED; PG8_LDA(At, 0, 0); PG8_STAGE(PG8_SA(1, 1), a1 + hstep, voffA);
            PG8_WAIT_L(8); PG8_BAR; PG8_WAIT_L(0); PG8_MMA(0, 0, At, B0); PG8_BAR; PG8_SCHED;
            PG8_LDB(B1, 0, 1); PG8_STAGE(PG8_SB(0, 0), b2, voffB);
            PG8_BAR; PG8_WAIT_L(0); PG8_MMA(0, 1, At, B1); PG8_BAR;
            PG8_LDA(At, 0, 1); PG8_STAGE(PG8_SA(0, 0), a2, voffA);
            PG8_BAR; PG8_WAIT_L(0); PG8_MMA(1, 0, At, B0); PG8_BAR; PG8_SCHED;
            PG8_STAGE(PG8_SB(0, 1), b2 + hstep, voffB);
            PG8_WAIT_V(6); PG8_BAR; PG8_MMA(1, 1, At, B1); PG8_BAR;
            PG8_LDB(B0, 1, 0); PG8_SCHED; PG8_LDA(At, 1, 0); PG8_STAGE(PG8_SA(0, 1), a2 + hstep, voffA);
            PG8_WAIT_L(8); PG8_BAR; PG8_WAIT_L(0); PG8_MMA(0, 0, At, B0); PG8_BAR; PG8_SCHED;
            PG8_LDB(B1, 1, 1); PG8_STAGE(PG8_SB(1, 0), b3, voffB);
            PG8_BAR; PG8_WAIT_L(0); PG8_MMA(0, 1, At, B1); PG8_BAR;
            PG8_LDA(At, 1, 1); PG8_STAGE(PG8_SA(1, 0), a3, voffA);
            PG8_BAR; PG8_WAIT_L(0); PG8_MMA(1, 0, At, B0); PG8_BAR; PG8_SCHED;
            PG8_STAGE(PG8_SB(1, 1), b3 + hstep, voffB);
            PG8_WAIT_V(6); PG8_BAR; PG8_MMA(1, 1, At, B1); PG8_BAR;
            }
        }
        if constexpr (ALIGN_EPI) { if (wr == 0) PG8_BAR; }
        if constexpr (!Epi::AFTER_DRAIN) { E(acc, cur, wr, wc, fr, fq); S.done(cur); }
        const bool keep_acc = E.keep(cur);
        if (!has_next) break;
        if (!keep_acc) {
#pragma unroll
        for (int a = 0; a < 2; ++a)
#pragma unroll
            for (int b = 0; b < 2; ++b)
#pragma unroll
                for (int m = 0; m < 4; ++m)
#pragma unroll
                    for (int n = 0; n < 2; ++n) acc[a][b][m][n] = (f32x4){0.f, 0.f, 0.f, 0.f};
        }
        cur = nxt; cA = nA; cB = nB; ++ui;
        if constexpr (ALIGN_EPI) { if (wr == 1) PG8_BAR; }
    }
    PG8_WAIT_V(0);
    if constexpr (!ALIGN_EPI) { if (wr == 0) PG8_BAR; }
    PG8_BAR;
    if constexpr (Epi::AFTER_DRAIN) { E.fused(acc, cur, wr, wc, fr, fq, lds, wid, lane); S.done(cur); }
#undef PG8_SA
#undef PG8_SB
#undef PG8_STAGE
#undef PG8_LDA
#undef PG8_LDB
#undef PG8_MMA
#undef PG8_WAIT_V
#undef PG8_WAIT_L
#undef PG8_BAR
#undef PG8_SCHED
}
}

namespace {
using pg8::bf16_t; using pg8::f32x4; using pg8::u32x4; using pg8::Unit;
#define LAS __attribute__((address_space(3)))
constexpr int M = 16384, D = 1024, T = 2048, NB = 8, MEMLEN = 256, MM = NB * MEMLEN;
constexpr int INC = 6416, DFF = 4096, NCH = 32, NH = 8;
constexpr float EPS = 1e-6f;
constexpr size_t MiB = 1u << 20;
constexpr size_t WS_BAR = 0;
constexpr size_t WS_ROWSS = 64 * 1024;
constexpr size_t WS_ZERO_BYTES = 384 * 1024;
constexpr size_t WS_ROWSS_MEM = 384 * 1024;
constexpr size_t WS_G = 400 * 1024, WS_ML = 408 * 1024, WS_MIN = 416 * 1024;
constexpr size_t WS_DN = 512 * 1024;
constexpr size_t WS_WT = 1 * MiB;
constexpr size_t WT_WIN = 0, WT_WMEM = (size_t)6656 * D * 2, WT_WBR = WT_WMEM + (size_t)D * D * 2, WT_WOUT = WT_WBR + (size_t)3 * D * 512 * 2,
                 WT_FF1 = WT_WOUT + (size_t)D * D * 2, WT_FF2 = WT_FF1 + (size_t)DFF * D * 2, WT_LAYER = WT_FF2 + (size_t)D * DFF * 2;
constexpr size_t WS_MEMB = 73 * MiB, WS_POOL = 77 * MiB, WS_END = 256 * MiB;
static_assert(WS_WT + 2 * WT_LAYER <= WS_MEMB, "weights fit");
constexpr int LDS_RING = 131072, LDS_BYTES = 147456, LDS_CTL = LDS_BYTES - 256;

struct P {
    const float *x, *mem, *rel_bias, *g_mix, *w_in, *conv_w, *b_i, *b_f, *norm_g, *sinks, *g_mem, *w_mem_kv, *w_br0, *w_br1, *w_br2, *w_out, *g_ffn, *w_ff1, *w_ff2, *g_final;
    float* out; unsigned char* ws;
};
struct LB {
    bf16_t *xbin, *sq, *mo, *xq, *gates, *skv, *mqk, *mv, *memkv, *merged, *xbmid, *hff, *xbnext;
    float *iff, *state;
    const bf16_t *win, *wmem, *wbr, *wout, *wff1, *wff2;
};
__host__ __device__ inline LB layer_buf(unsigned char* ws, int l) {
    LB b; unsigned char* pool = ws + WS_POOL; const int p = l & 1;
    unsigned char* breg = pool + (p ? 0 : 32 * MiB);
    b.xbin = (bf16_t*)(pool + (p ? 147 * MiB : 0)); b.merged = b.xbin;
    b.xbmid = (bf16_t*)(pool + (p ? 0 : 147 * MiB)); b.xbnext = b.xbmid;
    b.hff = (bf16_t*)(pool + (p ? 32 * MiB : 0));
    b.sq = (bf16_t*)breg; b.mo = (bf16_t*)(breg + 16 * MiB); b.xq = (bf16_t*)(breg + 32 * MiB);
    b.gates = (bf16_t*)(breg + 48 * MiB);
    b.skv = (bf16_t*)(breg + 48 * MiB); b.mqk = (bf16_t*)(breg + 56 * MiB); b.mv = (bf16_t*)(breg + 88 * MiB);
    b.iff = (float*)(breg + 104 * MiB); b.memkv = (bf16_t*)(breg + 105 * MiB); b.state = (float*)(breg + 109 * MiB);
    unsigned char* wt = ws + WS_WT + (size_t)l * WT_LAYER;
    b.win = (const bf16_t*)(wt + WT_WIN); b.wmem = (const bf16_t*)(wt + WT_WMEM); b.wbr = (const bf16_t*)(wt + WT_WBR);
    b.wout = (const bf16_t*)(wt + WT_WOUT); b.wff1 = (const bf16_t*)(wt + WT_FF1); b.wff2 = (const bf16_t*)(wt + WT_FF2);
    return b;
}
__device__ __forceinline__ float* ws_f(unsigned char* ws, size_t off) { return (float*)(ws + off); }

__device__ __forceinline__ float bf2f(bf16_t h) { return __uint_as_float(((unsigned)h) << 16); }
__device__ __forceinline__ bf16_t f2bf(float f) { unsigned u = __float_as_uint(f); u = (u + 0x7fffu + ((u >> 16) & 1u)) >> 16; return (bf16_t)u; }
__device__ __forceinline__ unsigned pk2(float lo, float hi) { return (unsigned)f2bf(lo) | ((unsigned)f2bf(hi) << 16); }
__device__ __forceinline__ float sigmoidf_(float v) { return 1.f / (1.f + expf(-v)); }
__device__ __forceinline__ float fsigmoid(float v) { return __builtin_amdgcn_rcpf(1.f + __expf(-v)); }
__device__ __forceinline__ float wave_sum(float v) {
#pragma unroll
    for (int o = 1; o < 64; o <<= 1) v += __shfl_xor(v, o);
    return v;
}
__device__ __forceinline__ float wave_max(float v) {
#pragma unroll
    for (int o = 1; o < 64; o <<= 1) v = fmaxf(v, __shfl_xor(v, o));
    return v;
}
__device__ __forceinline__ void unpack8(const uint4 a, float (&f)[8]) {
    f[0] = __uint_as_float(a.x << 16); f[1] = __uint_as_float(a.x & 0xffff0000u); f[2] = __uint_as_float(a.y << 16); f[3] = __uint_as_float(a.y & 0xffff0000u);
    f[4] = __uint_as_float(a.z << 16); f[5] = __uint_as_float(a.z & 0xffff0000u); f[6] = __uint_as_float(a.w << 16); f[7] = __uint_as_float(a.w & 0xffff0000u);
}
__device__ const unsigned char T5_BUCKET[128] = {0, 1, 2, 3, 4, 5, 6, 7, 8, 9, 10, 11, 12, 13, 14, 15, 16, 16, 16, 17, 17, 18, 18, 18, 19, 19, 19, 20, 20, 20, 20, 21, 21, 21, 21, 22, 22, 22, 22, 22, 23, 23, 23, 23, 23, 23, 24, 24, 24, 24, 24, 24, 25, 25, 25, 25, 25, 25, 25, 26, 26, 26, 26, 26, 26, 26, 26, 27, 27, 27, 27, 27, 27, 27, 27, 27, 27, 28, 28, 28, 28, 28, 28, 28, 28, 28, 28, 29, 29, 29, 29, 29, 29, 29, 29, 29, 29, 29, 29, 30, 30, 30, 30, 30, 30, 30, 30, 30, 30, 30, 30, 30, 30, 31, 31, 31, 31, 31, 31, 31, 31, 31, 31, 31, 31, 31, 31, 31};

struct SchedRounds {
    int G, c, nfull, pn_base, tail, memA;
    __device__ __forceinline__ bool next(int i, Unit& u) const {
        const int L = i * G + c;
        if (L < nfull * 256) { const int r = L >> 8, w = L & 255, x = w & 7, j = w >> 3; u.pm = u.rm = 8 * x + (j & 7); u.pn = pn_base + 4 * r + (j >> 3); u.kind = 0; return true; }
        if (!tail) return false;
        const int t = L - nfull * 256;
        if (t < 64) { u.pm = u.rm = t; u.pn = 12; u.kind = 0; return true; }
        if (t < 128) { u.pm = u.rm = t - 64; u.pn = 25; u.kind = 0; return true; }
        if (t < 160) { const int q = t - 128; u.rm = q >> 2; u.pm = memA + (q >> 2); u.pn = 26 + (q & 3); u.kind = 1; return true; }
        return false;
    }
    __device__ __forceinline__ void a_ready(const Unit&) const {}
    __device__ __forceinline__ void done(const Unit&) const {}
};
struct SchedMerged {
    int G, c;
    __device__ __forceinline__ bool next(int i, Unit& u) const {
        const int tt = (i / 3) * G + c, seg = i % 3; if (tt >= 256) return false;
        const int x = tt & 7, j = tt >> 3; u.rm = 8 * x + (j & 7); u.pm = seg * 64 + u.rm; u.pn = seg * 4 + (j >> 3); u.kind = seg; return true;
    }
    __device__ __forceinline__ void a_ready(const Unit&) const {}
    __device__ __forceinline__ void done(const Unit&) const {}
};

__device__ __forceinline__ u32x4 pack8(f32x4 a, f32x4 b) { u32x4 w; w.x = pg8::cvt_pk_bf16(a[0], a[1]); w.y = pg8::cvt_pk_bf16(a[2], a[3]); w.z = pg8::cvt_pk_bf16(b[0], b[1]); w.w = pg8::cvt_pk_bf16(b[2], b[3]); return w; }
__device__ __forceinline__ f32x4 sig4(f32x4 v) { f32x4 r; r[0] = fsigmoid(v[0]); r[1] = fsigmoid(v[1]); r[2] = fsigmoid(v[2]); r[3] = fsigmoid(v[3]); return r; }
struct EpiProjMK {
    static constexpr bool PERM = true, AFTER_DRAIN = false;
    LB L; const float* rowss; const float* rowss_mem;
    __device__ __forceinline__ bool keep(const Unit&) const { return false; }
    __device__ __forceinline__ void operator()(f32x4 (&acc)[2][2][4][2], const Unit& u, int wr, int wc, int fr, int fq) const {
        const int rbase = u.rm * 256 + wr * 64 + fr, cin = wc * 32 + 8 * fq;
        const float* rs = rowss; bf16_t* dst; int ld, coff; bool sig = false; const int tile = u.pn;
        if (u.kind == 1) { rs = rowss_mem; dst = L.memkv; ld = 1024; coff = (tile - 26) * 256; }
        else if (tile < 2) { dst = L.sq; ld = 512; coff = tile * 256; }
        else if (tile < 3) { dst = L.skv; ld = 256; coff = 0; }
        else if (tile < 7) { dst = L.mqk; ld = 1024; coff = (tile - 3) * 256; }
        else if (tile < 9) { dst = L.mv; ld = 512; coff = (tile - 7) * 256; }
        else if (tile < 11) { dst = L.mo; ld = 512; coff = (tile - 9) * 256; sig = true; }
        else if (tile < 13) { dst = L.xq; ld = 512; coff = (tile - 11) * 256; }
        else if (tile < 25) { dst = L.gates; ld = 3072; coff = (tile - 13) * 256; sig = true; }
        else { dst = nullptr; ld = 0; coff = 0; }
#pragma unroll
        for (int ai = 0; ai < 2; ++ai)
#pragma unroll
            for (int m = 0; m < 4; ++m) {
                const int row = rbase + ai * 128 + m * 16; const float rstd = rsqrtf(rs[row] * (1.f / D) + EPS);
#pragma unroll
                for (int bj = 0; bj < 2; ++bj) {
                    f32x4 v0 = acc[ai][bj][m][0] * rstd, v1 = acc[ai][bj][m][1] * rstd;
                    if (dst) { if (sig) { v0 = sig4(v0); v1 = sig4(v1); }
                        *(u32x4*)(dst + (size_t)row * ld + coff + bj * 128 + cin) = pack8(v0, v1); }
                    else if (bj == 0 && cin < 16) { *(f32x4*)(L.iff + (size_t)row * 16 + cin) = v0; *(f32x4*)(L.iff + (size_t)row * 16 + cin + 4) = v1; }
                }
            }
    }
};
struct EpiMergedMK {
    static constexpr bool PERM = true, AFTER_DRAIN = false;
    const bf16_t* gates; bf16_t* merged;
    __device__ __forceinline__ bool keep(const Unit& u) const { return u.kind < 2; }
    __device__ __forceinline__ void operator()(f32x4 (&acc)[2][2][4][2], const Unit& u, int wr, int wc, int fr, int fq) const {
        const int rbase = u.rm * 256 + wr * 64 + fr, col0 = (u.pn & 3) * 256 + wc * 32 + 8 * fq, seg = u.kind;
#pragma unroll
        for (int ai = 0; ai < 2; ++ai)
#pragma unroll
            for (int m = 0; m < 4; ++m) {
                const int row = rbase + ai * 128 + m * 16;
#pragma unroll
                for (int bj = 0; bj < 2; ++bj) {
                    const int col = col0 + bj * 128;
                    float g[8]; unpack8(*(const uint4*)(gates + (size_t)row * 3072 + seg * 1024 + col), g);
                    if (seg < 2) { float gn[8]; unpack8(*(const uint4*)(gates + (size_t)row * 3072 + (seg + 1) * 1024 + col), gn);
#pragma unroll
                        for (int j = 0; j < 8; ++j) g[j] = g[j] * __builtin_amdgcn_rcpf(fmaxf(gn[j], 1e-30f)); }
                    f32x4 v0 = acc[ai][bj][m][0], v1 = acc[ai][bj][m][1];
                    v0[0] *= g[0]; v0[1] *= g[1]; v0[2] *= g[2]; v0[3] *= g[3]; v1[0] *= g[4]; v1[1] *= g[5]; v1[2] *= g[6]; v1[3] *= g[7];
                    acc[ai][bj][m][0] = v0; acc[ai][bj][m][1] = v1;
                    if (seg == 2) *(u32x4*)(merged + (size_t)row * D + col) = pack8(v0, v1);
                }
            }
    }
};
struct EpiResidMK {
    static constexpr bool PERM = false, AFTER_DRAIN = false;
    const float* xold; float* xnew; bf16_t* xb; float* rowss;
    __device__ __forceinline__ bool keep(const Unit&) const { return false; }
    __device__ __forceinline__ void operator()(f32x4 (&acc)[2][2][4][2], const Unit& u, int wr, int wc, int fr, int fq) const {
        const int rbase = u.rm * 256 + wr * 64 + fr, col0 = u.pn * 256 + wc * 32 + 4 * fq;
#pragma unroll
        for (int ai = 0; ai < 2; ++ai)
#pragma unroll
            for (int m = 0; m < 4; ++m) {
                const int row = rbase + ai * 128 + m * 16; const size_t off = (size_t)row * D + col0; float ss = 0.f;
#pragma unroll
                for (int bj = 0; bj < 2; ++bj)
#pragma unroll
                    for (int n = 0; n < 2; ++n) {
                        const f32x4 o = *(const f32x4*)(xold + off + bj * 128 + n * 16); const f32x4 v = acc[ai][bj][m][n] + o;
                        *(f32x4*)(xnew + off + bj * 128 + n * 16) = v;
                        uint2 w; w.x = pg8::cvt_pk_bf16(v[0], v[1]); w.y = pg8::cvt_pk_bf16(v[2], v[3]); *(uint2*)(xb + off + bj * 128 + n * 16) = w;
                        ss += (v[0] * v[0] + v[1] * v[1]) + (v[2] * v[2] + v[3] * v[3]);
                    }
                ss += __shfl_xor(ss, 16); ss += __shfl_xor(ss, 32);
                if (fq == 0) atomicAdd(rowss + row, ss);
                asm volatile("" ::: "memory");
            }
    }
};
struct EpiFF1MK {
    static constexpr bool PERM = true, AFTER_DRAIN = false;
    bf16_t* h; const float* rowss;
    __device__ __forceinline__ bool keep(const Unit&) const { return false; }
    __device__ __forceinline__ void operator()(f32x4 (&acc)[2][2][4][2], const Unit& u, int wr, int wc, int fr, int fq) const {
        const int rbase = u.rm * 256 + wr * 64 + fr, col0 = u.pn * 256 + wc * 32 + 8 * fq;
#pragma unroll
        for (int ai = 0; ai < 2; ++ai)
#pragma unroll
            for (int m = 0; m < 4; ++m) {
                const int row = rbase + ai * 128 + m * 16; const float rstd = rsqrtf(rowss[row] * (1.f / D) + EPS);
#pragma unroll
                for (int bj = 0; bj < 2; ++bj) {
                    f32x4 v0 = acc[ai][bj][m][0] * rstd, v1 = acc[ai][bj][m][1] * rstd;
#pragma unroll
                    for (int j = 0; j < 4; ++j) { v0[j] = fmaxf(v0[j], 0.f); v0[j] *= v0[j]; v1[j] = fmaxf(v1[j], 0.f); v1[j] *= v1[j]; }
                    *(u32x4*)(h + (size_t)row * DFF + col0 + bj * 128) = pack8(v0, v1);
                }
            }
    }
};

__device__ __forceinline__ void convert_tile(const float* src, int ldsrc, int col0, int ncols, int k0, const float* gain, float scale, bf16_t* dst, int K, float* tile) {
    int tid_l = threadIdx.x; asm volatile("" : "+v"(tid_l)); const int tid = tid_l;
#pragma unroll
    for (int j = 0; j < 8; ++j) { const int kk = (tid >> 6) + 8 * j, nn = tid & 63; float v = 0.f;
        if (nn < ncols) v = src[(size_t)(k0 + kk) * ldsrc + col0 + nn] * (gain ? gain[k0 + kk] : 1.f) * scale;
        tile[kk * 65 + nn] = v; }
    __syncthreads();
#pragma unroll
    for (int j = 0; j < 8; ++j) { const int nn = (tid >> 6) + 8 * j, kk = tid & 63; if (nn < ncols) dst[(size_t)nn * K + k0 + kk] = f2bf(tile[kk * 65 + nn]); }
    __syncthreads();
}
constexpr int CV_NJOB = 13, CV_ITEMS_LAYER = 4560;
__device__ __forceinline__ void convert_item(const P& p, int item, float* tile) {
    const int l = item / CV_ITEMS_LAYER; int r = item % CV_ITEMS_LAYER;
    unsigned char* wt = p.ws + WS_WT + (size_t)l * WT_LAYER;
    const float* src; const float* gain = nullptr; int ld, col0, ncols, K; float sc = 1.f; bf16_t* dst;
    if (r < 1616) {
        const float* win = p.w_in + (size_t)l * D * INC; src = win; ld = INC; K = D; gain = p.g_mix + l * D; int dr;
        if (r < 128) { col0 = 0; ncols = 512; dr = 0; sc = 0.125f; }
        else if ((r -= 128) < 448) { col0 = 512; ncols = 1792; dr = 512; }
        else if ((r -= 448) < 128) { col0 = 2320; ncols = 512; dr = 2304; }
        else if ((r -= 128) < 128) { col0 = 2832; ncols = 512; dr = 2816; sc = 0.08838834764831845f; }
        else if ((r -= 128) < 768) { col0 = 3344; ncols = 3072; dr = 3328; }
        else { r -= 768; col0 = 2304; ncols = 16; dr = 6400; }
        dst = (bf16_t*)(wt + WT_WIN) + (size_t)dr * D;
    } else if ((r -= 1616) < 256) { src = p.w_mem_kv + (size_t)l * D * 1024; ld = 1024; col0 = 0; ncols = 1024; K = D; gain = p.g_mem + l * D; dst = (bf16_t*)(wt + WT_WMEM); }
    else if ((r -= 256) < 384) { const int s = r / 128; r -= s * 128; src = (s == 0 ? p.w_br0 : s == 1 ? p.w_br1 : p.w_br2) + (size_t)l * 512 * 1024; ld = 1024; col0 = 0; ncols = 1024; K = 512; dst = (bf16_t*)(wt + WT_WBR) + (size_t)s * 1024 * 512; }
    else if ((r -= 384) < 256) { src = p.w_out + (size_t)l * D * D; ld = 1024; col0 = 0; ncols = 1024; K = D; dst = (bf16_t*)(wt + WT_WOUT); }
    else if ((r -= 256) < 1024) { src = p.w_ff1 + (size_t)l * D * DFF; ld = DFF; col0 = 0; ncols = DFF; K = D; gain = p.g_ffn + l * D; dst = (bf16_t*)(wt + WT_FF1); }
    else { r -= 1024; src = p.w_ff2 + (size_t)l * DFF * D; ld = D; col0 = 0; ncols = D; K = DFF; dst = (bf16_t*)(wt + WT_FF2); }
    const int nkb = K / 64, nb = r / nkb, kb = r % nkb, c0 = nb * 64, nc = (ncols - c0) < 64 ? (ncols - c0) : 64;
    convert_tile(src, ld, col0 + c0, nc, kb * 64, gain, sc, dst + (size_t)c0 * K, K, tile);
}
__device__ __forceinline__ void rowstat_rows(const float* src, int rows, bf16_t* xb, float* rowss, int gw, int ngw, int lane) {
    for (int r = gw; r < rows; r += ngw) {
        const float4* s4 = (const float4*)(src + (size_t)r * D); float ss = 0.f;
#pragma unroll
        for (int j = 0; j < 4; ++j) { const float4 v = s4[lane + 64 * j]; ss += v.x * v.x + v.y * v.y + v.z * v.z + v.w * v.w;
            uint2 o; o.x = pk2(v.x, v.y); o.y = pk2(v.z, v.w); *(uint2*)(xb + (size_t)r * D + 4 * (lane + 64 * j)) = o; }
        ss = wave_sum(ss);
        if (lane == 0) rowss[r] = ss;
    }
}
__device__ __forceinline__ void finalnorm_rows(float* x, const float* rowss, const float* g, int gw, int ngw, int lane) {
    for (int r = gw; r < M; r += ngw) {
        const float rstd = rsqrtf(rowss[r] * (1.f / D) + EPS);
        float4* s4 = (float4*)(x + (size_t)r * D); const float4* g4 = (const float4*)g;
#pragma unroll
        for (int j = 0; j < 4; ++j) { float4 v = s4[lane + 64 * j]; const float4 gg = g4[lane + 64 * j];
            v.x *= rstd * gg.x; v.y *= rstd * gg.y; v.z *= rstd * gg.z; v.w *= rstd * gg.w; s4[lane + 64 * j] = v; }
    }
}

__device__ __forceinline__ void swa_unit(const P& p, const LB& L, int l, int u) {
    int tid_l = threadIdx.x; asm volatile("" : "+v"(tid_l)); const int tid = tid_l, hq = tid & 7, row = u * 64 + (tid >> 3), b = row / T, t = row % T, hkv = hq >> 2;
    bf16_t* qp = L.sq + (size_t)row * 512 + hq * 64;
    float q[64], o[64];
#pragma unroll
    for (int c = 0; c < 8; ++c) { float f[8]; unpack8(*(const uint4*)(qp + 8 * c), f);
#pragma unroll
        for (int j = 0; j < 8; ++j) { q[8 * c + j] = f[j]; o[8 * c + j] = 0.f; } }
    float m = -1e30f, lsum = 0.f;
    const int j0 = t - 127 > 0 ? t - 127 : 0;
    for (int j = j0; j <= t; ++j) {
        const bf16_t* kp = L.skv + (size_t)(b * T + j) * 256 + hkv * 64;
        float s = 0.f;
#pragma unroll
        for (int c = 0; c < 8; ++c) { float f[8]; unpack8(*(const uint4*)(kp + 8 * c), f);
#pragma unroll
            for (int jj = 0; jj < 8; ++jj) s = fmaf(q[8 * c + jj], f[jj], s); }
        s += p.rel_bias[(int)T5_BUCKET[t - j] * 8 + hq];
        const float mn = fmaxf(m, s), alpha = expf(m - mn), pj = expf(s - mn);
        lsum = lsum * alpha + pj;
#pragma unroll
        for (int c = 0; c < 8; ++c) { float f[8]; unpack8(*(const uint4*)(kp + 128 + 8 * c), f);
#pragma unroll
            for (int jj = 0; jj < 8; ++jj) o[8 * c + jj] = o[8 * c + jj] * alpha + pj * f[jj]; }
        m = mn;
    }
    const float sink = p.sinks[l * 8 + hq], mf = fmaxf(m, sink), a = expf(m - mf), den = lsum * a + expf(sink - mf), sc = a / den;
#pragma unroll
    for (int c = 0; c < 8; ++c) { uint4 w; w.x = pk2(o[8 * c] * sc, o[8 * c + 1] * sc); w.y = pk2(o[8 * c + 2] * sc, o[8 * c + 3] * sc); w.z = pk2(o[8 * c + 4] * sc, o[8 * c + 5] * sc); w.w = pk2(o[8 * c + 6] * sc, o[8 * c + 7] * sc);
        *(uint4*)(qp + 8 * c) = w; }
}
__device__ __forceinline__ void xattn_unit(const LB& L, int u, float* pbuf  ) {
    int tid_l = threadIdx.x; asm volatile("" : "+v"(tid_l)); const int lane = tid_l & 63, wv = tid_l >> 6, w = u * 8 + wv, hx = w & 3, row = w >> 2, b = row / T;
    bf16_t* qp = L.xq + (size_t)row * 512 + hx * 128;
    const bf16_t* kbase = L.memkv + (size_t)(b * MEMLEN) * 1024 + hx * 128;
    float s[4] = {0.f, 0.f, 0.f, 0.f};
    for (int c = 0; c < 16; ++c) { float qf[8]; unpack8(*(const uint4*)(qp + 8 * c), qf);
#pragma unroll
        for (int i = 0; i < 4; ++i) { float kf[8]; unpack8(*(const uint4*)(kbase + (size_t)(lane + 64 * i) * 1024 + 8 * c), kf);
#pragma unroll
            for (int j = 0; j < 8; ++j) s[i] = fmaf(qf[j], kf[j], s[i]); } }
    float mx = fmaxf(fmaxf(s[0], s[1]), fmaxf(s[2], s[3])); mx = wave_max(mx);
    float pe[4], ls = 0.f;
#pragma unroll
    for (int i = 0; i < 4; ++i) { pe[i] = expf(s[i] - mx); ls += pe[i]; }
    ls = wave_sum(ls); const float inv = 1.f / ls;
    __syncthreads();
#pragma unroll
    for (int i = 0; i < 4; ++i) pbuf[wv * 256 + lane + 64 * i] = pe[i] * inv;
    __syncthreads();
    float o0 = 0.f, o1 = 0.f;
    for (int k = 0; k < 256; ++k) { const unsigned vv = *(const unsigned*)(kbase + (size_t)k * 1024 + 512 + 2 * lane); const float pk = pbuf[wv * 256 + k];
        o0 = fmaf(pk, __uint_as_float(vv << 16), o0); o1 = fmaf(pk, __uint_as_float(vv & 0xffff0000u), o1); }
    *(unsigned*)(qp + 2 * lane) = pk2(o0, o1);
}
__device__ __forceinline__ float conv_silu(const bf16_t* mqk, const float* cw, int b, int t, int ch) {
    float acc = 0.f;
#pragma unroll
    for (int j = 0; j < 4; ++j) { const int tt = t - 3 + j; if (tt >= 0) acc = fmaf(cw[j * 1024 + ch], bf2f(mqk[(size_t)(b * T + tt) * 1024 + ch]), acc); }
    return acc / (1.f + expf(-acc));
}
__device__ __forceinline__ void mlstm_gates(const P& p, const LB& L, int l, int b, int c, int h, float* sB, float* sI) {
    int tid_l = threadIdx.x; asm volatile("" : "+v"(tid_l)); const int tid = tid_l;
    __syncthreads();
    if (tid < 64) { const size_t row = (size_t)b * T + c * 64 + tid; const float ip = L.iff[row * 16 + h] + p.b_i[l * 8 + h], fp = L.iff[row * 16 + 8 + h] + p.b_f[l * 8 + h];
        sB[tid] = fp >= 0.f ? -log1pf(expf(-fp)) : fp - log1pf(expf(fp)); sI[tid] = ip; }
    __syncthreads();
    if (tid == 0) { float a = 0.f; for (int s = 0; s < 64; ++s) { a += sB[s]; sB[s] = a; } }
    __syncthreads();
}
__device__ __forceinline__ void mlstm_A_unit(const P& p, const LB& L, int l, int u, float* lds) {
    int tid_l = threadIdx.x; asm volatile("" : "+v"(tid_l)); const int tid = tid_l, h = u & 7, c = (u >> 3) & 31, b = u >> 8;
    float *sK = lds, *sV = lds + 64 * 65, *sB = sV + 64 * 65, *sI = sB + 64, *sW = sI + 64;
    const float* cw = p.conv_w + (size_t)l * 4 * 1024;
    mlstm_gates(p, L, l, b, c, h, sB, sI);
    for (int e = tid; e < 4096; e += 512) { const int s = e >> 6, d = e & 63;
        sK[s * 65 + d] = conv_silu(L.mqk, cw, b, c * 64 + s, 512 + h * 64 + d) * 0.125f;
        sV[s * 65 + d] = bf2f(L.mv[(size_t)(b * T + c * 64 + s) * 512 + h * 64 + d]); }
    const float g = sB[63];
    if (tid < 64) sW[tid] = g - sB[tid] + sI[tid];
    __syncthreads();
    float ml = -1e30f; for (int s = 0; s < 64; ++s) ml = fmaxf(ml, sW[s]);
    __syncthreads();
    if (tid < 64) sW[tid] = expf(sW[tid] - ml);
    __syncthreads();
    const int dk = tid >> 3, dv0 = (tid & 7) * 8;
    float acc[8] = {0.f, 0.f, 0.f, 0.f, 0.f, 0.f, 0.f, 0.f};
    for (int s = 0; s < 64; ++s) { const float wk = sW[s] * sK[s * 65 + dk];
#pragma unroll
        for (int j = 0; j < 8; ++j) acc[j] = fmaf(wk, sV[s * 65 + dv0 + j], acc[j]); }
    float* st = L.state + (size_t)u * 4096 + dk * 64 + dv0;
#pragma unroll
    for (int j = 0; j < 8; ++j) st[j] = acc[j];
    if (tid < 64) { float a = 0.f; for (int s = 0; s < 64; ++s) a = fmaf(sW[s], sK[s * 65 + tid], a); ws_f(p.ws, WS_DN)[(size_t)u * 64 + tid] = a; }
    if (tid == 0) { ws_f(p.ws, WS_G)[u] = g; ws_f(p.ws, WS_ML)[u] = ml; }
}
__device__ __forceinline__ void mlstm_scan_unit(const P& p, const LB& L, int u) {
    int tid_l = threadIdx.x; asm volatile("" : "+v"(tid_l)); const int tid = tid_l, bh = u >> 3, b = bh >> 3, h = bh & 7, e = (u & 7) * 512 + tid;
    const bool first = (u & 7) == 0; const bool do_n = first && tid < 64;
    float m = 0.f, C = 0.f, n = 0.f;
    float *G = ws_f(p.ws, WS_G), *ML = ws_f(p.ws, WS_ML), *MIN = ws_f(p.ws, WS_MIN), *DN = ws_f(p.ws, WS_DN);
    for (int c = 0; c < NCH; ++c) { const int idx = (b * NCH + c) * 8 + h; const float g = G[idx], ml = ML[idx], mn = fmaxf(g + m, ml), a = expf(g + m - mn), s = expf(ml - mn);
        float* sp = L.state + (size_t)idx * 4096 + e; const float d = *sp; *sp = C; C = a * C + s * d;
        if (do_n) { float* np_ = DN + (size_t)idx * 64 + tid; const float dn = *np_; *np_ = n; n = a * n + s * dn; }
        if (first && tid == 0) MIN[idx] = m;
        m = mn; }
}
__device__ __forceinline__ void mlstm_C_unit(const P& p, const LB& L, int l, int u, float* lds) {
    int tid_l = threadIdx.x; asm volatile("" : "+v"(tid_l)); const int tid = tid_l, h = u & 7, c = (u >> 3) & 31, b = u >> 8;
    float *sQ = lds, *sK = sQ + 64 * 65, *sV = sK + 64 * 65, *sC = sV + 64 * 65, *sS = sC + 64 * 65, *sH = sS + 64 * 65, *sB = sH + 64 * 65, *sI = sB + 64, *sMt = sI + 64, *sIw = sMt + 64, *sDen = sIw + 64, *sN = sDen + 64;
    const float* cw = p.conv_w + (size_t)l * 4 * 1024;
    mlstm_gates(p, L, l, b, c, h, sB, sI);
    const float m_in = ws_f(p.ws, WS_MIN)[u];
    for (int e = tid; e < 4096; e += 512) { const int s = e >> 6, d = e & 63;
        sQ[s * 65 + d] = conv_silu(L.mqk, cw, b, c * 64 + s, h * 64 + d);
        sK[s * 65 + d] = conv_silu(L.mqk, cw, b, c * 64 + s, 512 + h * 64 + d) * 0.125f;
        sV[s * 65 + d] = bf2f(L.mv[(size_t)(b * T + c * 64 + s) * 512 + h * 64 + d]);
        sC[s * 65 + d] = L.state[(size_t)u * 4096 + e]; }
    if (tid < 64) sN[tid] = ws_f(p.ws, WS_DN)[(size_t)u * 64 + tid];
    __syncthreads();
    if (tid < 64) { const int t = tid; const float bt = sB[t]; float mx = -1e30f; for (int s = 0; s <= t; ++s) mx = fmaxf(mx, bt - sB[s] + sI[s]);
        const float il = bt + m_in, mt = fmaxf(mx, il); sMt[t] = mt; sIw[t] = expf(il - mt); }
    __syncthreads();
    for (int e = tid; e < 4096; e += 512) { const int t = e >> 6, s = e & 63; float v = 0.f;
        if (s <= t) { float dot = 0.f; for (int d = 0; d < 64; ++d) dot = fmaf(sQ[t * 65 + d], sK[s * 65 + d], dot); v = dot * expf(sB[t] - sB[s] + sI[s] - sMt[t]); }
        sS[t * 65 + s] = v; }
    __syncthreads();
    if (tid < 64) { const int t = tid; float d = 0.f; for (int s = 0; s < 64; ++s) d += sS[t * 65 + s]; float qn = 0.f; for (int k = 0; k < 64; ++k) qn = fmaf(sQ[t * 65 + k], sN[k], qn); sDen[t] = d + sIw[t] * qn; }
    __syncthreads();
    for (int e = tid; e < 4096; e += 512) { const int t = e >> 6, dv = e & 63; float num = 0.f, qc = 0.f;
        for (int s = 0; s < 64; ++s) num = fmaf(sS[t * 65 + s], sV[s * 65 + dv], num);
        for (int k = 0; k < 64; ++k) qc = fmaf(sQ[t * 65 + k], sC[k * 65 + dv], qc);
        num += sIw[t] * qc; const float dn = fmaxf(fabsf(sDen[t]), expf(-sMt[t])); sH[t * 65 + dv] = num / dn; }
    __syncthreads();
    if (tid < 64) { const int t = tid; float mu = 0.f; for (int d = 0; d < 64; ++d) mu += sH[t * 65 + d]; mu *= (1.f / 64.f); float var = 0.f; for (int d = 0; d < 64; ++d) { const float x = sH[t * 65 + d] - mu; var += x * x; }
        var *= (1.f / 64.f); sMt[t] = mu; sIw[t] = rsqrtf(var + EPS); }
    __syncthreads();
    for (int e = tid; e < 4096; e += 512) { const int t = e >> 6, dv = e & 63; const size_t idx = (size_t)(b * T + c * 64 + t) * 512 + h * 64 + dv;
        const float y = (sH[t * 65 + dv] - sMt[t]) * sIw[t] * p.norm_g[l * 512 + h * 64 + dv] * bf2f(L.mo[idx]); L.mo[idx] = f2bf(y); }
}


typedef short bf16x8 __attribute__((ext_vector_type(8)));
typedef short s16x4 __attribute__((ext_vector_type(4)));
typedef float f32x16 __attribute__((ext_vector_type(16)));
typedef float f32x2 __attribute__((ext_vector_type(2)));
typedef __bf16 bf16x2v __attribute__((ext_vector_type(2)));
#define MFMA32(a, b, c) __builtin_amdgcn_mfma_f32_32x32x16_bf16((a), (b), (c), 0, 0, 0)
__device__ __forceinline__ int crow(int reg, int h) { return (reg & 3) + 8 * (reg >> 2) + 4 * h; }
__device__ __forceinline__ unsigned pkbf(float a, float b) { return __builtin_bit_cast(unsigned, __builtin_convertvector((f32x2){a, b}, bf16x2v)); }
__device__ __forceinline__ bf16x8 pack_step(const f32x16& x, int s) {
    u32x4 p; p.x = pkbf(x[8 * s], x[8 * s + 1]); p.y = pkbf(x[8 * s + 2], x[8 * s + 3]); p.z = pkbf(x[8 * s + 4], x[8 * s + 5]); p.w = pkbf(x[8 * s + 6], x[8 * s + 7]);
    return __builtin_bit_cast(bf16x8, p);
}
__device__ __forceinline__ bf16x8 tr_frag(const LAS unsigned char* img, int row_lo, int row_hi, int lane) {
    const int i16 = lane & 15, q = i16 >> 2, p = i16 & 3, blk = (lane >> 4) & 1;
    const s16x4 lo = __builtin_amdgcn_ds_read_tr16_b64_v4i16((LAS s16x4*)(img + (row_lo + q) * 64 + 32 * blk + 8 * p));
    const s16x4 hi = __builtin_amdgcn_ds_read_tr16_b64_v4i16((LAS s16x4*)(img + (row_hi + q) * 64 + 32 * blk + 8 * p));
    return __builtin_shufflevector(lo, hi, 0, 1, 2, 3, 4, 5, 6, 7);
}

constexpr int SWA_KIMG = 0, SWA_VIMG = 256 * 144, SWA_TAB = SWA_VIMG + 2 * 16384;
__device__ __forceinline__ void swa_mfma_unit(const P& p, const LB& L, int l, int u, LAS unsigned char* l3) {
    int tid_l = threadIdx.x; asm volatile("" : "+v"(tid_l)); const int tid = tid_l, lane = tid & 63, wave = tid >> 6, h = lane >> 5, ql = lane & 31;
    const int hkv = u & 1, n = (u >> 1) & 15, b = u >> 5;
    __syncthreads();
#pragma unroll
    for (int i = 0; i < 4; ++i) {
        const int c = tid + 512 * i, row = c >> 3, cc = c & 7, t = 128 * (n - 1) + row;
        u32x4 kv = (u32x4){0u, 0u, 0u, 0u}, vv = (u32x4){0u, 0u, 0u, 0u};
        if (t >= 0) { const bf16_t* src = L.skv + (size_t)(b * T + t) * 256 + hkv * 64 + cc * 8; kv = *(const u32x4*)src; vv = *(const u32x4*)(src + 128); }
        *(LAS u32x4*)(l3 + SWA_KIMG + row * 144 + cc * 16) = kv;
        *(LAS u32x4*)(l3 + SWA_VIMG + (cc >> 2) * 16384 + row * 64 + (cc & 3) * 16) = vv;
    }
    for (int idx = tid; idx < 4 * 192; idx += 512) { const int g = idx / 192, e = idx % 192, dist = 159 - e;
        ((LAS float*)(l3 + SWA_TAB))[idx] = (dist >= 0 && dist < 128) ? p.rel_bias[(int)T5_BUCKET[dist] * 8 + hkv * 4 + g] : -1e30f; }
    __syncthreads();
    const int g = wave >> 1, half = wave & 1, hq = hkv * 4 + g;
    const float sink = p.sinks[l * 8 + hq];
    const LAS float* tab = (const LAS float*)(l3 + SWA_TAB) + g * 192 + 31 - ql;
#pragma unroll 1
    for (int sb = 0; sb < 2; ++sb) {
        const int r0 = 64 * half + 32 * sb, kb0 = 2 * half + sb;
        bf16_t* qptr = L.sq + (size_t)(b * T + 128 * n + r0 + ql) * 512 + hq * 64;
        bf16x8 Qf[4];
#pragma unroll
        for (int ks = 0; ks < 4; ++ks) Qf[ks] = *(const bf16x8*)(qptr + 16 * ks + 8 * h);
        f32x16 S[5];
#pragma unroll
        for (int i = 0; i < 5; ++i) {
#pragma unroll
            for (int r = 0; r < 16; ++r) S[i][r] = 0.f;
#pragma unroll
            for (int ks = 0; ks < 4; ++ks) { const bf16x8 Kf = *(const LAS bf16x8*)(l3 + SWA_KIMG + (32 * (kb0 + i) + ql) * 144 + 32 * ks + 16 * h); S[i] = MFMA32(Kf, Qf[ks], S[i]); }
        }
        float m = sink;
#pragma unroll
        for (int i = 0; i < 5; ++i)
#pragma unroll
            for (int r = 0; r < 16; ++r) { const int kk = 32 * i + crow(r, h); float sv = S[i][r] + tab[kk];
                if (n == 0 && 32 * kb0 + kk < 128) sv = -1e30f;
                S[i][r] = sv; m = fmaxf(m, sv); }
        m = fmaxf(m, __shfl_xor(m, 32));
        float lsum = 0.f;
#pragma unroll
        for (int i = 0; i < 5; ++i)
#pragma unroll
            for (int r = 0; r < 16; ++r) { const float pe = __expf(S[i][r] - m); S[i][r] = pe; lsum += pe; }
        lsum += __shfl_xor(lsum, 32);
        f32x16 O[2];
#pragma unroll
        for (int db = 0; db < 2; ++db)
#pragma unroll
            for (int r = 0; r < 16; ++r) O[db][r] = 0.f;
#pragma unroll
        for (int i = 0; i < 5; ++i)
#pragma unroll
            for (int s2 = 0; s2 < 2; ++s2) { const bf16x8 Pf = pack_step(S[i], s2); const int k0 = 32 * (kb0 + i) + 16 * s2;
#pragma unroll
                for (int db = 0; db < 2; ++db) { const bf16x8 Vf = tr_frag(l3 + SWA_VIMG + db * 16384, k0 + 4 * h, k0 + 8 + 4 * h, lane); O[db] = MFMA32(Vf, Pf, O[db]); } }
        const float inv = 1.f / (lsum + __expf(sink - m));
#pragma unroll
        for (int db = 0; db < 2; ++db)
#pragma unroll
            for (int gq = 0; gq < 4; ++gq) { uint2 w; w.x = pkbf(O[db][4 * gq] * inv, O[db][4 * gq + 1] * inv); w.y = pkbf(O[db][4 * gq + 2] * inv, O[db][4 * gq + 3] * inv);
                *(uint2*)(qptr + 32 * db + 8 * gq + 4 * h) = w; }
    }
}

constexpr int XA_KIMG = 0, XA_VIMG = 256 * 272;
__device__ __forceinline__ void xattn_mfma_unit(const LB& L, int u, LAS unsigned char* l3) {
    int tid_l = threadIdx.x; asm volatile("" : "+v"(tid_l)); const int tid = tid_l, lane = tid & 63, wave = tid >> 6, h = lane >> 5, ql = lane & 31;
    const int qb = u & 7, hx = (u >> 3) & 3, b = u >> 5;
    __syncthreads();
#pragma unroll
    for (int i = 0; i < 8; ++i) {
        const int c = tid + 512 * i, row = c >> 4, cc = c & 15;
        const bf16_t* src = L.memkv + (size_t)(b * MEMLEN + row) * 1024 + hx * 128 + cc * 8;
        const u32x4 kv = *(const u32x4*)src, vv = *(const u32x4*)(src + 512);
        *(LAS u32x4*)(l3 + XA_KIMG + row * 272 + cc * 16) = kv;
        *(LAS u32x4*)(l3 + XA_VIMG + (cc >> 2) * 16384 + row * 64 + (cc & 3) * 16) = vv;
    }
    __syncthreads();
    bf16_t* qptr = L.xq + (size_t)(b * T + qb * 256 + wave * 32 + ql) * 512 + hx * 128;
    f32x16 S[8];
    {
        bf16x8 Qf[8];
#pragma unroll
        for (int ks = 0; ks < 8; ++ks) Qf[ks] = *(const bf16x8*)(qptr + 16 * ks + 8 * h);
#pragma unroll
        for (int i = 0; i < 8; ++i) {
#pragma unroll
            for (int r = 0; r < 16; ++r) S[i][r] = 0.f;
#pragma unroll
            for (int ks = 0; ks < 8; ++ks) { const bf16x8 Kf = *(const LAS bf16x8*)(l3 + XA_KIMG + (32 * i + ql) * 272 + 32 * ks + 16 * h); S[i] = MFMA32(Kf, Qf[ks], S[i]); }
        }
    }
    float m = -1e30f;
#pragma unroll
    for (int i = 0; i < 8; ++i)
#pragma unroll
        for (int r = 0; r < 16; ++r) m = fmaxf(m, S[i][r]);
    m = fmaxf(m, __shfl_xor(m, 32));
    float lsum = 0.f;
#pragma unroll
    for (int i = 0; i < 8; ++i)
#pragma unroll
        for (int r = 0; r < 16; ++r) { const float pe = __expf(S[i][r] - m); S[i][r] = pe; lsum += pe; }
    lsum += __shfl_xor(lsum, 32);
    f32x16 O[4];
#pragma unroll
    for (int db = 0; db < 4; ++db)
#pragma unroll
        for (int r = 0; r < 16; ++r) O[db][r] = 0.f;
#pragma unroll
    for (int i = 0; i < 8; ++i)
#pragma unroll
        for (int s2 = 0; s2 < 2; ++s2) { const bf16x8 Pf = pack_step(S[i], s2); const int k0 = 32 * i + 16 * s2;
#pragma unroll
            for (int db = 0; db < 4; ++db) { const bf16x8 Vf = tr_frag(l3 + XA_VIMG + db * 16384, k0 + 4 * h, k0 + 8 + 4 * h, lane); O[db] = MFMA32(Vf, Pf, O[db]); } }
    const float inv = 1.f / lsum;
#pragma unroll
    for (int db = 0; db < 4; ++db)
#pragma unroll
        for (int gq = 0; gq < 4; ++gq) { uint2 w; w.x = pkbf(O[db][4 * gq] * inv, O[db][4 * gq + 1] * inv); w.y = pkbf(O[db][4 * gq + 2] * inv, O[db][4 * gq + 3] * inv);
            *(uint2*)(qptr + 32 * db + 8 * gq + 4 * h) = w; }
}


constexpr int ML_VIMG = 0, ML_T0 = 8192, ML_T1 = 8448, ML_T2 = 8704, ML_T3 = 8960;
__device__ __forceinline__ float log_sigmoid_f(float x) { return x >= 0.f ? -log1pf(expf(-x)) : x - log1pf(expf(x)); }
__device__ __forceinline__ void mlstm_gates_wave(const P& p, const LB& L, int l, int b, int c, int hh, int lane, float& bcum, float& ig) {
    const size_t row = (size_t)b * T + c * 64 + lane;
    ig = L.iff[row * 16 + hh] + p.b_i[l * 8 + hh];
    float v = log_sigmoid_f(L.iff[row * 16 + 8 + hh] + p.b_f[l * 8 + hh]);
#pragma unroll
    for (int o = 1; o < 64; o <<= 1) { const float t = __shfl_up(v, o); if (lane >= o) v += t; }
    bcum = v;
}
__device__ __forceinline__ void mlstm_stage_v(const LB& L, int b, int c, int hh, int lane, LAS unsigned char* wl) {
#pragma unroll
    for (int i = 0; i < 8; ++i) { const int s = (lane >> 3) + 8 * i, cc = lane & 7;
        const u32x4 v = *(const u32x4*)(L.mv + (size_t)(b * T + c * 64 + s) * 512 + hh * 64 + cc * 8);
        *(LAS u32x4*)(wl + ML_VIMG + (cc >> 2) * 4096 + s * 64 + (cc & 3) * 16) = v; }
}
__device__ __forceinline__ bf16x8 conv_frag_row(const bf16_t* xrow, int t_in_batch, const float* cw, float scale) {
    float a[8] = {0.f, 0.f, 0.f, 0.f, 0.f, 0.f, 0.f, 0.f};
#pragma unroll
    for (int tap = 0; tap < 4; ++tap) {
        if (t_in_batch - 3 + tap >= 0) {
            float xf[8]; unpack8(*(const uint4*)(xrow - (3 - tap) * 1024), xf);
            const f32x4 w0 = *(const f32x4*)(cw + tap * 1024), w1 = *(const f32x4*)(cw + tap * 1024 + 4);
            a[0] = fmaf(w0[0], xf[0], a[0]); a[1] = fmaf(w0[1], xf[1], a[1]); a[2] = fmaf(w0[2], xf[2], a[2]); a[3] = fmaf(w0[3], xf[3], a[3]);
            a[4] = fmaf(w1[0], xf[4], a[4]); a[5] = fmaf(w1[1], xf[5], a[5]); a[6] = fmaf(w1[2], xf[6], a[6]); a[7] = fmaf(w1[3], xf[7], a[7]);
        }
    }
#pragma unroll
    for (int j = 0; j < 8; ++j) a[j] = a[j] * scale * __builtin_amdgcn_rcpf(1.f + __expf(-a[j]));
    u32x4 w; w.x = pkbf(a[0], a[1]); w.y = pkbf(a[2], a[3]); w.z = pkbf(a[4], a[5]); w.w = pkbf(a[6], a[7]);
    return __builtin_bit_cast(bf16x8, w);
}
__device__ __forceinline__ void mlstm_A_mfma_unit(const P& p, const LB& L, int l, int u, LAS unsigned char* l3) {
    int tid_l = threadIdx.x; asm volatile("" : "+v"(tid_l)); const int tid = tid_l, lane = tid & 63, hh = tid >> 6, h = lane >> 5, ql = lane & 31;
    const int c = u & 31, b = u >> 5, uh = u * 8 + hh;
    LAS unsigned char* wl = l3 + hh * 16384;
    const float* cw = p.conv_w + (size_t)l * 4 * 1024;
    __syncthreads();
    float bcum, ig; mlstm_gates_wave(p, L, l, b, c, hh, lane, bcum, ig);
    const float g = __shfl(bcum, 63), alog = g - bcum + ig, ml = wave_max(alog);
    ((LAS float*)(wl + ML_T0))[lane] = __expf(alog - ml);
    mlstm_stage_v(L, b, c, hh, lane, wl);
    __syncthreads();
    f32x16 acc[2][2];
#pragma unroll
    for (int a = 0; a < 2; ++a)
#pragma unroll
        for (int d = 0; d < 2; ++d)
#pragma unroll
            for (int r = 0; r < 16; ++r) acc[a][d][r] = 0.f;
    float dnacc[2] = {0.f, 0.f};
#pragma unroll
    for (int ks = 0; ks < 4; ++ks) {
        const int s0 = 16 * ks + 8 * h;
        const f32x4 we0 = *(const LAS f32x4*)(wl + ML_T0 + s0 * 4), we1 = *(const LAS f32x4*)(wl + ML_T0 + s0 * 4 + 16);
        const float we[8] = {we0[0], we0[1], we0[2], we0[3], we1[0], we1[1], we1[2], we1[3]};
        bf16x8 WKf[2];
#pragma unroll
        for (int dkb = 0; dkb < 2; ++dkb) {
            const int ch = 512 + hh * 64 + 32 * dkb + ql;
            float x[11];
#pragma unroll
            for (int r = 0; r < 11; ++r) { const int tt = c * 64 + s0 - 3 + r; x[r] = tt >= 0 ? bf2f(L.mqk[(size_t)(b * T + tt) * 1024 + ch]) : 0.f; }
            const float w0 = cw[ch], w1 = cw[1024 + ch], w2 = cw[2048 + ch], w3 = cw[3072 + ch];
            float wk[8];
#pragma unroll
            for (int j = 0; j < 8; ++j) { const float cv = fmaf(w3, x[j + 3], fmaf(w2, x[j + 2], fmaf(w1, x[j + 1], w0 * x[j])));
                wk[j] = cv * 0.125f * __builtin_amdgcn_rcpf(1.f + __expf(-cv)) * we[j]; dnacc[dkb] += wk[j]; }
            u32x4 w; w.x = pkbf(wk[0], wk[1]); w.y = pkbf(wk[2], wk[3]); w.z = pkbf(wk[4], wk[5]); w.w = pkbf(wk[6], wk[7]);
            WKf[dkb] = __builtin_bit_cast(bf16x8, w);
        }
#pragma unroll
        for (int dvb = 0; dvb < 2; ++dvb) { const bf16x8 Vf = tr_frag(wl + ML_VIMG + dvb * 4096, s0, s0 + 4, lane);
#pragma unroll
            for (int dkb = 0; dkb < 2; ++dkb) acc[dkb][dvb] = MFMA32(WKf[dkb], Vf, acc[dkb][dvb]); }
    }
    float* st = L.state + (size_t)uh * 4096;
#pragma unroll
    for (int dkb = 0; dkb < 2; ++dkb)
#pragma unroll
        for (int dvb = 0; dvb < 2; ++dvb)
#pragma unroll
            for (int gq = 0; gq < 4; ++gq) { f32x4 v; v[0] = acc[dkb][dvb][4 * gq]; v[1] = acc[dkb][dvb][4 * gq + 1]; v[2] = acc[dkb][dvb][4 * gq + 2]; v[3] = acc[dkb][dvb][4 * gq + 3];
                *(f32x4*)(st + (32 * dvb + ql) * 64 + 32 * dkb + 8 * gq + 4 * h) = v; }
#pragma unroll
    for (int dkb = 0; dkb < 2; ++dkb) { const float t = dnacc[dkb] + __shfl_xor(dnacc[dkb], 32); if (h == 0) ws_f(p.ws, WS_DN)[(size_t)uh * 64 + 32 * dkb + ql] = t; }
    if (lane == 0) { ws_f(p.ws, WS_G)[uh] = g; ws_f(p.ws, WS_ML)[uh] = ml; }
}
__device__ __forceinline__ void mlstm_scan2_unit(const P& p, const LB& L, int u) {
    int tid_l = threadIdx.x; asm volatile("" : "+v"(tid_l)); const int tid = tid_l, bh = u >> 3, b = bh >> 3, hh = bh & 7, e = (u & 7) * 512 + tid;
    const bool first = (u & 7) == 0; const bool do_n = first && tid < 64;
    float *G = ws_f(p.ws, WS_G), *ML = ws_f(p.ws, WS_ML), *MIN = ws_f(p.ws, WS_MIN), *DN = ws_f(p.ws, WS_DN);
    float d[NCH], dn[NCH];
#pragma unroll
    for (int c = 0; c < NCH; ++c) { const int idx = (b * NCH + c) * 8 + hh; d[c] = L.state[(size_t)idx * 4096 + e]; dn[c] = do_n ? DN[(size_t)idx * 64 + tid] : 0.f; }
    float m = 0.f, C = 0.f, n = 0.f;
#pragma unroll
    for (int c = 0; c < NCH; ++c) { const int idx = (b * NCH + c) * 8 + hh; const float g = G[idx], ml = ML[idx], mn = fmaxf(g + m, ml), a = __expf(g + m - mn), sc = __expf(ml - mn);
        L.state[(size_t)idx * 4096 + e] = C; C = a * C + sc * d[c];
        if (do_n) { DN[(size_t)idx * 64 + tid] = n; n = a * n + sc * dn[c]; }
        if (first && tid == 0) MIN[idx] = m;
        m = mn; }
}
template <int TB>
__device__ __forceinline__ void mlstm_C_block(const P& p, const LB& L, int l, int b, int c, int hh, int uh, int lane, int h, int ql, LAS unsigned char* wl, const float* cw, bf16x8 (&Kf0)[4]) {
    bf16x8 Qf[4]; float qn = 0.f;
#pragma unroll
    for (int ks = 0; ks < 4; ++ks) { const int t = c * 64 + 32 * TB + ql, ch0 = hh * 64 + 16 * ks + 8 * h;
        Qf[ks] = conv_frag_row(L.mqk + (size_t)(b * T + t) * 1024 + ch0, t, cw + ch0, 1.f);
        const float* np_ = ws_f(p.ws, WS_DN) + (size_t)uh * 64 + 16 * ks + 8 * h; const f32x4 n0 = *(const f32x4*)np_, n1 = *(const f32x4*)(np_ + 4);
        float qv[8]; unpack8(__builtin_bit_cast(uint4, Qf[ks]), qv);
#pragma unroll
        for (int j = 0; j < 4; ++j) { qn = fmaf(qv[j], n0[j], qn); qn = fmaf(qv[j + 4], n1[j], qn); } }
    f32x16 S0, S1;
#pragma unroll
    for (int r = 0; r < 16; ++r) { S0[r] = 0.f; S1[r] = 0.f; }
#pragma unroll
    for (int ks = 0; ks < 4; ++ks) { const int ch0 = 512 + hh * 64 + 16 * ks + 8 * h;
        if (TB == 0) { const int s = c * 64 + ql; Kf0[ks] = conv_frag_row(L.mqk + (size_t)(b * T + s) * 1024 + ch0, s, cw + ch0, 0.125f); }
        S0 = MFMA32(Kf0[ks], Qf[ks], S0);
        if (TB == 1) { const int s = c * 64 + 32 + ql; const bf16x8 Kf = conv_frag_row(L.mqk + (size_t)(b * T + s) * 1024 + ch0, s, cw + ch0, 0.125f); S1 = MFMA32(Kf, Qf[ks], S1); } }
    const float Mt = ((const LAS float*)(wl + ML_T1))[32 * TB + ql];
    float dsum = 0.f;
#pragma unroll
    for (int gq = 0; gq < 4; ++gq) {
        const f32x4 a0 = *(const LAS f32x4*)(wl + ML_T0 + (8 * gq + 4 * h) * 4), a1 = *(const LAS f32x4*)(wl + ML_T0 + (32 + 8 * gq + 4 * h) * 4);
#pragma unroll
        for (int j = 0; j < 4; ++j) { const int r = 4 * gq + j, sl = 8 * gq + 4 * h + j;
            if (TB == 0) { const float v = sl <= ql ? S0[r] * __expf(a0[j] - Mt) : 0.f; S0[r] = v; dsum += v; }
            else { const float v0 = S0[r] * __expf(a0[j] - Mt); S0[r] = v0; const float v1 = sl <= ql ? S1[r] * __expf(a1[j] - Mt) : 0.f; S1[r] = v1; dsum += v0 + v1; } }
    }
    f32x16 acc[2];
#pragma unroll
    for (int d = 0; d < 2; ++d)
#pragma unroll
        for (int r = 0; r < 16; ++r) acc[d][r] = 0.f;
    const float* st = L.state + (size_t)uh * 4096;
#pragma unroll
    for (int ks = 0; ks < 4; ++ks)
#pragma unroll
        for (int dvb = 0; dvb < 2; ++dvb) { const float* cp = st + (32 * dvb + ql) * 64 + 16 * ks + 8 * h; const f32x4 c0 = *(const f32x4*)cp, c1 = *(const f32x4*)(cp + 4);
            u32x4 w; w.x = pkbf(c0[0], c0[1]); w.y = pkbf(c0[2], c0[3]); w.z = pkbf(c1[0], c1[1]); w.w = pkbf(c1[2], c1[3]);
            acc[dvb] = MFMA32(__builtin_bit_cast(bf16x8, w), Qf[ks], acc[dvb]); }
    const float iw = ((const LAS float*)(wl + ML_T2))[32 * TB + ql];
#pragma unroll
    for (int dvb = 0; dvb < 2; ++dvb)
#pragma unroll
        for (int r = 0; r < 16; ++r) acc[dvb][r] *= iw;
#pragma unroll
    for (int s2 = 0; s2 < 2; ++s2) {
        const bf16x8 P0 = pack_step(S0, s2), P1 = pack_step(S1, s2);
#pragma unroll
        for (int dvb = 0; dvb < 2; ++dvb) {
            acc[dvb] = MFMA32(tr_frag(wl + ML_VIMG + dvb * 4096, 16 * s2 + 4 * h, 16 * s2 + 8 + 4 * h, lane), P0, acc[dvb]);
            if (TB == 1) acc[dvb] = MFMA32(tr_frag(wl + ML_VIMG + dvb * 4096, 32 + 16 * s2 + 4 * h, 32 + 16 * s2 + 8 + 4 * h, lane), P1, acc[dvb]); }
    }
    dsum += __shfl_xor(dsum, 32); qn += __shfl_xor(qn, 32);
    const float den = dsum + iw * qn, mt = ((const LAS float*)(wl + ML_T3))[32 * TB + ql];
    const float sc = 1.f / fmaxf(fabsf(den), __expf(-mt));
    float sum = 0.f;
#pragma unroll
    for (int dvb = 0; dvb < 2; ++dvb)
#pragma unroll
        for (int r = 0; r < 16; ++r) { const float v = acc[dvb][r] * sc; acc[dvb][r] = v; sum += v; }
    sum += __shfl_xor(sum, 32); const float mu = sum * (1.f / 64.f);
    float var = 0.f;
#pragma unroll
    for (int dvb = 0; dvb < 2; ++dvb)
#pragma unroll
        for (int r = 0; r < 16; ++r) { const float dlt = acc[dvb][r] - mu; var += dlt * dlt; }
    var += __shfl_xor(var, 32); const float rstd = rsqrtf(var * (1.f / 64.f) + EPS);
    bf16_t* op = L.mo + (size_t)(b * T + c * 64 + 32 * TB + ql) * 512 + hh * 64;
#pragma unroll
    for (int dvb = 0; dvb < 2; ++dvb)
#pragma unroll
        for (int gq = 0; gq < 4; ++gq) { const int dv = 32 * dvb + 8 * gq + 4 * h; const f32x4 ng = *(const f32x4*)(p.norm_g + l * 512 + hh * 64 + dv);
            const uint2 mo = *(const uint2*)(op + dv);
            const float y0 = (acc[dvb][4 * gq] - mu) * rstd * ng[0] * __uint_as_float(mo.x << 16), y1 = (acc[dvb][4 * gq + 1] - mu) * rstd * ng[1] * __uint_as_float(mo.x & 0xffff0000u);
            const float y2 = (acc[dvb][4 * gq + 2] - mu) * rstd * ng[2] * __uint_as_float(mo.y << 16), y3 = (acc[dvb][4 * gq + 3] - mu) * rstd * ng[3] * __uint_as_float(mo.y & 0xffff0000u);
            uint2 w; w.x = pkbf(y0, y1); w.y = pkbf(y2, y3); *(uint2*)(op + dv) = w; }
}
__device__ __forceinline__ void mlstm_C_mfma_unit(const P& p, const LB& L, int l, int u, LAS unsigned char* l3) {
    int tid_l = threadIdx.x; asm volatile("" : "+v"(tid_l)); const int tid = tid_l, lane = tid & 63, hh = tid >> 6, h = lane >> 5, ql = lane & 31;
    const int c = u & 31, b = u >> 5, uh = u * 8 + hh;
    LAS unsigned char* wl = l3 + hh * 16384;
    const float* cw = p.conv_w + (size_t)l * 4 * 1024;
    __syncthreads();
    {
        float bcum, ig; mlstm_gates_wave(p, L, l, b, c, hh, lane, bcum, ig);
        const float a = ig - bcum; float v = a;
#pragma unroll
        for (int o = 1; o < 64; o <<= 1) { const float t = __shfl_up(v, o); if (lane >= o) v = fmaxf(v, t); }
        const float m_in = ws_f(p.ws, WS_MIN)[uh], Mt = fmaxf(v, m_in);
        ((LAS float*)(wl + ML_T0))[lane] = a; ((LAS float*)(wl + ML_T1))[lane] = Mt; ((LAS float*)(wl + ML_T2))[lane] = __expf(m_in - Mt); ((LAS float*)(wl + ML_T3))[lane] = bcum + Mt;
    }
    mlstm_stage_v(L, b, c, hh, lane, wl);
    __syncthreads();
    bf16x8 Kf0[4];
    mlstm_C_block<0>(p, L, l, b, c, hh, uh, lane, h, ql, wl, cw, Kf0);
    asm volatile("" ::: "memory");
    mlstm_C_block<1>(p, L, l, b, c, hh, uh, lane, h, ql, wl, cw, Kf0);
}

#define XB_TMO      128
#define XB_XCNT(j)  (256  + 64 * (j))
#define XB_XSUB(j)  (1280 + 64 * (j))
#define XB_XGEN(j)  (2304 + 64 * (j))
#define XB_TOP      3328
#define XB_TOPGEN   3392
#define XCD_BAR_WORDS 3456
#define XB_SPIN_CAP (1u << 18)

__device__ __forceinline__ unsigned xb_ld(unsigned* p)              { return __hip_atomic_load(p, __ATOMIC_RELAXED, __HIP_MEMORY_SCOPE_AGENT); }
__device__ __forceinline__ unsigned xb_add(unsigned* p, unsigned v) { return __hip_atomic_fetch_add(p, v, __ATOMIC_RELAXED, __HIP_MEMORY_SCOPE_AGENT); }
__device__ __forceinline__ unsigned xb_xcc_id() { return (unsigned)__builtin_amdgcn_s_getreg((3 << 11) | 20) & 0xFu; }
#define XB_SPIN(cond, bar) do { unsigned _sp = 0; while (cond) { __builtin_amdgcn_s_sleep(1); \
    if ((++_sp & 255u) == 0u) { if (xb_ld(&(bar)[XB_TMO])) break; if (_sp > XB_SPIN_CAP) { atomicAdd(&(bar)[XB_TMO], 1u); break; } } } } while (0)

struct XcdBarrier {
    unsigned* bar; unsigned x;
    volatile LAS unsigned* st;
};

__device__ __forceinline__ XcdBarrier xcd_barrier_post(unsigned* bar, volatile LAS unsigned* st) {
    XcdBarrier b; b.bar = bar; b.x = xb_xcc_id(); b.st = st;
    if (threadIdx.x == 0) (void)xb_add(&bar[XB_XCNT(b.x)], 1u);
    return b;
}
__device__ __forceinline__ void xcd_barrier_complete(unsigned* bar, unsigned x, unsigned& nloc, unsigned& nx) {
    const unsigned G = gridDim.x * gridDim.y * gridDim.z;
    unsigned sum, cnt, mine, sp = 0u;
    for (;;) {
        sum = 0u; cnt = 0u; mine = 0u;
#pragma unroll
        for (unsigned j = 0; j < 16; ++j) { const unsigned c = xb_ld(&bar[XB_XCNT(j)]); sum += c; cnt += (c > 0u) ? 1u : 0u; mine = (j == x) ? c : mine; }
        if (sum == G) break;
        __builtin_amdgcn_s_sleep(1);
        if ((++sp & 255u) == 0u) { if (xb_ld(&bar[XB_TMO])) break; if (sp > XB_SPIN_CAP) { atomicAdd(&bar[XB_TMO], 1u); break; } }
    }
    nloc = mine > 0u ? mine : 1u; nx = cnt > 0u ? cnt : 1u;
}

__device__ __forceinline__ void xcd_barrier(const XcdBarrier& b) {
    asm volatile("s_waitcnt vmcnt(0)" ::: "memory");
    __syncthreads();
    if (threadIdx.x == 0) {
        unsigned* bar = b.bar;
        __builtin_amdgcn_s_waitcnt(0);
        unsigned nloc = b.st[0], nx = b.st[1];
        if (nloc == 0u) { xcd_barrier_complete(bar, b.x, nloc, nx); b.st[0] = nloc; b.st[1] = nx; }
        const unsigned old = xb_add(&bar[XB_XSUB(b.x)], 1u);
        const unsigned gen = old / nloc;
        if (old + 1u == (gen + 1u) * nloc) {
            __builtin_amdgcn_fence(__ATOMIC_RELEASE, "agent");
            asm volatile("s_waitcnt vmcnt(0)" ::: "memory");
            const unsigned og = xb_add(&bar[XB_TOP], 1u);
            const unsigned tg = og / nx;
            if (og + 1u == (tg + 1u) * nx) xb_add(&bar[XB_TOPGEN], 1u);
            else XB_SPIN(xb_ld(&bar[XB_TOPGEN]) == tg, bar);
            __builtin_amdgcn_fence(__ATOMIC_ACQUIRE, "agent");
            xb_add(&bar[XB_XGEN(b.x)], 1u);
            asm volatile("s_waitcnt vmcnt(0)" ::: "memory");
        } else {
            XB_SPIN(xb_ld(&bar[XB_XGEN(b.x)]) == gen, bar);
            __builtin_amdgcn_fence(__ATOMIC_ACQUIRE, "agent");
            asm volatile("s_waitcnt vmcnt(0)" ::: "memory");
        }
    }
    __syncthreads();
}

__global__ void __launch_bounds__(512, 2) mk_fwd(P p) {
    extern __shared__ __attribute__((aligned(16))) unsigned char lds[];
    LAS unsigned char* l3 = (LAS unsigned char*)lds;
    float* fl = (float*)lds;
    const int G = gridDim.x, bx = blockIdx.x;
    if (threadIdx.x < 64) ((LAS unsigned*)(l3 + LDS_CTL))[threadIdx.x] = 0u;
    __syncthreads();
    (void)xcd_barrier_post((unsigned*)(p.ws + WS_BAR), (volatile LAS unsigned*)(l3 + LDS_CTL + 32));
#define GRID_BAR() do { XcdBarrier b_; b_.bar = (unsigned*)(p.ws + WS_BAR); b_.x = xb_xcc_id(); b_.st = (volatile LAS unsigned*)(l3 + LDS_CTL + 32); xcd_barrier(b_); } while (0)
#define WAVE_IDS() int tid_w = threadIdx.x; asm volatile("" : "+v"(tid_w)); const int lane = tid_w & 63, gw = bx * 8 + (tid_w >> 6), ngw = G * 8

    {
        for (int it = bx; it < 2 * CV_ITEMS_LAYER; it += G) convert_item(p, it, fl);
        WAVE_IDS();
        rowstat_rows(p.x, M, layer_buf(p.ws, 0).xbin, ws_f(p.ws, WS_ROWSS), gw, ngw, lane);
        rowstat_rows(p.mem, MM, (bf16_t*)(p.ws + WS_MEMB), ws_f(p.ws, WS_ROWSS_MEM), gw, ngw, lane);
    }
    GRID_BAR();

#pragma unroll 1
    for (int l = 0; l < 2; ++l) {
        {
            const LB L = layer_buf(p.ws, l);
            pg8::Gemm g{L.xbin, L.win, M, 6656, D};
            const int memA = (int)(((long long)(p.ws + WS_MEMB) - (long long)L.xbin) / (long long)(256 * D * 2));
            SchedRounds S{G, bx, 3, 0, 1, memA};
            EpiProjMK E{L, ws_f(p.ws, WS_ROWSS) + (size_t)(2 * l) * M, ws_f(p.ws, WS_ROWSS_MEM)};
            pg8::gemm_phase<EpiProjMK, SchedRounds, true, true>(l3, g, S, E);
        }
        GRID_BAR();
        {
            const LB L = layer_buf(p.ws, l);
            for (int u = bx; u < NB * 16 * 2; u += G) swa_mfma_unit(p, L, l, u, l3);
            for (int u = bx; u < NB * 4 * 8; u += G) xattn_mfma_unit(L, u, l3);
            for (int u = bx; u < NB * NCH; u += G) mlstm_A_mfma_unit(p, L, l, u, l3);
        }
        GRID_BAR();
        {
            const LB L = layer_buf(p.ws, l);
            for (int u = bx; u < 512; u += G) mlstm_scan2_unit(p, L, u);
        }
        GRID_BAR();
        {
            const LB L = layer_buf(p.ws, l);
            for (int u = bx; u < NB * NCH; u += G) mlstm_C_mfma_unit(p, L, l, u, l3);
        }
        GRID_BAR();
        {
            const LB L = layer_buf(p.ws, l);
            pg8::Gemm g{L.xbin, L.win, M, 6656, D};
            SchedRounds S{G, bx, 3, 13, 0, 0};
            EpiProjMK E{L, ws_f(p.ws, WS_ROWSS) + (size_t)(2 * l) * M, ws_f(p.ws, WS_ROWSS_MEM)};
            pg8::gemm_phase<EpiProjMK, SchedRounds, true, true>(l3, g, S, E);
        }
        GRID_BAR();
        {
            const LB L = layer_buf(p.ws, l);
            pg8::Gemm g{L.sq, L.wbr, 3 * M, 3 * D, 512};
            SchedMerged S{G, bx};
            EpiMergedMK E{L.gates, L.merged};
            pg8::gemm_phase<EpiMergedMK, SchedMerged, false, true>(l3, g, S, E);
        }
        GRID_BAR();
        {
            const LB L = layer_buf(p.ws, l);
            pg8::Gemm g{L.merged, L.wout, M, D, D};
            SchedRounds S{G, bx, 1, 0, 0, 0};
            EpiResidMK E{l == 0 ? p.x : p.out, p.out, L.xbmid, ws_f(p.ws, WS_ROWSS) + (size_t)(2 * l + 1) * M};
            pg8::gemm_phase<EpiResidMK, SchedRounds, false, true>(l3, g, S, E);
        }
        GRID_BAR();
        {
            const LB L = layer_buf(p.ws, l);
            pg8::Gemm g{L.xbmid, L.wff1, M, DFF, D};
            SchedRounds S{G, bx, 4, 0, 0, 0};
            EpiFF1MK E{L.hff, ws_f(p.ws, WS_ROWSS) + (size_t)(2 * l + 1) * M};
            pg8::gemm_phase<EpiFF1MK, SchedRounds, true, true>(l3, g, S, E);
        }
        GRID_BAR();
        {
            const LB L = layer_buf(p.ws, l);
            pg8::Gemm g{L.hff, L.wff2, M, D, DFF};
            SchedRounds S{G, bx, 1, 0, 0, 0};
            EpiResidMK E{p.out, p.out, L.xbnext, ws_f(p.ws, WS_ROWSS) + (size_t)(2 * l + 2) * M};
            pg8::gemm_phase<EpiResidMK, SchedRounds, false, true>(l3, g, S, E);
        }
        GRID_BAR();
    }
    {
        WAVE_IDS();
        finalnorm_rows(p.out, ws_f(p.ws, WS_ROWSS) + (size_t)4 * M, p.g_final, gw, ngw, lane);
    }
}
}

extern "C" void kernel_launch(void* const* d_in, const int* in_sizes, int n_in, void* d_out, int out_size, void* d_ws, size_t ws_size, hipStream_t stream) {
    static int grid = 0;
    if (grid == 0) {
        if (n_in != 20 || out_size != M * D || ws_size < WS_END) { fprintf(stderr, "kernel_launch: unexpected shapes (n_in %d out %d ws %zu)\n", n_in, out_size, ws_size); grid = -1; return; }
        int dev = 0, cus = 0, per_cu = 0;
        if (hipGetDevice(&dev) != hipSuccess || hipDeviceGetAttribute(&cus, hipDeviceAttributeMultiprocessorCount, dev) != hipSuccess) { fprintf(stderr, "kernel_launch: device query failed\n"); grid = -1; return; }
        if (hipFuncSetAttribute((const void*)mk_fwd, hipFuncAttributeMaxDynamicSharedMemorySize, LDS_BYTES) != hipSuccess) { fprintf(stderr, "kernel_launch: hipFuncSetAttribute failed\n"); grid = -1; return; }
        if (hipOccupancyMaxActiveBlocksPerMultiprocessor(&per_cu, (const void*)mk_fwd, 512, LDS_BYTES) != hipSuccess || per_cu < 1) { fprintf(stderr, "kernel_launch: occupancy query says %d blocks per CU\n", per_cu); grid = -1; return; }
        grid = cus;
    }
    if (grid < 0) return;
    P p{};
    const float** pf = (const float**)&p;
    for (int i = 0; i < 20; ++i) pf[i] = (const float*)d_in[i];
    p.out = (float*)d_out; p.ws = (unsigned char*)d_ws;
    if (hipMemsetAsync(d_ws, 0, WS_ZERO_BYTES, stream) != hipSuccess) { fprintf(stderr, "kernel_launch: memset failed\n"); return; }
    void* args[] = {&p};
    const hipError_t e = hipLaunchCooperativeKernel((const void*)mk_fwd, dim3(grid), dim3(512), args, LDS_BYTES, stream);
    if (e != hipSuccess) fprintf(stderr, "kernel_launch: cooperative launch failed: %s (grid %d)\n", hipGetErrorString(e), grid);
}
```

```cpp
#include <hip/hip_runtime.h>
#include <cstdio>
#include <cstdint>
#ifndef PROBE_MASK
#define PROBE_MASK 0
#endif

namespace pg8 {
#define PG8_LAS __attribute__((address_space(3)))
typedef unsigned short bf16_t;
typedef short bf16x8 __attribute__((ext_vector_type(8)));
typedef float f32x4 __attribute__((ext_vector_type(4)));
typedef unsigned u32x4 __attribute__((ext_vector_type(4)));
constexpr int BM = 256, BK = 64, HALF = 128, HTB = HALF * BK * 2  , STAGE_BYTES = 8 * HTB, NXCD = 8, WGM = 8;

__host__ __device__ __forceinline__ int lds_byte(int r, int c) { const int st = (r >> 4) * 2 + (c >> 5), rr = r & 15, cc = c & 31, ob = rr * 64 + cc * 2; return st * 1024 + (ob ^ (((ob >> 9) & 1) << 5)); }
__host__ __device__ __forceinline__ void stage_rc(int b, int& R, int& C) { const int st = b / 1024, sb = b % 1024, swz = sb ^ (((sb >> 9) & 1) << 5); R = (st >> 1) * 16 + swz / 64; C = (st & 1) * 32 + (swz % 64) / 2; }
__host__ __device__ __forceinline__ int perm32(int rho) { const int n = rho >> 4, i = rho & 15; return 8 * (i >> 2) + 4 * n + (i & 3); }
struct Unit { int pm, pn, rm, kind, asel; };
struct Gemm { const bf16_t* A; const bf16_t* Bt; int M, N, K; const bf16_t* A2; };
__device__ __forceinline__ unsigned cvt_pk_bf16(float lo, float hi) { unsigned r; asm volatile("v_cvt_pk_bf16_f32 %0, %1, %2" : "=v"(r) : "v"(lo), "v"(hi)); return r; }
template <class Epi, class Sched, bool ALIGN_EPI = false, bool SP2 = false>
__device__ __forceinline__ void gemm_phase(PG8_LAS unsigned char* lds, const Gemm g, const Sched& S, const Epi& E) {
    int tid_l = threadIdx.x; asm volatile("" : "+v"(tid_l));
    const int tid = tid_l, wid = __builtin_amdgcn_readfirstlane(tid >> 6), lane = tid & 63, wr = wid >> 2, wc = wid & 3, fr = lane & 15, fq = lane >> 4;
    const int K = g.K, nt = K / BK;
    unsigned voffA[2], voffB[2];
#pragma unroll
    for (int i = 0; i < 2; ++i) { int R, C; stage_rc(tid * 16 + i * 8192, R, C); const int Rb = Epi::PERM ? ((R & ~31) + perm32(R & 31)) : R;
        voffA[i] = (unsigned)(R * K + C) * 2u; voffB[i] = (unsigned)(Rb * K + C) * 2u; }
    const size_t kstep = (size_t)(BK * 2);
    const size_t hstep = (size_t)HALF * K * 2;
    const size_t tstep = 2 * hstep;
    const unsigned ldsw = (unsigned)wid * 1024u;
    const int aoff = lds_byte(wr * 64 + fr, fq * 8), boff = lds_byte(wc * 32 + fr, fq * 8);
#define PG8_SA(b, h) (((b) * 2 + (h)) * HTB)
#define PG8_SB(b, h) ((4 + (b) * 2 + (h)) * HTB)
#define PG8_STAGE(bufoff, gbase, voff) do { _Pragma("unroll") for (int _i = 0; _i < 2; ++_i) \
        __builtin_amdgcn_global_load_lds((const unsigned*)((const char*)(gbase) + (voff)[_i]), (PG8_LAS unsigned*)(lds + (bufoff) + ldsw + _i * 8192), 16, 0, 0); } while (0)
#define PG8_LDA(dst, b, h) do { _Pragma("unroll") for (int m = 0; m < 4; ++m) _Pragma("unroll") for (int k = 0; k < 2; ++k) dst[m][k] = *(const PG8_LAS bf16x8*)(lds + PG8_SA(b, h) + aoff + m * 2048 + k * 1024); } while (0)
#define PG8_LDB(dst, b, h) do { _Pragma("unroll") for (int n = 0; n < 2; ++n) _Pragma("unroll") for (int k = 0; k < 2; ++k) dst[n][k] = *(const PG8_LAS bf16x8*)(lds + PG8_SB(b, h) + boff + n * 2048 + k * 1024); } while (0)
#define PG8_MMA(ai, bj, At, Bt) do { __builtin_amdgcn_s_setprio(1); _Pragma("unroll") for (int m = 0; m < 4; ++m) _Pragma("unroll") for (int n = 0; n < 2; ++n) _Pragma("unroll") for (int k = 0; k < 2; ++k) \
        acc[ai][bj][m][n] = __builtin_amdgcn_mfma_f32_16x16x32_bf16(Bt[n][k], At[m][k], acc[ai][bj][m][n], 0, 0, 0); __builtin_amdgcn_s_setprio(0); } while (0)
#define PG8_WAIT_V(n) asm volatile("s_waitcnt vmcnt(" #n ")" ::: "memory")
#define PG8_WAIT_L(n) asm volatile("s_waitcnt lgkmcnt(" #n ")" ::: "memory")
#define PG8_BAR __builtin_amdgcn_s_barrier()
#define PG8_SCHED __builtin_amdgcn_sched_barrier(0)
    Unit cur, nxt; int ui = 0;
    if (!S.next(0, cur)) return;
    f32x4 acc[2][2][4][2];
#pragma unroll
    for (int a = 0; a < 2; ++a)
#pragma unroll
        for (int b = 0; b < 2; ++b)
#pragma unroll
            for (int m = 0; m < 4; ++m)
#pragma unroll
                for (int n = 0; n < 2; ++n) acc[a][b][m][n] = (f32x4){0.f, 0.f, 0.f, 0.f};
    bf16x8 At[4][2], B0[2][2], B1[2][2];
    const char* cA = (const char*)(cur.asel ? g.A2 : g.A) + (size_t)cur.pm * tstep; const char* cB = (const char*)g.Bt + (size_t)cur.pn * tstep;
    S.a_ready(cur);
    if constexpr (SP2) {
        PG8_STAGE(PG8_SB(0, 0), cB, voffB); PG8_STAGE(PG8_SB(0, 1), cB + hstep, voffB); PG8_STAGE(PG8_SA(0, 0), cA, voffA); PG8_STAGE(PG8_SA(0, 1), cA + hstep, voffA);
        if (wr == 1) PG8_BAR;
        PG8_WAIT_V(2); PG8_BAR;
        PG8_STAGE(PG8_SB(1, 0), cB + kstep, voffB); PG8_STAGE(PG8_SA(1, 0), cA + kstep, voffA); PG8_STAGE(PG8_SB(1, 1), cB + hstep + kstep, voffB);
        PG8_WAIT_V(6); PG8_BAR;
    } else {
        PG8_STAGE(PG8_SB(0, 0), cB, voffB); PG8_STAGE(PG8_SA(0, 0), cA, voffA); PG8_STAGE(PG8_SB(0, 1), cB + hstep, voffB); PG8_STAGE(PG8_SA(0, 1), cA + hstep, voffA);
        if (wr == 1) PG8_BAR;
        PG8_WAIT_V(4); PG8_BAR;
        PG8_STAGE(PG8_SB(1, 0), cB + kstep, voffB); PG8_STAGE(PG8_SA(1, 0), cA + kstep, voffA); PG8_STAGE(PG8_SB(1, 1), cB + hstep + kstep, voffB);
        PG8_WAIT_V(6); PG8_BAR;
    }
    for (;;) {
        const bool has_next = S.next(ui + 1, nxt);
        const char* nA = has_next ? (const char*)(nxt.asel ? g.A2 : g.A) + (size_t)nxt.pm * tstep : cA; const char* nB = has_next ? (const char*)g.Bt + (size_t)nxt.pn * tstep : cB;
        for (int t = 0; t < nt; t += 2) {
            const bool last = (t == nt - 2);
            const char* a1 = cA + (size_t)(t + 1) * kstep;
            const char* a2 = last ? nA : cA + (size_t)(t + 2) * kstep; const char* b2 = last ? nB : cB + (size_t)(t + 2) * kstep;
            const char* a3 = a2 + kstep; const char* b3 = b2 + kstep;
            if (last && has_next) S.a_ready(nxt);
            if constexpr (SP2) {
            PG8_LDB(B0, 0, 0); PG8_LDB(B1, 0, 1); PG8_SCHED; PG8_LDA(At, 0, 0); PG8_STAGE(PG8_SA(1, 1), a1 + hstep, voffA);
            PG8_WAIT_V(8); PG8_WAIT_L(0); PG8_BAR; PG8_MMA(0, 0, At, B0); PG8_MMA(0, 1, At, B1); PG8_BAR; PG8_SCHED;
            PG8_LDA(At, 0, 1); PG8_STAGE(PG8_SB(0, 0), b2, voffB); PG8_STAGE(PG8_SB(0, 1), b2 + hstep, voffB); PG8_STAGE(PG8_SA(0, 0), a2, voffA);
            PG8_WAIT_V(8); PG8_WAIT_L(0); PG8_BAR; PG8_MMA(1, 0, At, B0); PG8_MMA(1, 1, At, B1); PG8_BAR; PG8_SCHED;
            PG8_LDB(B0, 1, 0); PG8_LDB(B1, 1, 1); PG8_SCHED; PG8_LDA(At, 1, 0); PG8_STAGE(PG8_SA(0, 1), a2 + hstep, voffA);
            PG8_WAIT_V(8); PG8_WAIT_L(0); PG8_BAR; PG8_MMA(0, 0, At, B0); PG8_MMA(0, 1, At, B1); PG8_BAR; PG8_SCHED;
            PG8_LDA(At, 1, 1); PG8_STAGE(PG8_SB(1, 0), b3, voffB); PG8_STAGE(PG8_SB(1, 1), b3 + hstep, voffB); PG8_STAGE(PG8_SA(1, 0), a3, voffA);
            PG8_WAIT_V(8); PG8_WAIT_L(0); PG8_BAR; PG8_MMA(1, 0, At, B0); PG8_MMA(1, 1, At, B1); PG8_BAR; PG8_SCHED;
            } else {
            PG8_LDB(B0, 0, 0); PG8_SCHED; PG8_LDA(At, 0, 0); PG8_STAGE(PG8_SA(1, 1), a1 + hstep, voffA);
            PG8_WAIT_L(8); PG8_BAR; PG8_WAIT_L(0); PG8_MMA(0, 0, At, B0); PG8_BAR; PG8_SCHED;
            PG8_LDB(B1, 0, 1); PG8_STAGE(PG8_SB(0, 0), b2, voffB);
            PG8_BAR; PG8_WAIT_L(0); PG8_MMA(0, 1, At, B1); PG8_BAR;
            PG8_LDA(At, 0, 1); PG8_STAGE(PG8_SA(0, 0), a2, voffA);
            PG8_BAR; PG8_WAIT_L(0); PG8_MMA(1, 0, At, B0); PG8_BAR; PG8_SCHED;
            PG8_STAGE(PG8_SB(0, 1), b2 + hstep, voffB);
            PG8_WAIT_V(6); PG8_BAR; PG8_MMA(1, 1, At, B1); PG8_BAR;
            PG8_LDB(B0, 1, 0); PG8_SCHED; PG8_LDA(At, 1, 0); PG8_STAGE(PG8_SA(0, 1), a2 + hstep, voffA);
            PG8_WAIT_L(8); PG8_BAR; PG8_WAIT_L(0); PG8_MMA(0, 0, At, B0); PG8_BAR; PG8_SCHED;
            PG8_LDB(B1, 1, 1); PG8_STAGE(PG8_SB(1, 0), b3, voffB);
            PG8_BAR; PG8_WAIT_L(0); PG8_MMA(0, 1, At, B1); PG8_BAR;
            PG8_LDA(At, 1, 1); PG8_STAGE(PG8_SA(1, 0), a3, voffA);
            PG8_BAR; PG8_WAIT_L(0); PG8_MMA(1, 0, At, B0); PG8_BAR; PG8_SCHED;
            PG8_STAGE(PG8_SB(1, 1), b3 + hstep, voffB);
            PG8_WAIT_V(6); PG8_BAR; PG8_MMA(1, 1, At, B1); PG8_BAR;
            }
        }
        if constexpr (ALIGN_EPI) { if (wr == 0) PG8_BAR; }
        if constexpr (!Epi::AFTER_DRAIN) { E(acc, cur, wr, wc, fr, fq); S.done(cur); }
        const bool keep_acc = E.keep(cur);
        if (!has_next) break;
        if (!keep_acc) {
#pragma unroll
        for (int a = 0; a < 2; ++a)
#pragma unroll
            for (int b = 0; b < 2; ++b)
#pragma unroll
                for (int m = 0; m < 4; ++m)
#pragma unroll
                    for (int n = 0; n < 2; ++n) acc[a][b][m][n] = (f32x4){0.f, 0.f, 0.f, 0.f};
        }
        cur = nxt; cA = nA; cB = nB; ++ui;
        if constexpr (ALIGN_EPI) { if (wr == 1) PG8_BAR; }
    }
    PG8_WAIT_V(0);
    if constexpr (!ALIGN_EPI) { if (wr == 0) PG8_BAR; }
    PG8_BAR;
    if constexpr (Epi::AFTER_DRAIN) { E.fused(acc, cur, wr, wc, fr, fq, lds, wid, lane); S.done(cur); }
#undef PG8_SA
#undef PG8_SB
#undef PG8_STAGE
#undef PG8_LDA
#undef PG8_LDB
#undef PG8_MMA
#undef PG8_WAIT_V
#undef PG8_WAIT_L
#undef PG8_BAR
#undef PG8_SCHED
}
}

namespace {
using pg8::bf16_t; using pg8::f32x4; using pg8::u32x4; using pg8::Unit;
#define LAS __attribute__((address_space(3)))
constexpr int M = 16384, D = 1024, T = 2048, NB = 8, MEMLEN = 256, MM = NB * MEMLEN;
constexpr int INC = 6416, DFF = 4096, NCH = 32, NH = 8;
constexpr float EPS = 1e-6f;
constexpr size_t MiB = 1u << 20;
constexpr size_t WS_POOL_C = 77u << 20;
constexpr size_t WS_BAR = 0;
constexpr size_t WS_ROWSS = WS_POOL_C + 142 * (1u << 20);
constexpr size_t WS_ZERO_BYTES = 64 * 1024;
constexpr size_t WS_ROWSS_MEM = WS_POOL_C + 141 * (1u << 20);
constexpr size_t WS_G = 400 * 1024, WS_ML = 408 * 1024, WS_MIN = 416 * 1024;
constexpr size_t WS_DN = 512 * 1024;
constexpr size_t WS_WT = 1 * MiB;
constexpr size_t WT_WIN = 0, WT_WMEM = (size_t)6656 * D * 2, WT_WBR = WT_WMEM + (size_t)D * D * 2, WT_WOUT = WT_WBR + (size_t)3 * D * 512 * 2,
                 WT_FF1 = WT_WOUT + (size_t)D * D * 2, WT_FF2 = WT_FF1 + (size_t)DFF * D * 2, WT_LAYER = WT_FF2 + (size_t)D * DFF * 2;
constexpr size_t WS_MEMB = 73 * MiB, WS_POOL = 77 * MiB, WS_END = 256 * MiB;
static_assert(WS_WT + 2 * WT_LAYER <= WS_MEMB && WS_POOL_C == WS_POOL, "weights fit");
constexpr int LDS_RING = 131072, LDS_BYTES = 147456, LDS_CTL = LDS_BYTES - 256;

struct P {
    const float *x, *mem, *rel_bias, *g_mix, *w_in, *conv_w, *b_i, *b_f, *norm_g, *sinks, *g_mem, *w_mem_kv, *w_br0, *w_br1, *w_br2, *w_out, *g_ffn, *w_ff1, *w_ff2, *g_final;
    float* out; unsigned char* ws;
};
struct LB {
    bf16_t *xbin, *sq, *mo, *xq, *skv, *mqk, *mv, *memkv, *merged, *xbmid, *hff, *xbnext;
    unsigned char* gates;
    float *iff, *state;
    const bf16_t *win, *wmem, *wbr, *wout, *wff1, *wff2;
};
__host__ __device__ inline LB layer_buf(unsigned char* ws, float* out, int l) {
    LB b; unsigned char* pool = ws + WS_POOL; unsigned char* breg = pool;
    b.xbin = (bf16_t*)out; b.xbmid = (bf16_t*)((unsigned char*)out + 32 * MiB); b.xbnext = l == 1 ? (bf16_t*)(pool + 147 * MiB) : (bf16_t*)out;
    b.merged = (bf16_t*)(pool + 147 * MiB); b.hff = (bf16_t*)pool;
    b.sq = (bf16_t*)breg; b.mo = (bf16_t*)(breg + 16 * MiB); b.xq = (bf16_t*)(breg + 32 * MiB);
    b.gates = breg + 48 * MiB;
    b.skv = (bf16_t*)(breg + 48 * MiB); b.mqk = (bf16_t*)(breg + 56 * MiB); b.mv = (bf16_t*)(breg + 88 * MiB);
    b.iff = (float*)(breg + 104 * MiB); b.memkv = (bf16_t*)(breg + 105 * MiB); b.state = (float*)(breg + 109 * MiB);
    unsigned char* wt = ws + WS_WT + (size_t)l * WT_LAYER;
    b.win = (const bf16_t*)(wt + WT_WIN); b.wmem = (const bf16_t*)(wt + WT_WMEM); b.wbr = (const bf16_t*)(wt + WT_WBR);
    b.wout = (const bf16_t*)(wt + WT_WOUT); b.wff1 = (const bf16_t*)(wt + WT_FF1); b.wff2 = (const bf16_t*)(wt + WT_FF2);
    return b;
}
__device__ __forceinline__ float* ws_f(unsigned char* ws, size_t off) { return (float*)(ws + off); }

__device__ __forceinline__ float bf2f(bf16_t h) { return __uint_as_float(((unsigned)h) << 16); }
__device__ __forceinline__ bf16_t f2bf(float f) { unsigned u = __float_as_uint(f); u = (u + 0x7fffu + ((u >> 16) & 1u)) >> 16; return (bf16_t)u; }
__device__ __forceinline__ unsigned pk2(float lo, float hi) { return (unsigned)f2bf(lo) | ((unsigned)f2bf(hi) << 16); }
__device__ __forceinline__ float sigmoidf_(float v) { return 1.f / (1.f + expf(-v)); }
__device__ __forceinline__ float fsigmoid(float v) { return __builtin_amdgcn_rcpf(1.f + __expf(-v)); }
__device__ __forceinline__ float wave_sum(float v) {
#pragma unroll
    for (int o = 1; o < 64; o <<= 1) v += __shfl_xor(v, o);
    return v;
}
__device__ __forceinline__ float wave_max(float v) {
#pragma unroll
    for (int o = 1; o < 64; o <<= 1) v = fmaxf(v, __shfl_xor(v, o));
    return v;
}
__device__ __forceinline__ void unpack8(const uint4 a, float (&f)[8]) {
    f[0] = __uint_as_float(a.x << 16); f[1] = __uint_as_float(a.x & 0xffff0000u); f[2] = __uint_as_float(a.y << 16); f[3] = __uint_as_float(a.y & 0xffff0000u);
    f[4] = __uint_as_float(a.z << 16); f[5] = __uint_as_float(a.z & 0xffff0000u); f[6] = __uint_as_float(a.w << 16); f[7] = __uint_as_float(a.w & 0xffff0000u);
}
__device__ const unsigned char T5_BUCKET[128] = {0, 1, 2, 3, 4, 5, 6, 7, 8, 9, 10, 11, 12, 13, 14, 15, 16, 16, 16, 17, 17, 18, 18, 18, 19, 19, 19, 20, 20, 20, 20, 21, 21, 21, 21, 22, 22, 22, 22, 22, 23, 23, 23, 23, 23, 23, 24, 24, 24, 24, 24, 24, 25, 25, 25, 25, 25, 25, 25, 26, 26, 26, 26, 26, 26, 26, 26, 27, 27, 27, 27, 27, 27, 27, 27, 27, 27, 28, 28, 28, 28, 28, 28, 28, 28, 28, 28, 29, 29, 29, 29, 29, 29, 29, 29, 29, 29, 29, 29, 30, 30, 30, 30, 30, 30, 30, 30, 30, 30, 30, 30, 30, 30, 31, 31, 31, 31, 31, 31, 31, 31, 31, 31, 31, 31, 31, 31, 31};

__device__ __forceinline__ float rstd_of(const float* rp, int row) {
    const f32x4* q = (const f32x4*)(rp + (size_t)row * 16); const f32x4 a = q[0], b = q[1], c = q[2], d = q[3];
    const float ss = ((a[0] + a[1]) + (a[2] + a[3])) + ((b[0] + b[1]) + (b[2] + b[3])) + (((c[0] + c[1]) + (c[2] + c[3])) + ((d[0] + d[1]) + (d[2] + d[3])));
    return rsqrtf(ss * (1.f / D) + EPS);
}
struct SchedRounds {
    int G, c, nfull, pn_base, tail;
    __device__ __forceinline__ bool next(int i, Unit& u) const {
        const int L = i * G + c;
        if (L < nfull * 256) { const int r = L >> 8, w = L & 255, x = w & 7, j = w >> 3; u.pm = u.rm = 8 * x + (j & 7); u.pn = pn_base + 4 * r + (j >> 3); u.kind = 0; u.asel = 0; return true; }
        if (!tail) return false;
        const int t = L - nfull * 256;
        if (t < 64) { u.pm = u.rm = t; u.pn = 12; u.kind = 0; u.asel = 0; return true; }
        if (t < 128) { u.pm = u.rm = t - 64; u.pn = 25; u.kind = 0; u.asel = 0; return true; }
        if (t < 160) { const int q = t - 128; u.pm = u.rm = q >> 2; u.pn = 26 + (q & 3); u.kind = 1; u.asel = 1; return true; }
        return false;
    }
    __device__ __forceinline__ void a_ready(const Unit&) const {}
    __device__ __forceinline__ void done(const Unit&) const {}
};
struct SchedMerged {
    int G, c;
    __device__ __forceinline__ bool next(int i, Unit& u) const {
        const int tt = (i / 3) * G + c, seg = i % 3; if (tt >= 256) return false;
        const int x = tt & 7, j = tt >> 3; u.rm = 8 * x + (j & 7); u.pm = seg * 64 + u.rm; u.pn = seg * 4 + (j >> 3); u.kind = seg; u.asel = 0; return true;
    }
    __device__ __forceinline__ void a_ready(const Unit&) const {}
    __device__ __forceinline__ void done(const Unit&) const {}
};

__device__ __forceinline__ u32x4 pack8(f32x4 a, f32x4 b) { u32x4 w; w.x = pg8::cvt_pk_bf16(a[0], a[1]); w.y = pg8::cvt_pk_bf16(a[2], a[3]); w.z = pg8::cvt_pk_bf16(b[0], b[1]); w.w = pg8::cvt_pk_bf16(b[2], b[3]); return w; }
__device__ __forceinline__ f32x4 sig4(f32x4 v) { f32x4 r; r[0] = fsigmoid(v[0]); r[1] = fsigmoid(v[1]); r[2] = fsigmoid(v[2]); r[3] = fsigmoid(v[3]); return r; }
struct EpiProjMK {
    static constexpr bool PERM = true, AFTER_DRAIN = false;
    LB L; const float* rowss; const float* rowss_mem;
    __device__ __forceinline__ bool keep(const Unit&) const { return false; }
    __device__ __forceinline__ void operator()(f32x4 (&acc)[2][2][4][2], const Unit& u, int wr, int wc, int fr, int fq) const {
        const int rbase = u.rm * 256 + wr * 64 + fr, cin = wc * 32 + 8 * fq;
        const float* rs = rowss; bf16_t* dst; int ld, coff; bool sig = false; const int tile = u.pn;
        if (u.kind == 1) { rs = rowss_mem; dst = L.memkv; ld = 1024; coff = (tile - 26) * 256; }
        else if (tile < 2) { dst = L.sq; ld = 512; coff = tile * 256; }
        else if (tile < 3) { dst = L.skv; ld = 256; coff = 0; }
        else if (tile < 7) { dst = L.mqk; ld = 1024; coff = (tile - 3) * 256; }
        else if (tile < 9) { dst = L.mv; ld = 512; coff = (tile - 7) * 256; }
        else if (tile < 11) { dst = L.mo; ld = 512; coff = (tile - 9) * 256; sig = true; }
        else if (tile < 13) { dst = L.xq; ld = 512; coff = (tile - 11) * 256; }
        else { dst = nullptr; ld = 0; coff = 0; }
#pragma unroll
        for (int ai = 0; ai < 2; ++ai)
#pragma unroll
            for (int m = 0; m < 4; ++m) {
                const int row = rbase + ai * 128 + m * 16; const float rstd = rstd_of(rs, row);
#pragma unroll
                for (int bj = 0; bj < 2; ++bj) {
                    f32x4 v0 = acc[ai][bj][m][0] * rstd, v1 = acc[ai][bj][m][1] * rstd;
                    if (dst) { if (sig) { v0 = sig4(v0); v1 = sig4(v1); }
                        *(u32x4*)(dst + (size_t)row * ld + coff + bj * 128 + cin) = pack8(v0, v1); }
                    else if (tile < 25) {
                        v0 = sig4(v0) * 256.f; v1 = sig4(v1) * 256.f; uint2 w;
                        w.x = (unsigned)fminf(v0[0], 255.f) | ((unsigned)fminf(v0[1], 255.f) << 8) | ((unsigned)fminf(v0[2], 255.f) << 16) | ((unsigned)fminf(v0[3], 255.f) << 24);
                        w.y = (unsigned)fminf(v1[0], 255.f) | ((unsigned)fminf(v1[1], 255.f) << 8) | ((unsigned)fminf(v1[2], 255.f) << 16) | ((unsigned)fminf(v1[3], 255.f) << 24);
                        *(uint2*)(L.gates + (size_t)row * 3072 + (tile - 13) * 256 + bj * 128 + cin) = w; }
                    else if (bj == 0 && cin < 16) { *(f32x4*)(L.iff + (size_t)row * 16 + cin) = v0; *(f32x4*)(L.iff + (size_t)row * 16 + cin + 4) = v1; }
                }
            }
    }
};
struct EpiMergedMK {
    static constexpr bool PERM = true, AFTER_DRAIN = false;
    const unsigned char* gates; bf16_t* merged;
    __device__ __forceinline__ bool keep(const Unit& u) const { return u.kind < 2; }
    __device__ __forceinline__ static void deq8(uint2 w, float (&g)[8]) {
        g[0] = (float)(w.x & 255u) + 0.5f; g[1] = (float)((w.x >> 8) & 255u) + 0.5f; g[2] = (float)((w.x >> 16) & 255u) + 0.5f; g[3] = (float)(w.x >> 24) + 0.5f;
        g[4] = (float)(w.y & 255u) + 0.5f; g[5] = (float)((w.y >> 8) & 255u) + 0.5f; g[6] = (float)((w.y >> 16) & 255u) + 0.5f; g[7] = (float)(w.y >> 24) + 0.5f; }
    __device__ __forceinline__ void operator()(f32x4 (&acc)[2][2][4][2], const Unit& u, int wr, int wc, int fr, int fq) const {
        const int rbase = u.rm * 256 + wr * 64 + fr, col0 = (u.pn & 3) * 256 + wc * 32 + 8 * fq, seg = u.kind;
#pragma unroll
        for (int ai = 0; ai < 2; ++ai)
#pragma unroll
            for (int m = 0; m < 4; ++m) {
                const int row = rbase + ai * 128 + m * 16;
#pragma unroll
                for (int bj = 0; bj < 2; ++bj) {
                    const int col = col0 + bj * 128;
                    float g[8]; deq8(*(const uint2*)(gates + (size_t)row * 3072 + seg * 1024 + col), g);
                    if (seg < 2) { float gn[8]; deq8(*(const uint2*)(gates + (size_t)row * 3072 + (seg + 1) * 1024 + col), gn);
#pragma unroll
                        for (int j = 0; j < 8; ++j) g[j] = g[j] * __builtin_amdgcn_rcpf(gn[j]); }
                    else {
#pragma unroll
                        for (int j = 0; j < 8; ++j) g[j] *= (1.f / 256.f); }
                    f32x4 v0 = acc[ai][bj][m][0], v1 = acc[ai][bj][m][1];
                    v0[0] *= g[0]; v0[1] *= g[1]; v0[2] *= g[2]; v0[3] *= g[3]; v1[0] *= g[4]; v1[1] *= g[5]; v1[2] *= g[6]; v1[3] *= g[7];
                    acc[ai][bj][m][0] = v0; acc[ai][bj][m][1] = v1;
                    if (seg == 2) *(u32x4*)(merged + (size_t)row * D + col) = pack8(v0, v1);
                }
            }
    }
};
struct EpiResidMK {
    static constexpr bool PERM = true, AFTER_DRAIN = false;
    const bf16_t* xold; bf16_t* xnew; float* rowss;
    __device__ __forceinline__ bool keep(const Unit&) const { return false; }
    __device__ __forceinline__ void operator()(f32x4 (&acc)[2][2][4][2], const Unit& u, int wr, int wc, int fr, int fq) const {
        const int rbase = u.rm * 256 + wr * 64 + fr, col0 = u.pn * 256 + wc * 32 + 8 * fq;
#pragma unroll
        for (int ai = 0; ai < 2; ++ai)
#pragma unroll
            for (int m = 0; m < 4; ++m) {
                const int row = rbase + ai * 128 + m * 16; const size_t off = (size_t)row * D + col0; float ss = 0.f;
#pragma unroll
                for (int bj = 0; bj < 2; ++bj) {
                    float o[8]; unpack8(*(const uint4*)(xold + off + bj * 128), o);
                    f32x4 v0 = acc[ai][bj][m][0], v1 = acc[ai][bj][m][1];
                    v0[0] += o[0]; v0[1] += o[1]; v0[2] += o[2]; v0[3] += o[3]; v1[0] += o[4]; v1[1] += o[5]; v1[2] += o[6]; v1[3] += o[7];
                    const u32x4 w = pack8(v0, v1); *(u32x4*)(xnew + off + bj * 128) = w;
                    float r[8]; unpack8(__builtin_bit_cast(uint4, w), r);
#pragma unroll
                    for (int j = 0; j < 8; ++j) ss = fmaf(r[j], r[j], ss);
                }
                ss += __shfl_xor(ss, 16); ss += __shfl_xor(ss, 32);
                if (fq == 0) rowss[(size_t)row * 16 + (u.pn & 3) * 4 + wc] = ss;
            }
    }
};
struct EpiFF1MK {
    static constexpr bool PERM = true, AFTER_DRAIN = false;
    bf16_t* h; const float* rowss;
    __device__ __forceinline__ bool keep(const Unit&) const { return false; }
    __device__ __forceinline__ void operator()(f32x4 (&acc)[2][2][4][2], const Unit& u, int wr, int wc, int fr, int fq) const {
        const int rbase = u.rm * 256 + wr * 64 + fr, col0 = u.pn * 256 + wc * 32 + 8 * fq;
#pragma unroll
        for (int ai = 0; ai < 2; ++ai)
#pragma unroll
            for (int m = 0; m < 4; ++m) {
                const int row = rbase + ai * 128 + m * 16; const float rstd = rstd_of(rowss, row);
#pragma unroll
                for (int bj = 0; bj < 2; ++bj) {
                    f32x4 v0 = acc[ai][bj][m][0] * rstd, v1 = acc[ai][bj][m][1] * rstd;
#pragma unroll
                    for (int j = 0; j < 4; ++j) { v0[j] = fmaxf(v0[j], 0.f); v0[j] *= v0[j]; v1[j] = fmaxf(v1[j], 0.f); v1[j] *= v1[j]; }
                    *(u32x4*)(h + (size_t)row * DFF + col0 + bj * 128) = pack8(v0, v1);
                }
            }
    }
};

__device__ __forceinline__ void convert_tile_w(const float* src, int ldsrc, int col0, int ncols, int k0, const float* gain, float scale, bf16_t* dst, int K, float* tile, int lane) {
    const int n4 = (lane & 7) * 4;
#pragma unroll
    for (int i = 0; i < 8; ++i) { const int kk = (lane >> 3) + 8 * i; f32x4 v = (f32x4){0.f, 0.f, 0.f, 0.f};
        if (n4 < ncols) v = *(const f32x4*)(src + (size_t)(k0 + kk) * ldsrc + col0 + n4);
        v = v * ((gain ? gain[k0 + kk] : 1.f) * scale);
        tile[kk * 33 + n4] = v[0]; tile[kk * 33 + n4 + 1] = v[1]; tile[kk * 33 + n4 + 2] = v[2]; tile[kk * 33 + n4 + 3] = v[3]; }
    asm volatile("s_waitcnt lgkmcnt(0)" ::: "memory");
    const int kc = lane & 7;
#pragma unroll
    for (int i = 0; i < 4; ++i) { const int n = (lane >> 3) + 8 * i; const float* tp = tile + (8 * kc) * 33 + n;
        u32x4 w; w.x = pk2(tp[0], tp[33]); w.y = pk2(tp[66], tp[99]); w.z = pk2(tp[132], tp[165]); w.w = pk2(tp[198], tp[231]);
        if (n < ncols) *(u32x4*)(dst + (size_t)n * K + k0 + 8 * kc) = w; }
    asm volatile("s_waitcnt lgkmcnt(0)" ::: "memory");
}
constexpr int CV_ITEMS_LAYER = 9104;
__device__ __forceinline__ void convert_item(const P& p, int item, float* tile, int lane) {
    const int l = item / CV_ITEMS_LAYER; int r = item % CV_ITEMS_LAYER;
    unsigned char* wt = p.ws + WS_WT + (size_t)l * WT_LAYER;
    const float* src; const float* gain = nullptr; int ld, col0, ncols, K; float sc = 1.f; bf16_t* dst;
    if (r < 3216) {
        const float* win = p.w_in + (size_t)l * D * INC; src = win; ld = INC; K = D; gain = p.g_mix + l * D; int dr;
        if (r < 256) { col0 = 0; ncols = 512; dr = 0; sc = 0.125f; }
        else if ((r -= 256) < 896) { col0 = 512; ncols = 1792; dr = 512; }
        else if ((r -= 896) < 256) { col0 = 2320; ncols = 512; dr = 2304; }
        else if ((r -= 256) < 256) { col0 = 2832; ncols = 512; dr = 2816; sc = 0.08838834764831845f; }
        else if ((r -= 256) < 1536) { col0 = 3344; ncols = 3072; dr = 3328; }
        else { r -= 1536; col0 = 2304; ncols = 16; dr = 6400; }
        dst = (bf16_t*)(wt + WT_WIN) + (size_t)dr * D;
    } else if ((r -= 3216) < 512) { src = p.w_mem_kv + (size_t)l * D * 1024; ld = 1024; col0 = 0; ncols = 1024; K = D; gain = p.g_mem + l * D; dst = (bf16_t*)(wt + WT_WMEM); }
    else if ((r -= 512) < 768) { const int sg = r / 256; r -= sg * 256; src = (sg == 0 ? p.w_br0 : sg == 1 ? p.w_br1 : p.w_br2) + (size_t)l * 512 * 1024; ld = 1024; col0 = 0; ncols = 1024; K = 512; dst = (bf16_t*)(wt + WT_WBR) + (size_t)sg * 1024 * 512; }
    else if ((r -= 768) < 512) { src = p.w_out + (size_t)l * D * D; ld = 1024; col0 = 0; ncols = 1024; K = D; dst = (bf16_t*)(wt + WT_WOUT); }
    else if ((r -= 512) < 2048) { src = p.w_ff1 + (size_t)l * D * DFF; ld = DFF; col0 = 0; ncols = DFF; K = D; gain = p.g_ffn + l * D; dst = (bf16_t*)(wt + WT_FF1); }
    else { r -= 2048; src = p.w_ff2 + (size_t)l * DFF * D; ld = D; col0 = 0; ncols = D; K = DFF; dst = (bf16_t*)(wt + WT_FF2); }
    const int nkb = K / 64, nb = r / nkb, kb = r % nkb, c0 = nb * 32, nc = (ncols - c0) < 32 ? (ncols - c0) : 32;
    convert_tile_w(src, ld, col0 + c0, nc, kb * 64, gain, sc, dst + (size_t)c0 * K, K, tile, lane);
}
__device__ __forceinline__ void rowstat_rows(const float* src, int rows, bf16_t* xb, float* rowss, int gw, int ngw, int lane) {
    for (int r = gw; r < rows; r += ngw) {
        const float4* s4 = (const float4*)(src + (size_t)r * D); float ss = 0.f;
#pragma unroll
        for (int j = 0; j < 4; ++j) { const float4 v = s4[lane + 64 * j]; ss += v.x * v.x + v.y * v.y + v.z * v.z + v.w * v.w;
            uint2 o; o.x = pk2(v.x, v.y); o.y = pk2(v.z, v.w); *(uint2*)(xb + (size_t)r * D + 4 * (lane + 64 * j)) = o; }
        ss = wave_sum(ss);
        if (lane < 16) rowss[(size_t)r * 16 + lane] = lane == 0 ? ss : 0.f;
    }
}
__device__ __forceinline__ void finalnorm_rows(const bf16_t* xb, float* out, const float* rowss, const float* g, int gw, int ngw, int lane) {
    for (int r = gw; r < M; r += ngw) {
        const float rstd = rstd_of(rowss, r);
#pragma unroll
        for (int j = 0; j < 2; ++j) { float x[8]; unpack8(*(const uint4*)(xb + (size_t)r * D + 8 * (lane + 64 * j)), x);
            const float4 g0 = *(const float4*)(g + 8 * (lane + 64 * j)), g1 = *(const float4*)(g + 8 * (lane + 64 * j) + 4);
            float4 o0, o1; o0.x = x[0] * rstd * g0.x; o0.y = x[1] * rstd * g0.y; o0.z = x[2] * rstd * g0.z; o0.w = x[3] * rstd * g0.w;
            o1.x = x[4] * rstd * g1.x; o1.y = x[5] * rstd * g1.y; o1.z = x[6] * rstd * g1.z; o1.w = x[7] * rstd * g1.w;
            *(float4*)(out + (size_t)r * D + 8 * (lane + 64 * j)) = o0; *(float4*)(out + (size_t)r * D + 8 * (lane + 64 * j) + 4) = o1; }
    }
}

__device__ __forceinline__ void swa_unit(const P& p, const LB& L, int l, int u) {
    int tid_l = threadIdx.x; asm volatile("" : "+v"(tid_l)); const int tid = tid_l, hq = tid & 7, row = u * 64 + (tid >> 3), b = row / T, t = row % T, hkv = hq >> 2;
    bf16_t* qp = L.sq + (size_t)row * 512 + hq * 64;
    float q[64], o[64];
#pragma unroll
    for (int c = 0; c < 8; ++c) { float f[8]; unpack8(*(const uint4*)(qp + 8 * c), f);
#pragma unroll
        for (int j = 0; j < 8; ++j) { q[8 * c + j] = f[j]; o[8 * c + j] = 0.f; } }
    float m = -1e30f, lsum = 0.f;
    const int j0 = t - 127 > 0 ? t - 127 : 0;
    for (int j = j0; j <= t; ++j) {
        const bf16_t* kp = L.skv + (size_t)(b * T + j) * 256 + hkv * 64;
        float s = 0.f;
#pragma unroll
        for (int c = 0; c < 8; ++c) { float f[8]; unpack8(*(const uint4*)(kp + 8 * c), f);
#pragma unroll
            for (int jj = 0; jj < 8; ++jj) s = fmaf(q[8 * c + jj], f[jj], s); }
        s += p.rel_bias[(int)T5_BUCKET[t - j] * 8 + hq];
        const float mn = fmaxf(m, s), alpha = expf(m - mn), pj = expf(s - mn);
        lsum = lsum * alpha + pj;
#pragma unroll
        for (int c = 0; c < 8; ++c) { float f[8]; unpack8(*(const uint4*)(kp + 128 + 8 * c), f);
#pragma unroll
            for (int jj = 0; jj < 8; ++jj) o[8 * c + jj] = o[8 * c + jj] * alpha + pj * f[jj]; }
        m = mn;
    }
    const float sink = p.sinks[l * 8 + hq], mf = fmaxf(m, sink), a = expf(m - mf), den = lsum * a + expf(sink - mf), sc = a / den;
#pragma unroll
    for (int c = 0; c < 8; ++c) { uint4 w; w.x = pk2(o[8 * c] * sc, o[8 * c + 1] * sc); w.y = pk2(o[8 * c + 2] * sc, o[8 * c + 3] * sc); w.z = pk2(o[8 * c + 4] * sc, o[8 * c + 5] * sc); w.w = pk2(o[8 * c + 6] * sc, o[8 * c + 7] * sc);
        *(uint4*)(qp + 8 * c) = w; }
}
__device__ __forceinline__ void xattn_unit(const LB& L, int u, float* pbuf  ) {
    int tid_l = threadIdx.x; asm volatile("" : "+v"(tid_l)); const int lane = tid_l & 63, wv = tid_l >> 6, w = u * 8 + wv, hx = w & 3, row = w >> 2, b = row / T;
    bf16_t* qp = L.xq + (size_t)row * 512 + hx * 128;
    const bf16_t* kbase = L.memkv + (size_t)(b * MEMLEN) * 1024 + hx * 128;
    float s[4] = {0.f, 0.f, 0.f, 0.f};
    for (int c = 0; c < 16; ++c) { float qf[8]; unpack8(*(const uint4*)(qp + 8 * c), qf);
#pragma unroll
        for (int i = 0; i < 4; ++i) { float kf[8]; unpack8(*(const uint4*)(kbase + (size_t)(lane + 64 * i) * 1024 + 8 * c), kf);
#pragma unroll
            for (int j = 0; j < 8; ++j) s[i] = fmaf(qf[j], kf[j], s[i]); } }
    float mx = fmaxf(fmaxf(s[0], s[1]), fmaxf(s[2], s[3])); mx = wave_max(mx);
    float pe[4], ls = 0.f;
#pragma unroll
    for (int i = 0; i < 4; ++i) { pe[i] = expf(s[i] - mx); ls += pe[i]; }
    ls = wave_sum(ls); const float inv = 1.f / ls;
    __syncthreads();
#pragma unroll
    for (int i = 0; i < 4; ++i) pbuf[wv * 256 + lane + 64 * i] = pe[i] * inv;
    __syncthreads();
    float o0 = 0.f, o1 = 0.f;
    for (int k = 0; k < 256; ++k) { const unsigned vv = *(const unsigned*)(kbase + (size_t)k * 1024 + 512 + 2 * lane); const float pk = pbuf[wv * 256 + k];
        o0 = fmaf(pk, __uint_as_float(vv << 16), o0); o1 = fmaf(pk, __uint_as_float(vv & 0xffff0000u), o1); }
    *(unsigned*)(qp + 2 * lane) = pk2(o0, o1);
}
__device__ __forceinline__ float conv_silu(const bf16_t* mqk, const float* cw, int b, int t, int ch) {
    float acc = 0.f;
#pragma unroll
    for (int j = 0; j < 4; ++j) { const int tt = t - 3 + j; if (tt >= 0) acc = fmaf(cw[j * 1024 + ch], bf2f(mqk[(size_t)(b * T + tt) * 1024 + ch]), acc); }
    return acc / (1.f + expf(-acc));
}
__device__ __forceinline__ void mlstm_gates(const P& p, const LB& L, int l, int b, int c, int h, float* sB, float* sI) {
    int tid_l = threadIdx.x; asm volatile("" : "+v"(tid_l)); const int tid = tid_l;
    __syncthreads();
    if (tid < 64) { const size_t row = (size_t)b * T + c * 64 + tid; const float ip = L.iff[row * 16 + h] + p.b_i[l * 8 + h], fp = L.iff[row * 16 + 8 + h] + p.b_f[l * 8 + h];
        sB[tid] = fp >= 0.f ? -log1pf(expf(-fp)) : fp - log1pf(expf(fp)); sI[tid] = ip; }
    __syncthreads();
    if (tid == 0) { float a = 0.f; for (int s = 0; s < 64; ++s) { a += sB[s]; sB[s] = a; } }
    __syncthreads();
}
__device__ __forceinline__ void mlstm_A_unit(const P& p, const LB& L, int l, int u, float* lds) {
    int tid_l = threadIdx.x; asm volatile("" : "+v"(tid_l)); const int tid = tid_l, h = u & 7, c = (u >> 3) & 31, b = u >> 8;
    float *sK = lds, *sV = lds + 64 * 65, *sB = sV + 64 * 65, *sI = sB + 64, *sW = sI + 64;
    const float* cw = p.conv_w + (size_t)l * 4 * 1024;
    mlstm_gates(p, L, l, b, c, h, sB, sI);
    for (int e = tid; e < 4096; e += 512) { const int s = e >> 6, d = e & 63;
        sK[s * 65 + d] = conv_silu(L.mqk, cw, b, c * 64 + s, 512 + h * 64 + d) * 0.125f;
        sV[s * 65 + d] = bf2f(L.mv[(size_t)(b * T + c * 64 + s) * 512 + h * 64 + d]); }
    const float g = sB[63];
    if (tid < 64) sW[tid] = g - sB[tid] + sI[tid];
    __syncthreads();
    float ml = -1e30f; for (int s = 0; s < 64; ++s) ml = fmaxf(ml, sW[s]);
    __syncthreads();
    if (tid < 64) sW[tid] = expf(sW[tid] - ml);
    __syncthreads();
    const int dk = tid >> 3, dv0 = (tid & 7) * 8;
    float acc[8] = {0.f, 0.f, 0.f, 0.f, 0.f, 0.f, 0.f, 0.f};
    for (int s = 0; s < 64; ++s) { const float wk = sW[s] * sK[s * 65 + dk];
#pragma unroll
        for (int j = 0; j < 8; ++j) acc[j] = fmaf(wk, sV[s * 65 + dv0 + j], acc[j]); }
    float* st = L.state + (size_t)u * 4096 + dk * 64 + dv0;
#pragma unroll
    for (int j = 0; j < 8; ++j) st[j] = acc[j];
    if (tid < 64) { float a = 0.f; for (int s = 0; s < 64; ++s) a = fmaf(sW[s], sK[s * 65 + tid], a); ws_f(p.ws, WS_DN)[(size_t)u * 64 + tid] = a; }
    if (tid == 0) { ws_f(p.ws, WS_G)[u] = g; ws_f(p.ws, WS_ML)[u] = ml; }
}
__device__ __forceinline__ void mlstm_scan_unit(const P& p, const LB& L, int u) {
    int tid_l = threadIdx.x; asm volatile("" : "+v"(tid_l)); const int tid = tid_l, bh = u >> 3, b = bh >> 3, h = bh & 7, e = (u & 7) * 512 + tid;
    const bool first = (u & 7) == 0; const bool do_n = first && tid < 64;
    float m = 0.f, C = 0.f, n = 0.f;
    float *G = ws_f(p.ws, WS_G), *ML = ws_f(p.ws, WS_ML), *MIN = ws_f(p.ws, WS_MIN), *DN = ws_f(p.ws, WS_DN);
    for (int c = 0; c < NCH; ++c) { const int idx = (b * NCH + c) * 8 + h; const float g = G[idx], ml = ML[idx], mn = fmaxf(g + m, ml), a = expf(g + m - mn), s = expf(ml - mn);
        float* sp = L.state + (size_t)idx * 4096 + e; const float d = *sp; *sp = C; C = a * C + s * d;
        if (do_n) { float* np_ = DN + (size_t)idx * 64 + tid; const float dn = *np_; *np_ = n; n = a * n + s * dn; }
        if (first && tid == 0) MIN[idx] = m;
        m = mn; }
}
__device__ __forceinline__ void mlstm_C_unit(const P& p, const LB& L, int l, int u, float* lds) {
    int tid_l = threadIdx.x; asm volatile("" : "+v"(tid_l)); const int tid = tid_l, h = u & 7, c = (u >> 3) & 31, b = u >> 8;
    float *sQ = lds, *sK = sQ + 64 * 65, *sV = sK + 64 * 65, *sC = sV + 64 * 65, *sS = sC + 64 * 65, *sH = sS + 64 * 65, *sB = sH + 64 * 65, *sI = sB + 64, *sMt = sI + 64, *sIw = sMt + 64, *sDen = sIw + 64, *sN = sDen + 64;
    const float* cw = p.conv_w + (size_t)l * 4 * 1024;
    mlstm_gates(p, L, l, b, c, h, sB, sI);
    const float m_in = ws_f(p.ws, WS_MIN)[u];
    for (int e = tid; e < 4096; e += 512) { const int s = e >> 6, d = e & 63;
        sQ[s * 65 + d] = conv_silu(L.mqk, cw, b, c * 64 + s, h * 64 + d);
        sK[s * 65 + d] = conv_silu(L.mqk, cw, b, c * 64 + s, 512 + h * 64 + d) * 0.125f;
        sV[s * 65 + d] = bf2f(L.mv[(size_t)(b * T + c * 64 + s) * 512 + h * 64 + d]);
        sC[s * 65 + d] = L.state[(size_t)u * 4096 + e]; }
    if (tid < 64) sN[tid] = ws_f(p.ws, WS_DN)[(size_t)u * 64 + tid];
    __syncthreads();
    if (tid < 64) { const int t = tid; const float bt = sB[t]; float mx = -1e30f; for (int s = 0; s <= t; ++s) mx = fmaxf(mx, bt - sB[s] + sI[s]);
        const float il = bt + m_in, mt = fmaxf(mx, il); sMt[t] = mt; sIw[t] = expf(il - mt); }
    __syncthreads();
    for (int e = tid; e < 4096; e += 512) { const int t = e >> 6, s = e & 63; float v = 0.f;
        if (s <= t) { float dot = 0.f; for (int d = 0; d < 64; ++d) dot = fmaf(sQ[t * 65 + d], sK[s * 65 + d], dot); v = dot * expf(sB[t] - sB[s] + sI[s] - sMt[t]); }
        sS[t * 65 + s] = v; }
    __syncthreads();
    if (tid < 64) { const int t = tid; float d = 0.f; for (int s = 0; s < 64; ++s) d += sS[t * 65 + s]; float qn = 0.f; for (int k = 0; k < 64; ++k) qn = fmaf(sQ[t * 65 + k], sN[k], qn); sDen[t] = d + sIw[t] * qn; }
    __syncthreads();
    for (int e = tid; e < 4096; e += 512) { const int t = e >> 6, dv = e & 63; float num = 0.f, qc = 0.f;
        for (int s = 0; s < 64; ++s) num = fmaf(sS[t * 65 + s], sV[s * 65 + dv], num);
        for (int k = 0; k < 64; ++k) qc = fmaf(sQ[t * 65 + k], sC[k * 65 + dv], qc);
        num += sIw[t] * qc; const float dn = fmaxf(fabsf(sDen[t]), expf(-sMt[t])); sH[t * 65 + dv] = num / dn; }
    __syncthreads();
    if (tid < 64) { const int t = tid; float mu = 0.f; for (int d = 0; d < 64; ++d) mu += sH[t * 65 + d]; mu *= (1.f / 64.f); float var = 0.f; for (int d = 0; d < 64; ++d) { const float x = sH[t * 65 + d] - mu; var += x * x; }
        var *= (1.f / 64.f); sMt[t] = mu; sIw[t] = rsqrtf(var + EPS); }
    __syncthreads();
    for (int e = tid; e < 4096; e += 512) { const int t = e >> 6, dv = e & 63; const size_t idx = (size_t)(b * T + c * 64 + t) * 512 + h * 64 + dv;
        const float y = (sH[t * 65 + dv] - sMt[t]) * sIw[t] * p.norm_g[l * 512 + h * 64 + dv] * bf2f(L.mo[idx]); L.mo[idx] = f2bf(y); }
}


typedef short bf16x8 __attribute__((ext_vector_type(8)));
typedef short s16x4 __attribute__((ext_vector_type(4)));
typedef float f32x16 __attribute__((ext_vector_type(16)));
typedef float f32x2 __attribute__((ext_vector_type(2)));
typedef __bf16 bf16x2v __attribute__((ext_vector_type(2)));
#define MFMA32(a, b, c) __builtin_amdgcn_mfma_f32_32x32x16_bf16((a), (b), (c), 0, 0, 0)
__device__ __forceinline__ int crow(int reg, int h) { return (reg & 3) + 8 * (reg >> 2) + 4 * h; }
__device__ __forceinline__ unsigned pkbf(float a, float b) { return __builtin_bit_cast(unsigned, __builtin_convertvector((f32x2){a, b}, bf16x2v)); }
__device__ __forceinline__ bf16x8 pack_step(const f32x16& x, int s) {
    u32x4 p; p.x = pkbf(x[8 * s], x[8 * s + 1]); p.y = pkbf(x[8 * s + 2], x[8 * s + 3]); p.z = pkbf(x[8 * s + 4], x[8 * s + 5]); p.w = pkbf(x[8 * s + 6], x[8 * s + 7]);
    return __builtin_bit_cast(bf16x8, p);
}
__device__ __forceinline__ bf16x8 tr_frag(const LAS unsigned char* img, int row_lo, int row_hi, int lane) {
    const int i16 = lane & 15, q = i16 >> 2, p = i16 & 3, blk = (lane >> 4) & 1;
    const s16x4 lo = __builtin_amdgcn_ds_read_tr16_b64_v4i16((LAS s16x4*)(img + (row_lo + q) * 64 + 32 * blk + 8 * p));
    const s16x4 hi = __builtin_amdgcn_ds_read_tr16_b64_v4i16((LAS s16x4*)(img + (row_hi + q) * 64 + 32 * blk + 8 * p));
    return __builtin_shufflevector(lo, hi, 0, 1, 2, 3, 4, 5, 6, 7);
}

constexpr int SWA_KIMG = 0, SWA_VIMG = 256 * 144, SWA_TAB = SWA_VIMG + 2 * 16384;
__device__ __forceinline__ void swa_mfma_unit(const P& p, const LB& L, int l, int u, LAS unsigned char* l3) {
    int tid_l = threadIdx.x; asm volatile("" : "+v"(tid_l)); const int tid = tid_l, lane = tid & 63, wave = tid >> 6, h = lane >> 5, ql = lane & 31;
    const int hkv = u & 1, n = (u >> 1) & 15, b = u >> 5;
    __syncthreads();
#pragma unroll
    for (int i = 0; i < 4; ++i) {
        const int c = tid + 512 * i, row = c >> 3, cc = c & 7, t = 128 * (n - 1) + row;
        u32x4 kv = (u32x4){0u, 0u, 0u, 0u}, vv = (u32x4){0u, 0u, 0u, 0u};
        if (t >= 0) { const bf16_t* src = L.skv + (size_t)(b * T + t) * 256 + hkv * 64 + cc * 8; kv = *(const u32x4*)src; vv = *(const u32x4*)(src + 128); }
        *(LAS u32x4*)(l3 + SWA_KIMG + row * 144 + cc * 16) = kv;
        *(LAS u32x4*)(l3 + SWA_VIMG + (cc >> 2) * 16384 + row * 64 + (cc & 3) * 16) = vv;
    }
    for (int idx = tid; idx < 4 * 192; idx += 512) { const int g = idx / 192, e = idx % 192, dist = 159 - e;
        ((LAS float*)(l3 + SWA_TAB))[idx] = (dist >= 0 && dist < 128) ? p.rel_bias[(int)T5_BUCKET[dist] * 8 + hkv * 4 + g] : -1e30f; }
    __syncthreads();
    const int g = wave >> 1, half = wave & 1, hq = hkv * 4 + g;
    const float sink = p.sinks[l * 8 + hq];
    const LAS float* tab = (const LAS float*)(l3 + SWA_TAB) + g * 192 + 31 - ql;
#pragma unroll 1
    for (int sb = 0; sb < 2; ++sb) {
        const int r0 = 64 * half + 32 * sb, kb0 = 2 * half + sb;
        bf16_t* qptr = L.sq + (size_t)(b * T + 128 * n + r0 + ql) * 512 + hq * 64;
        bf16x8 Qf[4];
#pragma unroll
        for (int ks = 0; ks < 4; ++ks) Qf[ks] = *(const bf16x8*)(qptr + 16 * ks + 8 * h);
        f32x16 S[5];
#pragma unroll
        for (int i = 0; i < 5; ++i) {
#pragma unroll
            for (int r = 0; r < 16; ++r) S[i][r] = 0.f;
#pragma unroll
            for (int ks = 0; ks < 4; ++ks) { const bf16x8 Kf = *(const LAS bf16x8*)(l3 + SWA_KIMG + (32 * (kb0 + i) + ql) * 144 + 32 * ks + 16 * h); S[i] = MFMA32(Kf, Qf[ks], S[i]); }
        }
        float m = sink;
#pragma unroll
        for (int i = 0; i < 5; ++i)
#pragma unroll
            for (int r = 0; r < 16; ++r) { const int kk = 32 * i + crow(r, h); float sv = S[i][r] + tab[kk];
                if (n == 0 && 32 * kb0 + kk < 128) sv = -1e30f;
                S[i][r] = sv; m = fmaxf(m, sv); }
        m = fmaxf(m, __shfl_xor(m, 32));
        float lsum = 0.f;
#pragma unroll
        for (int i = 0; i < 5; ++i)
#pragma unroll
            for (int r = 0; r < 16; ++r) { const float pe = __expf(S[i][r] - m); S[i][r] = pe; lsum += pe; }
        lsum += __shfl_xor(lsum, 32);
        f32x16 O[2];
#pragma unroll
        for (int db = 0; db < 2; ++db)
#pragma unroll
            for (int r = 0; r < 16; ++r) O[db][r] = 0.f;
#pragma unroll
        for (int i = 0; i < 5; ++i)
#pragma unroll
            for (int s2 = 0; s2 < 2; ++s2) { const bf16x8 Pf = pack_step(S[i], s2); const int k0 = 32 * (kb0 + i) + 16 * s2;
#pragma unroll
                for (int db = 0; db < 2; ++db) { const bf16x8 Vf = tr_frag(l3 + SWA_VIMG + db * 16384, k0 + 4 * h, k0 + 8 + 4 * h, lane); O[db] = MFMA32(Vf, Pf, O[db]); } }
        const float inv = 1.f / (lsum + __expf(sink - m));
#pragma unroll
        for (int db = 0; db < 2; ++db)
#pragma unroll
            for (int gq = 0; gq < 4; ++gq) { uint2 w; w.x = pkbf(O[db][4 * gq] * inv, O[db][4 * gq + 1] * inv); w.y = pkbf(O[db][4 * gq + 2] * inv, O[db][4 * gq + 3] * inv);
                *(uint2*)(qptr + 32 * db + 8 * gq + 4 * h) = w; }
    }
}

constexpr int XA_KIMG = 0, XA_VIMG = 256 * 272;
__device__ __forceinline__ void xattn_mfma_unit(const LB& L, int u, LAS unsigned char* l3) {
    int tid_l = threadIdx.x; asm volatile("" : "+v"(tid_l)); const int tid = tid_l, lane = tid & 63, wave = tid >> 6, h = lane >> 5, ql = lane & 31;
    const int qb = u & 7, hx = (u >> 3) & 3, b = u >> 5;
    __syncthreads();
#pragma unroll
    for (int i = 0; i < 8; ++i) {
        const int c = tid + 512 * i, row = c >> 4, cc = c & 15;
        const bf16_t* src = L.memkv + (size_t)(b * MEMLEN + row) * 1024 + hx * 128 + cc * 8;
        const u32x4 kv = *(const u32x4*)src, vv = *(const u32x4*)(src + 512);
        *(LAS u32x4*)(l3 + XA_KIMG + row * 272 + cc * 16) = kv;
        *(LAS u32x4*)(l3 + XA_VIMG + (cc >> 2) * 16384 + row * 64 + (cc & 3) * 16) = vv;
    }
    __syncthreads();
    bf16_t* qptr = L.xq + (size_t)(b * T + qb * 256 + wave * 32 + ql) * 512 + hx * 128;
    f32x16 S[8];
    {
        bf16x8 Qf[8];
#pragma unroll
        for (int ks = 0; ks < 8; ++ks) Qf[ks] = *(const bf16x8*)(qptr + 16 * ks + 8 * h);
#pragma unroll
        for (int i = 0; i < 8; ++i) {
#pragma unroll
            for (int r = 0; r < 16; ++r) S[i][r] = 0.f;
#pragma unroll
            for (int ks = 0; ks < 8; ++ks) { const bf16x8 Kf = *(const LAS bf16x8*)(l3 + XA_KIMG + (32 * i + ql) * 272 + 32 * ks + 16 * h); S[i] = MFMA32(Kf, Qf[ks], S[i]); }
        }
    }
    float m = -1e30f;
#pragma unroll
    for (int i = 0; i < 8; ++i)
#pragma unroll
        for (int r = 0; r < 16; ++r) m = fmaxf(m, S[i][r]);
    m = fmaxf(m, __shfl_xor(m, 32));
    float lsum = 0.f;
#pragma unroll
    for (int i = 0; i < 8; ++i)
#pragma unroll
        for (int r = 0; r < 16; ++r) { const float pe = __expf(S[i][r] - m); S[i][r] = pe; lsum += pe; }
    lsum += __shfl_xor(lsum, 32);
    f32x16 O[4];
#pragma unroll
    for (int db = 0; db < 4; ++db)
#pragma unroll
        for (int r = 0; r < 16; ++r) O[db][r] = 0.f;
#pragma unroll
    for (int i = 0; i < 8; ++i)
#pragma unroll
        for (int s2 = 0; s2 < 2; ++s2) { const bf16x8 Pf = pack_step(S[i], s2); const int k0 = 32 * i + 16 * s2;
#pragma unroll
            for (int db = 0; db < 4; ++db) { const bf16x8 Vf = tr_frag(l3 + XA_VIMG + db * 16384, k0 + 4 * h, k0 + 8 + 4 * h, lane); O[db] = MFMA32(Vf, Pf, O[db]); } }
    const float inv = 1.f / lsum;
#pragma unroll
    for (int db = 0; db < 4; ++db)
#pragma unroll
        for (int gq = 0; gq < 4; ++gq) { uint2 w; w.x = pkbf(O[db][4 * gq] * inv, O[db][4 * gq + 1] * inv); w.y = pkbf(O[db][4 * gq + 2] * inv, O[db][4 * gq + 3] * inv);
            *(uint2*)(qptr + 32 * db + 8 * gq + 4 * h) = w; }
}


constexpr int ML_VIMG = 0, ML_T0 = 8192, ML_T1 = 8448, ML_T2 = 8704, ML_T3 = 8960;
__device__ __forceinline__ float log_sigmoid_f(float x) { return x >= 0.f ? -log1pf(expf(-x)) : x - log1pf(expf(x)); }
__device__ __forceinline__ void mlstm_gates_wave(const P& p, const LB& L, int l, int b, int c, int hh, int lane, float& bcum, float& ig) {
    const size_t row = (size_t)b * T + c * 64 + lane;
    ig = L.iff[row * 16 + hh] + p.b_i[l * 8 + hh];
    float v = log_sigmoid_f(L.iff[row * 16 + 8 + hh] + p.b_f[l * 8 + hh]);
#pragma unroll
    for (int o = 1; o < 64; o <<= 1) { const float t = __shfl_up(v, o); if (lane >= o) v += t; }
    bcum = v;
}
__device__ __forceinline__ void mlstm_stage_v(const LB& L, int b, int c, int hh, int lane, LAS unsigned char* wl) {
#pragma unroll
    for (int i = 0; i < 8; ++i) { const int s = (lane >> 3) + 8 * i, cc = lane & 7;
        const u32x4 v = *(const u32x4*)(L.mv + (size_t)(b * T + c * 64 + s) * 512 + hh * 64 + cc * 8);
        *(LAS u32x4*)(wl + ML_VIMG + (cc >> 2) * 4096 + s * 64 + (cc & 3) * 16) = v; }
}
__device__ __forceinline__ bf16x8 conv_frag_row(const bf16_t* xrow, int t_in_batch, const float* cw, float scale) {
    float a[8] = {0.f, 0.f, 0.f, 0.f, 0.f, 0.f, 0.f, 0.f};
    uint4 xr[4];
#pragma unroll
    for (int tap = 0; tap < 4; ++tap) { const int back = (t_in_batch - 3 + tap >= 0) ? (3 - tap) : 0; xr[tap] = *(const uint4*)(xrow - back * 1024); }
#pragma unroll
    for (int tap = 0; tap < 4; ++tap) {
        const float ok = (t_in_batch - 3 + tap >= 0) ? 1.f : 0.f;
        float xf[8]; unpack8(xr[tap], xf);
        const f32x4 w0 = *(const f32x4*)(cw + tap * 1024) * ok, w1 = *(const f32x4*)(cw + tap * 1024 + 4) * ok;
        a[0] = fmaf(w0[0], xf[0], a[0]); a[1] = fmaf(w0[1], xf[1], a[1]); a[2] = fmaf(w0[2], xf[2], a[2]); a[3] = fmaf(w0[3], xf[3], a[3]);
        a[4] = fmaf(w1[0], xf[4], a[4]); a[5] = fmaf(w1[1], xf[5], a[5]); a[6] = fmaf(w1[2], xf[6], a[6]); a[7] = fmaf(w1[3], xf[7], a[7]);
    }
#pragma unroll
    for (int j = 0; j < 8; ++j) a[j] = a[j] * scale * __builtin_amdgcn_rcpf(1.f + __expf(-a[j]));
    u32x4 w; w.x = pkbf(a[0], a[1]); w.y = pkbf(a[2], a[3]); w.z = pkbf(a[4], a[5]); w.w = pkbf(a[6], a[7]);
    return __builtin_bit_cast(bf16x8, w);
}
__device__ __forceinline__ void mlstm_A_mfma_unit(const P& p, const LB& L, int l, int u, LAS unsigned char* l3) {
    int tid_l = threadIdx.x; asm volatile("" : "+v"(tid_l)); const int tid = tid_l, lane = tid & 63, hh = tid >> 6, h = lane >> 5, ql = lane & 31;
    const int c = u & 31, b = u >> 5, uh = u * 8 + hh;
    LAS unsigned char* wl = l3 + hh * 16384;
    const float* cw = p.conv_w + (size_t)l * 4 * 1024;
    __syncthreads();
    float bcum, ig; mlstm_gates_wave(p, L, l, b, c, hh, lane, bcum, ig);
    const float g = __shfl(bcum, 63), alog = g - bcum + ig, ml = wave_max(alog);
    ((LAS float*)(wl + ML_T0))[lane] = __expf(alog - ml);
    mlstm_stage_v(L, b, c, hh, lane, wl);
    __syncthreads();
    f32x16 acc[2][2];
#pragma unroll
    for (int a = 0; a < 2; ++a)
#pragma unroll
        for (int d = 0; d < 2; ++d)
#pragma unroll
            for (int r = 0; r < 16; ++r) acc[a][d][r] = 0.f;
    float dnacc[2] = {0.f, 0.f};
#pragma unroll
    for (int ks = 0; ks < 4; ++ks) {
        const int s0 = 16 * ks + 8 * h;
        const f32x4 we0 = *(const LAS f32x4*)(wl + ML_T0 + s0 * 4), we1 = *(const LAS f32x4*)(wl + ML_T0 + s0 * 4 + 16);
        const float we[8] = {we0[0], we0[1], we0[2], we0[3], we1[0], we1[1], we1[2], we1[3]};
        bf16x8 WKf[2];
#pragma unroll
        for (int dkb = 0; dkb < 2; ++dkb) {
            const int ch = 512 + hh * 64 + 32 * dkb + ql;
            float x[11];
#pragma unroll
            for (int r = 0; r < 11; ++r) { const int tt = c * 64 + s0 - 3 + r; const float xv = bf2f(L.mqk[(size_t)(b * T + (tt >= 0 ? tt : 0)) * 1024 + ch]); x[r] = tt >= 0 ? xv : 0.f; }
            const float w0 = cw[ch], w1 = cw[1024 + ch], w2 = cw[2048 + ch], w3 = cw[3072 + ch];
            float wk[8];
#pragma unroll
            for (int j = 0; j < 8; ++j) { const float cv = fmaf(w3, x[j + 3], fmaf(w2, x[j + 2], fmaf(w1, x[j + 1], w0 * x[j])));
                wk[j] = cv * 0.125f * __builtin_amdgcn_rcpf(1.f + __expf(-cv)) * we[j]; dnacc[dkb] += wk[j]; }
            u32x4 w; w.x = pkbf(wk[0], wk[1]); w.y = pkbf(wk[2], wk[3]); w.z = pkbf(wk[4], wk[5]); w.w = pkbf(wk[6], wk[7]);
            WKf[dkb] = __builtin_bit_cast(bf16x8, w);
        }
#pragma unroll
        for (int dvb = 0; dvb < 2; ++dvb) { const bf16x8 Vf = tr_frag(wl + ML_VIMG + dvb * 4096, s0, s0 + 4, lane);
#pragma unroll
            for (int dkb = 0; dkb < 2; ++dkb) acc[dkb][dvb] = MFMA32(WKf[dkb], Vf, acc[dkb][dvb]); }
    }
    float* st = L.state + (size_t)uh * 4096;
#pragma unroll
    for (int dkb = 0; dkb < 2; ++dkb)
#pragma unroll
        for (int dvb = 0; dvb < 2; ++dvb)
#pragma unroll
            for (int gq = 0; gq < 4; ++gq) { f32x4 v; v[0] = acc[dkb][dvb][4 * gq]; v[1] = acc[dkb][dvb][4 * gq + 1]; v[2] = acc[dkb][dvb][4 * gq + 2]; v[3] = acc[dkb][dvb][4 * gq + 3];
                *(f32x4*)(st + (32 * dvb + ql) * 64 + 32 * dkb + 8 * gq + 4 * h) = v; }
#pragma unroll
    for (int dkb = 0; dkb < 2; ++dkb) { const float t = dnacc[dkb] + __shfl_xor(dnacc[dkb], 32); if (h == 0) ws_f(p.ws, WS_DN)[(size_t)uh * 64 + 32 * dkb + ql] = t; }
    if (lane == 0) { ws_f(p.ws, WS_G)[uh] = g; ws_f(p.ws, WS_ML)[uh] = ml; }
}
__device__ __forceinline__ void mlstm_scan2_unit(const P& p, const LB& L, int u) {
    int tid_l = threadIdx.x; asm volatile("" : "+v"(tid_l)); const int tid = tid_l, bh = u >> 2, b = bh >> 3, hh = bh & 7, e = (u & 3) * 1024 + 2 * tid;
    const bool first = (u & 3) == 0; const bool do_n = first && tid < 64;
    float *G = ws_f(p.ws, WS_G), *ML = ws_f(p.ws, WS_ML), *MIN = ws_f(p.ws, WS_MIN), *DN = ws_f(p.ws, WS_DN);
    f32x2 d[NCH]; float dn[NCH];
#pragma unroll
    for (int c = 0; c < NCH; ++c) { const int idx = (b * NCH + c) * 8 + hh; d[c] = *(const f32x2*)(L.state + (size_t)idx * 4096 + e); dn[c] = do_n ? DN[(size_t)idx * 64 + tid] : 0.f; }
    float m = 0.f, n = 0.f; f32x2 C = (f32x2){0.f, 0.f};
#pragma unroll
    for (int c = 0; c < NCH; ++c) { const int idx = (b * NCH + c) * 8 + hh; const float g = G[idx], ml = ML[idx], mn = fmaxf(g + m, ml), a = __expf(g + m - mn), sc = __expf(ml - mn);
        *(f32x2*)(L.state + (size_t)idx * 4096 + e) = C; C = C * a + d[c] * sc;
        if (do_n) { DN[(size_t)idx * 64 + tid] = n; n = a * n + sc * dn[c]; }
        if (first && tid == 0) MIN[idx] = m;
        m = mn; }
}
template <int TB>
__device__ __forceinline__ void mlstm_C_block(const P& p, const LB& L, int l, int b, int c, int hh, int uh, int lane, int h, int ql, LAS unsigned char* wl, const float* cw, bf16x8 (&Kf0)[4]) {
    bf16x8 Qf[4]; float qn = 0.f;
#pragma unroll
    for (int ks = 0; ks < 4; ++ks) { const int t = c * 64 + 32 * TB + ql, ch0 = hh * 64 + 16 * ks + 8 * h;
        Qf[ks] = conv_frag_row(L.mqk + (size_t)(b * T + t) * 1024 + ch0, t, cw + ch0, 1.f);
        const float* np_ = ws_f(p.ws, WS_DN) + (size_t)uh * 64 + 16 * ks + 8 * h; const f32x4 n0 = *(const f32x4*)np_, n1 = *(const f32x4*)(np_ + 4);
        float qv[8]; unpack8(__builtin_bit_cast(uint4, Qf[ks]), qv);
#pragma unroll
        for (int j = 0; j < 4; ++j) { qn = fmaf(qv[j], n0[j], qn); qn = fmaf(qv[j + 4], n1[j], qn); } }
    f32x16 S0, S1;
#pragma unroll
    for (int r = 0; r < 16; ++r) { S0[r] = 0.f; S1[r] = 0.f; }
#pragma unroll
    for (int ks = 0; ks < 4; ++ks) { const int ch0 = 512 + hh * 64 + 16 * ks + 8 * h;
        if (TB == 0) { const int s = c * 64 + ql; Kf0[ks] = conv_frag_row(L.mqk + (size_t)(b * T + s) * 1024 + ch0, s, cw + ch0, 0.125f); }
        S0 = MFMA32(Kf0[ks], Qf[ks], S0);
        if (TB == 1) { const int s = c * 64 + 32 + ql; const bf16x8 Kf = conv_frag_row(L.mqk + (size_t)(b * T + s) * 1024 + ch0, s, cw + ch0, 0.125f); S1 = MFMA32(Kf, Qf[ks], S1); } }
    const float Mt = ((const LAS float*)(wl + ML_T1))[32 * TB + ql];
    float dsum = 0.f;
#pragma unroll
    for (int gq = 0; gq < 4; ++gq) {
        const f32x4 a0 = *(const LAS f32x4*)(wl + ML_T0 + (8 * gq + 4 * h) * 4), a1 = *(const LAS f32x4*)(wl + ML_T0 + (32 + 8 * gq + 4 * h) * 4);
#pragma unroll
        for (int j = 0; j < 4; ++j) { const int r = 4 * gq + j, sl = 8 * gq + 4 * h + j;
            if (TB == 0) { const float v = sl <= ql ? S0[r] * __expf(a0[j] - Mt) : 0.f; S0[r] = v; dsum += v; }
            else { const float v0 = S0[r] * __expf(a0[j] - Mt); S0[r] = v0; const float v1 = sl <= ql ? S1[r] * __expf(a1[j] - Mt) : 0.f; S1[r] = v1; dsum += v0 + v1; } }
    }
    f32x16 acc[2];
#pragma unroll
    for (int d = 0; d < 2; ++d)
#pragma unroll
        for (int r = 0; r < 16; ++r) acc[d][r] = 0.f;
    const float* st = L.state + (size_t)uh * 4096;
#pragma unroll
    for (int ks = 0; ks < 4; ++ks)
#pragma unroll
        for (int dvb = 0; dvb < 2; ++dvb) { const float* cp = st + (32 * dvb + ql) * 64 + 16 * ks + 8 * h; const f32x4 c0 = *(const f32x4*)cp, c1 = *(const f32x4*)(cp + 4);
            u32x4 w; w.x = pkbf(c0[0], c0[1]); w.y = pkbf(c0[2], c0[3]); w.z = pkbf(c1[0], c1[1]); w.w = pkbf(c1[2], c1[3]);
            acc[dvb] = MFMA32(__builtin_bit_cast(bf16x8, w), Qf[ks], acc[dvb]); }
    const float iw = ((const LAS float*)(wl + ML_T2))[32 * TB + ql];
#pragma unroll
    for (int dvb = 0; dvb < 2; ++dvb)
#pragma unroll
        for (int r = 0; r < 16; ++r) acc[dvb][r] *= iw;
#pragma unroll
    for (int s2 = 0; s2 < 2; ++s2) {
        const bf16x8 P0 = pack_step(S0, s2), P1 = pack_step(S1, s2);
#pragma unroll
        for (int dvb = 0; dvb < 2; ++dvb) {
            acc[dvb] = MFMA32(tr_frag(wl + ML_VIMG + dvb * 4096, 16 * s2 + 4 * h, 16 * s2 + 8 + 4 * h, lane), P0, acc[dvb]);
            if (TB == 1) acc[dvb] = MFMA32(tr_frag(wl + ML_VIMG + dvb * 4096, 32 + 16 * s2 + 4 * h, 32 + 16 * s2 + 8 + 4 * h, lane), P1, acc[dvb]); }
    }
    dsum += __shfl_xor(dsum, 32); qn += __shfl_xor(qn, 32);
    const float den = dsum + iw * qn, mt = ((const LAS float*)(wl + ML_T3))[32 * TB + ql];
    const float sc = 1.f / fmaxf(fabsf(den), __expf(-mt));
    float sum = 0.f;
#pragma unroll
    for (int dvb = 0; dvb < 2; ++dvb)
#pragma unroll
        for (int r = 0; r < 16; ++r) { const float v = acc[dvb][r] * sc; acc[dvb][r] = v; sum += v; }
    sum += __shfl_xor(sum, 32); const float mu = sum * (1.f / 64.f);
    float var = 0.f;
#pragma unroll
    for (int dvb = 0; dvb < 2; ++dvb)
#pragma unroll
        for (int r = 0; r < 16; ++r) { const float dlt = acc[dvb][r] - mu; var += dlt * dlt; }
    var += __shfl_xor(var, 32); const float rstd = rsqrtf(var * (1.f / 64.f) + EPS);
    bf16_t* op = L.mo + (size_t)(b * T + c * 64 + 32 * TB + ql) * 512 + hh * 64;
#pragma unroll
    for (int dvb = 0; dvb < 2; ++dvb)
#pragma unroll
        for (int gq = 0; gq < 4; ++gq) { const int dv = 32 * dvb + 8 * gq + 4 * h; const f32x4 ng = *(const f32x4*)(p.norm_g + l * 512 + hh * 64 + dv);
            const uint2 mo = *(const uint2*)(op + dv);
            const float y0 = (acc[dvb][4 * gq] - mu) * rstd * ng[0] * __uint_as_float(mo.x << 16), y1 = (acc[dvb][4 * gq + 1] - mu) * rstd * ng[1] * __uint_as_float(mo.x & 0xffff0000u);
            const float y2 = (acc[dvb][4 * gq + 2] - mu) * rstd * ng[2] * __uint_as_float(mo.y << 16), y3 = (acc[dvb][4 * gq + 3] - mu) * rstd * ng[3] * __uint_as_float(mo.y & 0xffff0000u);
            uint2 w; w.x = pkbf(y0, y1); w.y = pkbf(y2, y3); *(uint2*)(op + dv) = w; }
}
__device__ __forceinline__ void mlstm_C_mfma_unit(const P& p, const LB& L, int l, int u, LAS unsigned char* l3) {
    int tid_l = threadIdx.x; asm volatile("" : "+v"(tid_l)); const int tid = tid_l, lane = tid & 63, hh = tid >> 6, h = lane >> 5, ql = lane & 31;
    const int c = u & 31, b = u >> 5, uh = u * 8 + hh;
    LAS unsigned char* wl = l3 + hh * 16384;
    const float* cw = p.conv_w + (size_t)l * 4 * 1024;
    __syncthreads();
    {
        float bcum, ig; mlstm_gates_wave(p, L, l, b, c, hh, lane, bcum, ig);
        const float a = ig - bcum; float v = a;
#pragma unroll
        for (int o = 1; o < 64; o <<= 1) { const float t = __shfl_up(v, o); if (lane >= o) v = fmaxf(v, t); }
        const float m_in = ws_f(p.ws, WS_MIN)[uh], Mt = fmaxf(v, m_in);
        ((LAS float*)(wl + ML_T0))[lane] = a; ((LAS float*)(wl + ML_T1))[lane] = Mt; ((LAS float*)(wl + ML_T2))[lane] = __expf(m_in - Mt); ((LAS float*)(wl + ML_T3))[lane] = bcum + Mt;
    }
    mlstm_stage_v(L, b, c, hh, lane, wl);
    __syncthreads();
    bf16x8 Kf0[4];
    mlstm_C_block<0>(p, L, l, b, c, hh, uh, lane, h, ql, wl, cw, Kf0);
    asm volatile("" ::: "memory");
    mlstm_C_block<1>(p, L, l, b, c, hh, uh, lane, h, ql, wl, cw, Kf0);
}

#define XB_TMO      128
#define XB_XCNT(j)  (256  + 64 * (j))
#define XB_XSUB(j)  (1280 + 64 * (j))
#define XB_XGEN(j)  (2304 + 64 * (j))
#define XB_TOP      3328
#define XB_TOPGEN   3392
#define XCD_BAR_WORDS 3456
#define XB_SPIN_CAP (1u << 18)

__device__ __forceinline__ unsigned xb_ld(unsigned* p)              { return __hip_atomic_load(p, __ATOMIC_RELAXED, __HIP_MEMORY_SCOPE_AGENT); }
__device__ __forceinline__ unsigned xb_add(unsigned* p, unsigned v) { return __hip_atomic_fetch_add(p, v, __ATOMIC_RELAXED, __HIP_MEMORY_SCOPE_AGENT); }
__device__ __forceinline__ unsigned xb_xcc_id() { return (unsigned)__builtin_amdgcn_s_getreg((3 << 11) | 20) & 0xFu; }
#define XB_SPIN(cond, bar) do { unsigned _sp = 0; while (cond) { __builtin_amdgcn_s_sleep(1); \
    if ((++_sp & 255u) == 0u) { if (xb_ld(&(bar)[XB_TMO])) break; if (_sp > XB_SPIN_CAP) { atomicAdd(&(bar)[XB_TMO], 1u); break; } } } } while (0)

struct XcdBarrier {
    unsigned* bar; unsigned x;
    volatile LAS unsigned* st;
};

__device__ __forceinline__ XcdBarrier xcd_barrier_post(unsigned* bar, volatile LAS unsigned* st) {
    XcdBarrier b; b.bar = bar; b.x = xb_xcc_id(); b.st = st;
    if (threadIdx.x == 0) (void)xb_add(&bar[XB_XCNT(b.x)], 1u);
    return b;
}
__device__ __forceinline__ void xcd_barrier_complete(unsigned* bar, unsigned x, unsigned& nloc, unsigned& nx) {
    const unsigned G = gridDim.x * gridDim.y * gridDim.z;
    unsigned sum, cnt, mine, sp = 0u;
    for (;;) {
        sum = 0u; cnt = 0u; mine = 0u;
#pragma unroll
        for (unsigned j = 0; j < 16; ++j) { const unsigned c = xb_ld(&bar[XB_XCNT(j)]); sum += c; cnt += (c > 0u) ? 1u : 0u; mine = (j == x) ? c : mine; }
        if (sum == G) break;
        __builtin_amdgcn_s_sleep(1);
        if ((++sp & 255u) == 0u) { if (xb_ld(&bar[XB_TMO])) break; if (sp > XB_SPIN_CAP) { atomicAdd(&bar[XB_TMO], 1u); break; } }
    }
    nloc = mine > 0u ? mine : 1u; nx = cnt > 0u ? cnt : 1u;
}

__device__ __forceinline__ void xcd_barrier(const XcdBarrier& b) {
    asm volatile("s_waitcnt vmcnt(0)" ::: "memory");
    __syncthreads();
    if (threadIdx.x == 0) {
        unsigned* bar = b.bar;
        __builtin_amdgcn_s_waitcnt(0);
        unsigned nloc = b.st[0], nx = b.st[1];
        if (nloc == 0u) { xcd_barrier_complete(bar, b.x, nloc, nx); b.st[0] = nloc; b.st[1] = nx; }
        const unsigned old = xb_add(&bar[XB_XSUB(b.x)], 1u);
        const unsigned gen = old / nloc;
        if (old + 1u == (gen + 1u) * nloc) {
            __builtin_amdgcn_fence(__ATOMIC_RELEASE, "agent");
            asm volatile("s_waitcnt vmcnt(0)" ::: "memory");
            const unsigned og = xb_add(&bar[XB_TOP], 1u);
            const unsigned tg = og / nx;
            if (og + 1u == (tg + 1u) * nx) xb_add(&bar[XB_TOPGEN], 1u);
            else XB_SPIN(xb_ld(&bar[XB_TOPGEN]) == tg, bar);
            __builtin_amdgcn_fence(__ATOMIC_ACQUIRE, "agent");
            xb_add(&bar[XB_XGEN(b.x)], 1u);
            asm volatile("s_waitcnt vmcnt(0)" ::: "memory");
        } else {
            XB_SPIN(xb_ld(&bar[XB_XGEN(b.x)]) == gen, bar);
            __builtin_amdgcn_fence(__ATOMIC_ACQUIRE, "agent");
            asm volatile("s_waitcnt vmcnt(0)" ::: "memory");
        }
    }
    __syncthreads();
}

__global__ void __launch_bounds__(512, 2) mk_fwd(P p) {
    extern __shared__ __attribute__((aligned(16))) unsigned char lds[];
    LAS unsigned char* l3 = (LAS unsigned char*)lds;
    float* fl = (float*)lds;
    const int G = gridDim.x, bx = blockIdx.x;
    if (threadIdx.x < 64) ((LAS unsigned*)(l3 + LDS_CTL))[threadIdx.x] = 0u;
    __syncthreads();
    (void)xcd_barrier_post((unsigned*)(p.ws + WS_BAR), (volatile LAS unsigned*)(l3 + LDS_CTL + 32));
#define PH_BEGIN(id) do { if ((PROBE_MASK >> (id)) & 1) { if (bx == 0 && threadIdx.x == 0) pr_t0 = __builtin_amdgcn_s_memrealtime(); } } while (0)
#define PH_END(id) do { if ((PROBE_MASK >> (id)) & 1) { if (bx == 0 && threadIdx.x == 0) pr_acc += __builtin_amdgcn_s_memrealtime() - pr_t0; } } while (0)
    unsigned long long pr_t0 = 0, pr_acc = 0;
#define GRID_BAR() do { XcdBarrier b_; b_.bar = (unsigned*)(p.ws + WS_BAR); b_.x = xb_xcc_id(); b_.st = (volatile LAS unsigned*)(l3 + LDS_CTL + 32); xcd_barrier(b_); } while (0)
#define WAVE_IDS() int tid_w = threadIdx.x; asm volatile("" : "+v"(tid_w)); const int lane = tid_w & 63, gw = bx * 8 + (tid_w >> 6), ngw = G * 8

        PH_BEGIN(0);
    {
        WAVE_IDS();
        for (int it = gw; it < 2 * CV_ITEMS_LAYER; it += ngw) convert_item(p, it, fl + (tid_w >> 6) * (64 * 33), lane);
        rowstat_rows(p.x, M, layer_buf(p.ws, p.out, 0).xbin, ws_f(p.ws, WS_ROWSS), gw, ngw, lane);
        rowstat_rows(p.mem, MM, (bf16_t*)(p.ws + WS_MEMB), ws_f(p.ws, WS_ROWSS_MEM), gw, ngw, lane);
    }
    GRID_BAR();
        PH_END(0);

#pragma unroll 1
    for (int l = 0; l < 2; ++l) {
        PH_BEGIN(1);
        {
            const LB L = layer_buf(p.ws, p.out, l);
            pg8::Gemm g{L.xbin, L.win, M, 6656, D, (const bf16_t*)(p.ws + WS_MEMB)};
            SchedRounds S{G, bx, 3, 0, 1};
            EpiProjMK E{L, ws_f(p.ws, WS_ROWSS) + (size_t)(2 * l) * M * 16, ws_f(p.ws, WS_ROWSS_MEM)};
            pg8::gemm_phase<EpiProjMK, SchedRounds, true, true>(l3, g, S, E);
        }
        GRID_BAR();
        PH_END(1);
        PH_BEGIN(2);
        {
            const LB L = layer_buf(p.ws, p.out, l);
            PH_BEGIN(10); for (int u = bx; u < NB * 16 * 2; u += G) swa_mfma_unit(p, L, l, u, l3); PH_END(10);
            PH_BEGIN(11); for (int u = bx; u < NB * 4 * 8; u += G) xattn_mfma_unit(L, u, l3); PH_END(11);
            PH_BEGIN(12); for (int u = bx; u < NB * NCH; u += G) mlstm_A_mfma_unit(p, L, l, u, l3); PH_END(12);
        }
        GRID_BAR();
        PH_END(2);
        PH_BEGIN(3);
        {
            const LB L = layer_buf(p.ws, p.out, l);
            for (int u = bx; u < 256; u += G) mlstm_scan2_unit(p, L, u);
        }
        GRID_BAR();
        PH_END(3);
        PH_BEGIN(4);
        {
            const LB L = layer_buf(p.ws, p.out, l);
            for (int u = bx; u < NB * NCH; u += G) mlstm_C_mfma_unit(p, L, l, u, l3);
        }
        GRID_BAR();
        PH_END(4);
        PH_BEGIN(5);
        {
            const LB L = layer_buf(p.ws, p.out, l);
            pg8::Gemm g{L.xbin, L.win, M, 6656, D, nullptr};
            SchedRounds S{G, bx, 3, 13, 0};
            EpiProjMK E{L, ws_f(p.ws, WS_ROWSS) + (size_t)(2 * l) * M * 16, ws_f(p.ws, WS_ROWSS_MEM)};
            pg8::gemm_phase<EpiProjMK, SchedRounds, true, true>(l3, g, S, E);
        }
        GRID_BAR();
        PH_END(5);
        PH_BEGIN(6);
        {
            const LB L = layer_buf(p.ws, p.out, l);
            pg8::Gemm g{L.sq, L.wbr, 3 * M, 3 * D, 512, nullptr};
            SchedMerged S{G, bx};
            EpiMergedMK E{L.gates, L.merged};
            pg8::gemm_phase<EpiMergedMK, SchedMerged, false, true>(l3, g, S, E);
        }
        GRID_BAR();
        PH_END(6);
        PH_BEGIN(7);
        {
            const LB L = layer_buf(p.ws, p.out, l);
            pg8::Gemm g{L.merged, L.wout, M, D, D, nullptr};
            SchedRounds S{G, bx, 1, 0, 0};
            EpiResidMK E{L.xbin, L.xbmid, ws_f(p.ws, WS_ROWSS) + (size_t)(2 * l + 1) * M * 16};
            pg8::gemm_phase<EpiResidMK, SchedRounds, true, true>(l3, g, S, E);
        }
        GRID_BAR();
        PH_END(7);
        PH_BEGIN(8);
        {
            const LB L = layer_buf(p.ws, p.out, l);
            pg8::Gemm g{L.xbmid, L.wff1, M, DFF, D, nullptr};
            SchedRounds S{G, bx, 4, 0, 0};
            EpiFF1MK E{L.hff, ws_f(p.ws, WS_ROWSS) + (size_t)(2 * l + 1) * M * 16};
            pg8::gemm_phase<EpiFF1MK, SchedRounds, true, true>(l3, g, S, E);
        }
        GRID_BAR();
        PH_END(8);
        PH_BEGIN(9);
        {
            const LB L = layer_buf(p.ws, p.out, l);
            pg8::Gemm g{L.hff, L.wff2, M, D, DFF, nullptr};
            SchedRounds S{G, bx, 1, 0, 0};
            EpiResidMK E{L.xbmid, L.xbnext, ws_f(p.ws, WS_ROWSS) + (size_t)(2 * l + 2) * M * 16};
            pg8::gemm_phase<EpiResidMK, SchedRounds, true, true>(l3, g, S, E);
        }
        GRID_BAR();
        PH_END(9);
    }
    {
        WAVE_IDS();
        finalnorm_rows(layer_buf(p.ws, p.out, 1).xbnext, p.out, ws_f(p.ws, WS_ROWSS) + (size_t)4 * M * 16, p.g_final, gw, ngw, lane);
    }
    if (PROBE_MASK != 0 && bx == 0 && threadIdx.x == 0) { const unsigned long long te = __builtin_amdgcn_s_memrealtime(); while (__builtin_amdgcn_s_memrealtime() - te < 10ull * pr_acc) __builtin_amdgcn_s_sleep(8); }
}
}

extern "C" void kernel_launch(void* const* d_in, const int* in_sizes, int n_in, void* d_out, int out_size, void* d_ws, size_t ws_size, hipStream_t stream) {
    static int grid = 0;
    if (grid == 0) {
        if (n_in != 20 || out_size != M * D || ws_size < WS_END) { fprintf(stderr, "kernel_launch: unexpected shapes (n_in %d out %d ws %zu)\n", n_in, out_size, ws_size); grid = -1; return; }
        int dev = 0, cus = 0, per_cu = 0;
        if (hipGetDevice(&dev) != hipSuccess || hipDeviceGetAttribute(&cus, hipDeviceAttributeMultiprocessorCount, dev) != hipSuccess) { fprintf(stderr, "kernel_launch: device query failed\n"); grid = -1; return; }
        if (hipFuncSetAttribute((const void*)mk_fwd, hipFuncAttributeMaxDynamicSharedMemorySize, LDS_BYTES) != hipSuccess) { fprintf(stderr, "kernel_launch: hipFuncSetAttribute failed\n"); grid = -1; return; }
        if (hipOccupancyMaxActiveBlocksPerMultiprocessor(&per_cu, (const void*)mk_fwd, 512, LDS_BYTES) != hipSuccess || per_cu < 1) { fprintf(stderr, "kernel_launch: occupancy query says %d blocks per CU\n", per_cu); grid = -1; return; }
        grid = cus;
    }
    if (grid < 0) return;
    P p{};
    const float** pf = (const float**)&p;
    for (int i = 0; i < 20; ++i) pf[i] = (const float*)d_in[i];
    p.out = (float*)d_out; p.ws = (unsigned char*)d_ws;
    if (hipMemsetAsync(d_ws, 0, WS_ZERO_BYTES, stream) != hipSuccess) { fprintf(stderr, "kernel_launch: memset failed\n"); return; }
    void* args[] = {&p};
    const hipError_t e = hipLaunchCooperativeKernel((const void*)mk_fwd, dim3(grid), dim3(512), args, LDS_BYTES, stream);
    if (e != hipSuccess) fprintf(stderr, "kernel_launch: cooperative launch failed: %s (grid %d)\n", hipGetErrorString(e), grid);
}
```

```cpp
#include <hip/hip_runtime.h>
#include <cstdio>
#include <cstdint>
#ifndef PROBE_MASK
#define PROBE_MASK 0
#endif

namespace pg8 {
#define PG8_LAS __attribute__((address_space(3)))
typedef unsigned short bf16_t;
typedef short bf16x8 __attribute__((ext_vector_type(8)));
typedef float f32x4 __attribute__((ext_vector_type(4)));
typedef unsigned u32x4 __attribute__((ext_vector_type(4)));
constexpr int BM = 256, BK = 64, HALF = 128, HTB = HALF * BK * 2  , STAGE_BYTES = 8 * HTB, NXCD = 8, WGM = 8;

__host__ __device__ __forceinline__ int lds_byte(int r, int c) { const int st = (r >> 4) * 2 + (c >> 5), rr = r & 15, cc = c & 31, ob = rr * 64 + cc * 2; return st * 1024 + (ob ^ (((ob >> 9) & 1) << 5)); }
__host__ __device__ __forceinline__ void stage_rc(int b, int& R, int& C) { const int st = b / 1024, sb = b % 1024, swz = sb ^ (((sb >> 9) & 1) << 5); R = (st >> 1) * 16 + swz / 64; C = (st & 1) * 32 + (swz % 64) / 2; }
__host__ __device__ __forceinline__ int perm32(int rho) { const int n = rho >> 4, i = rho & 15; return 8 * (i >> 2) + 4 * n + (i & 3); }
struct Unit { int pm, pn, rm, kind, asel; };
struct Gemm { const bf16_t* A; const bf16_t* Bt; int M, N, K; const bf16_t* A2; };
__device__ __forceinline__ unsigned cvt_pk_bf16(float lo, float hi) { unsigned r; asm volatile("v_cvt_pk_bf16_f32 %0, %1, %2" : "=v"(r) : "v"(lo), "v"(hi)); return r; }
template <class Epi, class Sched, bool ALIGN_EPI = false, bool SP2 = false>
__device__ __forceinline__ void gemm_phase(PG8_LAS unsigned char* lds, const Gemm g, const Sched& S, const Epi& E) {
    int tid_l = threadIdx.x; asm volatile("" : "+v"(tid_l));
    const int tid = tid_l, wid = __builtin_amdgcn_readfirstlane(tid >> 6), lane = tid & 63, wr = wid >> 2, wc = wid & 3, fr = lane & 15, fq = lane >> 4;
    const int K = g.K, nt = K / BK;
    unsigned voffA[2], voffB[2];
#pragma unroll
    for (int i = 0; i < 2; ++i) { int R, C; stage_rc(tid * 16 + i * 8192, R, C); const int Rb = Epi::PERM ? ((R & ~31) + perm32(R & 31)) : R;
        voffA[i] = (unsigned)(R * K + C) * 2u; voffB[i] = (unsigned)(Rb * K + C) * 2u; }
    const size_t kstep = (size_t)(BK * 2);
    const size_t hstep = (size_t)HALF * K * 2;
    const size_t tstep = 2 * hstep;
    const unsigned ldsw = (unsigned)wid * 1024u;
    const int aoff = lds_byte(wr * 64 + fr, fq * 8), boff = lds_byte(wc * 32 + fr, fq * 8);
#define PG8_SA(b, h) (((b) * 2 + (h)) * HTB)
#define PG8_SB(b, h) ((4 + (b) * 2 + (h)) * HTB)
#define PG8_STAGE(bufoff, gbase, voff) do { _Pragma("unroll") for (int _i = 0; _i < 2; ++_i) \
        __builtin_amdgcn_global_load_lds((const unsigned*)((const char*)(gbase) + (voff)[_i]), (PG8_LAS unsigned*)(lds + (bufoff) + ldsw + _i * 8192), 16, 0, 0); } while (0)
#define PG8_LDA(dst, b, h) do { _Pragma("unroll") for (int m = 0; m < 4; ++m) _Pragma("unroll") for (int k = 0; k < 2; ++k) dst[m][k] = *(const PG8_LAS bf16x8*)(lds + PG8_SA(b, h) + aoff + m * 2048 + k * 1024); } while (0)
#define PG8_LDB(dst, b, h) do { _Pragma("unroll") for (int n = 0; n < 2; ++n) _Pragma("unroll") for (int k = 0; k < 2; ++k) dst[n][k] = *(const PG8_LAS bf16x8*)(lds + PG8_SB(b, h) + boff + n * 2048 + k * 1024); } while (0)
#define PG8_MMA(ai, bj, At, Bt) do { __builtin_amdgcn_s_setprio(1); _Pragma("unroll") for (int m = 0; m < 4; ++m) _Pragma("unroll") for (int n = 0; n < 2; ++n) _Pragma("unroll") for (int k = 0; k < 2; ++k) \
        acc[ai][bj][m][n] = __builtin_amdgcn_mfma_f32_16x16x32_bf16(Bt[n][k], At[m][k], acc[ai][bj][m][n], 0, 0, 0); __builtin_amdgcn_s_setprio(0); } while (0)
#define PG8_WAIT_V(n) asm volatile("s_waitcnt vmcnt(" #n ")" ::: "memory")
#define PG8_WAIT_L(n) asm volatile("s_waitcnt lgkmcnt(" #n ")" ::: "memory")
#define PG8_BAR __builtin_amdgcn_s_barrier()
#define PG8_SCHED __builtin_amdgcn_sched_barrier(0)
    Unit cur, nxt; int ui = 0;
    if (!S.next(0, cur)) return;
    f32x4 acc[2][2][4][2];
#pragma unroll
    for (int a = 0; a < 2; ++a)
#pragma unroll
        for (int b = 0; b < 2; ++b)
#pragma unroll
            for (int m = 0; m < 4; ++m)
#pragma unroll
                for (int n = 0; n < 2; ++n) acc[a][b][m][n] = (f32x4){0.f, 0.f, 0.f, 0.f};
    bf16x8 At[4][2], B0[2][2], B1[2][2];
    const char* cA = (const char*)(cur.asel ? g.A2 : g.A) + (size_t)cur.pm * tstep; const char* cB = (const char*)g.Bt + (size_t)cur.pn * tstep;
    S.a_ready(cur);
    if constexpr (SP2) {
        PG8_STAGE(PG8_SB(0, 0), cB, voffB); PG8_STAGE(PG8_SB(0, 1), cB + hstep, voffB); PG8_STAGE(PG8_SA(0, 0), cA, voffA); PG8_STAGE(PG8_SA(0, 1), cA + hstep, voffA);
        if (wr == 1) PG8_BAR;
        PG8_WAIT_V(2); PG8_BAR;
        PG8_STAGE(PG8_SB(1, 0), cB + kstep, voffB); PG8_STAGE(PG8_SA(1, 0), cA + kstep, voffA); PG8_STAGE(PG8_SB(1, 1), cB + hstep + kstep, voffB);
        PG8_WAIT_V(6); PG8_BAR;
    } else {
        PG8_STAGE(PG8_SB(0, 0), cB, voffB); PG8_STAGE(PG8_SA(0, 0), cA, voffA); PG8_STAGE(PG8_SB(0, 1), cB + hstep, voffB); PG8_STAGE(PG8_SA(0, 1), cA + hstep, voffA);
        if (wr == 1) PG8_BAR;
        PG8_WAIT_V(4); PG8_BAR;
        PG8_STAGE(PG8_SB(1, 0), cB + kstep, voffB); PG8_STAGE(PG8_SA(1, 0), cA + kstep, voffA); PG8_STAGE(PG8_SB(1, 1), cB + hstep + kstep, voffB);
        PG8_WAIT_V(6); PG8_BAR;
    }
    for (;;) {
        const bool has_next = S.next(ui + 1, nxt);
        const char* nA = has_next ? (const char*)(nxt.asel ? g.A2 : g.A) + (size_t)nxt.pm * tstep : cA; const char* nB = has_next ? (const char*)g.Bt + (size_t)nxt.pn * tstep : cB;
        for (int t = 0; t < nt; t += 2) {
            const bool last = (t == nt - 2);
            const char* a1 = cA + (size_t)(t + 1) * kstep;
            const char* a2 = last ? nA : cA + (size_t)(t + 2) * kstep; const char* b2 = last ? nB : cB + (size_t)(t + 2) * kstep;
            const char* a3 = a2 + kstep; const char* b3 = b2 + kstep;
            if (last && has_next) S.a_ready(nxt);
            if constexpr (SP2) {
            PG8_LDB(B0, 0, 0); PG8_LDB(B1, 0, 1); PG8_SCHED; PG8_LDA(At, 0, 0); PG8_STAGE(PG8_SA(1, 1), a1 + hstep, voffA);
            PG8_WAIT_V(8); PG8_WAIT_L(0); PG8_BAR; PG8_MMA(0, 0, At, B0); PG8_MMA(0, 1, At, B1); PG8_BAR; PG8_SCHED;
            PG8_LDA(At, 0, 1); PG8_STAGE(PG8_SB(0, 0), b2, voffB); PG8_STAGE(PG8_SB(0, 1), b2 + hstep, voffB); PG8_STAGE(PG8_SA(0, 0), a2, voffA);
            PG8_WAIT_V(8); PG8_WAIT_L(0); PG8_BAR; PG8_MMA(1, 0, At, B0); PG8_MMA(1, 1, At, B1); PG8_BAR; PG8_SCHED;
            PG8_LDB(B0, 1, 0); PG8_LDB(B1, 1, 1); PG8_SCHED; PG8_LDA(At, 1, 0); PG8_STAGE(PG8_SA(0, 1), a2 + hstep, voffA);
            PG8_WAIT_V(8); PG8_WAIT_L(0); PG8_BAR; PG8_MMA(0, 0, At, B0); PG8_MMA(0, 1, At, B1); PG8_BAR; PG8_SCHED;
            PG8_LDA(At, 1, 1); PG8_STAGE(PG8_SB(1, 0), b3, voffB); PG8_STAGE(PG8_SB(1, 1), b3 + hstep, voffB); PG8_STAGE(PG8_SA(1, 0), a3, voffA);
            PG8_WAIT_V(8); PG8_WAIT_L(0); PG8_BAR; PG8_MMA(1, 0, At, B0); PG8_MMA(1, 1, At, B1); PG8_BAR; PG8_SCHED;
            } else {
            PG8_LDB(B0, 0, 0); PG8_SCHED; PG8_LDA(At, 0, 0); PG8_STAGE(PG8_SA(1, 1), a1 + hstep, voffA);
            PG8_WAIT_L(8); PG8_BAR; PG8_WAIT_L(0); PG8_MMA(0, 0, At, B0); PG8_BAR; PG8_SCHED;
            PG8_LDB(B1, 0, 1); PG8_STAGE(PG8_SB(0, 0), b2, voffB);
            PG8_BAR; PG8_WAIT_L(0); PG8_MMA(0, 1, At, B1); PG8_BAR;
            PG8_LDA(At, 0, 1); PG8_STAGE(PG8_SA(0, 0), a2, voffA);
            PG8_BAR; PG8_WAIT_L(0); PG8_MMA(1, 0, At, B0); PG8_BAR; PG8_SCHED;
            PG8_STAGE(PG8_SB(0, 1), b2 + hstep, voffB);
            PG8_WAIT_V(6); PG8_BAR; PG8_MMA(1, 1, At, B1); PG8_BAR;
            PG8_LDB(B0, 1, 0); PG8_SCHED; PG8_LDA(At, 1, 0); PG8_STAGE(PG8_SA(0, 1), a2 + hstep, voffA);
            PG8_WAIT_L(8); PG8_BAR; PG8_WAIT_L(0); PG8_MMA(0, 0, At, B0); PG8_BAR; PG8_SCHED;
            PG8_LDB(B1, 1, 1); PG8_STAGE(PG8_SB(1, 0), b3, voffB);
            PG8_BAR; PG8_WAIT_L(0); PG8_MMA(0, 1, At, B1); PG8_BAR;
            PG8_LDA(At, 1, 1); PG8_STAGE(PG8_SA(1, 0), a3, voffA);
            PG8_BAR; PG8_WAIT_L(0); PG8_MMA(1, 0, At, B0); PG8_BAR; PG8_SCHED;
            PG8_STAGE(PG8_SB(1, 1), b3 + hstep, voffB);
            PG8_WAIT_V(6); PG8_BAR; PG8_MMA(1, 1, At, B1); PG8_BAR;
            }
        }
        if constexpr (ALIGN_EPI) { if (wr == 0) PG8_BAR; }
        if constexpr (!Epi::AFTER_DRAIN) { E(acc, cur, wr, wc, fr, fq); S.done(cur); }
        const bool keep_acc = E.keep(cur);
        if (!has_next) break;
        if (!keep_acc) {
#pragma unroll
        for (int a = 0; a < 2; ++a)
#pragma unroll
            for (int b = 0; b < 2; ++b)
#pragma unroll
                for (int m = 0; m < 4; ++m)
#pragma unroll
                    for (int n = 0; n < 2; ++n) acc[a][b][m][n] = (f32x4){0.f, 0.f, 0.f, 0.f};
        }
        cur = nxt; cA = nA; cB = nB; ++ui;
        if constexpr (ALIGN_EPI) { if (wr == 1) PG8_BAR; }
    }
    PG8_WAIT_V(0);
    if constexpr (!ALIGN_EPI) { if (wr == 0) PG8_BAR; }
    PG8_BAR;
    if constexpr (Epi::AFTER_DRAIN) { E.fused(acc, cur, wr, wc, fr, fq, lds, wid, lane); S.done(cur); }
#undef PG8_SA
#undef PG8_SB
#undef PG8_STAGE
#undef PG8_LDA
#undef PG8_LDB
#undef PG8_MMA
#undef PG8_WAIT_V
#undef PG8_WAIT_L
#undef PG8_BAR
#undef PG8_SCHED
}
}

namespace {
using pg8::bf16_t; using pg8::f32x4; using pg8::u32x4; using pg8::Unit;
#define LAS __attribute__((address_space(3)))
constexpr int M = 16384, D = 1024, T = 2048, NB = 8, MEMLEN = 256, MM = NB * MEMLEN;
constexpr int INC = 6416, DFF = 4096, NCH = 32, NH = 8;
constexpr float EPS = 1e-6f;
constexpr size_t MiB = 1u << 20;
constexpr size_t WS_POOL_C = 77u << 20;
constexpr size_t WS_BAR = 0;
constexpr size_t WS_ROWSS = WS_POOL_C + 142 * (1u << 20);
constexpr size_t WS_ZERO_BYTES = 64 * 1024;
constexpr size_t WS_ROWSS_MEM = WS_POOL_C + 141 * (1u << 20);
constexpr size_t WS_G = 400 * 1024, WS_ML = 408 * 1024, WS_MIN = 416 * 1024;
constexpr size_t WS_DN = 512 * 1024;
constexpr size_t WS_WT = 1 * MiB;
constexpr size_t WT_WIN = 0, WT_WMEM = (size_t)6656 * D * 2, WT_WBR = WT_WMEM + (size_t)D * D * 2, WT_WOUT = WT_WBR + (size_t)3 * D * 512 * 2,
                 WT_FF1 = WT_WOUT + (size_t)D * D * 2, WT_FF2 = WT_FF1 + (size_t)DFF * D * 2, WT_LAYER = WT_FF2 + (size_t)D * DFF * 2;
constexpr size_t WS_MEMB = 73 * MiB, WS_POOL = 77 * MiB, WS_END = 256 * MiB;
static_assert(WS_WT + 2 * WT_LAYER <= WS_MEMB && WS_POOL_C == WS_POOL, "weights fit");
constexpr int LDS_RING = 131072, LDS_BYTES = 147456, LDS_CTL = LDS_BYTES - 256;

struct P {
    const float *x, *mem, *rel_bias, *g_mix, *w_in, *conv_w, *b_i, *b_f, *norm_g, *sinks, *g_mem, *w_mem_kv, *w_br0, *w_br1, *w_br2, *w_out, *g_ffn, *w_ff1, *w_ff2, *g_final;
    float* out; unsigned char* ws;
};
struct LB {
    bf16_t *xbin, *sq, *mo, *xq, *skv, *mqk, *mv, *memkv, *merged, *xbmid, *hff, *xbnext;
    unsigned char* gates;
    float* iff; bf16_t* state;
    const bf16_t *win, *wmem, *wbr, *wout, *wff1, *wff2;
};
__host__ __device__ inline LB layer_buf(unsigned char* ws, float* out, int l) {
    LB b; unsigned char* pool = ws + WS_POOL; unsigned char* breg = pool;
    b.xbin = (bf16_t*)out; b.xbmid = (bf16_t*)((unsigned char*)out + 32 * MiB); b.xbnext = l == 1 ? (bf16_t*)(pool + 147 * MiB) : (bf16_t*)out;
    b.merged = (bf16_t*)(pool + 147 * MiB); b.hff = (bf16_t*)pool;
    b.sq = (bf16_t*)breg; b.mo = (bf16_t*)(breg + 16 * MiB); b.xq = (bf16_t*)(breg + 32 * MiB);
    b.gates = breg + 48 * MiB;
    b.skv = (bf16_t*)(breg + 48 * MiB); b.mqk = (bf16_t*)(breg + 56 * MiB); b.mv = (bf16_t*)(breg + 88 * MiB);
    b.iff = (float*)(breg + 104 * MiB); b.memkv = (bf16_t*)(breg + 105 * MiB); b.state = (bf16_t*)(breg + 109 * MiB);
    unsigned char* wt = ws + WS_WT + (size_t)l * WT_LAYER;
    b.win = (const bf16_t*)(wt + WT_WIN); b.wmem = (const bf16_t*)(wt + WT_WMEM); b.wbr = (const bf16_t*)(wt + WT_WBR);
    b.wout = (const bf16_t*)(wt + WT_WOUT); b.wff1 = (const bf16_t*)(wt + WT_FF1); b.wff2 = (const bf16_t*)(wt + WT_FF2);
    return b;
}
__device__ __forceinline__ float* ws_f(unsigned char* ws, size_t off) { return (float*)(ws + off); }

__device__ __forceinline__ float bf2f(bf16_t h) { return __uint_as_float(((unsigned)h) << 16); }
__device__ __forceinline__ bf16_t f2bf(float f) { unsigned u = __float_as_uint(f); u = (u + 0x7fffu + ((u >> 16) & 1u)) >> 16; return (bf16_t)u; }
__device__ __forceinline__ unsigned pk2(float lo, float hi) { return (unsigned)f2bf(lo) | ((unsigned)f2bf(hi) << 16); }
__device__ __forceinline__ float sigmoidf_(float v) { return 1.f / (1.f + expf(-v)); }
__device__ __forceinline__ float fsigmoid(float v) { return __builtin_amdgcn_rcpf(1.f + __expf(-v)); }
__device__ __forceinline__ float wave_sum(float v) {
#pragma unroll
    for (int o = 1; o < 64; o <<= 1) v += __shfl_xor(v, o);
    return v;
}
__device__ __forceinline__ float wave_max(float v) {
#pragma unroll
    for (int o = 1; o < 64; o <<= 1) v = fmaxf(v, __shfl_xor(v, o));
    return v;
}
__device__ __forceinline__ void unpack8(const uint4 a, float (&f)[8]) {
    f[0] = __uint_as_float(a.x << 16); f[1] = __uint_as_float(a.x & 0xffff0000u); f[2] = __uint_as_float(a.y << 16); f[3] = __uint_as_float(a.y & 0xffff0000u);
    f[4] = __uint_as_float(a.z << 16); f[5] = __uint_as_float(a.z & 0xffff0000u); f[6] = __uint_as_float(a.w << 16); f[7] = __uint_as_float(a.w & 0xffff0000u);
}
__device__ const unsigned char T5_BUCKET[128] = {0, 1, 2, 3, 4, 5, 6, 7, 8, 9, 10, 11, 12, 13, 14, 15, 16, 16, 16, 17, 17, 18, 18, 18, 19, 19, 19, 20, 20, 20, 20, 21, 21, 21, 21, 22, 22, 22, 22, 22, 23, 23, 23, 23, 23, 23, 24, 24, 24, 24, 24, 24, 25, 25, 25, 25, 25, 25, 25, 26, 26, 26, 26, 26, 26, 26, 26, 27, 27, 27, 27, 27, 27, 27, 27, 27, 27, 28, 28, 28, 28, 28, 28, 28, 28, 28, 28, 29, 29, 29, 29, 29, 29, 29, 29, 29, 29, 29, 29, 30, 30, 30, 30, 30, 30, 30, 30, 30, 30, 30, 30, 30, 30, 31, 31, 31, 31, 31, 31, 31, 31, 31, 31, 31, 31, 31, 31, 31};

__device__ __forceinline__ float rstd_of(const float* rp, int row) {
    const f32x4* q = (const f32x4*)(rp + (size_t)row * 16); const f32x4 a = q[0], b = q[1], c = q[2], d = q[3];
    const float ss = ((a[0] + a[1]) + (a[2] + a[3])) + ((b[0] + b[1]) + (b[2] + b[3])) + (((c[0] + c[1]) + (c[2] + c[3])) + ((d[0] + d[1]) + (d[2] + d[3])));
    return rsqrtf(ss * (1.f / D) + EPS);
}
struct SchedRounds {
    int G, c, nfull, pn_base, tail;
    __device__ __forceinline__ bool next(int i, Unit& u) const {
        const int L = i * G + c;
        if (L < nfull * 256) { const int r = L >> 8, w = L & 255, x = w & 7, j = w >> 3; u.pm = u.rm = 8 * x + (j & 7); u.pn = pn_base + 4 * r + (j >> 3); u.kind = 0; u.asel = 0; return true; }
        if (!tail) return false;
        const int t = L - nfull * 256;
        if (t < 64) { u.pm = u.rm = t; u.pn = 12; u.kind = 0; u.asel = 0; return true; }
        if (t < 128) { u.pm = u.rm = t - 64; u.pn = 25; u.kind = 0; u.asel = 0; return true; }
        if (t < 160) { const int q = t - 128; u.pm = u.rm = q >> 2; u.pn = 26 + (q & 3); u.kind = 1; u.asel = 1; return true; }
        return false;
    }
    __device__ __forceinline__ void a_ready(const Unit&) const {}
    __device__ __forceinline__ void done(const Unit&) const {}
};
struct SchedMerged {
    int G, c;
    __device__ __forceinline__ bool next(int i, Unit& u) const {
        const int tt = (i / 3) * G + c, seg = i % 3; if (tt >= 256) return false;
        const int x = tt & 7, j = tt >> 3; u.rm = 8 * x + (j & 7); u.pm = seg * 64 + u.rm; u.pn = seg * 4 + (j >> 3); u.kind = seg; u.asel = 0; return true;
    }
    __device__ __forceinline__ void a_ready(const Unit&) const {}
    __device__ __forceinline__ void done(const Unit&) const {}
};

__device__ __forceinline__ u32x4 pack8(f32x4 a, f32x4 b) { u32x4 w; w.x = pg8::cvt_pk_bf16(a[0], a[1]); w.y = pg8::cvt_pk_bf16(a[2], a[3]); w.z = pg8::cvt_pk_bf16(b[0], b[1]); w.w = pg8::cvt_pk_bf16(b[2], b[3]); return w; }
__device__ __forceinline__ f32x4 sig4(f32x4 v) { f32x4 r; r[0] = fsigmoid(v[0]); r[1] = fsigmoid(v[1]); r[2] = fsigmoid(v[2]); r[3] = fsigmoid(v[3]); return r; }
struct EpiProjMK {
    static constexpr bool PERM = true, AFTER_DRAIN = false;
    LB L; const float* rowss; const float* rowss_mem;
    __device__ __forceinline__ bool keep(const Unit&) const { return false; }
    __device__ __forceinline__ void operator()(f32x4 (&acc)[2][2][4][2], const Unit& u, int wr, int wc, int fr, int fq) const {
        const int rbase = u.rm * 256 + wr * 64 + fr, cin = wc * 32 + 8 * fq;
        const float* rs = rowss; bf16_t* dst; int ld, coff; bool sig = false; const int tile = u.pn;
        if (u.kind == 1) { rs = rowss_mem; dst = L.memkv; ld = 1024; coff = (tile - 26) * 256; }
        else if (tile < 2) { dst = L.sq; ld = 512; coff = tile * 256; }
        else if (tile < 3) { dst = L.skv; ld = 256; coff = 0; }
        else if (tile < 7) { dst = L.mqk; ld = 1024; coff = (tile - 3) * 256; }
        else if (tile < 9) { dst = L.mv; ld = 512; coff = (tile - 7) * 256; }
        else if (tile < 11) { dst = L.mo; ld = 512; coff = (tile - 9) * 256; sig = true; }
        else if (tile < 13) { dst = L.xq; ld = 512; coff = (tile - 11) * 256; }
        else { dst = nullptr; ld = 0; coff = 0; }
#pragma unroll
        for (int ai = 0; ai < 2; ++ai)
#pragma unroll
            for (int m = 0; m < 4; ++m) {
                const int row = rbase + ai * 128 + m * 16; const float rstd = rstd_of(rs, row);
#pragma unroll
                for (int bj = 0; bj < 2; ++bj) {
                    f32x4 v0 = acc[ai][bj][m][0] * rstd, v1 = acc[ai][bj][m][1] * rstd;
                    if (dst) { if (sig) { v0 = sig4(v0); v1 = sig4(v1); }
                        *(u32x4*)(dst + (size_t)row * ld + coff + bj * 128 + cin) = pack8(v0, v1); }
                    else if (tile < 25) {
                        v0 = sig4(v0) * 256.f; v1 = sig4(v1) * 256.f; uint2 w;
                        w.x = (unsigned)fminf(v0[0], 255.f) | ((unsigned)fminf(v0[1], 255.f) << 8) | ((unsigned)fminf(v0[2], 255.f) << 16) | ((unsigned)fminf(v0[3], 255.f) << 24);
                        w.y = (unsigned)fminf(v1[0], 255.f) | ((unsigned)fminf(v1[1], 255.f) << 8) | ((unsigned)fminf(v1[2], 255.f) << 16) | ((unsigned)fminf(v1[3], 255.f) << 24);
                        *(uint2*)(L.gates + (size_t)row * 3072 + (tile - 13) * 256 + bj * 128 + cin) = w; }
                    else if (bj == 0 && cin < 16) { *(f32x4*)(L.iff + (size_t)row * 16 + cin) = v0; *(f32x4*)(L.iff + (size_t)row * 16 + cin + 4) = v1; }
                }
            }
    }
};
struct EpiMergedMK {
    static constexpr bool PERM = true, AFTER_DRAIN = false;
    const unsigned char* gates; bf16_t* merged;
    __device__ __forceinline__ bool keep(const Unit& u) const { return u.kind < 2; }
    __device__ __forceinline__ static void deq8(uint2 w, float (&g)[8]) {
        g[0] = (float)(w.x & 255u) + 0.5f; g[1] = (float)((w.x >> 8) & 255u) + 0.5f; g[2] = (float)((w.x >> 16) & 255u) + 0.5f; g[3] = (float)(w.x >> 24) + 0.5f;
        g[4] = (float)(w.y & 255u) + 0.5f; g[5] = (float)((w.y >> 8) & 255u) + 0.5f; g[6] = (float)((w.y >> 16) & 255u) + 0.5f; g[7] = (float)(w.y >> 24) + 0.5f; }
    __device__ __forceinline__ void operator()(f32x4 (&acc)[2][2][4][2], const Unit& u, int wr, int wc, int fr, int fq) const {
        const int rbase = u.rm * 256 + wr * 64 + fr, col0 = (u.pn & 3) * 256 + wc * 32 + 8 * fq, seg = u.kind;
#pragma unroll
        for (int ai = 0; ai < 2; ++ai)
#pragma unroll
            for (int m = 0; m < 4; ++m) {
                const int row = rbase + ai * 128 + m * 16;
#pragma unroll
                for (int bj = 0; bj < 2; ++bj) {
                    const int col = col0 + bj * 128;
                    float g[8]; deq8(*(const uint2*)(gates + (size_t)row * 3072 + seg * 1024 + col), g);
                    if (seg < 2) { float gn[8]; deq8(*(const uint2*)(gates + (size_t)row * 3072 + (seg + 1) * 1024 + col), gn);
#pragma unroll
                        for (int j = 0; j < 8; ++j) g[j] = g[j] * __builtin_amdgcn_rcpf(gn[j]); }
                    else {
#pragma unroll
                        for (int j = 0; j < 8; ++j) g[j] *= (1.f / 256.f); }
                    f32x4 v0 = acc[ai][bj][m][0], v1 = acc[ai][bj][m][1];
                    v0[0] *= g[0]; v0[1] *= g[1]; v0[2] *= g[2]; v0[3] *= g[3]; v1[0] *= g[4]; v1[1] *= g[5]; v1[2] *= g[6]; v1[3] *= g[7];
                    acc[ai][bj][m][0] = v0; acc[ai][bj][m][1] = v1;
                    if (seg == 2) *(u32x4*)(merged + (size_t)row * D + col) = pack8(v0, v1);
                }
            }
    }
};
struct EpiResidMK {
    static constexpr bool PERM = true, AFTER_DRAIN = false;
    const bf16_t* xold; bf16_t* xnew; float* rowss;
    __device__ __forceinline__ bool keep(const Unit&) const { return false; }
    __device__ __forceinline__ void operator()(f32x4 (&acc)[2][2][4][2], const Unit& u, int wr, int wc, int fr, int fq) const {
        const int rbase = u.rm * 256 + wr * 64 + fr, col0 = u.pn * 256 + wc * 32 + 8 * fq;
#pragma unroll
        for (int ai = 0; ai < 2; ++ai)
#pragma unroll
            for (int m = 0; m < 4; ++m) {
                const int row = rbase + ai * 128 + m * 16; const size_t off = (size_t)row * D + col0; float ss = 0.f;
#pragma unroll
                for (int bj = 0; bj < 2; ++bj) {
                    float o[8]; unpack8(*(const uint4*)(xold + off + bj * 128), o);
                    f32x4 v0 = acc[ai][bj][m][0], v1 = acc[ai][bj][m][1];
                    v0[0] += o[0]; v0[1] += o[1]; v0[2] += o[2]; v0[3] += o[3]; v1[0] += o[4]; v1[1] += o[5]; v1[2] += o[6]; v1[3] += o[7];
                    const u32x4 w = pack8(v0, v1); *(u32x4*)(xnew + off + bj * 128) = w;
                    float r[8]; unpack8(__builtin_bit_cast(uint4, w), r);
#pragma unroll
                    for (int j = 0; j < 8; ++j) ss = fmaf(r[j], r[j], ss);
                }
                ss += __shfl_xor(ss, 16); ss += __shfl_xor(ss, 32);
                if (fq == 0) rowss[(size_t)row * 16 + (u.pn & 3) * 4 + wc] = ss;
            }
    }
};
struct EpiFF1MK {
    static constexpr bool PERM = true, AFTER_DRAIN = false;
    bf16_t* h; const float* rowss;
    __device__ __forceinline__ bool keep(const Unit&) const { return false; }
    __device__ __forceinline__ void operator()(f32x4 (&acc)[2][2][4][2], const Unit& u, int wr, int wc, int fr, int fq) const {
        const int rbase = u.rm * 256 + wr * 64 + fr, col0 = u.pn * 256 + wc * 32 + 8 * fq;
#pragma unroll
        for (int ai = 0; ai < 2; ++ai)
#pragma unroll
            for (int m = 0; m < 4; ++m) {
                const int row = rbase + ai * 128 + m * 16; const float rstd = rstd_of(rowss, row);
#pragma unroll
                for (int bj = 0; bj < 2; ++bj) {
                    f32x4 v0 = acc[ai][bj][m][0] * rstd, v1 = acc[ai][bj][m][1] * rstd;
#pragma unroll
                    for (int j = 0; j < 4; ++j) { v0[j] = fmaxf(v0[j], 0.f); v0[j] *= v0[j]; v1[j] = fmaxf(v1[j], 0.f); v1[j] *= v1[j]; }
                    *(u32x4*)(h + (size_t)row * DFF + col0 + bj * 128) = pack8(v0, v1);
                }
            }
    }
};

__device__ __forceinline__ void convert_tile_w(const float* src, int ldsrc, int col0, int ncols, int k0, const float* gain, float scale, bf16_t* dst, int K, float* tile, int lane) {
    const int n4 = (lane & 7) * 4;
#pragma unroll
    for (int i = 0; i < 8; ++i) { const int kk = (lane >> 3) + 8 * i; f32x4 v = (f32x4){0.f, 0.f, 0.f, 0.f};
        if (n4 < ncols) v = *(const f32x4*)(src + (size_t)(k0 + kk) * ldsrc + col0 + n4);
        v = v * ((gain ? gain[k0 + kk] : 1.f) * scale);
        tile[kk * 33 + n4] = v[0]; tile[kk * 33 + n4 + 1] = v[1]; tile[kk * 33 + n4 + 2] = v[2]; tile[kk * 33 + n4 + 3] = v[3]; }
    asm volatile("s_waitcnt lgkmcnt(0)" ::: "memory");
    const int kc = lane & 7;
#pragma unroll
    for (int i = 0; i < 4; ++i) { const int n = (lane >> 3) + 8 * i; const float* tp = tile + (8 * kc) * 33 + n;
        u32x4 w; w.x = pk2(tp[0], tp[33]); w.y = pk2(tp[66], tp[99]); w.z = pk2(tp[132], tp[165]); w.w = pk2(tp[198], tp[231]);
        if (n < ncols) *(u32x4*)(dst + (size_t)n * K + k0 + 8 * kc) = w; }
    asm volatile("s_waitcnt lgkmcnt(0)" ::: "memory");
}
constexpr int CV_ITEMS_LAYER = 9104;
__device__ __forceinline__ void convert_item(const P& p, int item, float* tile, int lane) {
    const int l = item / CV_ITEMS_LAYER; int r = item % CV_ITEMS_LAYER;
    unsigned char* wt = p.ws + WS_WT + (size_t)l * WT_LAYER;
    const float* src; const float* gain = nullptr; int ld, col0, ncols, K; float sc = 1.f; bf16_t* dst;
    if (r < 3216) {
        const float* win = p.w_in + (size_t)l * D * INC; src = win; ld = INC; K = D; gain = p.g_mix + l * D; int dr;
        if (r < 256) { col0 = 0; ncols = 512; dr = 0; sc = 0.125f; }
        else if ((r -= 256) < 896) { col0 = 512; ncols = 1792; dr = 512; }
        else if ((r -= 896) < 256) { col0 = 2320; ncols = 512; dr = 2304; }
        else if ((r -= 256) < 256) { col0 = 2832; ncols = 512; dr = 2816; sc = 0.08838834764831845f; }
        else if ((r -= 256) < 1536) { col0 = 3344; ncols = 3072; dr = 3328; }
        else { r -= 1536; col0 = 2304; ncols = 16; dr = 6400; }
        dst = (bf16_t*)(wt + WT_WIN) + (size_t)dr * D;
    } else if ((r -= 3216) < 512) { src = p.w_mem_kv + (size_t)l * D * 1024; ld = 1024; col0 = 0; ncols = 1024; K = D; gain = p.g_mem + l * D; dst = (bf16_t*)(wt + WT_WMEM); }
    else if ((r -= 512) < 768) { const int sg = r / 256; r -= sg * 256; src = (sg == 0 ? p.w_br0 : sg == 1 ? p.w_br1 : p.w_br2) + (size_t)l * 512 * 1024; ld = 1024; col0 = 0; ncols = 1024; K = 512; dst = (bf16_t*)(wt + WT_WBR) + (size_t)sg * 1024 * 512; }
    else if ((r -= 768) < 512) { src = p.w_out + (size_t)l * D * D; ld = 1024; col0 = 0; ncols = 1024; K = D; dst = (bf16_t*)(wt + WT_WOUT); }
    else if ((r -= 512) < 2048) { src = p.w_ff1 + (size_t)l * D * DFF; ld = DFF; col0 = 0; ncols = DFF; K = D; gain = p.g_ffn + l * D; dst = (bf16_t*)(wt + WT_FF1); }
    else { r -= 2048; src = p.w_ff2 + (size_t)l * DFF * D; ld = D; col0 = 0; ncols = D; K = DFF; dst = (bf16_t*)(wt + WT_FF2); }
    const int nnb = (ncols + 31) / 32, kb = r / nnb, nb = r % nnb, c0 = nb * 32, nc = (ncols - c0) < 32 ? (ncols - c0) : 32;
    convert_tile_w(src, ld, col0 + c0, nc, kb * 64, gain, sc, dst + (size_t)c0 * K, K, tile, lane);
}
__device__ __forceinline__ void rowstat_rows(const float* src, int rows, bf16_t* xb, float* rowss, int gw, int ngw, int lane) {
    for (int r = gw; r < rows; r += ngw) {
        const float4* s4 = (const float4*)(src + (size_t)r * D); float ss = 0.f;
#pragma unroll
        for (int j = 0; j < 4; ++j) { const float4 v = s4[lane + 64 * j]; ss += v.x * v.x + v.y * v.y + v.z * v.z + v.w * v.w;
            uint2 o; o.x = pk2(v.x, v.y); o.y = pk2(v.z, v.w); *(uint2*)(xb + (size_t)r * D + 4 * (lane + 64 * j)) = o; }
        ss = wave_sum(ss);
        if (lane < 16) rowss[(size_t)r * 16 + lane] = lane == 0 ? ss : 0.f;
    }
}
__device__ __forceinline__ void finalnorm_rows(const bf16_t* xb, float* out, const float* rowss, const float* g, int gw, int ngw, int lane) {
    for (int r = gw; r < M; r += ngw) {
        const float rstd = rstd_of(rowss, r);
#pragma unroll
        for (int j = 0; j < 2; ++j) { float x[8]; unpack8(*(const uint4*)(xb + (size_t)r * D + 8 * (lane + 64 * j)), x);
            const float4 g0 = *(const float4*)(g + 8 * (lane + 64 * j)), g1 = *(const float4*)(g + 8 * (lane + 64 * j) + 4);
            float4 o0, o1; o0.x = x[0] * rstd * g0.x; o0.y = x[1] * rstd * g0.y; o0.z = x[2] * rstd * g0.z; o0.w = x[3] * rstd * g0.w;
            o1.x = x[4] * rstd * g1.x; o1.y = x[5] * rstd * g1.y; o1.z = x[6] * rstd * g1.z; o1.w = x[7] * rstd * g1.w;
            *(float4*)(out + (size_t)r * D + 8 * (lane + 64 * j)) = o0; *(float4*)(out + (size_t)r * D + 8 * (lane + 64 * j) + 4) = o1; }
    }
}

typedef short bf16x8 __attribute__((ext_vector_type(8)));
typedef short s16x4 __attribute__((ext_vector_type(4)));
typedef float f32x16 __attribute__((ext_vector_type(16)));
typedef float f32x2 __attribute__((ext_vector_type(2)));
typedef __bf16 bf16x2v __attribute__((ext_vector_type(2)));
#define MFMA32(a, b, c) __builtin_amdgcn_mfma_f32_32x32x16_bf16((a), (b), (c), 0, 0, 0)
__device__ __forceinline__ int crow(int reg, int h) { return (reg & 3) + 8 * (reg >> 2) + 4 * h; }
__device__ __forceinline__ unsigned pkbf(float a, float b) { return __builtin_bit_cast(unsigned, __builtin_convertvector((f32x2){a, b}, bf16x2v)); }
__device__ __forceinline__ bf16x8 pack_step(const f32x16& x, int s) {
    u32x4 p; p.x = pkbf(x[8 * s], x[8 * s + 1]); p.y = pkbf(x[8 * s + 2], x[8 * s + 3]); p.z = pkbf(x[8 * s + 4], x[8 * s + 5]); p.w = pkbf(x[8 * s + 6], x[8 * s + 7]);
    return __builtin_bit_cast(bf16x8, p);
}
__device__ __forceinline__ bf16x8 tr_frag(const LAS unsigned char* img, int row_lo, int row_hi, int lane) {
    const int i16 = lane & 15, q = i16 >> 2, p = i16 & 3, blk = (lane >> 4) & 1;
    const s16x4 lo = __builtin_amdgcn_ds_read_tr16_b64_v4i16((LAS s16x4*)(img + (row_lo + q) * 64 + 32 * blk + 8 * p));
    const s16x4 hi = __builtin_amdgcn_ds_read_tr16_b64_v4i16((LAS s16x4*)(img + (row_hi + q) * 64 + 32 * blk + 8 * p));
    return __builtin_shufflevector(lo, hi, 0, 1, 2, 3, 4, 5, 6, 7);
}

constexpr int SWA_KIMG = 0, SWA_VIMG = 256 * 144, SWA_TAB = SWA_VIMG + 2 * 16384;
__device__ __forceinline__ void swa_mfma_unit(const P& p, const LB& L, int l, int u, LAS unsigned char* l3) {
    int tid_l = threadIdx.x; asm volatile("" : "+v"(tid_l)); const int tid = tid_l, lane = tid & 63, wave = tid >> 6, h = lane >> 5, ql = lane & 31;
    const int hkv = u & 1, n = (u >> 1) & 15, b = u >> 5;
    __syncthreads();
#pragma unroll
    for (int i = 0; i < 4; ++i) {
        const int c = tid + 512 * i, row = c >> 3, cc = c & 7, t = 128 * (n - 1) + row;
        u32x4 kv = (u32x4){0u, 0u, 0u, 0u}, vv = (u32x4){0u, 0u, 0u, 0u};
        if (t >= 0) { const bf16_t* src = L.skv + (size_t)(b * T + t) * 256 + hkv * 64 + cc * 8; kv = *(const u32x4*)src; vv = *(const u32x4*)(src + 128); }
        *(LAS u32x4*)(l3 + SWA_KIMG + row * 144 + cc * 16) = kv;
        *(LAS u32x4*)(l3 + SWA_VIMG + (cc >> 2) * 16384 + row * 64 + (cc & 3) * 16) = vv;
    }
    for (int idx = tid; idx < 4 * 192; idx += 512) { const int g = idx / 192, e = idx % 192, dist = 159 - e;
        ((LAS float*)(l3 + SWA_TAB))[idx] = (dist >= 0 && dist < 128) ? p.rel_bias[(int)T5_BUCKET[dist] * 8 + hkv * 4 + g] : -1e30f; }
    __syncthreads();
    const int g = wave >> 1, half = wave & 1, hq = hkv * 4 + g;
    const float sink = p.sinks[l * 8 + hq];
    const LAS float* tab = (const LAS float*)(l3 + SWA_TAB) + g * 192 + 31 - ql;
#pragma unroll 1
    for (int sb = 0; sb < 2; ++sb) {
        const int r0 = 64 * half + 32 * sb, kb0 = 2 * half + sb;
        bf16_t* qptr = L.sq + (size_t)(b * T + 128 * n + r0 + ql) * 512 + hq * 64;
        bf16x8 Qf[4];
#pragma unroll
        for (int ks = 0; ks < 4; ++ks) Qf[ks] = *(const bf16x8*)(qptr + 16 * ks + 8 * h);
        f32x16 S[5];
#pragma unroll
        for (int i = 0; i < 5; ++i) {
#pragma unroll
            for (int r = 0; r < 16; ++r) S[i][r] = 0.f;
#pragma unroll
            for (int ks = 0; ks < 4; ++ks) { const bf16x8 Kf = *(const LAS bf16x8*)(l3 + SWA_KIMG + (32 * (kb0 + i) + ql) * 144 + 32 * ks + 16 * h); S[i] = MFMA32(Kf, Qf[ks], S[i]); }
        }
        float m = sink;
#pragma unroll
        for (int i = 0; i < 5; ++i)
#pragma unroll
            for (int r = 0; r < 16; ++r) { const int kk = 32 * i + crow(r, h); float sv = S[i][r] + tab[kk];
                if (n == 0 && 32 * kb0 + kk < 128) sv = -1e30f;
                S[i][r] = sv; m = fmaxf(m, sv); }
        m = fmaxf(m, __shfl_xor(m, 32));
        float lsum = 0.f;
#pragma unroll
        for (int i = 0; i < 5; ++i)
#pragma unroll
            for (int r = 0; r < 16; ++r) { const float pe = __expf(S[i][r] - m); S[i][r] = pe; lsum += pe; }
        lsum += __shfl_xor(lsum, 32);
        f32x16 O[2];
#pragma unroll
        for (int db = 0; db < 2; ++db)
#pragma unroll
            for (int r = 0; r < 16; ++r) O[db][r] = 0.f;
#pragma unroll
        for (int i = 0; i < 5; ++i)
#pragma unroll
            for (int s2 = 0; s2 < 2; ++s2) { const bf16x8 Pf = pack_step(S[i], s2); const int k0 = 32 * (kb0 + i) + 16 * s2;
#pragma unroll
                for (int db = 0; db < 2; ++db) { const bf16x8 Vf = tr_frag(l3 + SWA_VIMG + db * 16384, k0 + 4 * h, k0 + 8 + 4 * h, lane); O[db] = MFMA32(Vf, Pf, O[db]); } }
        const float inv = 1.f / (lsum + __expf(sink - m));
#pragma unroll
        for (int db = 0; db < 2; ++db)
#pragma unroll
            for (int gq = 0; gq < 4; ++gq) { uint2 w; w.x = pkbf(O[db][4 * gq] * inv, O[db][4 * gq + 1] * inv); w.y = pkbf(O[db][4 * gq + 2] * inv, O[db][4 * gq + 3] * inv);
                *(uint2*)(qptr + 32 * db + 8 * gq + 4 * h) = w; }
    }
}

constexpr int XA_KIMG = 0, XA_VIMG = 256 * 272;
__device__ __forceinline__ void xattn_mfma_unit(const LB& L, int u, LAS unsigned char* l3) {
    int tid_l = threadIdx.x; asm volatile("" : "+v"(tid_l)); const int tid = tid_l, lane = tid & 63, wave = tid >> 6, h = lane >> 5, ql = lane & 31;
    const int qb = u & 7, hx = (u >> 3) & 3, b = u >> 5;
    __syncthreads();
#pragma unroll
    for (int i = 0; i < 8; ++i) {
        const int c = tid + 512 * i, row = c >> 4, cc = c & 15;
        const bf16_t* src = L.memkv + (size_t)(b * MEMLEN + row) * 1024 + hx * 128 + cc * 8;
        const u32x4 kv = *(const u32x4*)src, vv = *(const u32x4*)(src + 512);
        *(LAS u32x4*)(l3 + XA_KIMG + row * 272 + cc * 16) = kv;
        *(LAS u32x4*)(l3 + XA_VIMG + (cc >> 2) * 16384 + row * 64 + (cc & 3) * 16) = vv;
    }
    bf16_t* qptr = L.xq + (size_t)(b * T + qb * 256 + wave * 32 + ql) * 512 + hx * 128;
    bf16x8 Qf[8];
#pragma unroll
    for (int ks = 0; ks < 8; ++ks) Qf[ks] = *(const bf16x8*)(qptr + 16 * ks + 8 * h);
    __syncthreads();
    f32x16 S[8];
    {
#pragma unroll
        for (int i = 0; i < 8; ++i) {
#pragma unroll
            for (int r = 0; r < 16; ++r) S[i][r] = 0.f;
#pragma unroll
            for (int ks = 0; ks < 8; ++ks) { const bf16x8 Kf = *(const LAS bf16x8*)(l3 + XA_KIMG + (32 * i + ql) * 272 + 32 * ks + 16 * h); S[i] = MFMA32(Kf, Qf[ks], S[i]); }
        }
    }
    float m = -1e30f;
#pragma unroll
    for (int i = 0; i < 8; ++i)
#pragma unroll
        for (int r = 0; r < 16; ++r) m = fmaxf(m, S[i][r]);
    m = fmaxf(m, __shfl_xor(m, 32));
    float lsum = 0.f;
#pragma unroll
    for (int i = 0; i < 8; ++i)
#pragma unroll
        for (int r = 0; r < 16; ++r) { const float pe = __expf(S[i][r] - m); S[i][r] = pe; lsum += pe; }
    lsum += __shfl_xor(lsum, 32);
    f32x16 O[4];
#pragma unroll
    for (int db = 0; db < 4; ++db)
#pragma unroll
        for (int r = 0; r < 16; ++r) O[db][r] = 0.f;
#pragma unroll
    for (int i = 0; i < 8; ++i)
#pragma unroll
        for (int s2 = 0; s2 < 2; ++s2) { const bf16x8 Pf = pack_step(S[i], s2); const int k0 = 32 * i + 16 * s2;
#pragma unroll
            for (int db = 0; db < 4; ++db) { const bf16x8 Vf = tr_frag(l3 + XA_VIMG + db * 16384, k0 + 4 * h, k0 + 8 + 4 * h, lane); O[db] = MFMA32(Vf, Pf, O[db]); } }
    const float inv = 1.f / lsum;
#pragma unroll
    for (int db = 0; db < 4; ++db)
#pragma unroll
        for (int gq = 0; gq < 4; ++gq) { uint2 w; w.x = pkbf(O[db][4 * gq] * inv, O[db][4 * gq + 1] * inv); w.y = pkbf(O[db][4 * gq + 2] * inv, O[db][4 * gq + 3] * inv);
            *(uint2*)(qptr + 32 * db + 8 * gq + 4 * h) = w; }
}


__device__ __forceinline__ float log_sigmoid_f(float x) { return x >= 0.f ? -log1pf(expf(-x)) : x - log1pf(expf(x)); }
__device__ __forceinline__ void mlstm_gates_wave(const P& p, const LB& L, int l, int b, int c, int hh, int lane, float& bcum, float& ig) {
    const size_t row = (size_t)b * T + c * 64 + lane;
    ig = L.iff[row * 16 + hh] + p.b_i[l * 8 + hh];
    float v = log_sigmoid_f(L.iff[row * 16 + 8 + hh] + p.b_f[l * 8 + hh]);
#pragma unroll
    for (int o = 1; o < 64; o <<= 1) { const float t = __shfl_up(v, o); if (lane >= o) v += t; }
    bcum = v;
}
constexpr int MA_SLOT = 18368, MA_XK = 0, MA_VIMG = 8704, MA_T0 = 16896;
__device__ __forceinline__ void mlstm_A_mfma_unit(const P& p, const LB& L, int l, int u, LAS unsigned char* l3) {
    int tid_l = threadIdx.x; asm volatile("" : "+v"(tid_l)); const int tid = tid_l, lane = tid & 63, hh = tid >> 6, h = lane >> 5, ql = lane & 31;
    const int c = u & 31, b = u >> 5, uh = u * 8 + hh;
    LAS unsigned char* wl = l3 + hh * MA_SLOT;
    const float* cw = p.conv_w + (size_t)l * 4 * 1024;
    __syncthreads();
    for (int idx = lane; idx < 67 * 8; idx += 64) { const int row = idx >> 3, cc = idx & 7, t = c * 64 - 3 + row; u32x4 v = (u32x4){0u, 0u, 0u, 0u};
        if (t >= 0) v = *(const u32x4*)(L.mqk + (size_t)(b * T + t) * 1024 + 512 + hh * 64 + cc * 8);
        *(LAS u32x4*)(wl + MA_XK + row * 128 + cc * 16) = v; }
#pragma unroll
    for (int i = 0; i < 8; ++i) { const int s = (lane >> 3) + 8 * i, cc = lane & 7;
        const u32x4 v = *(const u32x4*)(L.mv + (size_t)(b * T + c * 64 + s) * 512 + hh * 64 + cc * 8);
        *(LAS u32x4*)(wl + MA_VIMG + (cc >> 2) * 4096 + s * 64 + (cc & 3) * 16) = v; }
    float bcum, ig; mlstm_gates_wave(p, L, l, b, c, hh, lane, bcum, ig);
    const float g = __shfl(bcum, 63), alog = g - bcum + ig, ml = wave_max(alog);
    ((LAS float*)(wl + MA_T0))[lane] = __expf(alog - ml);
    __syncthreads();
    f32x16 acc[2][2];
#pragma unroll
    for (int a = 0; a < 2; ++a)
#pragma unroll
        for (int d = 0; d < 2; ++d)
#pragma unroll
            for (int r = 0; r < 16; ++r) acc[a][d][r] = 0.f;
    float dnacc[2] = {0.f, 0.f};
    float cwr[2][4];
#pragma unroll
    for (int dkb = 0; dkb < 2; ++dkb)
#pragma unroll
        for (int tap = 0; tap < 4; ++tap) cwr[dkb][tap] = cw[tap * 1024 + 512 + hh * 64 + 32 * dkb + ql];
#pragma unroll
    for (int ks = 0; ks < 4; ++ks) {
        const int s0 = 16 * ks + 8 * h;
        const f32x4 we0 = *(const LAS f32x4*)(wl + MA_T0 + s0 * 4), we1 = *(const LAS f32x4*)(wl + MA_T0 + s0 * 4 + 16);
        const float we[8] = {we0[0], we0[1], we0[2], we0[3], we1[0], we1[1], we1[2], we1[3]};
        bf16x8 WKf[2];
#pragma unroll
        for (int dkb = 0; dkb < 2; ++dkb) {
            float x[11];
#pragma unroll
            for (int r = 0; r < 11; ++r) x[r] = bf2f(*(const LAS unsigned short*)(wl + MA_XK + (s0 + r) * 128 + (32 * dkb + ql) * 2));
            float wk[8];
#pragma unroll
            for (int j = 0; j < 8; ++j) { const float cv = fmaf(cwr[dkb][3], x[j + 3], fmaf(cwr[dkb][2], x[j + 2], fmaf(cwr[dkb][1], x[j + 1], cwr[dkb][0] * x[j])));
                wk[j] = cv * 0.125f * __builtin_amdgcn_rcpf(1.f + __expf(-cv)) * we[j]; dnacc[dkb] += wk[j]; }
            u32x4 w; w.x = pkbf(wk[0], wk[1]); w.y = pkbf(wk[2], wk[3]); w.z = pkbf(wk[4], wk[5]); w.w = pkbf(wk[6], wk[7]);
            WKf[dkb] = __builtin_bit_cast(bf16x8, w);
        }
#pragma unroll
        for (int dvb = 0; dvb < 2; ++dvb) { const bf16x8 Vf = tr_frag(wl + MA_VIMG + dvb * 4096, s0, s0 + 4, lane);
#pragma unroll
            for (int dkb = 0; dkb < 2; ++dkb) acc[dkb][dvb] = MFMA32(WKf[dkb], Vf, acc[dkb][dvb]); }
    }
    bf16_t* st = L.state + (size_t)uh * 4096;
#pragma unroll
    for (int dkb = 0; dkb < 2; ++dkb)
#pragma unroll
        for (int dvb = 0; dvb < 2; ++dvb)
#pragma unroll
            for (int gq = 0; gq < 4; ++gq) { uint2 w; w.x = pkbf(acc[dkb][dvb][4 * gq], acc[dkb][dvb][4 * gq + 1]); w.y = pkbf(acc[dkb][dvb][4 * gq + 2], acc[dkb][dvb][4 * gq + 3]);
                *(uint2*)(st + (32 * dvb + ql) * 64 + 32 * dkb + 8 * gq + 4 * h) = w; }
#pragma unroll
    for (int dkb = 0; dkb < 2; ++dkb) { const float t = dnacc[dkb] + __shfl_xor(dnacc[dkb], 32); if (h == 0) ws_f(p.ws, WS_DN)[(size_t)uh * 64 + 32 * dkb + ql] = t; }
    if (lane == 0) { ws_f(p.ws, WS_G)[uh] = g; ws_f(p.ws, WS_ML)[uh] = ml; }
}
__device__ __forceinline__ void mlstm_scan2_unit(const P& p, const LB& L, int u) {
    int tid_l = threadIdx.x; asm volatile("" : "+v"(tid_l)); const int tid = tid_l, bh = u >> 2, b = bh >> 3, hh = bh & 7, e = (u & 3) * 1024 + 2 * tid;
    const bool first = (u & 3) == 0; const bool do_n = first && tid < 64;
    float *G = ws_f(p.ws, WS_G), *ML = ws_f(p.ws, WS_ML), *MIN = ws_f(p.ws, WS_MIN), *DN = ws_f(p.ws, WS_DN);
    unsigned d[NCH]; float dn[NCH];
#pragma unroll
    for (int c = 0; c < NCH; ++c) { const int idx = (b * NCH + c) * 8 + hh; d[c] = *(const unsigned*)(L.state + (size_t)idx * 4096 + e); dn[c] = do_n ? DN[(size_t)idx * 64 + tid] : 0.f; }
    float m = 0.f, n = 0.f, C0 = 0.f, C1 = 0.f;
#pragma unroll
    for (int c = 0; c < NCH; ++c) { const int idx = (b * NCH + c) * 8 + hh; const float g = G[idx], ml = ML[idx], mn = fmaxf(g + m, ml), a = __expf(g + m - mn), sc = __expf(ml - mn);
        *(unsigned*)(L.state + (size_t)idx * 4096 + e) = pkbf(C0, C1);
        C0 = fmaf(C0, a, sc * __uint_as_float(d[c] << 16)); C1 = fmaf(C1, a, sc * __uint_as_float(d[c] & 0xffff0000u));
        if (do_n) { DN[(size_t)idx * 64 + tid] = n; n = a * n + sc * dn[c]; }
        if (first && tid == 0) MIN[idx] = m;
        m = mn; }
}
constexpr int MC_SLOT = 31232, MC_XQ = 0, MC_XK = 9728, MC_VIMG = 19456, MC_CW = 27648, MC_T0 = 29696, MC_T1 = 29952, MC_T2 = 30208, MC_T3 = 30464, MC_T4 = 30720  , MC_T5 = 30976  ;
__device__ __forceinline__ bf16x8 conv_frag_lds(const LAS unsigned char* img, int tok, int ch0, const LAS float* cwl, float scale) {
    float a[8] = {0.f, 0.f, 0.f, 0.f, 0.f, 0.f, 0.f, 0.f};
#pragma unroll
    for (int tap = 0; tap < 4; ++tap) {
        float xf[8]; unpack8(__builtin_bit_cast(uint4, *(const LAS u32x4*)(img + (tok + tap) * 144 + ch0 * 2)), xf);
        const f32x4 w0 = *(const LAS f32x4*)(cwl + tap * 128 + ch0), w1 = *(const LAS f32x4*)(cwl + tap * 128 + ch0 + 4);
        a[0] = fmaf(w0[0], xf[0], a[0]); a[1] = fmaf(w0[1], xf[1], a[1]); a[2] = fmaf(w0[2], xf[2], a[2]); a[3] = fmaf(w0[3], xf[3], a[3]);
        a[4] = fmaf(w1[0], xf[4], a[4]); a[5] = fmaf(w1[1], xf[5], a[5]); a[6] = fmaf(w1[2], xf[6], a[6]); a[7] = fmaf(w1[3], xf[7], a[7]);
    }
#pragma unroll
    for (int j = 0; j < 8; ++j) a[j] = a[j] * scale * __builtin_amdgcn_rcpf(1.f + __expf(-a[j]));
    u32x4 w; w.x = pkbf(a[0], a[1]); w.y = pkbf(a[2], a[3]); w.z = pkbf(a[4], a[5]); w.w = pkbf(a[6], a[7]);
    return __builtin_bit_cast(bf16x8, w);
}
template <int TB>
__device__ __forceinline__ void mlstm_C_block(const LB& L, int b, int c, int hh, int lane, int h, int ql, LAS unsigned char* wl, const bf16x8 (&Cf)[2][4], const uint2 (&mo)[2][4]) {
    const LAS float* cwl = (const LAS float*)(wl + MC_CW);
    bf16x8 Qf[4]; float qn = 0.f;
#pragma unroll
    for (int ks = 0; ks < 4; ++ks) { const int ch0 = 16 * ks + 8 * h;
        Qf[ks] = conv_frag_lds(wl + MC_XQ, 32 * TB + ql, ch0, cwl, 1.f);
        const f32x4 n0 = *(const LAS f32x4*)(wl + MC_T4 + ch0 * 4), n1 = *(const LAS f32x4*)(wl + MC_T4 + ch0 * 4 + 16);
        float qv[8]; unpack8(__builtin_bit_cast(uint4, Qf[ks]), qv);
#pragma unroll
        for (int j = 0; j < 4; ++j) { qn = fmaf(qv[j], n0[j], qn); qn = fmaf(qv[j + 4], n1[j], qn); } }
    f32x16 S0, S1;
#pragma unroll
    for (int r = 0; r < 16; ++r) { S0[r] = 0.f; S1[r] = 0.f; }
#pragma unroll
    for (int ks = 0; ks < 4; ++ks) { const int ch0 = 16 * ks + 8 * h;
        S0 = MFMA32(conv_frag_lds(wl + MC_XK, ql, ch0, cwl + 64, 0.125f), Qf[ks], S0);
        if (TB == 1) S1 = MFMA32(conv_frag_lds(wl + MC_XK, 32 + ql, ch0, cwl + 64, 0.125f), Qf[ks], S1); }
    const float Mt = ((const LAS float*)(wl + MC_T1))[32 * TB + ql];
    float dsum = 0.f;
#pragma unroll
    for (int gq = 0; gq < 4; ++gq) {
        const f32x4 a0 = *(const LAS f32x4*)(wl + MC_T0 + (8 * gq + 4 * h) * 4), a1 = *(const LAS f32x4*)(wl + MC_T0 + (32 + 8 * gq + 4 * h) * 4);
#pragma unroll
        for (int j = 0; j < 4; ++j) { const int r = 4 * gq + j, sl = 8 * gq + 4 * h + j;
            if (TB == 0) { const float v = sl <= ql ? S0[r] * __expf(a0[j] - Mt) : 0.f; S0[r] = v; dsum += v; }
            else { const float v0 = S0[r] * __expf(a0[j] - Mt); S0[r] = v0; const float v1 = sl <= ql ? S1[r] * __expf(a1[j] - Mt) : 0.f; S1[r] = v1; dsum += v0 + v1; } }
    }
    f32x16 acc[2];
#pragma unroll
    for (int d = 0; d < 2; ++d)
#pragma unroll
        for (int r = 0; r < 16; ++r) acc[d][r] = 0.f;
#pragma unroll
    for (int ks = 0; ks < 4; ++ks)
#pragma unroll
        for (int dvb = 0; dvb < 2; ++dvb) acc[dvb] = MFMA32(Cf[dvb][ks], Qf[ks], acc[dvb]);
    const float iw = ((const LAS float*)(wl + MC_T2))[32 * TB + ql];
#pragma unroll
    for (int dvb = 0; dvb < 2; ++dvb)
#pragma unroll
        for (int r = 0; r < 16; ++r) acc[dvb][r] *= iw;
#pragma unroll
    for (int s2 = 0; s2 < 2; ++s2) {
        const bf16x8 P0 = pack_step(S0, s2), P1 = pack_step(S1, s2);
#pragma unroll
        for (int dvb = 0; dvb < 2; ++dvb) {
            acc[dvb] = MFMA32(tr_frag(wl + MC_VIMG + dvb * 4096, 16 * s2 + 4 * h, 16 * s2 + 8 + 4 * h, lane), P0, acc[dvb]);
            if (TB == 1) acc[dvb] = MFMA32(tr_frag(wl + MC_VIMG + dvb * 4096, 32 + 16 * s2 + 4 * h, 32 + 16 * s2 + 8 + 4 * h, lane), P1, acc[dvb]); }
    }
    dsum += __shfl_xor(dsum, 32); qn += __shfl_xor(qn, 32);
    const float den = dsum + iw * qn, mt = ((const LAS float*)(wl + MC_T3))[32 * TB + ql];
    const float sc = 1.f / fmaxf(fabsf(den), __expf(-mt));
    float sum = 0.f;
#pragma unroll
    for (int dvb = 0; dvb < 2; ++dvb)
#pragma unroll
        for (int r = 0; r < 16; ++r) { const float v = acc[dvb][r] * sc; acc[dvb][r] = v; sum += v; }
    sum += __shfl_xor(sum, 32); const float mu = sum * (1.f / 64.f);
    float var = 0.f;
#pragma unroll
    for (int dvb = 0; dvb < 2; ++dvb)
#pragma unroll
        for (int r = 0; r < 16; ++r) { const float dlt = acc[dvb][r] - mu; var += dlt * dlt; }
    var += __shfl_xor(var, 32); const float rstd = rsqrtf(var * (1.f / 64.f) + EPS);
    bf16_t* op = L.mo + (size_t)(b * T + c * 64 + 32 * TB + ql) * 512 + hh * 64;
#pragma unroll
    for (int dvb = 0; dvb < 2; ++dvb)
#pragma unroll
        for (int gq = 0; gq < 4; ++gq) { const int dv = 32 * dvb + 8 * gq + 4 * h; const f32x4 ng = *(const LAS f32x4*)(wl + MC_T5 + dv * 4);
            const uint2 mg = mo[dvb][gq];
            const float y0 = (acc[dvb][4 * gq] - mu) * rstd * ng[0] * __uint_as_float(mg.x << 16), y1 = (acc[dvb][4 * gq + 1] - mu) * rstd * ng[1] * __uint_as_float(mg.x & 0xffff0000u);
            const float y2 = (acc[dvb][4 * gq + 2] - mu) * rstd * ng[2] * __uint_as_float(mg.y << 16), y3 = (acc[dvb][4 * gq + 3] - mu) * rstd * ng[3] * __uint_as_float(mg.y & 0xffff0000u);
            uint2 w; w.x = pkbf(y0, y1); w.y = pkbf(y2, y3); *(uint2*)(op + dv) = w; }
}
__device__ __forceinline__ void mlstm_C_mfma_unit(const P& p, const LB& L, int l, int u, LAS unsigned char* l3) {
    int tid_l = threadIdx.x; asm volatile("" : "+v"(tid_l)); const int tid = tid_l, lane = tid & 63, wave = tid >> 6, h = lane >> 5, ql = lane & 31;
    const int hg = u & 1, c = (u >> 1) & 31, b = u >> 6, hh = 4 * hg + (wave >> 1), tb = wave & 1, uh = (b * 32 + c) * 8 + hh, l128 = tid & 127;
    LAS unsigned char* wl = l3 + (wave >> 1) * MC_SLOT;
    const float* cw = p.conv_w + (size_t)l * 4 * 1024;
    bf16x8 Cf[2][4]; uint2 mo[2][4];
    {
        const bf16_t* st = L.state + (size_t)uh * 4096; const bf16_t* op = L.mo + (size_t)(b * T + c * 64 + 32 * tb + ql) * 512 + hh * 64;
#pragma unroll
        for (int dvb = 0; dvb < 2; ++dvb) {
#pragma unroll
            for (int ks = 0; ks < 4; ++ks) Cf[dvb][ks] = *(const bf16x8*)(st + (32 * dvb + ql) * 64 + 16 * ks + 8 * h);
#pragma unroll
            for (int gq = 0; gq < 4; ++gq) mo[dvb][gq] = *(const uint2*)(op + 32 * dvb + 8 * gq + 4 * h);
        }
    }
    __syncthreads();
    for (int idx = l128; idx < 67 * 8; idx += 128) { const int row = idx >> 3, cc = idx & 7, t = c * 64 - 3 + row; u32x4 vq = (u32x4){0u, 0u, 0u, 0u}, vk = vq;
        if (t >= 0) { const bf16_t* src = L.mqk + (size_t)(b * T + t) * 1024 + hh * 64 + cc * 8; vq = *(const u32x4*)src; vk = *(const u32x4*)(src + 512); }
        *(LAS u32x4*)(wl + MC_XQ + row * 144 + cc * 16) = vq; *(LAS u32x4*)(wl + MC_XK + row * 144 + cc * 16) = vk; }
#pragma unroll
    for (int i = 0; i < 4; ++i) { const int s = (l128 >> 3) + 16 * i, cc = l128 & 7;
        const u32x4 v = *(const u32x4*)(L.mv + (size_t)(b * T + c * 64 + s) * 512 + hh * 64 + cc * 8);
        *(LAS u32x4*)(wl + MC_VIMG + (cc >> 2) * 4096 + s * 64 + (cc & 3) * 16) = v; }
#pragma unroll
    for (int i = 0; i < 4; ++i) { const int e = l128 + 128 * i, tap = e >> 7, wch = e & 127;
        ((LAS float*)(wl + MC_CW))[e] = cw[tap * 1024 + (wch >> 6) * 512 + hh * 64 + (wch & 63)]; }
    {
        float bcum, ig; mlstm_gates_wave(p, L, l, b, c, hh, lane, bcum, ig);
        const float a = ig - bcum; float v = a;
#pragma unroll
        for (int o = 1; o < 64; o <<= 1) { const float t = __shfl_up(v, o); if (lane >= o) v = fmaxf(v, t); }
        const float m_in = ws_f(p.ws, WS_MIN)[uh], Mt = fmaxf(v, m_in);
        if (tb == 1) { ((LAS float*)(wl + MC_T4))[lane] = ws_f(p.ws, WS_DN)[(size_t)uh * 64 + lane]; ((LAS float*)(wl + MC_T5))[lane] = p.norm_g[l * 512 + hh * 64 + lane]; }
        if (tb == 0) { ((LAS float*)(wl + MC_T0))[lane] = a; ((LAS float*)(wl + MC_T1))[lane] = Mt; ((LAS float*)(wl + MC_T2))[lane] = __expf(m_in - Mt); ((LAS float*)(wl + MC_T3))[lane] = bcum + Mt; }
    }
    __syncthreads();
    if (tb == 0) mlstm_C_block<0>(L, b, c, hh, lane, h, ql, wl, Cf, mo);
    else mlstm_C_block<1>(L, b, c, hh, lane, h, ql, wl, Cf, mo);
}

#define XB_TMO      128
#define XB_XCNT(j)  (256  + 64 * (j))
#define XB_XSUB(j)  (1280 + 64 * (j))
#define XB_XGEN(j)  (2304 + 64 * (j))
#define XB_TOP      3328
#define XB_TOPGEN   3392
#define XCD_BAR_WORDS 3456
#define XB_SPIN_CAP (1u << 18)

__device__ __forceinline__ unsigned xb_ld(unsigned* p)              { return __hip_atomic_load(p, __ATOMIC_RELAXED, __HIP_MEMORY_SCOPE_AGENT); }
__device__ __forceinline__ unsigned xb_add(unsigned* p, unsigned v) { return __hip_atomic_fetch_add(p, v, __ATOMIC_RELAXED, __HIP_MEMORY_SCOPE_AGENT); }
__device__ __forceinline__ unsigned xb_xcc_id() { return (unsigned)__builtin_amdgcn_s_getreg((3 << 11) | 20) & 0xFu; }
#define XB_SPIN(cond, bar) do { unsigned _sp = 0; while (cond) { __builtin_amdgcn_s_sleep(1); \
    if ((++_sp & 255u) == 0u) { if (xb_ld(&(bar)[XB_TMO])) break; if (_sp > XB_SPIN_CAP) { atomicAdd(&(bar)[XB_TMO], 1u); break; } } } } while (0)

struct XcdBarrier {
    unsigned* bar; unsigned x;
    volatile LAS unsigned* st;
};

__device__ __forceinline__ XcdBarrier xcd_barrier_post(unsigned* bar, volatile LAS unsigned* st) {
    XcdBarrier b; b.bar = bar; b.x = xb_xcc_id(); b.st = st;
    if (threadIdx.x == 0) (void)xb_add(&bar[XB_XCNT(b.x)], 1u);
    return b;
}
__device__ __forceinline__ void xcd_barrier_complete(unsigned* bar, unsigned x, unsigned& nloc, unsigned& nx) {
    const unsigned G = gridDim.x * gridDim.y * gridDim.z;
    unsigned sum, cnt, mine, sp = 0u;
    for (;;) {
        sum = 0u; cnt = 0u; mine = 0u;
#pragma unroll
        for (unsigned j = 0; j < 16; ++j) { const unsigned c = xb_ld(&bar[XB_XCNT(j)]); sum += c; cnt += (c > 0u) ? 1u : 0u; mine = (j == x) ? c : mine; }
        if (sum == G) break;
        __builtin_amdgcn_s_sleep(1);
        if ((++sp & 255u) == 0u) { if (xb_ld(&bar[XB_TMO])) break; if (sp > XB_SPIN_CAP) { atomicAdd(&bar[XB_TMO], 1u); break; } }
    }
    nloc = mine > 0u ? mine : 1u; nx = cnt > 0u ? cnt : 1u;
}

__device__ __forceinline__ void xcd_barrier(const XcdBarrier& b) {
    asm volatile("s_waitcnt vmcnt(0)" ::: "memory");
    __syncthreads();
    if (threadIdx.x == 0) {
        unsigned* bar = b.bar;
        __builtin_amdgcn_s_waitcnt(0);
        unsigned nloc = b.st[0], nx = b.st[1];
        if (nloc == 0u) { xcd_barrier_complete(bar, b.x, nloc, nx); b.st[0] = nloc; b.st[1] = nx; }
        const unsigned old = xb_add(&bar[XB_XSUB(b.x)], 1u);
        const unsigned gen = old / nloc;
        if (old + 1u == (gen + 1u) * nloc) {
            __builtin_amdgcn_fence(__ATOMIC_RELEASE, "agent");
            asm volatile("s_waitcnt vmcnt(0)" ::: "memory");
            const unsigned og = xb_add(&bar[XB_TOP], 1u);
            const unsigned tg = og / nx;
            if (og + 1u == (tg + 1u) * nx) xb_add(&bar[XB_TOPGEN], 1u);
            else XB_SPIN(xb_ld(&bar[XB_TOPGEN]) == tg, bar);
            __builtin_amdgcn_fence(__ATOMIC_ACQUIRE, "agent");
            xb_add(&bar[XB_XGEN(b.x)], 1u);
            asm volatile("s_waitcnt vmcnt(0)" ::: "memory");
        } else {
            XB_SPIN(xb_ld(&bar[XB_XGEN(b.x)]) == gen, bar);
            __builtin_amdgcn_fence(__ATOMIC_ACQUIRE, "agent");
            asm volatile("s_waitcnt vmcnt(0)" ::: "memory");
        }
    }
    __syncthreads();
}

__global__ void __launch_bounds__(512, 2) mk_fwd(P p) {
    extern __shared__ __attribute__((aligned(16))) unsigned char lds[];
    LAS unsigned char* l3 = (LAS unsigned char*)lds;
    float* fl = (float*)lds;
    const int G = gridDim.x, bx = blockIdx.x;
    if (threadIdx.x < 64) ((LAS unsigned*)(l3 + LDS_CTL))[threadIdx.x] = 0u;
    __syncthreads();
    (void)xcd_barrier_post((unsigned*)(p.ws + WS_BAR), (volatile LAS unsigned*)(l3 + LDS_CTL + 32));
#define PH_BEGIN(id) do { if ((PROBE_MASK >> (id)) & 1) { if (bx == 0 && threadIdx.x == 0) pr_t0 = __builtin_amdgcn_s_memrealtime(); } } while (0)
#define PH_END(id) do { if ((PROBE_MASK >> (id)) & 1) { if (bx == 0 && threadIdx.x == 0) pr_acc += __builtin_amdgcn_s_memrealtime() - pr_t0; } } while (0)
    unsigned long long pr_t0 = 0, pr_acc = 0;
#define GRID_BAR() do { XcdBarrier b_; b_.bar = (unsigned*)(p.ws + WS_BAR); b_.x = xb_xcc_id(); b_.st = (volatile LAS unsigned*)(l3 + LDS_CTL + 32); xcd_barrier(b_); } while (0)
#define WAVE_IDS() int tid_w = threadIdx.x; asm volatile("" : "+v"(tid_w)); const int lane = tid_w & 63, gw = bx * 8 + (tid_w >> 6), ngw = G * 8

        PH_BEGIN(0);
    {
        WAVE_IDS();
        for (int it = gw; it < 2 * CV_ITEMS_LAYER; it += ngw) convert_item(p, it, fl + (tid_w >> 6) * (64 * 33), lane);
        rowstat_rows(p.x, M, layer_buf(p.ws, p.out, 0).xbin, ws_f(p.ws, WS_ROWSS), gw, ngw, lane);
        rowstat_rows(p.mem, MM, (bf16_t*)(p.ws + WS_MEMB), ws_f(p.ws, WS_ROWSS_MEM), gw, ngw, lane);
    }
    GRID_BAR();
        PH_END(0);

#pragma unroll 1
    for (int l = 0; l < 2; ++l) {
        PH_BEGIN(1);
        {
            const LB L = layer_buf(p.ws, p.out, l);
            pg8::Gemm g{L.xbin, L.win, M, 6656, D, (const bf16_t*)(p.ws + WS_MEMB)};
            SchedRounds S{G, bx, 3, 0, 1};
            EpiProjMK E{L, ws_f(p.ws, WS_ROWSS) + (size_t)(2 * l) * M * 16, ws_f(p.ws, WS_ROWSS_MEM)};
            pg8::gemm_phase<EpiProjMK, SchedRounds, true, true>(l3, g, S, E);
        }
        GRID_BAR();
        PH_END(1);
        PH_BEGIN(2);
        {
            const LB L = layer_buf(p.ws, p.out, l);
            PH_BEGIN(10); for (int u = bx; u < NB * 16 * 2; u += G) swa_mfma_unit(p, L, l, u, l3); PH_END(10);
            PH_BEGIN(11); for (int u = bx; u < NB * 4 * 8; u += G) xattn_mfma_unit(L, u, l3); PH_END(11);
            PH_BEGIN(12); for (int u = bx; u < NB * NCH; u += G) mlstm_A_mfma_unit(p, L, l, u, l3); PH_END(12);
        }
        GRID_BAR();
        PH_END(2);
        PH_BEGIN(3);
        {
            const LB L = layer_buf(p.ws, p.out, l);
            for (int u = bx; u < 256; u += G) mlstm_scan2_unit(p, L, u);
        }
        GRID_BAR();
        PH_END(3);
        PH_BEGIN(4);
        {
            const LB L = layer_buf(p.ws, p.out, l);
            for (int u = bx; u < NB * NCH * 2; u += G) mlstm_C_mfma_unit(p, L, l, u, l3);
        }
        GRID_BAR();
        PH_END(4);
        PH_BEGIN(5);
        {
            const LB L = layer_buf(p.ws, p.out, l);
            pg8::Gemm g{L.xbin, L.win, M, 6656, D, nullptr};
            SchedRounds S{G, bx, 3, 13, 0};
            EpiProjMK E{L, ws_f(p.ws, WS_ROWSS) + (size_t)(2 * l) * M * 16, ws_f(p.ws, WS_ROWSS_MEM)};
            pg8::gemm_phase<EpiProjMK, SchedRounds, true, true>(l3, g, S, E);
        }
        GRID_BAR();
        PH_END(5);
        PH_BEGIN(6);
        {
            const LB L = layer_buf(p.ws, p.out, l);
            pg8::Gemm g{L.sq, L.wbr, 3 * M, 3 * D, 512, nullptr};
            SchedMerged S{G, bx};
            EpiMergedMK E{L.gates, L.merged};
            pg8::gemm_phase<EpiMergedMK, SchedMerged, true, true>(l3, g, S, E);
        }
        GRID_BAR();
        PH_END(6);
        PH_BEGIN(7);
        {
            const LB L = layer_buf(p.ws, p.out, l);
            pg8::Gemm g{L.merged, L.wout, M, D, D, nullptr};
            SchedRounds S{G, bx, 1, 0, 0};
            EpiResidMK E{L.xbin, L.xbmid, ws_f(p.ws, WS_ROWSS) + (size_t)(2 * l + 1) * M * 16};
            pg8::gemm_phase<EpiResidMK, SchedRounds, true, true>(l3, g, S, E);
        }
        GRID_BAR();
        PH_END(7);
        PH_BEGIN(8);
        {
            const LB L = layer_buf(p.ws, p.out, l);
            pg8::Gemm g{L.xbmid, L.wff1, M, DFF, D, nullptr};
            SchedRounds S{G, bx, 4, 0, 0};
            EpiFF1MK E{L.hff, ws_f(p.ws, WS_ROWSS) + (size_t)(2 * l + 1) * M * 16};
            pg8::gemm_phase<EpiFF1MK, SchedRounds, true, true>(l3, g, S, E);
        }
        GRID_BAR();
        PH_END(8);
        PH_BEGIN(9);
        {
            const LB L = layer_buf(p.ws, p.out, l);
            pg8::Gemm g{L.hff, L.wff2, M, D, DFF, nullptr};
            SchedRounds S{G, bx, 1, 0, 0};
            EpiResidMK E{L.xbmid, L.xbnext, ws_f(p.ws, WS_ROWSS) + (size_t)(2 * l + 2) * M * 16};
            pg8::gemm_phase<EpiResidMK, SchedRounds, true, true>(l3, g, S, E);
        }
        GRID_BAR();
        PH_END(9);
    }
    {
        WAVE_IDS();
        finalnorm_rows(layer_buf(p.ws, p.out, 1).xbnext, p.out, ws_f(p.ws, WS_ROWSS) + (size_t)4 * M * 16, p.g_final, gw, ngw, lane);
    }
    if (PROBE_MASK != 0 && bx == 0 && threadIdx.x == 0) { const unsigned long long te = __builtin_amdgcn_s_memrealtime(); while (__builtin_amdgcn_s_memrealtime() - te < 10ull * pr_acc) __builtin_amdgcn_s_sleep(8); }
}
}

extern "C" void kernel_launch(void* const* d_in, const int* in_sizes, int n_in, void* d_out, int out_size, void* d_ws, size_t ws_size, hipStream_t stream) {
    static int grid = 0;
    if (grid == 0) {
        if (n_in != 20 || out_size != M * D || ws_size < WS_END) { fprintf(stderr, "kernel_launch: unexpected shapes (n_in %d out %d ws %zu)\n", n_in, out_size, ws_size); grid = -1; return; }
        int dev = 0, cus = 0, per_cu = 0;
        if (hipGetDevice(&dev) != hipSuccess || hipDeviceGetAttribute(&cus, hipDeviceAttributeMultiprocessorCount, dev) != hipSuccess) { fprintf(stderr, "kernel_launch: device query failed\n"); grid = -1; return; }
        if (hipFuncSetAttribute((const void*)mk_fwd, hipFuncAttributeMaxDynamicSharedMemorySize, LDS_BYTES) != hipSuccess) { fprintf(stderr, "kernel_launch: hipFuncSetAttribute failed\n"); grid = -1; return; }
        if (hipOccupancyMaxActiveBlocksPerMultiprocessor(&per_cu, (const void*)mk_fwd, 512, LDS_BYTES) != hipSuccess || per_cu < 1) { fprintf(stderr, "kernel_launch: occupancy query says %d blocks per CU\n", per_cu); grid = -1; return; }
        grid = cus;
    }
    if (grid < 0) return;
    P p{};
    const float** pf = (const float**)&p;
    for (int i = 0; i < 20; ++i) pf[i] = (const float*)d_in[i];
    p.out = (float*)d_out; p.ws = (unsigned char*)d_ws;
    if (hipMemsetAsync(d_ws, 0, WS_ZERO_BYTES, stream) != hipSuccess) { fprintf(stderr, "kernel_launch: memset failed\n"); return; }
    void* args[] = {&p};
    const hipError_t e = hipLaunchCooperativeKernel((const void*)mk_fwd, dim3(grid), dim3(512), args, LDS_BYTES, stream);
    if (e != hipSuccess) fprintf(stderr, "kernel_launch: cooperative launch failed: %s (grid %d)\n", hipGetErrorString(e), grid);
}
```

```cpp
#include <hip/hip_runtime.h>
#include <cstdio>
#include <cstdint>
#ifndef PROBE_MASK
#define PROBE_MASK 0
#endif

namespace pg8 {
#define PG8_LAS __attribute__((address_space(3)))
typedef unsigned short bf16_t;
typedef short bf16x8 __attribute__((ext_vector_type(8)));
typedef float f32x4 __attribute__((ext_vector_type(4)));
typedef unsigned u32x4 __attribute__((ext_vector_type(4)));
constexpr int BM = 256, BK = 64, HALF = 128, HTB = HALF * BK * 2  , STAGE_BYTES = 8 * HTB, NXCD = 8, WGM = 8;

__host__ __device__ __forceinline__ int lds_byte(int r, int c) { const int st = (r >> 4) * 2 + (c >> 5), rr = r & 15, cc = c & 31, ob = rr * 64 + cc * 2; return st * 1024 + (ob ^ (((ob >> 9) & 1) << 5)); }
__host__ __device__ __forceinline__ void stage_rc(int b, int& R, int& C) { const int st = b / 1024, sb = b % 1024, swz = sb ^ (((sb >> 9) & 1) << 5); R = (st >> 1) * 16 + swz / 64; C = (st & 1) * 32 + (swz % 64) / 2; }
__host__ __device__ __forceinline__ int perm32(int rho) { const int n = rho >> 4, i = rho & 15; return 8 * (i >> 2) + 4 * n + (i & 3); }
struct Unit { int pm, pn, rm, kind, asel; };
struct Gemm { const bf16_t* A; const bf16_t* Bt; int M, N, K; const bf16_t* A2; };
__device__ __forceinline__ unsigned cvt_pk_bf16(float lo, float hi) { unsigned r; asm volatile("v_cvt_pk_bf16_f32 %0, %1, %2" : "=v"(r) : "v"(lo), "v"(hi)); return r; }
template <class Epi, class Sched, bool ALIGN_EPI = false, bool SP2 = false>
__device__ __forceinline__ void gemm_phase(PG8_LAS unsigned char* lds, const Gemm g, const Sched& S, const Epi& E) {
    int tid_l = threadIdx.x; asm volatile("" : "+v"(tid_l));
    const int tid = tid_l, wid = __builtin_amdgcn_readfirstlane(tid >> 6), lane = tid & 63, wr = wid >> 2, wc = wid & 3, fr = lane & 15, fq = lane >> 4;
    const int K = g.K, nt = K / BK;
    unsigned voffA[2], voffB[2];
#pragma unroll
    for (int i = 0; i < 2; ++i) { int R, C; stage_rc(tid * 16 + i * 8192, R, C); const int Rb = Epi::PERM ? ((R & ~31) + perm32(R & 31)) : R;
        voffA[i] = (unsigned)(R * K + C) * 2u; voffB[i] = (unsigned)(Rb * K + C) * 2u; }
    const size_t kstep = (size_t)(BK * 2);
    const size_t hstep = (size_t)HALF * K * 2;
    const size_t tstep = 2 * hstep;
    const unsigned ldsw = (unsigned)wid * 1024u;
    const int aoff = lds_byte(wr * 64 + fr, fq * 8), boff = lds_byte(wc * 32 + fr, fq * 8);
#define PG8_SA(b, h) (((b) * 2 + (h)) * HTB)
#define PG8_SB(b, h) ((4 + (b) * 2 + (h)) * HTB)
#define PG8_STAGE(bufoff, gbase, voff) do { _Pragma("unroll") for (int _i = 0; _i < 2; ++_i) \
        __builtin_amdgcn_global_load_lds((const unsigned*)((const char*)(gbase) + (voff)[_i]), (PG8_LAS unsigned*)(lds + (bufoff) + ldsw + _i * 8192), 16, 0, 0); } while (0)
#define PG8_LDA(dst, b, h) do { _Pragma("unroll") for (int m = 0; m < 4; ++m) _Pragma("unroll") for (int k = 0; k < 2; ++k) dst[m][k] = *(const PG8_LAS bf16x8*)(lds + PG8_SA(b, h) + aoff + m * 2048 + k * 1024); } while (0)
#define PG8_LDB(dst, b, h) do { _Pragma("unroll") for (int n = 0; n < 2; ++n) _Pragma("unroll") for (int k = 0; k < 2; ++k) dst[n][k] = *(const PG8_LAS bf16x8*)(lds + PG8_SB(b, h) + boff + n * 2048 + k * 1024); } while (0)
#define PG8_MMA(ai, bj, At, Bt) do { __builtin_amdgcn_s_setprio(1); _Pragma("unroll") for (int m = 0; m < 4; ++m) _Pragma("unroll") for (int n = 0; n < 2; ++n) _Pragma("unroll") for (int k = 0; k < 2; ++k) \
        acc[ai][bj][m][n] = __builtin_amdgcn_mfma_f32_16x16x32_bf16(Bt[n][k], At[m][k], acc[ai][bj][m][n], 0, 0, 0); __builtin_amdgcn_s_setprio(0); } while (0)
#define PG8_WAIT_V(n) asm volatile("s_waitcnt vmcnt(" #n ")" ::: "memory")
#define PG8_WAIT_L(n) asm volatile("s_waitcnt lgkmcnt(" #n ")" ::: "memory")
#define PG8_BAR __builtin_amdgcn_s_barrier()
#define PG8_SCHED __builtin_amdgcn_sched_barrier(0)
    Unit cur, nxt; int ui = 0;
    if (!S.next(0, cur)) return;
    f32x4 acc[2][2][4][2];
#pragma unroll
    for (int a = 0; a < 2; ++a)
#pragma unroll
        for (int b = 0; b < 2; ++b)
#pragma unroll
            for (int m = 0; m < 4; ++m)
#pragma unroll
                for (int n = 0; n < 2; ++n) acc[a][b][m][n] = (f32x4){0.f, 0.f, 0.f, 0.f};
    bf16x8 At[4][2], B0[2][2], B1[2][2];
    const char* cA = (const char*)(cur.asel ? g.A2 : g.A) + (size_t)cur.pm * tstep; const char* cB = (const char*)g.Bt + (size_t)cur.pn * tstep;
    S.a_ready(cur);
    if constexpr (SP2) {
        PG8_STAGE(PG8_SB(0, 0), cB, voffB); PG8_STAGE(PG8_SB(0, 1), cB + hstep, voffB); PG8_STAGE(PG8_SA(0, 0), cA, voffA); PG8_STAGE(PG8_SA(0, 1), cA + hstep, voffA);
        if (wr == 1) PG8_BAR;
        PG8_WAIT_V(2); PG8_BAR;
        PG8_STAGE(PG8_SB(1, 0), cB + kstep, voffB); PG8_STAGE(PG8_SA(1, 0), cA + kstep, voffA); PG8_STAGE(PG8_SB(1, 1), cB + hstep + kstep, voffB);
        PG8_WAIT_V(6); PG8_BAR;
    } else {
        PG8_STAGE(PG8_SB(0, 0), cB, voffB); PG8_STAGE(PG8_SA(0, 0), cA, voffA); PG8_STAGE(PG8_SB(0, 1), cB + hstep, voffB); PG8_STAGE(PG8_SA(0, 1), cA + hstep, voffA);
        if (wr == 1) PG8_BAR;
        PG8_WAIT_V(4); PG8_BAR;
        PG8_STAGE(PG8_SB(1, 0), cB + kstep, voffB); PG8_STAGE(PG8_SA(1, 0), cA + kstep, voffA); PG8_STAGE(PG8_SB(1, 1), cB + hstep + kstep, voffB);
        PG8_WAIT_V(6); PG8_BAR;
    }
    for (;;) {
        const bool has_next = S.next(ui + 1, nxt);
        const char* nA = has_next ? (const char*)(nxt.asel ? g.A2 : g.A) + (size_t)nxt.pm * tstep : cA; const char* nB = has_next ? (const char*)g.Bt + (size_t)nxt.pn * tstep : cB;
        for (int t = 0; t < nt; t += 2) {
            const bool last = (t == nt - 2);
            const char* a1 = cA + (size_t)(t + 1) * kstep;
            const char* a2 = last ? nA : cA + (size_t)(t + 2) * kstep; const char* b2 = last ? nB : cB + (size_t)(t + 2) * kstep;
            const char* a3 = a2 + kstep; const char* b3 = b2 + kstep;
            if (last && has_next) S.a_ready(nxt);
            if constexpr (SP2) {
            PG8_LDB(B0, 0, 0); PG8_LDB(B1, 0, 1); PG8_SCHED; PG8_LDA(At, 0, 0); PG8_STAGE(PG8_SA(1, 1), a1 + hstep, voffA);
            PG8_WAIT_V(8); PG8_WAIT_L(0); PG8_BAR; PG8_MMA(0, 0, At, B0); PG8_MMA(0, 1, At, B1); PG8_BAR; PG8_SCHED;
            PG8_LDA(At, 0, 1); PG8_STAGE(PG8_SB(0, 0), b2, voffB); PG8_STAGE(PG8_SB(0, 1), b2 + hstep, voffB); PG8_STAGE(PG8_SA(0, 0), a2, voffA);
            PG8_WAIT_V(8); PG8_WAIT_L(0); PG8_BAR; PG8_MMA(1, 0, At, B0); PG8_MMA(1, 1, At, B1); PG8_BAR; PG8_SCHED;
            PG8_LDB(B0, 1, 0); PG8_LDB(B1, 1, 1); PG8_SCHED; PG8_LDA(At, 1, 0); PG8_STAGE(PG8_SA(0, 1), a2 + hstep, voffA);
            PG8_WAIT_V(8); PG8_WAIT_L(0); PG8_BAR; PG8_MMA(0, 0, At, B0); PG8_MMA(0, 1, At, B1); PG8_BAR; PG8_SCHED;
            PG8_LDA(At, 1, 1); PG8_STAGE(PG8_SB(1, 0), b3, voffB); PG8_STAGE(PG8_SB(1, 1), b3 + hstep, voffB); PG8_STAGE(PG8_SA(1, 0), a3, voffA);
            PG8_WAIT_V(8); PG8_WAIT_L(0); PG8_BAR; PG8_MMA(1, 0, At, B0); PG8_MMA(1, 1, At, B1); PG8_BAR; PG8_SCHED;
            } else {
            PG8_LDB(B0, 0, 0); PG8_SCHED; PG8_LDA(At, 0, 0); PG8_STAGE(PG8_SA(1, 1), a1 + hstep, voffA);
            PG8_WAIT_L(8); PG8_BAR; PG8_WAIT_L(0); PG8_MMA(0, 0, At, B0); PG8_BAR; PG8_SCHED;
            PG8_LDB(B1, 0, 1); PG8_STAGE(PG8_SB(0, 0), b2, voffB);
            PG8_BAR; PG8_WAIT_L(0); PG8_MMA(0, 1, At, B1); PG8_BAR;
            PG8_LDA(At, 0, 1); PG8_STAGE(PG8_SA(0, 0), a2, voffA);
            PG8_BAR; PG8_WAIT_L(0); PG8_MMA(1, 0, At, B0); PG8_BAR; PG8_SCHED;
            PG8_STAGE(PG8_SB(0, 1), b2 + hstep, voffB);
            PG8_WAIT_V(6); PG8_BAR; PG8_MMA(1, 1, At, B1); PG8_BAR;
            PG8_LDB(B0, 1, 0); PG8_SCHED; PG8_LDA(At, 1, 0); PG8_STAGE(PG8_SA(0, 1), a2 + hstep, voffA);
            PG8_WAIT_L(8); PG8_BAR; PG8_WAIT_L(0); PG8_MMA(0, 0, At, B0); PG8_BAR; PG8_SCHED;
            PG8_LDB(B1, 1, 1); PG8_STAGE(PG8_SB(1, 0), b3, voffB);
            PG8_BAR; PG8_WAIT_L(0); PG8_MMA(0, 1, At, B1); PG8_BAR;
            PG8_LDA(At, 1, 1); PG8_STAGE(PG8_SA(1, 0), a3, voffA);
            PG8_BAR; PG8_WAIT_L(0); PG8_MMA(1, 0, At, B0); PG8_BAR; PG8_SCHED;
            PG8_STAGE(PG8_SB(1, 1), b3 + hstep, voffB);
            PG8_WAIT_V(6); PG8_BAR; PG8_MMA(1, 1, At, B1); PG8_BAR;
            }
        }
        if constexpr (ALIGN_EPI) { if (wr == 0) PG8_BAR; }
        if constexpr (!Epi::AFTER_DRAIN) { E(acc, cur, wr, wc, fr, fq); S.done(cur); }
        const bool keep_acc = E.keep(cur);
        if (!has_next) break;
        if (!keep_acc) {
#pragma unroll
        for (int a = 0; a < 2; ++a)
#pragma unroll
            for (int b = 0; b < 2; ++b)
#pragma unroll
                for (int m = 0; m < 4; ++m)
#pragma unroll
                    for (int n = 0; n < 2; ++n) acc[a][b][m][n] = (f32x4){0.f, 0.f, 0.f, 0.f};
        }
        cur = nxt; cA = nA; cB = nB; ++ui;
        if constexpr (ALIGN_EPI) { if (wr == 1) PG8_BAR; }
    }
    PG8_WAIT_V(0);
    if constexpr (!ALIGN_EPI) { if (wr == 0) PG8_BAR; }
    PG8_BAR;
    if constexpr (Epi::AFTER_DRAIN) { E.fused(acc, cur, wr, wc, fr, fq, lds, wid, lane); S.done(cur); }
#undef PG8_SA
#undef PG8_SB
#undef PG8_STAGE
#undef PG8_LDA
#undef PG8_LDB
#undef PG8_MMA
#undef PG8_WAIT_V
#undef PG8_WAIT_L
#undef PG8_BAR
#undef PG8_SCHED
}
}

namespace {
using pg8::bf16_t; using pg8::f32x4; using pg8::u32x4; using pg8::Unit;
#define LAS __attribute__((address_space(3)))
constexpr int M = 16384, D = 1024, T = 2048, NB = 8, MEMLEN = 256, MM = NB * MEMLEN;
constexpr int INC = 6416, DFF = 4096, NCH = 32, NH = 8;
constexpr float EPS = 1e-6f;
constexpr size_t MiB = 1u << 20;
constexpr size_t WS_POOL_C = 77u << 20;
constexpr size_t WS_BAR = 0;
constexpr size_t WS_ROWSS = WS_POOL_C + 174 * (1u << 20);
constexpr size_t WS_ZERO_BYTES = 64 * 1024;
constexpr size_t WS_ROWSS_MEM = WS_POOL_C + 173 * (1u << 20);
constexpr size_t WS_G = 400 * 1024, WS_ML = 408 * 1024, WS_MIN = 416 * 1024;
constexpr size_t WS_DN = 512 * 1024;
constexpr size_t WS_WT = 1 * MiB;
constexpr size_t WT_WIN = 0, WT_WMEM = (size_t)6656 * D * 2, WT_WBR = WT_WMEM + (size_t)D * D * 2, WT_WOUT = WT_WBR + (size_t)3 * D * 512 * 2,
                 WT_FF1 = WT_WOUT + (size_t)D * D * 2, WT_FF2 = WT_FF1 + (size_t)DFF * D * 2, WT_LAYER = WT_FF2 + (size_t)D * DFF * 2;
constexpr size_t WS_MEMB = 73 * MiB, WS_POOL = 77 * MiB, WS_END = 256 * MiB;
static_assert(WS_WT + 2 * WT_LAYER <= WS_MEMB && WS_POOL_C == WS_POOL, "weights fit");
constexpr int LDS_RING = 131072, LDS_BYTES = 147456, LDS_CTL = LDS_BYTES - 256, LDS_RSTD0 = LDS_RING, LDS_RSTD1 = LDS_RING + 1024;

struct P {
    const float *x, *mem, *rel_bias, *g_mix, *w_in, *conv_w, *b_i, *b_f, *norm_g, *sinks, *g_mem, *w_mem_kv, *w_br0, *w_br1, *w_br2, *w_out, *g_ffn, *w_ff1, *w_ff2, *g_final;
    float* out; unsigned char* ws;
};
struct LB {
    bf16_t *xbin, *sq, *mo, *xq, *skv, *mqk, *mv, *memkv, *merged, *xbmid, *hff, *xbnext;
    unsigned char* gates;
    float* iff; bf16_t* state;
    const bf16_t *win, *wmem, *wbr, *wout, *wff1, *wff2;
};
__host__ __device__ inline LB layer_buf(unsigned char* ws, float* out, int l) {
    LB b; unsigned char* pool = ws + WS_POOL; unsigned char* breg = pool;
    b.xbin = (bf16_t*)out; b.xbmid = (bf16_t*)((unsigned char*)out + 32 * MiB); b.xbnext = l == 1 ? (bf16_t*)(pool + 128 * MiB) : (bf16_t*)out;
    b.merged = (bf16_t*)(pool + 48 * MiB); b.hff = (bf16_t*)pool;
    b.sq = (bf16_t*)breg; b.mo = (bf16_t*)(breg + 16 * MiB); b.xq = (bf16_t*)(breg + 32 * MiB);
    b.gates = pool + 125 * MiB;
    b.skv = (bf16_t*)(breg + 48 * MiB); b.mqk = (bf16_t*)(breg + 56 * MiB); b.mv = (bf16_t*)(breg + 88 * MiB);
    b.iff = (float*)(breg + 104 * MiB); b.memkv = (bf16_t*)(breg + 105 * MiB); b.state = (bf16_t*)(breg + 109 * MiB);
    unsigned char* wt = ws + WS_WT + (size_t)l * WT_LAYER;
    b.win = (const bf16_t*)(wt + WT_WIN); b.wmem = (const bf16_t*)(wt + WT_WMEM); b.wbr = (const bf16_t*)(wt + WT_WBR);
    b.wout = (const bf16_t*)(wt + WT_WOUT); b.wff1 = (const bf16_t*)(wt + WT_FF1); b.wff2 = (const bf16_t*)(wt + WT_FF2);
    return b;
}
__device__ __forceinline__ float* ws_f(unsigned char* ws, size_t off) { return (float*)(ws + off); }

__device__ __forceinline__ float bf2f(bf16_t h) { return __uint_as_float(((unsigned)h) << 16); }
__device__ __forceinline__ bf16_t f2bf(float f) { unsigned u = __float_as_uint(f); u = (u + 0x7fffu + ((u >> 16) & 1u)) >> 16; return (bf16_t)u; }
__device__ __forceinline__ unsigned pk2(float lo, float hi) { return (unsigned)f2bf(lo) | ((unsigned)f2bf(hi) << 16); }
__device__ __forceinline__ float sigmoidf_(float v) { return 1.f / (1.f + expf(-v)); }
__device__ __forceinline__ float fsigmoid(float v) { return __builtin_amdgcn_rcpf(1.f + __expf(-v)); }
__device__ __forceinline__ float wave_sum(float v) {
#pragma unroll
    for (int o = 1; o < 64; o <<= 1) v += __shfl_xor(v, o);
    return v;
}
__device__ __forceinline__ float wave_max(float v) {
#pragma unroll
    for (int o = 1; o < 64; o <<= 1) v = fmaxf(v, __shfl_xor(v, o));
    return v;
}
__device__ __forceinline__ void unpack8(const uint4 a, float (&f)[8]) {
    f[0] = __uint_as_float(a.x << 16); f[1] = __uint_as_float(a.x & 0xffff0000u); f[2] = __uint_as_float(a.y << 16); f[3] = __uint_as_float(a.y & 0xffff0000u);
    f[4] = __uint_as_float(a.z << 16); f[5] = __uint_as_float(a.z & 0xffff0000u); f[6] = __uint_as_float(a.w << 16); f[7] = __uint_as_float(a.w & 0xffff0000u);
}
__device__ const unsigned char T5_BUCKET[128] = {0, 1, 2, 3, 4, 5, 6, 7, 8, 9, 10, 11, 12, 13, 14, 15, 16, 16, 16, 17, 17, 18, 18, 18, 19, 19, 19, 20, 20, 20, 20, 21, 21, 21, 21, 22, 22, 22, 22, 22, 23, 23, 23, 23, 23, 23, 24, 24, 24, 24, 24, 24, 25, 25, 25, 25, 25, 25, 25, 26, 26, 26, 26, 26, 26, 26, 26, 27, 27, 27, 27, 27, 27, 27, 27, 27, 27, 28, 28, 28, 28, 28, 28, 28, 28, 28, 28, 29, 29, 29, 29, 29, 29, 29, 29, 29, 29, 29, 29, 30, 30, 30, 30, 30, 30, 30, 30, 30, 30, 30, 30, 30, 30, 31, 31, 31, 31, 31, 31, 31, 31, 31, 31, 31, 31, 31, 31, 31};

__device__ __forceinline__ float rstd_of(const float* rp, int row) {
    const f32x4* q = (const f32x4*)(rp + (size_t)row * 16); const f32x4 a = q[0], b = q[1], c = q[2], d = q[3];
    const float ss = ((a[0] + a[1]) + (a[2] + a[3])) + ((b[0] + b[1]) + (b[2] + b[3])) + (((c[0] + c[1]) + (c[2] + c[3])) + ((d[0] + d[1]) + (d[2] + d[3])));
    return rsqrtf(ss * (1.f / D) + EPS);
}
__device__ __forceinline__ void fill_rstd_table(const float* rp, int rm, LAS float* tab) {
    const int t = threadIdx.x; if (t < 256) tab[t] = rstd_of(rp, rm * 256 + t);
}
struct SchedRounds {
    int G, c, nfull, pn_base, tail, skip_at;
    __device__ __forceinline__ bool next(int i, Unit& u) const {
        const int L = i * G + c;
        if (L < nfull * 256) { const int r = L >> 8, w = L & 255, x = w & 7, j = w >> 3; u.pm = u.rm = 8 * x + (j & 7); u.pn = pn_base + 4 * r + (j >> 3) + (r >= skip_at ? 1 : 0); u.kind = 0; u.asel = 0; return true; }
        if (!tail) return false;
        const int t = L - nfull * 256;
        if (t < 64) { u.pm = u.rm = t; u.pn = 12; u.kind = 0; u.asel = 0; return true; }
        if (t < 128) { u.pm = u.rm = t - 64; u.pn = 25; u.kind = 0; u.asel = 0; return true; }
        if (t < 160) { const int q = t - 128; u.pm = u.rm = q >> 2; u.pn = 26 + (q & 3); u.kind = 1; u.asel = 1; return true; }
        return false;
    }
    __device__ __forceinline__ void a_ready(const Unit&) const {}
    __device__ __forceinline__ void done(const Unit&) const {}
};
struct SchedMerged {
    int G, c;
    __device__ __forceinline__ bool next(int i, Unit& u) const {
        const int tt = (i / 3) * G + c, seg = i % 3; if (tt >= 256) return false;
        const int x = tt & 7, j = tt >> 3; u.rm = 8 * x + (j & 7); u.pm = seg * 64 + u.rm; u.pn = seg * 4 + (j >> 3); u.kind = seg; u.asel = 0; return true;
    }
    __device__ __forceinline__ void a_ready(const Unit&) const {}
    __device__ __forceinline__ void done(const Unit&) const {}
};

__device__ __forceinline__ u32x4 pack8(f32x4 a, f32x4 b) { u32x4 w; w.x = pg8::cvt_pk_bf16(a[0], a[1]); w.y = pg8::cvt_pk_bf16(a[2], a[3]); w.z = pg8::cvt_pk_bf16(b[0], b[1]); w.w = pg8::cvt_pk_bf16(b[2], b[3]); return w; }
__device__ __forceinline__ f32x4 sig4(f32x4 v) { f32x4 r; r[0] = fsigmoid(v[0]); r[1] = fsigmoid(v[1]); r[2] = fsigmoid(v[2]); r[3] = fsigmoid(v[3]); return r; }
struct EpiProjMK {
    static constexpr bool PERM = true, AFTER_DRAIN = false;
    LB L; const LAS float* tab0; const LAS float* tab1; int rm0;
    __device__ __forceinline__ bool keep(const Unit&) const { return false; }
    __device__ __forceinline__ void operator()(f32x4 (&acc)[2][2][4][2], const Unit& u, int wr, int wc, int fr, int fq) const {
        const int rbase = u.rm * 256 + wr * 64 + fr, cin = wc * 32 + 8 * fq, rloc = wr * 64 + fr;
        const LAS float* rs = (u.kind == 0 && u.rm == rm0) ? tab0 : tab1; bf16_t* dst; int ld, coff; bool sig = false; const int tile = u.pn;
        if (u.kind == 1) { dst = L.memkv; ld = 1024; coff = (tile - 26) * 256; }
        else if (tile < 2) { dst = L.sq; ld = 512; coff = tile * 256; }
        else if (tile < 3) { dst = L.skv; ld = 256; coff = 0; }
        else if (tile < 7) { dst = L.mqk; ld = 1024; coff = (tile - 3) * 256; }
        else if (tile < 9) { dst = L.mv; ld = 512; coff = (tile - 7) * 256; }
        else if (tile < 11) { dst = L.mo; ld = 512; coff = (tile - 9) * 256; sig = true; }
        else if (tile < 13) { dst = L.xq; ld = 512; coff = (tile - 11) * 256; }
        else { dst = nullptr; ld = 0; coff = 0; }
#pragma unroll
        for (int ai = 0; ai < 2; ++ai)
#pragma unroll
            for (int m = 0; m < 4; ++m) {
                const int row = rbase + ai * 128 + m * 16; const float rstd = rs[rloc + ai * 128 + m * 16];
#pragma unroll
                for (int bj = 0; bj < 2; ++bj) {
                    f32x4 v0 = acc[ai][bj][m][0] * rstd, v1 = acc[ai][bj][m][1] * rstd;
                    if (dst) { if (sig) { v0 = sig4(v0); v1 = sig4(v1); }
                        *(u32x4*)(dst + (size_t)row * ld + coff + bj * 128 + cin) = pack8(v0, v1); }
                    else if (tile < 25) {
                        v0 = sig4(v0) * 256.f; v1 = sig4(v1) * 256.f; uint2 w;
                        w.x = (unsigned)fminf(v0[0], 255.f) | ((unsigned)fminf(v0[1], 255.f) << 8) | ((unsigned)fminf(v0[2], 255.f) << 16) | ((unsigned)fminf(v0[3], 255.f) << 24);
                        w.y = (unsigned)fminf(v1[0], 255.f) | ((unsigned)fminf(v1[1], 255.f) << 8) | ((unsigned)fminf(v1[2], 255.f) << 16) | ((unsigned)fminf(v1[3], 255.f) << 24);
                        *(uint2*)(L.gates + (size_t)row * 3072 + (tile - 13) * 256 + bj * 128 + cin) = w; }
                    else if (bj == 0 && cin < 16) { *(f32x4*)(L.iff + (size_t)row * 16 + cin) = v0; *(f32x4*)(L.iff + (size_t)row * 16 + cin + 4) = v1; }
                }
            }
    }
};
struct EpiMergedMK {
    static constexpr bool PERM = true, AFTER_DRAIN = false;
    const unsigned char* gates; bf16_t* merged;
    __device__ __forceinline__ bool keep(const Unit& u) const { return u.kind < 2; }
    __device__ __forceinline__ static void deq8(uint2 w, float (&g)[8]) {
        g[0] = (float)(w.x & 255u) + 0.5f; g[1] = (float)((w.x >> 8) & 255u) + 0.5f; g[2] = (float)((w.x >> 16) & 255u) + 0.5f; g[3] = (float)(w.x >> 24) + 0.5f;
        g[4] = (float)(w.y & 255u) + 0.5f; g[5] = (float)((w.y >> 8) & 255u) + 0.5f; g[6] = (float)((w.y >> 16) & 255u) + 0.5f; g[7] = (float)(w.y >> 24) + 0.5f; }
    __device__ __forceinline__ void operator()(f32x4 (&acc)[2][2][4][2], const Unit& u, int wr, int wc, int fr, int fq) const {
        const int rbase = u.rm * 256 + wr * 64 + fr, col0 = (u.pn & 3) * 256 + wc * 32 + 8 * fq, seg = u.kind;
        uint2 gs[2][4][2], gn[2][4][2];
#pragma unroll
        for (int ai = 0; ai < 2; ++ai)
#pragma unroll
            for (int m = 0; m < 4; ++m)
#pragma unroll
                for (int bj = 0; bj < 2; ++bj) { const unsigned char* gp = gates + (size_t)(rbase + ai * 128 + m * 16) * 3072 + seg * 1024 + col0 + bj * 128;
                    gs[ai][m][bj] = *(const uint2*)gp; gn[ai][m][bj] = seg < 2 ? *(const uint2*)(gp + 1024) : make_uint2(0u, 0u); }
#pragma unroll
        for (int ai = 0; ai < 2; ++ai)
#pragma unroll
            for (int m = 0; m < 4; ++m) {
                const int row = rbase + ai * 128 + m * 16;
#pragma unroll
                for (int bj = 0; bj < 2; ++bj) {
                    const int col = col0 + bj * 128;
                    float g[8]; deq8(gs[ai][m][bj], g);
                    if (seg < 2) { float gd[8]; deq8(gn[ai][m][bj], gd);
#pragma unroll
                        for (int j = 0; j < 8; ++j) g[j] = g[j] * __builtin_amdgcn_rcpf(gd[j]); }
                    else {
#pragma unroll
                        for (int j = 0; j < 8; ++j) g[j] *= (1.f / 256.f); }
                    f32x4 v0 = acc[ai][bj][m][0], v1 = acc[ai][bj][m][1];
                    v0[0] *= g[0]; v0[1] *= g[1]; v0[2] *= g[2]; v0[3] *= g[3]; v1[0] *= g[4]; v1[1] *= g[5]; v1[2] *= g[6]; v1[3] *= g[7];
                    acc[ai][bj][m][0] = v0; acc[ai][bj][m][1] = v1;
                    if (seg == 2) *(u32x4*)(merged + (size_t)row * D + col) = pack8(v0, v1);
                }
            }
    }
};
struct EpiResidMK {
    static constexpr bool PERM = true, AFTER_DRAIN = false;
    const bf16_t* xold; bf16_t* xnew; float* rowss;
    __device__ __forceinline__ bool keep(const Unit&) const { return false; }
    __device__ __forceinline__ void operator()(f32x4 (&acc)[2][2][4][2], const Unit& u, int wr, int wc, int fr, int fq) const {
        const int rbase = u.rm * 256 + wr * 64 + fr, col0 = u.pn * 256 + wc * 32 + 8 * fq;
#pragma unroll
        for (int ai = 0; ai < 2; ++ai) {
            uint4 xo[4][2];
#pragma unroll
            for (int m = 0; m < 4; ++m)
#pragma unroll
                for (int bj = 0; bj < 2; ++bj) xo[m][bj] = *(const uint4*)(xold + (size_t)(rbase + ai * 128 + m * 16) * D + col0 + bj * 128);
#pragma unroll
            for (int m = 0; m < 4; ++m) {
                const int row = rbase + ai * 128 + m * 16; const size_t off = (size_t)row * D + col0; float ss = 0.f;
#pragma unroll
                for (int bj = 0; bj < 2; ++bj) {
                    float o[8]; unpack8(xo[m][bj], o);
                    f32x4 v0 = acc[ai][bj][m][0], v1 = acc[ai][bj][m][1];
                    v0[0] += o[0]; v0[1] += o[1]; v0[2] += o[2]; v0[3] += o[3]; v1[0] += o[4]; v1[1] += o[5]; v1[2] += o[6]; v1[3] += o[7];
                    const u32x4 w = pack8(v0, v1); *(u32x4*)(xnew + off + bj * 128) = w;
                    float r[8]; unpack8(__builtin_bit_cast(uint4, w), r);
#pragma unroll
                    for (int j = 0; j < 8; ++j) ss = fmaf(r[j], r[j], ss);
                }
                ss += __shfl_xor(ss, 16); ss += __shfl_xor(ss, 32);
                if (fq == 0) rowss[(size_t)row * 16 + (u.pn & 3) * 4 + wc] = ss;
            }
            asm volatile("" ::: "memory");
        }
    }
};
struct EpiFF1MK {
    static constexpr bool PERM = true, AFTER_DRAIN = false;
    bf16_t* h; const LAS float* tab0;
    __device__ __forceinline__ bool keep(const Unit&) const { return false; }
    __device__ __forceinline__ void operator()(f32x4 (&acc)[2][2][4][2], const Unit& u, int wr, int wc, int fr, int fq) const {
        const int rbase = u.rm * 256 + wr * 64 + fr, col0 = u.pn * 256 + wc * 32 + 8 * fq, rloc = wr * 64 + fr;
#pragma unroll
        for (int ai = 0; ai < 2; ++ai)
#pragma unroll
            for (int m = 0; m < 4; ++m) {
                const int row = rbase + ai * 128 + m * 16; const float rstd = tab0[rloc + ai * 128 + m * 16];
#pragma unroll
                for (int bj = 0; bj < 2; ++bj) {
                    f32x4 v0 = acc[ai][bj][m][0] * rstd, v1 = acc[ai][bj][m][1] * rstd;
#pragma unroll
                    for (int j = 0; j < 4; ++j) { v0[j] = fmaxf(v0[j], 0.f); v0[j] *= v0[j]; v1[j] = fmaxf(v1[j], 0.f); v1[j] *= v1[j]; }
                    *(u32x4*)(h + (size_t)row * DFF + col0 + bj * 128) = pack8(v0, v1);
                }
            }
    }
};

__device__ __forceinline__ void convert_tile_w(const float* src, int ldsrc, int col0, int ncols, int k0, const float* gain, float scale, bf16_t* dst, int K, float* tile, int lane) {
    const int n4 = (lane & 15) * 4;
    f32x4 v[16];
#pragma unroll
    for (int i = 0; i < 16; ++i) { const int kk = (lane >> 4) + 4 * i; v[i] = n4 < ncols ? *(const f32x4*)(src + (size_t)(k0 + kk) * ldsrc + col0 + n4) : (f32x4){0.f, 0.f, 0.f, 0.f}; }
#pragma unroll
    for (int i = 0; i < 16; ++i) { const int kk = (lane >> 4) + 4 * i; const f32x4 w = v[i] * ((gain ? gain[k0 + kk] : 1.f) * scale);
        tile[kk * 65 + n4] = w[0]; tile[kk * 65 + n4 + 1] = w[1]; tile[kk * 65 + n4 + 2] = w[2]; tile[kk * 65 + n4 + 3] = w[3]; }
    asm volatile("s_waitcnt lgkmcnt(0)" ::: "memory");
    const int kc = lane & 7;
#pragma unroll
    for (int i = 0; i < 8; ++i) { const int n = (lane >> 3) + 8 * i; const float* tp = tile + (8 * kc) * 65 + n;
        u32x4 w; w.x = pk2(tp[0], tp[65]); w.y = pk2(tp[130], tp[195]); w.z = pk2(tp[260], tp[325]); w.w = pk2(tp[390], tp[455]);
        if (n < ncols) *(u32x4*)(dst + (size_t)n * K + k0 + 8 * kc) = w; }
    asm volatile("s_waitcnt lgkmcnt(0)" ::: "memory");
}
constexpr int CV_ITEMS_LAYER = 4560;
__device__ __forceinline__ void convert_item(const P& p, int item, float* tile, int lane) {
    const int l = item / CV_ITEMS_LAYER; int r = item % CV_ITEMS_LAYER;
    unsigned char* wt = p.ws + WS_WT + (size_t)l * WT_LAYER;
    const float* src; const float* gain = nullptr; int ld, col0, ncols, K; float sc = 1.f; bf16_t* dst;
    if (r < 1616) {
        const float* win = p.w_in + (size_t)l * D * INC; src = win; ld = INC; K = D; gain = p.g_mix + l * D; int dr;
        if (r < 128) { col0 = 0; ncols = 512; dr = 0; sc = 0.125f; }
        else if ((r -= 128) < 448) { col0 = 512; ncols = 1792; dr = 512; }
        else if ((r -= 448) < 128) { col0 = 2320; ncols = 512; dr = 2304; }
        else if ((r -= 128) < 128) { col0 = 2832; ncols = 512; dr = 2816; sc = 0.08838834764831845f; }
        else if ((r -= 128) < 768) { col0 = 3344; ncols = 3072; dr = 3328; }
        else { r -= 768; col0 = 2304; ncols = 16; dr = 6400; }
        dst = (bf16_t*)(wt + WT_WIN) + (size_t)dr * D;
    } else if ((r -= 1616) < 256) { src = p.w_mem_kv + (size_t)l * D * 1024; ld = 1024; col0 = 0; ncols = 1024; K = D; gain = p.g_mem + l * D; dst = (bf16_t*)(wt + WT_WMEM); }
    else if ((r -= 256) < 384) { const int sg = r / 128; r -= sg * 128; src = (sg == 0 ? p.w_br0 : sg == 1 ? p.w_br1 : p.w_br2) + (size_t)l * 512 * 1024; ld = 1024; col0 = 0; ncols = 1024; K = 512; dst = (bf16_t*)(wt + WT_WBR) + (size_t)sg * 1024 * 512; }
    else if ((r -= 384) < 256) { src = p.w_out + (size_t)l * D * D; ld = 1024; col0 = 0; ncols = 1024; K = D; dst = (bf16_t*)(wt + WT_WOUT); }
    else if ((r -= 256) < 1024) { src = p.w_ff1 + (size_t)l * D * DFF; ld = DFF; col0 = 0; ncols = DFF; K = D; gain = p.g_ffn + l * D; dst = (bf16_t*)(wt + WT_FF1); }
    else { r -= 1024; src = p.w_ff2 + (size_t)l * DFF * D; ld = D; col0 = 0; ncols = D; K = DFF; dst = (bf16_t*)(wt + WT_FF2); }
    const int nnb = (ncols + 63) / 64, kb = r / nnb, nb = r % nnb, c0 = nb * 64, nc = (ncols - c0) < 64 ? (ncols - c0) : 64;
    convert_tile_w(src, ld, col0 + c0, nc, kb * 64, gain, sc, dst + (size_t)c0 * K, K, tile, lane);
}
__device__ __forceinline__ void rowstat_rows(const float* src, int rows, bf16_t* xb, float* rowss, int gw, int ngw, int lane) {
    for (int r = gw; r < rows; r += 2 * ngw) {
        const int r1 = r + ngw; const bool two = r1 < rows;
        const float4* s0 = (const float4*)(src + (size_t)r * D); const float4* s1 = (const float4*)(src + (size_t)(two ? r1 : r) * D);
        float4 a[4], b[4];
#pragma unroll
        for (int j = 0; j < 4; ++j) { a[j] = s0[lane + 64 * j]; b[j] = s1[lane + 64 * j]; }
        float ssa = 0.f, ssb = 0.f;
#pragma unroll
        for (int j = 0; j < 4; ++j) { ssa += a[j].x * a[j].x + a[j].y * a[j].y + a[j].z * a[j].z + a[j].w * a[j].w; ssb += b[j].x * b[j].x + b[j].y * b[j].y + b[j].z * b[j].z + b[j].w * b[j].w;
            uint2 o; o.x = pk2(a[j].x, a[j].y); o.y = pk2(a[j].z, a[j].w); *(uint2*)(xb + (size_t)r * D + 4 * (lane + 64 * j)) = o;
            if (two) { uint2 o1; o1.x = pk2(b[j].x, b[j].y); o1.y = pk2(b[j].z, b[j].w); *(uint2*)(xb + (size_t)r1 * D + 4 * (lane + 64 * j)) = o1; } }
        ssa = wave_sum(ssa); ssb = wave_sum(ssb);
        if (lane < 16) { rowss[(size_t)r * 16 + lane] = lane == 0 ? ssa : 0.f; if (two) rowss[(size_t)r1 * 16 + lane] = lane == 0 ? ssb : 0.f; }
    }
}
__device__ __forceinline__ void finalnorm_rows(const bf16_t* xb, float* out, const float* rowss, const float* g, int gw, int ngw, int lane) {
    for (int r = gw; r < M; r += ngw) {
        const float rstd = rstd_of(rowss, r);
#pragma unroll
        for (int j = 0; j < 2; ++j) { float x[8]; unpack8(*(const uint4*)(xb + (size_t)r * D + 8 * (lane + 64 * j)), x);
            const float4 g0 = *(const float4*)(g + 8 * (lane + 64 * j)), g1 = *(const float4*)(g + 8 * (lane + 64 * j) + 4);
            float4 o0, o1; o0.x = x[0] * rstd * g0.x; o0.y = x[1] * rstd * g0.y; o0.z = x[2] * rstd * g0.z; o0.w = x[3] * rstd * g0.w;
            o1.x = x[4] * rstd * g1.x; o1.y = x[5] * rstd * g1.y; o1.z = x[6] * rstd * g1.z; o1.w = x[7] * rstd * g1.w;
            *(float4*)(out + (size_t)r * D + 8 * (lane + 64 * j)) = o0; *(float4*)(out + (size_t)r * D + 8 * (lane + 64 * j) + 4) = o1; }
    }
}

typedef short bf16x8 __attribute__((ext_vector_type(8)));
typedef short s16x4 __attribute__((ext_vector_type(4)));
typedef float f32x16 __attribute__((ext_vector_type(16)));
typedef float f32x2 __attribute__((ext_vector_type(2)));
typedef __bf16 bf16x2v __attribute__((ext_vector_type(2)));
#define MFMA32(a, b, c) __builtin_amdgcn_mfma_f32_32x32x16_bf16((a), (b), (c), 0, 0, 0)
__device__ __forceinline__ int crow(int reg, int h) { return (reg & 3) + 8 * (reg >> 2) + 4 * h; }
__device__ __forceinline__ unsigned pkbf(float a, float b) { return __builtin_bit_cast(unsigned, __builtin_convertvector((f32x2){a, b}, bf16x2v)); }
__device__ __forceinline__ bf16x8 pack_step(const f32x16& x, int s) {
    u32x4 p; p.x = pkbf(x[8 * s], x[8 * s + 1]); p.y = pkbf(x[8 * s + 2], x[8 * s + 3]); p.z = pkbf(x[8 * s + 4], x[8 * s + 5]); p.w = pkbf(x[8 * s + 6], x[8 * s + 7]);
    return __builtin_bit_cast(bf16x8, p);
}
__device__ __forceinline__ bf16x8 tr_frag(const LAS unsigned char* img, int row_lo, int row_hi, int lane) {
    const int i16 = lane & 15, q = i16 >> 2, p = i16 & 3, blk = (lane >> 4) & 1;
    const s16x4 lo = __builtin_amdgcn_ds_read_tr16_b64_v4i16((LAS s16x4*)(img + (row_lo + q) * 64 + 32 * blk + 8 * p));
    const s16x4 hi = __builtin_amdgcn_ds_read_tr16_b64_v4i16((LAS s16x4*)(img + (row_hi + q) * 64 + 32 * blk + 8 * p));
    return __builtin_shufflevector(lo, hi, 0, 1, 2, 3, 4, 5, 6, 7);
}

constexpr int SWA_KIMG = 0, SWA_VIMG = 256 * 144, SWA_TAB = SWA_VIMG + 2 * 16384;
__device__ __forceinline__ void swa_mfma_unit(const P& p, const LB& L, int l, int u, LAS unsigned char* l3) {
    int tid_l = threadIdx.x; asm volatile("" : "+v"(tid_l)); const int tid = tid_l, lane = tid & 63, wave = tid >> 6, h = lane >> 5, ql = lane & 31;
    const int hkv = u & 1, n = (u >> 1) & 15, b = u >> 5;
    __syncthreads();
#pragma unroll
    for (int i = 0; i < 4; ++i) {
        const int c = tid + 512 * i, row = c >> 3, cc = c & 7, t = 128 * (n - 1) + row;
        u32x4 kv = (u32x4){0u, 0u, 0u, 0u}, vv = (u32x4){0u, 0u, 0u, 0u};
        if (t >= 0) { const bf16_t* src = L.skv + (size_t)(b * T + t) * 256 + hkv * 64 + cc * 8; kv = *(const u32x4*)src; vv = *(const u32x4*)(src + 128); }
        *(LAS u32x4*)(l3 + SWA_KIMG + row * 144 + cc * 16) = kv;
        *(LAS u32x4*)(l3 + SWA_VIMG + (cc >> 2) * 16384 + row * 64 + (cc & 3) * 16) = vv;
    }
    for (int idx = tid; idx < 4 * 192; idx += 512) { const int g = idx / 192, e = idx % 192, dist = 159 - e;
        ((LAS float*)(l3 + SWA_TAB))[idx] = (dist >= 0 && dist < 128) ? p.rel_bias[(int)T5_BUCKET[dist] * 8 + hkv * 4 + g] : -1e30f; }
    __syncthreads();
    const int g = wave >> 1, half = wave & 1, hq = hkv * 4 + g;
    const float sink = p.sinks[l * 8 + hq];
    const LAS float* tab = (const LAS float*)(l3 + SWA_TAB) + g * 192 + 31 - ql;
#pragma unroll 1
    for (int sb = 0; sb < 2; ++sb) {
        const int r0 = 64 * half + 32 * sb, kb0 = 2 * half + sb;
        bf16_t* qptr = L.sq + (size_t)(b * T + 128 * n + r0 + ql) * 512 + hq * 64;
        bf16x8 Qf[4];
#pragma unroll
        for (int ks = 0; ks < 4; ++ks) Qf[ks] = *(const bf16x8*)(qptr + 16 * ks + 8 * h);
        f32x16 S[5];
#pragma unroll
        for (int i = 0; i < 5; ++i) {
#pragma unroll
            for (int r = 0; r < 16; ++r) S[i][r] = 0.f;
#pragma unroll
            for (int ks = 0; ks < 4; ++ks) { const bf16x8 Kf = *(const LAS bf16x8*)(l3 + SWA_KIMG + (32 * (kb0 + i) + ql) * 144 + 32 * ks + 16 * h); S[i] = MFMA32(Kf, Qf[ks], S[i]); }
        }
        float m = sink;
#pragma unroll
        for (int i = 0; i < 5; ++i)
#pragma unroll
            for (int r = 0; r < 16; ++r) { const int kk = 32 * i + crow(r, h); float sv = S[i][r] + tab[kk];
                if (n == 0 && 32 * kb0 + kk < 128) sv = -1e30f;
                S[i][r] = sv; m = fmaxf(m, sv); }
        m = fmaxf(m, __shfl_xor(m, 32));
        float lsum = 0.f;
#pragma unroll
        for (int i = 0; i < 5; ++i)
#pragma unroll
            for (int r = 0; r < 16; ++r) { const float pe = __expf(S[i][r] - m); S[i][r] = pe; lsum += pe; }
        lsum += __shfl_xor(lsum, 32);
        f32x16 O[2];
#pragma unroll
        for (int db = 0; db < 2; ++db)
#pragma unroll
            for (int r = 0; r < 16; ++r) O[db][r] = 0.f;
#pragma unroll
        for (int i = 0; i < 5; ++i)
#pragma unroll
            for (int s2 = 0; s2 < 2; ++s2) { const bf16x8 Pf = pack_step(S[i], s2); const int k0 = 32 * (kb0 + i) + 16 * s2;
#pragma unroll
                for (int db = 0; db < 2; ++db) { const bf16x8 Vf = tr_frag(l3 + SWA_VIMG + db * 16384, k0 + 4 * h, k0 + 8 + 4 * h, lane); O[db] = MFMA32(Vf, Pf, O[db]); } }
        const float inv = 1.f / (lsum + __expf(sink - m));
#pragma unroll
        for (int db = 0; db < 2; ++db)
#pragma unroll
            for (int gq = 0; gq < 4; ++gq) { uint2 w; w.x = pkbf(O[db][4 * gq] * inv, O[db][4 * gq + 1] * inv); w.y = pkbf(O[db][4 * gq + 2] * inv, O[db][4 * gq + 3] * inv);
                *(uint2*)(qptr + 32 * db + 8 * gq + 4 * h) = w; }
    }
}

constexpr int XA_KIMG = 0, XA_VIMG = 256 * 272;
__device__ __forceinline__ void xattn_mfma_unit(const LB& L, int u, LAS unsigned char* l3) {
    int tid_l = threadIdx.x; asm volatile("" : "+v"(tid_l)); const int tid = tid_l, lane = tid & 63, wave = tid >> 6, h = lane >> 5, ql = lane & 31;
    const int qb = u & 7, hx = (u >> 3) & 3, b = u >> 5;
    __syncthreads();
#pragma unroll
    for (int i = 0; i < 8; ++i) {
        const int c = tid + 512 * i, row = c >> 4, cc = c & 15;
        const bf16_t* src = L.memkv + (size_t)(b * MEMLEN + row) * 1024 + hx * 128 + cc * 8;
        const u32x4 kv = *(const u32x4*)src, vv = *(const u32x4*)(src + 512);
        *(LAS u32x4*)(l3 + XA_KIMG + row * 272 + cc * 16) = kv;
        *(LAS u32x4*)(l3 + XA_VIMG + (cc >> 2) * 16384 + row * 64 + (cc & 3) * 16) = vv;
    }
    bf16_t* qptr = L.xq + (size_t)(b * T + qb * 256 + wave * 32 + ql) * 512 + hx * 128;
    bf16x8 Qf[8];
#pragma unroll
    for (int ks = 0; ks < 8; ++ks) Qf[ks] = *(const bf16x8*)(qptr + 16 * ks + 8 * h);
    __syncthreads();
    f32x16 S[8];
    {
#pragma unroll
        for (int i = 0; i < 8; ++i) {
#pragma unroll
            for (int r = 0; r < 16; ++r) S[i][r] = 0.f;
#pragma unroll
            for (int ks = 0; ks < 8; ++ks) { const bf16x8 Kf = *(const LAS bf16x8*)(l3 + XA_KIMG + (32 * i + ql) * 272 + 32 * ks + 16 * h); S[i] = MFMA32(Kf, Qf[ks], S[i]); }
        }
    }
    float m = -1e30f;
#pragma unroll
    for (int i = 0; i < 8; ++i)
#pragma unroll
        for (int r = 0; r < 16; ++r) m = fmaxf(m, S[i][r]);
    m = fmaxf(m, __shfl_xor(m, 32));
    float lsum = 0.f;
#pragma unroll
    for (int i = 0; i < 8; ++i)
#pragma unroll
        for (int r = 0; r < 16; ++r) { const float pe = __expf(S[i][r] - m); S[i][r] = pe; lsum += pe; }
    lsum += __shfl_xor(lsum, 32);
    f32x16 O[4];
#pragma unroll
    for (int db = 0; db < 4; ++db)
#pragma unroll
        for (int r = 0; r < 16; ++r) O[db][r] = 0.f;
#pragma unroll
    for (int i = 0; i < 8; ++i)
#pragma unroll
        for (int s2 = 0; s2 < 2; ++s2) { const bf16x8 Pf = pack_step(S[i], s2); const int k0 = 32 * i + 16 * s2;
#pragma unroll
            for (int db = 0; db < 4; ++db) { const bf16x8 Vf = tr_frag(l3 + XA_VIMG + db * 16384, k0 + 4 * h, k0 + 8 + 4 * h, lane); O[db] = MFMA32(Vf, Pf, O[db]); } }
    const float inv = 1.f / lsum;
#pragma unroll
    for (int db = 0; db < 4; ++db)
#pragma unroll
        for (int gq = 0; gq < 4; ++gq) { uint2 w; w.x = pkbf(O[db][4 * gq] * inv, O[db][4 * gq + 1] * inv); w.y = pkbf(O[db][4 * gq + 2] * inv, O[db][4 * gq + 3] * inv);
            *(uint2*)(qptr + 32 * db + 8 * gq + 4 * h) = w; }
}


__device__ __forceinline__ float log_sigmoid_f(float x) { return x >= 0.f ? -log1pf(expf(-x)) : x - log1pf(expf(x)); }
__device__ __forceinline__ void mlstm_gates_wave(const P& p, const LB& L, int l, int b, int c, int hh, int lane, float& bcum, float& ig) {
    const size_t row = (size_t)b * T + c * 64 + lane;
    ig = L.iff[row * 16 + hh] + p.b_i[l * 8 + hh];
    float v = log_sigmoid_f(L.iff[row * 16 + 8 + hh] + p.b_f[l * 8 + hh]);
#pragma unroll
    for (int o = 1; o < 64; o <<= 1) { const float t = __shfl_up(v, o); if (lane >= o) v += t; }
    bcum = v;
}
constexpr int MA_SLOT = 18368, MA_XK = 0, MA_VIMG = 8704, MA_T0 = 16896;
__device__ __forceinline__ void mlstm_A_mfma_unit(const P& p, const LB& L, int l, int u, LAS unsigned char* l3) {
    int tid_l = threadIdx.x; asm volatile("" : "+v"(tid_l)); const int tid = tid_l, lane = tid & 63, hh = tid >> 6, h = lane >> 5, ql = lane & 31;
    const int c = u & 31, b = u >> 5, uh = u * 8 + hh;
    LAS unsigned char* wl = l3 + hh * MA_SLOT;
    const float* cw = p.conv_w + (size_t)l * 4 * 1024;
    __syncthreads();
    for (int idx = lane; idx < 67 * 8; idx += 64) { const int row = idx >> 3, cc = idx & 7, t = c * 64 - 3 + row; u32x4 v = (u32x4){0u, 0u, 0u, 0u};
        if (t >= 0) v = *(const u32x4*)(L.mqk + (size_t)(b * T + t) * 1024 + 512 + hh * 64 + cc * 8);
        *(LAS u32x4*)(wl + MA_XK + row * 128 + cc * 16) = v; }
#pragma unroll
    for (int i = 0; i < 8; ++i) { const int s = (lane >> 3) + 8 * i, cc = lane & 7;
        const u32x4 v = *(const u32x4*)(L.mv + (size_t)(b * T + c * 64 + s) * 512 + hh * 64 + cc * 8);
        *(LAS u32x4*)(wl + MA_VIMG + (cc >> 2) * 4096 + s * 64 + (cc & 3) * 16) = v; }
    float bcum, ig; mlstm_gates_wave(p, L, l, b, c, hh, lane, bcum, ig);
    const float g = __shfl(bcum, 63), alog = g - bcum + ig, ml = wave_max(alog);
    ((LAS float*)(wl + MA_T0))[lane] = __expf(alog - ml);
    __syncthreads();
    f32x16 acc[2][2];
#pragma unroll
    for (int a = 0; a < 2; ++a)
#pragma unroll
        for (int d = 0; d < 2; ++d)
#pragma unroll
            for (int r = 0; r < 16; ++r) acc[a][d][r] = 0.f;
    float dnacc[2] = {0.f, 0.f};
    float cwr[2][4];
#pragma unroll
    for (int dkb = 0; dkb < 2; ++dkb)
#pragma unroll
        for (int tap = 0; tap < 4; ++tap) cwr[dkb][tap] = cw[tap * 1024 + 512 + hh * 64 + 32 * dkb + ql];
#pragma unroll
    for (int ks = 0; ks < 4; ++ks) {
        const int s0 = 16 * ks + 8 * h;
        const f32x4 we0 = *(const LAS f32x4*)(wl + MA_T0 + s0 * 4), we1 = *(const LAS f32x4*)(wl + MA_T0 + s0 * 4 + 16);
        const float we[8] = {we0[0], we0[1], we0[2], we0[3], we1[0], we1[1], we1[2], we1[3]};
        bf16x8 WKf[2];
#pragma unroll
        for (int dkb = 0; dkb < 2; ++dkb) {
            float x[11];
#pragma unroll
            for (int r = 0; r < 11; ++r) x[r] = bf2f(*(const LAS unsigned short*)(wl + MA_XK + (s0 + r) * 128 + (32 * dkb + ql) * 2));
            float wk[8];
#pragma unroll
            for (int j = 0; j < 8; ++j) { const float cv = fmaf(cwr[dkb][3], x[j + 3], fmaf(cwr[dkb][2], x[j + 2], fmaf(cwr[dkb][1], x[j + 1], cwr[dkb][0] * x[j])));
                wk[j] = cv * 0.125f * __builtin_amdgcn_rcpf(1.f + __expf(-cv)) * we[j]; dnacc[dkb] += wk[j]; }
            u32x4 w; w.x = pkbf(wk[0], wk[1]); w.y = pkbf(wk[2], wk[3]); w.z = pkbf(wk[4], wk[5]); w.w = pkbf(wk[6], wk[7]);
            WKf[dkb] = __builtin_bit_cast(bf16x8, w);
        }
#pragma unroll
        for (int dvb = 0; dvb < 2; ++dvb) { const bf16x8 Vf = tr_frag(wl + MA_VIMG + dvb * 4096, s0, s0 + 4, lane);
#pragma unroll
            for (int dkb = 0; dkb < 2; ++dkb) acc[dkb][dvb] = MFMA32(WKf[dkb], Vf, acc[dkb][dvb]); }
    }
    bf16_t* st = L.state + (size_t)uh * 4096;
#pragma unroll
    for (int dkb = 0; dkb < 2; ++dkb)
#pragma unroll
        for (int dvb = 0; dvb < 2; ++dvb)
#pragma unroll
            for (int gq = 0; gq < 4; ++gq) { uint2 w; w.x = pkbf(acc[dkb][dvb][4 * gq], acc[dkb][dvb][4 * gq + 1]); w.y = pkbf(acc[dkb][dvb][4 * gq + 2], acc[dkb][dvb][4 * gq + 3]);
                *(uint2*)(st + (32 * dvb + ql) * 64 + 32 * dkb + 8 * gq + 4 * h) = w; }
#pragma unroll
    for (int dkb = 0; dkb < 2; ++dkb) { const float t = dnacc[dkb] + __shfl_xor(dnacc[dkb], 32); if (h == 0) ws_f(p.ws, WS_DN)[(size_t)uh * 64 + 32 * dkb + ql] = t; }
    if (lane == 0) { ws_f(p.ws, WS_G)[uh] = g; ws_f(p.ws, WS_ML)[uh] = ml; }
}
__device__ __forceinline__ void mlstm_scan2_unit(const P& p, const LB& L, int u) {
    int tid_l = threadIdx.x; asm volatile("" : "+v"(tid_l)); const int tid = tid_l, bh = u >> 2, b = bh >> 3, hh = bh & 7, e = (u & 3) * 1024 + 2 * tid;
    const bool first = (u & 3) == 0; const bool do_n = first && tid < 64;
    float *G = ws_f(p.ws, WS_G), *ML = ws_f(p.ws, WS_ML), *MIN = ws_f(p.ws, WS_MIN), *DN = ws_f(p.ws, WS_DN);
    unsigned d[NCH]; float dn[NCH];
#pragma unroll
    for (int c = 0; c < NCH; ++c) { const int idx = (b * NCH + c) * 8 + hh; d[c] = *(const unsigned*)(L.state + (size_t)idx * 4096 + e); dn[c] = do_n ? DN[(size_t)idx * 64 + tid] : 0.f; }
    float m = 0.f, n = 0.f, C0 = 0.f, C1 = 0.f;
#pragma unroll
    for (int c = 0; c < NCH; ++c) { const int idx = (b * NCH + c) * 8 + hh; const float g = G[idx], ml = ML[idx], mn = fmaxf(g + m, ml), a = __expf(g + m - mn), sc = __expf(ml - mn);
        *(unsigned*)(L.state + (size_t)idx * 4096 + e) = pkbf(C0, C1);
        C0 = fmaf(C0, a, sc * __uint_as_float(d[c] << 16)); C1 = fmaf(C1, a, sc * __uint_as_float(d[c] & 0xffff0000u));
        if (do_n) { DN[(size_t)idx * 64 + tid] = n; n = a * n + sc * dn[c]; }
        if (first && tid == 0) MIN[idx] = m;
        m = mn; }
}
constexpr int MC_SLOT = 31232, MC_XQ = 0, MC_XK = 9728, MC_VIMG = 19456, MC_CW = 27648, MC_T0 = 29696, MC_T1 = 29952, MC_T2 = 30208, MC_T3 = 30464, MC_T4 = 30720  , MC_T5 = 30976  ;
__device__ __forceinline__ bf16x8 conv_frag_lds(const LAS unsigned char* img, int tok, int ch0, const LAS float* cwl, float scale) {
    float a[8] = {0.f, 0.f, 0.f, 0.f, 0.f, 0.f, 0.f, 0.f};
#pragma unroll
    for (int tap = 0; tap < 4; ++tap) {
        float xf[8]; unpack8(__builtin_bit_cast(uint4, *(const LAS u32x4*)(img + (tok + tap) * 144 + ch0 * 2)), xf);
        const f32x4 w0 = *(const LAS f32x4*)(cwl + tap * 128 + ch0), w1 = *(const LAS f32x4*)(cwl + tap * 128 + ch0 + 4);
        a[0] = fmaf(w0[0], xf[0], a[0]); a[1] = fmaf(w0[1], xf[1], a[1]); a[2] = fmaf(w0[2], xf[2], a[2]); a[3] = fmaf(w0[3], xf[3], a[3]);
        a[4] = fmaf(w1[0], xf[4], a[4]); a[5] = fmaf(w1[1], xf[5], a[5]); a[6] = fmaf(w1[2], xf[6], a[6]); a[7] = fmaf(w1[3], xf[7], a[7]);
    }
#pragma unroll
    for (int j = 0; j < 8; ++j) a[j] = a[j] * scale * __builtin_amdgcn_rcpf(1.f + __expf(-a[j]));
    u32x4 w; w.x = pkbf(a[0], a[1]); w.y = pkbf(a[2], a[3]); w.z = pkbf(a[4], a[5]); w.w = pkbf(a[6], a[7]);
    return __builtin_bit_cast(bf16x8, w);
}
template <int TB>
__device__ __forceinline__ void mlstm_C_block(const LB& L, int b, int c, int hh, int lane, int h, int ql, LAS unsigned char* wl, const bf16x8 (&Cf)[2][4], const uint2 (&mo)[2][4]) {
    const LAS float* cwl = (const LAS float*)(wl + MC_CW);
    bf16x8 Qf[4]; float qn = 0.f;
#pragma unroll
    for (int ks = 0; ks < 4; ++ks) { const int ch0 = 16 * ks + 8 * h;
        Qf[ks] = conv_frag_lds(wl + MC_XQ, 32 * TB + ql, ch0, cwl, 1.f);
        const f32x4 n0 = *(const LAS f32x4*)(wl + MC_T4 + ch0 * 4), n1 = *(const LAS f32x4*)(wl + MC_T4 + ch0 * 4 + 16);
        float qv[8]; unpack8(__builtin_bit_cast(uint4, Qf[ks]), qv);
#pragma unroll
        for (int j = 0; j < 4; ++j) { qn = fmaf(qv[j], n0[j], qn); qn = fmaf(qv[j + 4], n1[j], qn); } }
    f32x16 S0, S1;
#pragma unroll
    for (int r = 0; r < 16; ++r) { S0[r] = 0.f; S1[r] = 0.f; }
#pragma unroll
    for (int ks = 0; ks < 4; ++ks) { const int ch0 = 16 * ks + 8 * h;
        S0 = MFMA32(conv_frag_lds(wl + MC_XK, ql, ch0, cwl + 64, 0.125f), Qf[ks], S0);
        if (TB == 1) S1 = MFMA32(conv_frag_lds(wl + MC_XK, 32 + ql, ch0, cwl + 64, 0.125f), Qf[ks], S1); }
    const float Mt = ((const LAS float*)(wl + MC_T1))[32 * TB + ql];
    float dsum = 0.f;
#pragma unroll
    for (int gq = 0; gq < 4; ++gq) {
        const f32x4 a0 = *(const LAS f32x4*)(wl + MC_T0 + (8 * gq + 4 * h) * 4), a1 = *(const LAS f32x4*)(wl + MC_T0 + (32 + 8 * gq + 4 * h) * 4);
#pragma unroll
        for (int j = 0; j < 4; ++j) { const int r = 4 * gq + j, sl = 8 * gq + 4 * h + j;
            if (TB == 0) { const float v = sl <= ql ? S0[r] * __expf(a0[j] - Mt) : 0.f; S0[r] = v; dsum += v; }
            else { const float v0 = S0[r] * __expf(a0[j] - Mt); S0[r] = v0; const float v1 = sl <= ql ? S1[r] * __expf(a1[j] - Mt) : 0.f; S1[r] = v1; dsum += v0 + v1; } }
    }
    f32x16 acc[2];
#pragma unroll
    for (int d = 0; d < 2; ++d)
#pragma unroll
        for (int r = 0; r < 16; ++r) acc[d][r] = 0.f;
#pragma unroll
    for (int ks = 0; ks < 4; ++ks)
#pragma unroll
        for (int dvb = 0; dvb < 2; ++dvb) acc[dvb] = MFMA32(Cf[dvb][ks], Qf[ks], acc[dvb]);
    const float iw = ((const LAS float*)(wl + MC_T2))[32 * TB + ql];
#pragma unroll
    for (int dvb = 0; dvb < 2; ++dvb)
#pragma unroll
        for (int r = 0; r < 16; ++r) acc[dvb][r] *= iw;
#pragma unroll
    for (int s2 = 0; s2 < 2; ++s2) {
        const bf16x8 P0 = pack_step(S0, s2), P1 = pack_step(S1, s2);
#pragma unroll
        for (int dvb = 0; dvb < 2; ++dvb) {
            acc[dvb] = MFMA32(tr_frag(wl + MC_VIMG + dvb * 4096, 16 * s2 + 4 * h, 16 * s2 + 8 + 4 * h, lane), P0, acc[dvb]);
            if (TB == 1) acc[dvb] = MFMA32(tr_frag(wl + MC_VIMG + dvb * 4096, 32 + 16 * s2 + 4 * h, 32 + 16 * s2 + 8 + 4 * h, lane), P1, acc[dvb]); }
    }
    dsum += __shfl_xor(dsum, 32); qn += __shfl_xor(qn, 32);
    const float den = dsum + iw * qn, mt = ((const LAS float*)(wl + MC_T3))[32 * TB + ql];
    const float sc = 1.f / fmaxf(fabsf(den), __expf(-mt));
    float sum = 0.f;
#pragma unroll
    for (int dvb = 0; dvb < 2; ++dvb)
#pragma unroll
        for (int r = 0; r < 16; ++r) { const float v = acc[dvb][r] * sc; acc[dvb][r] = v; sum += v; }
    sum += __shfl_xor(sum, 32); const float mu = sum * (1.f / 64.f);
    float var = 0.f;
#pragma unroll
    for (int dvb = 0; dvb < 2; ++dvb)
#pragma unroll
        for (int r = 0; r < 16; ++r) { const float dlt = acc[dvb][r] - mu; var += dlt * dlt; }
    var += __shfl_xor(var, 32); const float rstd = rsqrtf(var * (1.f / 64.f) + EPS);
    bf16_t* op = L.mo + (size_t)(b * T + c * 64 + 32 * TB + ql) * 512 + hh * 64;
#pragma unroll
    for (int dvb = 0; dvb < 2; ++dvb)
#pragma unroll
        for (int gq = 0; gq < 4; ++gq) { const int dv = 32 * dvb + 8 * gq + 4 * h; const f32x4 ng = *(const LAS f32x4*)(wl + MC_T5 + dv * 4);
            const uint2 mg = mo[dvb][gq];
            const float y0 = (acc[dvb][4 * gq] - mu) * rstd * ng[0] * __uint_as_float(mg.x << 16), y1 = (acc[dvb][4 * gq + 1] - mu) * rstd * ng[1] * __uint_as_float(mg.x & 0xffff0000u);
            const float y2 = (acc[dvb][4 * gq + 2] - mu) * rstd * ng[2] * __uint_as_float(mg.y << 16), y3 = (acc[dvb][4 * gq + 3] - mu) * rstd * ng[3] * __uint_as_float(mg.y & 0xffff0000u);
            uint2 w; w.x = pkbf(y0, y1); w.y = pkbf(y2, y3); *(uint2*)(op + dv) = w; }
}
__device__ __forceinline__ void mlstm_C_mfma_unit(const P& p, const LB& L, int l, int u, LAS unsigned char* l3) {
    int tid_l = threadIdx.x; asm volatile("" : "+v"(tid_l)); const int tid = tid_l, lane = tid & 63, wave = tid >> 6, h = lane >> 5, ql = lane & 31;
    const int hg = u & 1, c = (u >> 1) & 31, b = u >> 6, hh = 4 * hg + (wave >> 1), tb = wave & 1, uh = (b * 32 + c) * 8 + hh, l128 = tid & 127;
    LAS unsigned char* wl = l3 + (wave >> 1) * MC_SLOT;
    const float* cw = p.conv_w + (size_t)l * 4 * 1024;
    bf16x8 Cf[2][4]; uint2 mo[2][4];
    {
        const bf16_t* st = L.state + (size_t)uh * 4096; const bf16_t* op = L.mo + (size_t)(b * T + c * 64 + 32 * tb + ql) * 512 + hh * 64;
#pragma unroll
        for (int dvb = 0; dvb < 2; ++dvb) {
#pragma unroll
            for (int ks = 0; ks < 4; ++ks) Cf[dvb][ks] = *(const bf16x8*)(st + (32 * dvb + ql) * 64 + 16 * ks + 8 * h);
#pragma unroll
            for (int gq = 0; gq < 4; ++gq) mo[dvb][gq] = *(const uint2*)(op + 32 * dvb + 8 * gq + 4 * h);
        }
    }
    __syncthreads();
    for (int idx = l128; idx < 67 * 8; idx += 128) { const int row = idx >> 3, cc = idx & 7, t = c * 64 - 3 + row; u32x4 vq = (u32x4){0u, 0u, 0u, 0u}, vk = vq;
        if (t >= 0) { const bf16_t* src = L.mqk + (size_t)(b * T + t) * 1024 + hh * 64 + cc * 8; vq = *(const u32x4*)src; vk = *(const u32x4*)(src + 512); }
        *(LAS u32x4*)(wl + MC_XQ + row * 144 + cc * 16) = vq; *(LAS u32x4*)(wl + MC_XK + row * 144 + cc * 16) = vk; }
#pragma unroll
    for (int i = 0; i < 4; ++i) { const int s = (l128 >> 3) + 16 * i, cc = l128 & 7;
        const u32x4 v = *(const u32x4*)(L.mv + (size_t)(b * T + c * 64 + s) * 512 + hh * 64 + cc * 8);
        *(LAS u32x4*)(wl + MC_VIMG + (cc >> 2) * 4096 + s * 64 + (cc & 3) * 16) = v; }
#pragma unroll
    for (int i = 0; i < 4; ++i) { const int e = l128 + 128 * i, tap = e >> 7, wch = e & 127;
        ((LAS float*)(wl + MC_CW))[e] = cw[tap * 1024 + (wch >> 6) * 512 + hh * 64 + (wch & 63)]; }
    {
        float bcum, ig; mlstm_gates_wave(p, L, l, b, c, hh, lane, bcum, ig);
        const float a = ig - bcum; float v = a;
#pragma unroll
        for (int o = 1; o < 64; o <<= 1) { const float t = __shfl_up(v, o); if (lane >= o) v = fmaxf(v, t); }
        const float m_in = ws_f(p.ws, WS_MIN)[uh], Mt = fmaxf(v, m_in);
        if (tb == 1) { ((LAS float*)(wl + MC_T4))[lane] = ws_f(p.ws, WS_DN)[(size_t)uh * 64 + lane]; ((LAS float*)(wl + MC_T5))[lane] = p.norm_g[l * 512 + hh * 64 + lane]; }
        if (tb == 0) { ((LAS float*)(wl + MC_T0))[lane] = a; ((LAS float*)(wl + MC_T1))[lane] = Mt; ((LAS float*)(wl + MC_T2))[lane] = __expf(m_in - Mt); ((LAS float*)(wl + MC_T3))[lane] = bcum + Mt; }
    }
    __syncthreads();
    if (tb == 0) mlstm_C_block<0>(L, b, c, hh, lane, h, ql, wl, Cf, mo);
    else mlstm_C_block<1>(L, b, c, hh, lane, h, ql, wl, Cf, mo);
}

#define XB_TMO      128
#define XB_XCNT(j)  (256  + 64 * (j))
#define XB_XSUB(j)  (1280 + 64 * (j))
#define XB_XGEN(j)  (2304 + 64 * (j))
#define XB_TOP      3328
#define XB_TOPGEN   3392
#define XCD_BAR_WORDS 3456
#define XB_SPIN_CAP (1u << 18)

__device__ __forceinline__ unsigned xb_ld(unsigned* p)              { return __hip_atomic_load(p, __ATOMIC_RELAXED, __HIP_MEMORY_SCOPE_AGENT); }
__device__ __forceinline__ unsigned xb_add(unsigned* p, unsigned v) { return __hip_atomic_fetch_add(p, v, __ATOMIC_RELAXED, __HIP_MEMORY_SCOPE_AGENT); }
__device__ __forceinline__ unsigned xb_xcc_id() { return (unsigned)__builtin_amdgcn_s_getreg((3 << 11) | 20) & 0xFu; }
#define XB_SPIN(cond, bar) do { unsigned _sp = 0; while (cond) { __builtin_amdgcn_s_sleep(1); \
    if ((++_sp & 255u) == 0u) { if (xb_ld(&(bar)[XB_TMO])) break; if (_sp > XB_SPIN_CAP) { atomicAdd(&(bar)[XB_TMO], 1u); break; } } } } while (0)

struct XcdBarrier {
    unsigned* bar; unsigned x;
    volatile LAS unsigned* st;
};

__device__ __forceinline__ XcdBarrier xcd_barrier_post(unsigned* bar, volatile LAS unsigned* st) {
    XcdBarrier b; b.bar = bar; b.x = xb_xcc_id(); b.st = st;
    if (threadIdx.x == 0) (void)xb_add(&bar[XB_XCNT(b.x)], 1u);
    return b;
}
__device__ __forceinline__ void xcd_barrier_complete(unsigned* bar, unsigned x, unsigned& nloc, unsigned& nx) {
    const unsigned G = gridDim.x * gridDim.y * gridDim.z;
    unsigned sum, cnt, mine, sp = 0u;
    for (;;) {
        sum = 0u; cnt = 0u; mine = 0u;
#pragma unroll
        for (unsigned j = 0; j < 16; ++j) { const unsigned c = xb_ld(&bar[XB_XCNT(j)]); sum += c; cnt += (c > 0u) ? 1u : 0u; mine = (j == x) ? c : mine; }
        if (sum == G) break;
        __builtin_amdgcn_s_sleep(1);
        if ((++sp & 255u) == 0u) { if (xb_ld(&bar[XB_TMO])) break; if (sp > XB_SPIN_CAP) { atomicAdd(&bar[XB_TMO], 1u); break; } }
    }
    nloc = mine > 0u ? mine : 1u; nx = cnt > 0u ? cnt : 1u;
}

__device__ __forceinline__ void xcd_barrier(const XcdBarrier& b) {
    asm volatile("s_waitcnt vmcnt(0)" ::: "memory");
    __syncthreads();
    if (threadIdx.x == 0) {
        unsigned* bar = b.bar;
        __builtin_amdgcn_s_waitcnt(0);
        unsigned nloc = b.st[0], nx = b.st[1];
        if (nloc == 0u) { xcd_barrier_complete(bar, b.x, nloc, nx); b.st[0] = nloc; b.st[1] = nx; }
        const unsigned old = xb_add(&bar[XB_XSUB(b.x)], 1u);
        const unsigned gen = old / nloc;
        if (old + 1u == (gen + 1u) * nloc) {
            __builtin_amdgcn_fence(__ATOMIC_RELEASE, "agent");
            asm volatile("s_waitcnt vmcnt(0)" ::: "memory");
            const unsigned og = xb_add(&bar[XB_TOP], 1u);
            const unsigned tg = og / nx;
            if (og + 1u == (tg + 1u) * nx) xb_add(&bar[XB_TOPGEN], 1u);
            else XB_SPIN(xb_ld(&bar[XB_TOPGEN]) == tg, bar);
            __builtin_amdgcn_fence(__ATOMIC_ACQUIRE, "agent");
            xb_add(&bar[XB_XGEN(b.x)], 1u);
            asm volatile("s_waitcnt vmcnt(0)" ::: "memory");
        } else {
            XB_SPIN(xb_ld(&bar[XB_XGEN(b.x)]) == gen, bar);
            __builtin_amdgcn_fence(__ATOMIC_ACQUIRE, "agent");
            asm volatile("s_waitcnt vmcnt(0)" ::: "memory");
        }
    }
    __syncthreads();
}

__global__ void __launch_bounds__(512, 2) mk_fwd(P p) {
    extern __shared__ __attribute__((aligned(16))) unsigned char lds[];
    LAS unsigned char* l3 = (LAS unsigned char*)lds;
    float* fl = (float*)lds;
    const int G = gridDim.x, bx = blockIdx.x;
    if (threadIdx.x < 64) ((LAS unsigned*)(l3 + LDS_CTL))[threadIdx.x] = 0u;
    __syncthreads();
    (void)xcd_barrier_post((unsigned*)(p.ws + WS_BAR), (volatile LAS unsigned*)(l3 + LDS_CTL + 32));
#define PR_T0 (*(volatile LAS unsigned long long*)(l3 + LDS_CTL + 64))
#define PR_ACC (*(volatile LAS unsigned long long*)(l3 + LDS_CTL + 72))
#define PH_BEGIN(id) do { if ((PROBE_MASK >> (id)) & 1) { if (bx == 0 && threadIdx.x == 0) PR_T0 = __builtin_amdgcn_s_memrealtime(); } } while (0)
#define PH_END(id) do { if ((PROBE_MASK >> (id)) & 1) { if (bx == 0 && threadIdx.x == 0) PR_ACC = PR_ACC + (__builtin_amdgcn_s_memrealtime() - PR_T0); } } while (0)
#define GRID_BAR() do { XcdBarrier b_; b_.bar = (unsigned*)(p.ws + WS_BAR); b_.x = xb_xcc_id(); b_.st = (volatile LAS unsigned*)(l3 + LDS_CTL + 32); xcd_barrier(b_); } while (0)
#define WAVE_IDS() int tid_w = threadIdx.x; asm volatile("" : "+v"(tid_w)); const int lane = tid_w & 63, gw = bx * 8 + (tid_w >> 6), ngw = G * 8

        PH_BEGIN(0);
    {
        WAVE_IDS();
        for (int it = gw; it < 2 * CV_ITEMS_LAYER; it += ngw) convert_item(p, it, fl + (tid_w >> 6) * (64 * 65), lane);
        rowstat_rows(p.x, M, layer_buf(p.ws, p.out, 0).xbin, ws_f(p.ws, WS_ROWSS), gw, ngw, lane);
        rowstat_rows(p.mem, MM, (bf16_t*)(p.ws + WS_MEMB), ws_f(p.ws, WS_ROWSS_MEM), gw, ngw, lane);
    }
    GRID_BAR();
        PH_END(0);

#pragma unroll 1
    for (int l = 0; l < 2; ++l) {
        PH_BEGIN(1);
        {
            const LB L = layer_buf(p.ws, p.out, l);
            pg8::Gemm g{L.xbin, L.win, M, 6656, D, (const bf16_t*)(p.ws + WS_MEMB)};
            SchedRounds S{G, bx, 6, 0, 1, 3};
            Unit u0, u3; S.next(0, u0); const bool has_tail = S.next(6, u3);
            fill_rstd_table(ws_f(p.ws, WS_ROWSS) + (size_t)(2 * l) * M * 16, u0.rm, (LAS float*)(l3 + LDS_RSTD0));
            if (has_tail) fill_rstd_table(u3.kind == 1 ? ws_f(p.ws, WS_ROWSS_MEM) : ws_f(p.ws, WS_ROWSS) + (size_t)(2 * l) * M * 16, u3.rm, (LAS float*)(l3 + LDS_RSTD1));
            __syncthreads();
            EpiProjMK E{L, (const LAS float*)(l3 + LDS_RSTD0), (const LAS float*)(l3 + LDS_RSTD1), u0.rm};
            pg8::gemm_phase<EpiProjMK, SchedRounds, true, true>(l3, g, S, E);
        }
        GRID_BAR();
        PH_END(1);
        PH_BEGIN(2);
        {
            const LB L = layer_buf(p.ws, p.out, l);
            PH_BEGIN(10); for (int u = bx; u < NB * 16 * 2; u += G) swa_mfma_unit(p, L, l, u, l3); PH_END(10);
            PH_BEGIN(11); for (int u = bx; u < NB * 4 * 8; u += G) xattn_mfma_unit(L, u, l3); PH_END(11);
            PH_BEGIN(12); for (int u = bx; u < NB * NCH; u += G) mlstm_A_mfma_unit(p, L, l, u, l3); PH_END(12);
        }
        GRID_BAR();
        PH_END(2);
        PH_BEGIN(3);
        {
            const LB L = layer_buf(p.ws, p.out, l);
            for (int u = bx; u < 256; u += G) mlstm_scan2_unit(p, L, u);
        }
        GRID_BAR();
        PH_END(3);
        PH_BEGIN(4);
        {
            const LB L = layer_buf(p.ws, p.out, l);
            for (int u = bx; u < NB * NCH * 2; u += G) mlstm_C_mfma_unit(p, L, l, u, l3);
        }
        GRID_BAR();
        PH_END(4);
        PH_BEGIN(6);
        {
            const LB L = layer_buf(p.ws, p.out, l);
            pg8::Gemm g{L.sq, L.wbr, 3 * M, 3 * D, 512, nullptr};
            SchedMerged S{G, bx};
            EpiMergedMK E{L.gates, L.merged};
            pg8::gemm_phase<EpiMergedMK, SchedMerged, true, true>(l3, g, S, E);
        }
        GRID_BAR();
        PH_END(6);
        PH_BEGIN(7);
        {
            const LB L = layer_buf(p.ws, p.out, l);
            pg8::Gemm g{L.merged, L.wout, M, D, D, nullptr};
            SchedRounds S{G, bx, 1, 0, 0, 99};
            EpiResidMK E{L.xbin, L.xbmid, ws_f(p.ws, WS_ROWSS) + (size_t)(2 * l + 1) * M * 16};
            pg8::gemm_phase<EpiResidMK, SchedRounds, true, true>(l3, g, S, E);
        }
        GRID_BAR();
        PH_END(7);
        PH_BEGIN(8);
        {
            const LB L = layer_buf(p.ws, p.out, l);
            pg8::Gemm g{L.xbmid, L.wff1, M, DFF, D, nullptr};
            SchedRounds S{G, bx, 4, 0, 0, 99};
            Unit u0; S.next(0, u0);
            fill_rstd_table(ws_f(p.ws, WS_ROWSS) + (size_t)(2 * l + 1) * M * 16, u0.rm, (LAS float*)(l3 + LDS_RSTD0));
            __syncthreads();
            EpiFF1MK E{L.hff, (const LAS float*)(l3 + LDS_RSTD0)};
            pg8::gemm_phase<EpiFF1MK, SchedRounds, true, true>(l3, g, S, E);
        }
        GRID_BAR();
        PH_END(8);
        PH_BEGIN(9);
        {
            const LB L = layer_buf(p.ws, p.out, l);
            pg8::Gemm g{L.hff, L.wff2, M, D, DFF, nullptr};
            SchedRounds S{G, bx, 1, 0, 0, 99};
            EpiResidMK E{L.xbmid, L.xbnext, ws_f(p.ws, WS_ROWSS) + (size_t)(2 * l + 2) * M * 16};
            pg8::gemm_phase<EpiResidMK, SchedRounds, true, true>(l3, g, S, E);
        }
        GRID_BAR();
        PH_END(9);
    }
    {
        WAVE_IDS();
        finalnorm_rows(layer_buf(p.ws, p.out, 1).xbnext, p.out, ws_f(p.ws, WS_ROWSS) + (size_t)4 * M * 16, p.g_final, gw, ngw, lane);
    }
    if (PROBE_MASK != 0 && bx == 0 && threadIdx.x == 0) { const unsigned long long te = __builtin_amdgcn_s_memrealtime(); const unsigned long long acc_ = PR_ACC; while (__builtin_amdgcn_s_memrealtime() - te < 10ull * acc_) __builtin_amdgcn_s_sleep(8); }
}
}

extern "C" void kernel_launch(void* const* d_in, const int* in_sizes, int n_in, void* d_out, int out_size, void* d_ws, size_t ws_size, hipStream_t stream) {
    static int grid = 0;
    if (grid == 0) {
        if (n_in != 20 || out_size != M * D || ws_size < WS_END) { fprintf(stderr, "kernel_launch: unexpected shapes (n_in %d out %d ws %zu)\n", n_in, out_size, ws_size); grid = -1; return; }
        int dev = 0, cus = 0, per_cu = 0;
        if (hipGetDevice(&dev) != hipSuccess || hipDeviceGetAttribute(&cus, hipDeviceAttributeMultiprocessorCount, dev) != hipSuccess) { fprintf(stderr, "kernel_launch: device query failed\n"); grid = -1; return; }
        if (hipFuncSetAttribute((const void*)mk_fwd, hipFuncAttributeMaxDynamicSharedMemorySize, LDS_BYTES) != hipSuccess) { fprintf(stderr, "kernel_launch: hipFuncSetAttribute failed\n"); grid = -1; return; }
        if (hipOccupancyMaxActiveBlocksPerMultiprocessor(&per_cu, (const void*)mk_fwd, 512, LDS_BYTES) != hipSuccess || per_cu < 1) { fprintf(stderr, "kernel_launch: occupancy query says %d blocks per CU\n", per_cu); grid = -1; return; }
        grid = cus;
    }
    if (grid < 0) return;
    P p{};
    const float** pf = (const float**)&p;
    for (int i = 0; i < 20; ++i) pf[i] = (const float*)d_in[i];
    p.out = (float*)d_out; p.ws = (unsigned char*)d_ws;
    if (hipMemsetAsync(d_ws, 0, WS_ZERO_BYTES, stream) != hipSuccess) { fprintf(stderr, "kernel_launch: memset failed\n"); return; }
    void* args[] = {&p};
    const hipError_t e = hipLaunchCooperativeKernel((const void*)mk_fwd, dim3(grid), dim3(512), args, LDS_BYTES, stream);
    if (e != hipSuccess) fprintf(stderr, "kernel_launch: cooperative launch failed: %s (grid %d)\n", hipGetErrorString(e), grid);
}
```

```cpp
#include <hip/hip_runtime.h>
#include <cstdio>
#include <cstdint>
#ifndef PROBE_MASK
#define PROBE_MASK 0
#endif

namespace pg8 {
#define PG8_LAS __attribute__((address_space(3)))
typedef unsigned short bf16_t;
typedef short bf16x8 __attribute__((ext_vector_type(8)));
typedef float f32x4 __attribute__((ext_vector_type(4)));
typedef unsigned u32x4 __attribute__((ext_vector_type(4)));
constexpr int BM = 256, BK = 64, HALF = 128, HTB = HALF * BK * 2  , STAGE_BYTES = 8 * HTB, NXCD = 8, WGM = 8;

__host__ __device__ __forceinline__ int lds_byte(int r, int c) { const int st = (r >> 4) * 2 + (c >> 5), rr = r & 15, cc = c & 31, ob = rr * 64 + cc * 2; return st * 1024 + (ob ^ (((ob >> 9) & 1) << 5)); }
__host__ __device__ __forceinline__ void stage_rc(int b, int& R, int& C) { const int st = b / 1024, sb = b % 1024, swz = sb ^ (((sb >> 9) & 1) << 5); R = (st >> 1) * 16 + swz / 64; C = (st & 1) * 32 + (swz % 64) / 2; }
__host__ __device__ __forceinline__ int perm32(int rho) { const int n = rho >> 4, i = rho & 15; return 8 * (i >> 2) + 4 * n + (i & 3); }
struct Unit { int pm, pn, rm, kind, asel; };
struct Gemm { const bf16_t* A; const bf16_t* Bt; int M, N, K; const bf16_t* A2; };
__device__ __forceinline__ unsigned cvt_pk_bf16(float lo, float hi) { unsigned r; asm volatile("v_cvt_pk_bf16_f32 %0, %1, %2" : "=v"(r) : "v"(lo), "v"(hi)); return r; }
template <class Epi, class Sched, bool ALIGN_EPI = false, bool SP2 = false>
__device__ __forceinline__ void gemm_phase(PG8_LAS unsigned char* lds, const Gemm g, const Sched& S, const Epi& E) {
    int tid_l = threadIdx.x; asm volatile("" : "+v"(tid_l));
    const int tid = tid_l, wid = __builtin_amdgcn_readfirstlane(tid >> 6), lane = tid & 63, wr = wid >> 2, wc = wid & 3, fr = lane & 15, fq = lane >> 4;
    const int K = g.K, nt = K / BK;
    unsigned voffA[2], voffB[2];
#pragma unroll
    for (int i = 0; i < 2; ++i) { int R, C; stage_rc(tid * 16 + i * 8192, R, C); const int Rb = Epi::PERM ? ((R & ~31) + perm32(R & 31)) : R;
        voffA[i] = (unsigned)(R * K + C) * 2u; voffB[i] = (unsigned)(Rb * K + C) * 2u; }
    const size_t kstep = (size_t)(BK * 2);
    const size_t hstep = (size_t)HALF * K * 2;
    const size_t tstep = 2 * hstep;
    const unsigned ldsw = (unsigned)wid * 1024u;
    const int aoff = lds_byte(wr * 64 + fr, fq * 8), boff = lds_byte(wc * 32 + fr, fq * 8);
#define PG8_SA(b, h) (((b) * 2 + (h)) * HTB)
#define PG8_SB(b, h) ((4 + (b) * 2 + (h)) * HTB)
#define PG8_STAGE(bufoff, gbase, voff) do { _Pragma("unroll") for (int _i = 0; _i < 2; ++_i) \
        __builtin_amdgcn_global_load_lds((const unsigned*)((const char*)(gbase) + (voff)[_i]), (PG8_LAS unsigned*)(lds + (bufoff) + ldsw + _i * 8192), 16, 0, 0); } while (0)
#define PG8_LDA(dst, b, h) do { _Pragma("unroll") for (int m = 0; m < 4; ++m) _Pragma("unroll") for (int k = 0; k < 2; ++k) dst[m][k] = *(const PG8_LAS bf16x8*)(lds + PG8_SA(b, h) + aoff + m * 2048 + k * 1024); } while (0)
#define PG8_LDB(dst, b, h) do { _Pragma("unroll") for (int n = 0; n < 2; ++n) _Pragma("unroll") for (int k = 0; k < 2; ++k) dst[n][k] = *(const PG8_LAS bf16x8*)(lds + PG8_SB(b, h) + boff + n * 2048 + k * 1024); } while (0)
#define PG8_MMA(ai, bj, At, Bt) do { __builtin_amdgcn_s_setprio(1); _Pragma("unroll") for (int m = 0; m < 4; ++m) _Pragma("unroll") for (int n = 0; n < 2; ++n) _Pragma("unroll") for (int k = 0; k < 2; ++k) \
        acc[ai][bj][m][n] = __builtin_amdgcn_mfma_f32_16x16x32_bf16(Bt[n][k], At[m][k], acc[ai][bj][m][n], 0, 0, 0); __builtin_amdgcn_s_setprio(0); } while (0)
#define PG8_WAIT_V(n) asm volatile("s_waitcnt vmcnt(" #n ")" ::: "memory")
#define PG8_WAIT_L(n) asm volatile("s_waitcnt lgkmcnt(" #n ")" ::: "memory")
#define PG8_BAR __builtin_amdgcn_s_barrier()
#define PG8_SCHED __builtin_amdgcn_sched_barrier(0)
    Unit cur, nxt; int ui = 0;
    if (!S.next(0, cur)) return;
    f32x4 acc[2][2][4][2];
#pragma unroll
    for (int a = 0; a < 2; ++a)
#pragma unroll
        for (int b = 0; b < 2; ++b)
#pragma unroll
            for (int m = 0; m < 4; ++m)
#pragma unroll
                for (int n = 0; n < 2; ++n) acc[a][b][m][n] = (f32x4){0.f, 0.f, 0.f, 0.f};
    bf16x8 At[4][2], B0[2][2], B1[2][2];
    const char* cA = (const char*)(cur.asel ? g.A2 : g.A) + (size_t)cur.pm * tstep; const char* cB = (const char*)g.Bt + (size_t)cur.pn * tstep;
    S.a_ready(cur);
    if constexpr (SP2) {
        PG8_STAGE(PG8_SB(0, 0), cB, voffB); PG8_STAGE(PG8_SB(0, 1), cB + hstep, voffB); PG8_STAGE(PG8_SA(0, 0), cA, voffA); PG8_STAGE(PG8_SA(0, 1), cA + hstep, voffA);
        if (wr == 1) PG8_BAR;
        PG8_WAIT_V(2); PG8_BAR;
        PG8_STAGE(PG8_SB(1, 0), cB + kstep, voffB); PG8_STAGE(PG8_SA(1, 0), cA + kstep, voffA); PG8_STAGE(PG8_SB(1, 1), cB + hstep + kstep, voffB);
        PG8_WAIT_V(6); PG8_BAR;
    } else {
        PG8_STAGE(PG8_SB(0, 0), cB, voffB); PG8_STAGE(PG8_SA(0, 0), cA, voffA); PG8_STAGE(PG8_SB(0, 1), cB + hstep, voffB); PG8_STAGE(PG8_SA(0, 1), cA + hstep, voffA);
        if (wr == 1) PG8_BAR;
        PG8_WAIT_V(4); PG8_BAR;
        PG8_STAGE(PG8_SB(1, 0), cB + kstep, voffB); PG8_STAGE(PG8_SA(1, 0), cA + kstep, voffA); PG8_STAGE(PG8_SB(1, 1), cB + hstep + kstep, voffB);
        PG8_WAIT_V(6); PG8_BAR;
    }
    for (;;) {
        const bool has_next = S.next(ui + 1, nxt);
        const char* nA = has_next ? (const char*)(nxt.asel ? g.A2 : g.A) + (size_t)nxt.pm * tstep : cA; const char* nB = has_next ? (const char*)g.Bt + (size_t)nxt.pn * tstep : cB;
        for (int t = 0; t < nt; t += 2) {
            const bool last = (t == nt - 2);
            const char* a1 = cA + (size_t)(t + 1) * kstep;
            const char* a2 = last ? nA : cA + (size_t)(t + 2) * kstep; const char* b2 = last ? nB : cB + (size_t)(t + 2) * kstep;
            const char* a3 = a2 + kstep; const char* b3 = b2 + kstep;
            if (last && has_next) S.a_ready(nxt);
            if constexpr (SP2) {
            PG8_LDB(B0, 0, 0); PG8_LDB(B1, 0, 1); PG8_SCHED; PG8_LDA(At, 0, 0); PG8_STAGE(PG8_SA(1, 1), a1 + hstep, voffA);
            PG8_WAIT_V(8); PG8_WAIT_L(0); PG8_BAR; PG8_MMA(0, 0, At, B0); PG8_MMA(0, 1, At, B1); PG8_BAR; PG8_SCHED;
            PG8_LDA(At, 0, 1); PG8_STAGE(PG8_SB(0, 0), b2, voffB); PG8_STAGE(PG8_SB(0, 1), b2 + hstep, voffB); PG8_STAGE(PG8_SA(0, 0), a2, voffA);
            PG8_WAIT_V(8); PG8_WAIT_L(0); PG8_BAR; PG8_MMA(1, 0, At, B0); PG8_MMA(1, 1, At, B1); PG8_BAR; PG8_SCHED;
            PG8_LDB(B0, 1, 0); PG8_LDB(B1, 1, 1); PG8_SCHED; PG8_LDA(At, 1, 0); PG8_STAGE(PG8_SA(0, 1), a2 + hstep, voffA);
            PG8_WAIT_V(8); PG8_WAIT_L(0); PG8_BAR; PG8_MMA(0, 0, At, B0); PG8_MMA(0, 1, At, B1); PG8_BAR; PG8_SCHED;
            PG8_LDA(At, 1, 1); PG8_STAGE(PG8_SB(1, 0), b3, voffB); PG8_STAGE(PG8_SB(1, 1), b3 + hstep, voffB); PG8_STAGE(PG8_SA(1, 0), a3, voffA);
            PG8_WAIT_V(8); PG8_WAIT_L(0); PG8_BAR; PG8_MMA(1, 0, At, B0); PG8_MMA(1, 1, At, B1); PG8_BAR; PG8_SCHED;
            } else {
            PG8_LDB(B0, 0, 0); PG8_SCHED; PG8_LDA(At, 0, 0); PG8_STAGE(PG8_SA(1, 1), a1 + hstep, voffA);
            PG8_WAIT_L(8); PG8_BAR; PG8_WAIT_L(0); PG8_MMA(0, 0, At, B0); PG8_BAR; PG8_SCHED;
            PG8_LDB(B1, 0, 1); PG8_STAGE(PG8_SB(0, 0), b2, voffB);
            PG8_BAR; PG8_WAIT_L(0); PG8_MMA(0, 1, At, B1); PG8_BAR;
            PG8_LDA(At, 0, 1); PG8_STAGE(PG8_SA(0, 0), a2, voffA);
            PG8_BAR; PG8_WAIT_L(0); PG8_MMA(1, 0, At, B0); PG8_BAR; PG8_SCHED;
            PG8_STAGE(PG8_SB(0, 1), b2 + hstep, voffB);
            PG8_WAIT_V(6); PG8_BAR; PG8_MMA(1, 1, At, B1); PG8_BAR;
            PG8_LDB(B0, 1, 0); PG8_SCHED; PG8_LDA(At, 1, 0); PG8_STAGE(PG8_SA(0, 1), a2 + hstep, voffA);
            PG8_WAIT_L(8); PG8_BAR; PG8_WAIT_L(0); PG8_MMA(0, 0, At, B0); PG8_BAR; PG8_SCHED;
            PG8_LDB(B1, 1, 1); PG8_STAGE(PG8_SB(1, 0), b3, voffB);
            PG8_BAR; PG8_WAIT_L(0); PG8_MMA(0, 1, At, B1); PG8_BAR;
            PG8_LDA(At, 1, 1); PG8_STAGE(PG8_SA(1, 0), a3, voffA);
            PG8_BAR; PG8_WAIT_L(0); PG8_MMA(1, 0, At, B0); PG8_BAR; PG8_SCHED;
            PG8_STAGE(PG8_SB(1, 1), b3 + hstep, voffB);
            PG8_WAIT_V(6); PG8_BAR; PG8_MMA(1, 1, At, B1); PG8_BAR;
            }
        }
        if constexpr (ALIGN_EPI) { if (wr == 0) PG8_BAR; }
        if constexpr (!Epi::AFTER_DRAIN) { E(acc, cur, wr, wc, fr, fq); S.done(cur); }
        const bool keep_acc = E.keep(cur);
        if (!has_next) break;
        if (!keep_acc) {
#pragma unroll
        for (int a = 0; a < 2; ++a)
#pragma unroll
            for (int b = 0; b < 2; ++b)
#pragma unroll
                for (int m = 0; m < 4; ++m)
#pragma unroll
                    for (int n = 0; n < 2; ++n) acc[a][b][m][n] = (f32x4){0.f, 0.f, 0.f, 0.f};
        }
        cur = nxt; cA = nA; cB = nB; ++ui;
        if constexpr (ALIGN_EPI) { if (wr == 1) PG8_BAR; }
    }
    PG8_WAIT_V(0);
    if constexpr (!ALIGN_EPI) { if (wr == 0) PG8_BAR; }
    PG8_BAR;
    if constexpr (Epi::AFTER_DRAIN) { E.fused(acc, cur, wr, wc, fr, fq, lds, wid, lane); S.done(cur); }
#undef PG8_SA
#undef PG8_SB
#undef PG8_STAGE
#undef PG8_LDA
#undef PG8_LDB
#undef PG8_MMA
#undef PG8_WAIT_V
#undef PG8_WAIT_L
#undef PG8_BAR
#undef PG8_SCHED
}
}

namespace {
using pg8::bf16_t; using pg8::f32x4; using pg8::u32x4; using pg8::Unit;
#define LAS __attribute__((address_space(3)))
constexpr int M = 16384, D = 1024, T = 2048, NB = 8, MEMLEN = 256, MM = NB * MEMLEN;
constexpr int INC = 6416, DFF = 4096, NCH = 32, NH = 8;
constexpr float EPS = 1e-6f;
constexpr size_t MiB = 1u << 20;
constexpr size_t WS_POOL_C = 77u << 20;
constexpr size_t WS_BAR = 0;
constexpr size_t WS_ROWSS = WS_POOL_C + 174 * (1u << 20);
constexpr size_t WS_ZERO_BYTES = 64 * 1024;
constexpr size_t WS_ROWSS_MEM = WS_POOL_C + 173 * (1u << 20);
constexpr size_t WS_G = 400 * 1024, WS_ML = 408 * 1024, WS_MIN = 416 * 1024;
constexpr size_t WS_DN = 512 * 1024;
constexpr size_t WS_WT = 1 * MiB;
constexpr size_t WT_WIN = 0, WT_WMEM = (size_t)6656 * D * 2, WT_WBR = WT_WMEM + (size_t)D * D * 2, WT_WOUT = WT_WBR + (size_t)3 * D * 512 * 2,
                 WT_FF1 = WT_WOUT + (size_t)D * D * 2, WT_FF2 = WT_FF1 + (size_t)DFF * D * 2, WT_LAYER = WT_FF2 + (size_t)D * DFF * 2;
constexpr size_t WS_MEMB = 73 * MiB, WS_POOL = 77 * MiB, WS_END = 256 * MiB;
static_assert(WS_WT + 2 * WT_LAYER <= WS_MEMB && WS_POOL_C == WS_POOL, "weights fit");
constexpr int LDS_RING = 131072, LDS_BYTES = 147456, LDS_CTL = LDS_BYTES - 256, LDS_RSTD0 = LDS_RING, LDS_RSTD1 = LDS_RING + 1024;

struct P {
    const float *x, *mem, *rel_bias, *g_mix, *w_in, *conv_w, *b_i, *b_f, *norm_g, *sinks, *g_mem, *w_mem_kv, *w_br0, *w_br1, *w_br2, *w_out, *g_ffn, *w_ff1, *w_ff2, *g_final;
    float* out; unsigned char* ws;
};
struct LB {
    bf16_t *xbin, *sq, *mo, *xq, *skv, *mqk, *mv, *memkv, *merged, *xbmid, *hff, *xbnext;
    unsigned char* gates;
    float* iff; bf16_t* state;
    const bf16_t *win, *wmem, *wbr, *wout, *wff1, *wff2;
};
__host__ __device__ inline LB layer_buf(unsigned char* ws, float* out, int l) {
    LB b; unsigned char* pool = ws + WS_POOL; unsigned char* breg = pool;
    b.xbin = (bf16_t*)out; b.xbmid = (bf16_t*)((unsigned char*)out + 32 * MiB); b.xbnext = l == 1 ? (bf16_t*)(pool + 128 * MiB) : (bf16_t*)out;
    b.merged = (bf16_t*)(pool + 48 * MiB); b.hff = (bf16_t*)pool;
    b.sq = (bf16_t*)breg; b.mo = (bf16_t*)(breg + 16 * MiB); b.xq = (bf16_t*)(breg + 32 * MiB);
    b.gates = pool + 125 * MiB;
    b.skv = (bf16_t*)(breg + 48 * MiB); b.mqk = (bf16_t*)(breg + 56 * MiB); b.mv = (bf16_t*)(breg + 88 * MiB);
    b.iff = (float*)(breg + 104 * MiB); b.memkv = (bf16_t*)(breg + 105 * MiB); b.state = (bf16_t*)(breg + 109 * MiB);
    unsigned char* wt = ws + WS_WT + (size_t)l * WT_LAYER;
    b.win = (const bf16_t*)(wt + WT_WIN); b.wmem = (const bf16_t*)(wt + WT_WMEM); b.wbr = (const bf16_t*)(wt + WT_WBR);
    b.wout = (const bf16_t*)(wt + WT_WOUT); b.wff1 = (const bf16_t*)(wt + WT_FF1); b.wff2 = (const bf16_t*)(wt + WT_FF2);
    return b;
}
__device__ __forceinline__ float* ws_f(unsigned char* ws, size_t off) { return (float*)(ws + off); }

__device__ __forceinline__ float bf2f(bf16_t h) { return __uint_as_float(((unsigned)h) << 16); }
__device__ __forceinline__ bf16_t f2bf(float f) { unsigned u = __float_as_uint(f); u = (u + 0x7fffu + ((u >> 16) & 1u)) >> 16; return (bf16_t)u; }
__device__ __forceinline__ unsigned pk2(float lo, float hi) { return (unsigned)f2bf(lo) | ((unsigned)f2bf(hi) << 16); }
__device__ __forceinline__ float sigmoidf_(float v) { return 1.f / (1.f + expf(-v)); }
__device__ __forceinline__ float fsigmoid(float v) { return __builtin_amdgcn_rcpf(1.f + __expf(-v)); }
__device__ __forceinline__ float wave_sum(float v) {
#pragma unroll
    for (int o = 1; o < 64; o <<= 1) v += __shfl_xor(v, o);
    return v;
}
__device__ __forceinline__ float wave_max(float v) {
#pragma unroll
    for (int o = 1; o < 64; o <<= 1) v = fmaxf(v, __shfl_xor(v, o));
    return v;
}
__device__ __forceinline__ void unpack8(const uint4 a, float (&f)[8]) {
    f[0] = __uint_as_float(a.x << 16); f[1] = __uint_as_float(a.x & 0xffff0000u); f[2] = __uint_as_float(a.y << 16); f[3] = __uint_as_float(a.y & 0xffff0000u);
    f[4] = __uint_as_float(a.z << 16); f[5] = __uint_as_float(a.z & 0xffff0000u); f[6] = __uint_as_float(a.w << 16); f[7] = __uint_as_float(a.w & 0xffff0000u);
}
__device__ const unsigned char T5_BUCKET[128] = {0, 1, 2, 3, 4, 5, 6, 7, 8, 9, 10, 11, 12, 13, 14, 15, 16, 16, 16, 17, 17, 18, 18, 18, 19, 19, 19, 20, 20, 20, 20, 21, 21, 21, 21, 22, 22, 22, 22, 22, 23, 23, 23, 23, 23, 23, 24, 24, 24, 24, 24, 24, 25, 25, 25, 25, 25, 25, 25, 26, 26, 26, 26, 26, 26, 26, 26, 27, 27, 27, 27, 27, 27, 27, 27, 27, 27, 28, 28, 28, 28, 28, 28, 28, 28, 28, 28, 29, 29, 29, 29, 29, 29, 29, 29, 29, 29, 29, 29, 30, 30, 30, 30, 30, 30, 30, 30, 30, 30, 30, 30, 30, 30, 31, 31, 31, 31, 31, 31, 31, 31, 31, 31, 31, 31, 31, 31, 31};

__device__ __forceinline__ float rstd_of(const float* rp, int row) {
    const f32x4* q = (const f32x4*)(rp + (size_t)row * 16); const f32x4 a = q[0], b = q[1], c = q[2], d = q[3];
    const float ss = ((a[0] + a[1]) + (a[2] + a[3])) + ((b[0] + b[1]) + (b[2] + b[3])) + (((c[0] + c[1]) + (c[2] + c[3])) + ((d[0] + d[1]) + (d[2] + d[3])));
    return rsqrtf(ss * (1.f / D) + EPS);
}
__device__ __forceinline__ void fill_rstd_table(const float* rp, int rm, LAS float* tab) {
    const int t = threadIdx.x; if (t < 256) tab[t] = rstd_of(rp, rm * 256 + t);
}
struct SchedRounds {
    int G, c, nfull, pn_base, tail, skip_at;
    __device__ __forceinline__ bool next(int i, Unit& u) const {
        const int L = i * G + c;
        if (L < nfull * 256) { const int r = L >> 8, w = L & 255, x = w & 7, j = w >> 3; u.pm = u.rm = 8 * x + (j & 7); u.pn = pn_base + 4 * r + (j >> 3) + (r >= skip_at ? 1 : 0); u.kind = 0; u.asel = 0; return true; }
        if (!tail) return false;
        const int t = L - nfull * 256;
        if (t < 64) { u.pm = u.rm = t; u.pn = 12; u.kind = 0; u.asel = 0; return true; }
        if (t < 128) { u.pm = u.rm = t - 64; u.pn = 25; u.kind = 0; u.asel = 0; return true; }
        if (t < 160) { const int q = t - 128; u.pm = u.rm = q >> 2; u.pn = 26 + (q & 3); u.kind = 1; u.asel = 1; return true; }
        return false;
    }
    __device__ __forceinline__ void a_ready(const Unit&) const {}
    __device__ __forceinline__ void done(const Unit&) const {}
};
struct SchedMerged {
    int G, c;
    __device__ __forceinline__ bool next(int i, Unit& u) const {
        const int tt = (i / 3) * G + c, seg = i % 3; if (tt >= 256) return false;
        const int x = tt & 7, j = tt >> 3; u.rm = 8 * x + (j & 7); u.pm = seg * 64 + u.rm; u.pn = seg * 4 + (j >> 3); u.kind = seg; u.asel = 0; return true;
    }
    __device__ __forceinline__ void a_ready(const Unit&) const {}
    __device__ __forceinline__ void done(const Unit&) const {}
};

__device__ __forceinline__ u32x4 pack8(f32x4 a, f32x4 b) { u32x4 w; w.x = pg8::cvt_pk_bf16(a[0], a[1]); w.y = pg8::cvt_pk_bf16(a[2], a[3]); w.z = pg8::cvt_pk_bf16(b[0], b[1]); w.w = pg8::cvt_pk_bf16(b[2], b[3]); return w; }
__device__ __forceinline__ f32x4 sig4(f32x4 v) { f32x4 r; r[0] = fsigmoid(v[0]); r[1] = fsigmoid(v[1]); r[2] = fsigmoid(v[2]); r[3] = fsigmoid(v[3]); return r; }
struct EpiProjMK {
    static constexpr bool PERM = true, AFTER_DRAIN = false;
    LB L; const LAS float* tab0; const LAS float* tab1; int rm0;
    __device__ __forceinline__ bool keep(const Unit&) const { return false; }
    __device__ __forceinline__ void operator()(f32x4 (&acc)[2][2][4][2], const Unit& u, int wr, int wc, int fr, int fq) const {
        const int rbase = u.rm * 256 + wr * 64 + fr, cin = wc * 32 + 8 * fq, rloc = wr * 64 + fr;
        const LAS float* rs = (u.kind == 0 && u.rm == rm0) ? tab0 : tab1; bf16_t* dst; int ld, coff; bool sig = false; const int tile = u.pn;
        if (u.kind == 1) { dst = L.memkv; ld = 1024; coff = (tile - 26) * 256; }
        else if (tile < 2) { dst = L.sq; ld = 512; coff = tile * 256; }
        else if (tile < 3) { dst = L.skv; ld = 256; coff = 0; }
        else if (tile < 7) { dst = L.mqk; ld = 1024; coff = (tile - 3) * 256; }
        else if (tile < 9) { dst = L.mv; ld = 512; coff = (tile - 7) * 256; }
        else if (tile < 11) { dst = L.mo; ld = 512; coff = (tile - 9) * 256; sig = true; }
        else if (tile < 13) { dst = L.xq; ld = 512; coff = (tile - 11) * 256; }
        else { dst = nullptr; ld = 0; coff = 0; }
#pragma unroll
        for (int ai = 0; ai < 2; ++ai)
#pragma unroll
            for (int m = 0; m < 4; ++m) {
                const int row = rbase + ai * 128 + m * 16; const float rstd = rs[rloc + ai * 128 + m * 16];
#pragma unroll
                for (int bj = 0; bj < 2; ++bj) {
                    f32x4 v0 = acc[ai][bj][m][0] * rstd, v1 = acc[ai][bj][m][1] * rstd;
                    if (dst) { if (sig) { v0 = sig4(v0); v1 = sig4(v1); }
                        *(u32x4*)(dst + (size_t)row * ld + coff + bj * 128 + cin) = pack8(v0, v1); }
                    else if (tile < 25) {
                        v0 = sig4(v0) * 256.f; v1 = sig4(v1) * 256.f; uint2 w;
                        w.x = (unsigned)fminf(v0[0], 255.f) | ((unsigned)fminf(v0[1], 255.f) << 8) | ((unsigned)fminf(v0[2], 255.f) << 16) | ((unsigned)fminf(v0[3], 255.f) << 24);
                        w.y = (unsigned)fminf(v1[0], 255.f) | ((unsigned)fminf(v1[1], 255.f) << 8) | ((unsigned)fminf(v1[2], 255.f) << 16) | ((unsigned)fminf(v1[3], 255.f) << 24);
                        *(uint2*)(L.gates + (size_t)row * 3072 + (tile - 13) * 256 + bj * 128 + cin) = w; }
                    else if (bj == 0 && cin < 16) { *(f32x4*)(L.iff + (size_t)row * 16 + cin) = v0; *(f32x4*)(L.iff + (size_t)row * 16 + cin + 4) = v1; }
                }
            }
    }
};
struct EpiMergedMK {
    static constexpr bool PERM = true, AFTER_DRAIN = false;
    const unsigned char* gates; bf16_t* merged;
    __device__ __forceinline__ bool keep(const Unit& u) const { return u.kind < 2; }
    __device__ __forceinline__ static void deq8(uint2 w, float (&g)[8]) {
        g[0] = (float)(w.x & 255u) + 0.5f; g[1] = (float)((w.x >> 8) & 255u) + 0.5f; g[2] = (float)((w.x >> 16) & 255u) + 0.5f; g[3] = (float)(w.x >> 24) + 0.5f;
        g[4] = (float)(w.y & 255u) + 0.5f; g[5] = (float)((w.y >> 8) & 255u) + 0.5f; g[6] = (float)((w.y >> 16) & 255u) + 0.5f; g[7] = (float)(w.y >> 24) + 0.5f; }
    __device__ __forceinline__ void operator()(f32x4 (&acc)[2][2][4][2], const Unit& u, int wr, int wc, int fr, int fq) const {
        const int rbase = u.rm * 256 + wr * 64 + fr, col0 = (u.pn & 3) * 256 + wc * 32 + 8 * fq, seg = u.kind;
#pragma unroll
        for (int ai = 0; ai < 2; ++ai) {
            uint2 gs[4][2], gn[4][2];
#pragma unroll
            for (int m = 0; m < 4; ++m)
#pragma unroll
                for (int bj = 0; bj < 2; ++bj) { const unsigned char* gp = gates + (size_t)(rbase + ai * 128 + m * 16) * 3072 + seg * 1024 + col0 + bj * 128;
                    gs[m][bj] = *(const uint2*)gp; gn[m][bj] = seg < 2 ? *(const uint2*)(gp + 1024) : make_uint2(0u, 0u); }
#pragma unroll
            for (int m = 0; m < 4; ++m) {
                const int row = rbase + ai * 128 + m * 16;
#pragma unroll
                for (int bj = 0; bj < 2; ++bj) {
                    const int col = col0 + bj * 128;
                    float g[8]; deq8(gs[m][bj], g);
                    if (seg < 2) { float gd[8]; deq8(gn[m][bj], gd);
#pragma unroll
                        for (int j = 0; j < 8; ++j) g[j] = g[j] * __builtin_amdgcn_rcpf(gd[j]); }
                    else {
#pragma unroll
                        for (int j = 0; j < 8; ++j) g[j] *= (1.f / 256.f); }
                    f32x4 v0 = acc[ai][bj][m][0], v1 = acc[ai][bj][m][1];
                    v0[0] *= g[0]; v0[1] *= g[1]; v0[2] *= g[2]; v0[3] *= g[3]; v1[0] *= g[4]; v1[1] *= g[5]; v1[2] *= g[6]; v1[3] *= g[7];
                    acc[ai][bj][m][0] = v0; acc[ai][bj][m][1] = v1;
                    if (seg == 2) *(u32x4*)(merged + (size_t)row * D + col) = pack8(v0, v1);
                }
            }
            asm volatile("" ::: "memory");
        }
    }
};
struct EpiResidMK {
    static constexpr bool PERM = true, AFTER_DRAIN = false;
    const bf16_t* xold; bf16_t* xnew; float* rowss;
    __device__ __forceinline__ bool keep(const Unit&) const { return false; }
    __device__ __forceinline__ void operator()(f32x4 (&acc)[2][2][4][2], const Unit& u, int wr, int wc, int fr, int fq) const {
        const int rbase = u.rm * 256 + wr * 64 + fr, col0 = u.pn * 256 + wc * 32 + 8 * fq;
#pragma unroll
        for (int ai = 0; ai < 2; ++ai) {
            uint4 xo[4][2];
#pragma unroll
            for (int m = 0; m < 4; ++m)
#pragma unroll
                for (int bj = 0; bj < 2; ++bj) xo[m][bj] = *(const uint4*)(xold + (size_t)(rbase + ai * 128 + m * 16) * D + col0 + bj * 128);
#pragma unroll
            for (int m = 0; m < 4; ++m) {
                const int row = rbase + ai * 128 + m * 16; const size_t off = (size_t)row * D + col0; float ss = 0.f;
#pragma unroll
                for (int bj = 0; bj < 2; ++bj) {
                    float o[8]; unpack8(xo[m][bj], o);
                    f32x4 v0 = acc[ai][bj][m][0], v1 = acc[ai][bj][m][1];
                    v0[0] += o[0]; v0[1] += o[1]; v0[2] += o[2]; v0[3] += o[3]; v1[0] += o[4]; v1[1] += o[5]; v1[2] += o[6]; v1[3] += o[7];
                    const u32x4 w = pack8(v0, v1); *(u32x4*)(xnew + off + bj * 128) = w;
                    float r[8]; unpack8(__builtin_bit_cast(uint4, w), r);
#pragma unroll
                    for (int j = 0; j < 8; ++j) ss = fmaf(r[j], r[j], ss);
                }
                ss += __shfl_xor(ss, 16); ss += __shfl_xor(ss, 32);
                if (fq == 0) rowss[(size_t)row * 16 + (u.pn & 3) * 4 + wc] = ss;
            }
            asm volatile("" ::: "memory");
        }
    }
};
struct EpiFF1MK {
    static constexpr bool PERM = true, AFTER_DRAIN = false;
    bf16_t* h; const LAS float* tab0;
    __device__ __forceinline__ bool keep(const Unit&) const { return false; }
    __device__ __forceinline__ void operator()(f32x4 (&acc)[2][2][4][2], const Unit& u, int wr, int wc, int fr, int fq) const {
        const int rbase = u.rm * 256 + wr * 64 + fr, col0 = u.pn * 256 + wc * 32 + 8 * fq, rloc = wr * 64 + fr;
#pragma unroll
        for (int ai = 0; ai < 2; ++ai)
#pragma unroll
            for (int m = 0; m < 4; ++m) {
                const int row = rbase + ai * 128 + m * 16; const float rstd = tab0[rloc + ai * 128 + m * 16];
#pragma unroll
                for (int bj = 0; bj < 2; ++bj) {
                    f32x4 v0 = acc[ai][bj][m][0] * rstd, v1 = acc[ai][bj][m][1] * rstd;
#pragma unroll
                    for (int j = 0; j < 4; ++j) { v0[j] = fmaxf(v0[j], 0.f); v0[j] *= v0[j]; v1[j] = fmaxf(v1[j], 0.f); v1[j] *= v1[j]; }
                    *(u32x4*)(h + (size_t)row * DFF + col0 + bj * 128) = pack8(v0, v1);
                }
            }
    }
};

__device__ __forceinline__ void convert_tile_w(const float* src, int ldsrc, int col0, int ncols, int k0, const float* gain, float scale, bf16_t* dst, int K, float* tile, int lane) {
    const int n4 = (lane & 15) * 4;
    f32x4 v[16];
#pragma unroll
    for (int i = 0; i < 16; ++i) { const int kk = (lane >> 4) + 4 * i; v[i] = n4 < ncols ? *(const f32x4*)(src + (size_t)(k0 + kk) * ldsrc + col0 + n4) : (f32x4){0.f, 0.f, 0.f, 0.f}; }
#pragma unroll
    for (int i = 0; i < 16; ++i) { const int kk = (lane >> 4) + 4 * i; const f32x4 w = v[i] * ((gain ? gain[k0 + kk] : 1.f) * scale);
        tile[kk * 65 + n4] = w[0]; tile[kk * 65 + n4 + 1] = w[1]; tile[kk * 65 + n4 + 2] = w[2]; tile[kk * 65 + n4 + 3] = w[3]; }
    asm volatile("s_waitcnt lgkmcnt(0)" ::: "memory");
    const int kc = lane & 7;
#pragma unroll
    for (int i = 0; i < 8; ++i) { const int n = (lane >> 3) + 8 * i; const float* tp = tile + (8 * kc) * 65 + n;
        u32x4 w; w.x = pk2(tp[0], tp[65]); w.y = pk2(tp[130], tp[195]); w.z = pk2(tp[260], tp[325]); w.w = pk2(tp[390], tp[455]);
        if (n < ncols) *(u32x4*)(dst + (size_t)n * K + k0 + 8 * kc) = w; }
    asm volatile("s_waitcnt lgkmcnt(0)" ::: "memory");
}
constexpr int CV_ITEMS_LAYER = 4560;
__device__ __forceinline__ void convert_item(const P& p, int item, float* tile, int lane) {
    const int l = item / CV_ITEMS_LAYER; int r = item % CV_ITEMS_LAYER;
    unsigned char* wt = p.ws + WS_WT + (size_t)l * WT_LAYER;
    const float* src; const float* gain = nullptr; int ld, col0, ncols, K; float sc = 1.f; bf16_t* dst;
    if (r < 1616) {
        const float* win = p.w_in + (size_t)l * D * INC; src = win; ld = INC; K = D; gain = p.g_mix + l * D; int dr;
        if (r < 128) { col0 = 0; ncols = 512; dr = 0; sc = 0.125f; }
        else if ((r -= 128) < 448) { col0 = 512; ncols = 1792; dr = 512; }
        else if ((r -= 448) < 128) { col0 = 2320; ncols = 512; dr = 2304; }
        else if ((r -= 128) < 128) { col0 = 2832; ncols = 512; dr = 2816; sc = 0.08838834764831845f; }
        else if ((r -= 128) < 768) { col0 = 3344; ncols = 3072; dr = 3328; }
        else { r -= 768; col0 = 2304; ncols = 16; dr = 6400; }
        dst = (bf16_t*)(wt + WT_WIN) + (size_t)dr * D;
    } else if ((r -= 1616) < 256) { src = p.w_mem_kv + (size_t)l * D * 1024; ld = 1024; col0 = 0; ncols = 1024; K = D; gain = p.g_mem + l * D; dst = (bf16_t*)(wt + WT_WMEM); }
    else if ((r -= 256) < 384) { const int sg = r / 128; r -= sg * 128; src = (sg == 0 ? p.w_br0 : sg == 1 ? p.w_br1 : p.w_br2) + (size_t)l * 512 * 1024; ld = 1024; col0 = 0; ncols = 1024; K = 512; dst = (bf16_t*)(wt + WT_WBR) + (size_t)sg * 1024 * 512; }
    else if ((r -= 384) < 256) { src = p.w_out + (size_t)l * D * D; ld = 1024; col0 = 0; ncols = 1024; K = D; dst = (bf16_t*)(wt + WT_WOUT); }
    else if ((r -= 256) < 1024) { src = p.w_ff1 + (size_t)l * D * DFF; ld = DFF; col0 = 0; ncols = DFF; K = D; gain = p.g_ffn + l * D; dst = (bf16_t*)(wt + WT_FF1); }
    else { r -= 1024; src = p.w_ff2 + (size_t)l * DFF * D; ld = D; col0 = 0; ncols = D; K = DFF; dst = (bf16_t*)(wt + WT_FF2); }
    const int nnb = (ncols + 63) / 64, kb = r / nnb, nb = r % nnb, c0 = nb * 64, nc = (ncols - c0) < 64 ? (ncols - c0) : 64;
    convert_tile_w(src, ld, col0 + c0, nc, kb * 64, gain, sc, dst + (size_t)c0 * K, K, tile, lane);
}
__device__ __forceinline__ void rowstat_rows(const float* src, int rows, bf16_t* xb, float* rowss, int gw, int ngw, int lane) {
    for (int r = gw; r < rows; r += 2 * ngw) {
        const int r1 = r + ngw; const bool two = r1 < rows;
        const float4* s0 = (const float4*)(src + (size_t)r * D); const float4* s1 = (const float4*)(src + (size_t)(two ? r1 : r) * D);
        float4 a[4], b[4];
#pragma unroll
        for (int j = 0; j < 4; ++j) { a[j] = s0[lane + 64 * j]; b[j] = s1[lane + 64 * j]; }
        float ssa = 0.f, ssb = 0.f;
#pragma unroll
        for (int j = 0; j < 4; ++j) { ssa += a[j].x * a[j].x + a[j].y * a[j].y + a[j].z * a[j].z + a[j].w * a[j].w; ssb += b[j].x * b[j].x + b[j].y * b[j].y + b[j].z * b[j].z + b[j].w * b[j].w;
            uint2 o; o.x = pk2(a[j].x, a[j].y); o.y = pk2(a[j].z, a[j].w); *(uint2*)(xb + (size_t)r * D + 4 * (lane + 64 * j)) = o;
            if (two) { uint2 o1; o1.x = pk2(b[j].x, b[j].y); o1.y = pk2(b[j].z, b[j].w); *(uint2*)(xb + (size_t)r1 * D + 4 * (lane + 64 * j)) = o1; } }
        ssa = wave_sum(ssa); ssb = wave_sum(ssb);
        if (lane < 16) { rowss[(size_t)r * 16 + lane] = lane == 0 ? ssa : 0.f; if (two) rowss[(size_t)r1 * 16 + lane] = lane == 0 ? ssb : 0.f; }
    }
}
__device__ __forceinline__ void finalnorm_rows(const bf16_t* xb, float* out, const float* rowss, const float* g, int gw, int ngw, int lane) {
    for (int r = gw; r < M; r += ngw) {
        const float rstd = rstd_of(rowss, r);
#pragma unroll
        for (int j = 0; j < 2; ++j) { float x[8]; unpack8(*(const uint4*)(xb + (size_t)r * D + 8 * (lane + 64 * j)), x);
            const float4 g0 = *(const float4*)(g + 8 * (lane + 64 * j)), g1 = *(const float4*)(g + 8 * (lane + 64 * j) + 4);
            float4 o0, o1; o0.x = x[0] * rstd * g0.x; o0.y = x[1] * rstd * g0.y; o0.z = x[2] * rstd * g0.z; o0.w = x[3] * rstd * g0.w;
            o1.x = x[4] * rstd * g1.x; o1.y = x[5] * rstd * g1.y; o1.z = x[6] * rstd * g1.z; o1.w = x[7] * rstd * g1.w;
            *(float4*)(out + (size_t)r * D + 8 * (lane + 64 * j)) = o0; *(float4*)(out + (size_t)r * D + 8 * (lane + 64 * j) + 4) = o1; }
    }
}

typedef short bf16x8 __attribute__((ext_vector_type(8)));
typedef short s16x4 __attribute__((ext_vector_type(4)));
typedef float f32x16 __attribute__((ext_vector_type(16)));
typedef float f32x2 __attribute__((ext_vector_type(2)));
typedef __bf16 bf16x2v __attribute__((ext_vector_type(2)));
#define MFMA32(a, b, c) __builtin_amdgcn_mfma_f32_32x32x16_bf16((a), (b), (c), 0, 0, 0)
__device__ __forceinline__ int crow(int reg, int h) { return (reg & 3) + 8 * (reg >> 2) + 4 * h; }
__device__ __forceinline__ unsigned pkbf(float a, float b) { return __builtin_bit_cast(unsigned, __builtin_convertvector((f32x2){a, b}, bf16x2v)); }
__device__ __forceinline__ bf16x8 pack_step(const f32x16& x, int s) {
    u32x4 p; p.x = pkbf(x[8 * s], x[8 * s + 1]); p.y = pkbf(x[8 * s + 2], x[8 * s + 3]); p.z = pkbf(x[8 * s + 4], x[8 * s + 5]); p.w = pkbf(x[8 * s + 6], x[8 * s + 7]);
    return __builtin_bit_cast(bf16x8, p);
}
__device__ __forceinline__ bf16x8 tr_frag(const LAS unsigned char* img, int row_lo, int row_hi, int lane) {
    const int i16 = lane & 15, q = i16 >> 2, p = i16 & 3, blk = (lane >> 4) & 1;
    const s16x4 lo = __builtin_amdgcn_ds_read_tr16_b64_v4i16((LAS s16x4*)(img + (row_lo + q) * 64 + 32 * blk + 8 * p));
    const s16x4 hi = __builtin_amdgcn_ds_read_tr16_b64_v4i16((LAS s16x4*)(img + (row_hi + q) * 64 + 32 * blk + 8 * p));
    return __builtin_shufflevector(lo, hi, 0, 1, 2, 3, 4, 5, 6, 7);
}

constexpr int SWA_KIMG = 0, SWA_VIMG = 256 * 144, SWA_TAB = SWA_VIMG + 2 * 16384;
__device__ __forceinline__ void swa_mfma_unit(const P& p, const LB& L, int l, int u, LAS unsigned char* l3) {
    int tid_l = threadIdx.x; asm volatile("" : "+v"(tid_l)); const int tid = tid_l, lane = tid & 63, wave = tid >> 6, h = lane >> 5, ql = lane & 31;
    const int hkv = u & 1, n = (u >> 1) & 15, b = u >> 5;
    __syncthreads();
#pragma unroll
    for (int i = 0; i < 4; ++i) {
        const int c = tid + 512 * i, row = c >> 3, cc = c & 7, t = 128 * (n - 1) + row;
        u32x4 kv = (u32x4){0u, 0u, 0u, 0u}, vv = (u32x4){0u, 0u, 0u, 0u};
        if (t >= 0) { const bf16_t* src = L.skv + (size_t)(b * T + t) * 256 + hkv * 64 + cc * 8; kv = *(const u32x4*)src; vv = *(const u32x4*)(src + 128); }
        *(LAS u32x4*)(l3 + SWA_KIMG + row * 144 + cc * 16) = kv;
        *(LAS u32x4*)(l3 + SWA_VIMG + (cc >> 2) * 16384 + row * 64 + (cc & 3) * 16) = vv;
    }
    for (int idx = tid; idx < 4 * 192; idx += 512) { const int g = idx / 192, e = idx % 192, dist = 159 - e;
        ((LAS float*)(l3 + SWA_TAB))[idx] = (dist >= 0 && dist < 128) ? p.rel_bias[(int)T5_BUCKET[dist] * 8 + hkv * 4 + g] : -1e30f; }
    __syncthreads();
    const int g = wave >> 1, half = wave & 1, hq = hkv * 4 + g;
    const float sink = p.sinks[l * 8 + hq];
    const LAS float* tab = (const LAS float*)(l3 + SWA_TAB) + g * 192 + 31 - ql;
#pragma unroll 1
    for (int sb = 0; sb < 2; ++sb) {
        const int r0 = 64 * half + 32 * sb, kb0 = 2 * half + sb;
        bf16_t* qptr = L.sq + (size_t)(b * T + 128 * n + r0 + ql) * 512 + hq * 64;
        bf16x8 Qf[4];
#pragma unroll
        for (int ks = 0; ks < 4; ++ks) Qf[ks] = *(const bf16x8*)(qptr + 16 * ks + 8 * h);
        f32x16 S[5];
#pragma unroll
        for (int i = 0; i < 5; ++i) {
#pragma unroll
            for (int r = 0; r < 16; ++r) S[i][r] = 0.f;
#pragma unroll
            for (int ks = 0; ks < 4; ++ks) { const bf16x8 Kf = *(const LAS bf16x8*)(l3 + SWA_KIMG + (32 * (kb0 + i) + ql) * 144 + 32 * ks + 16 * h); S[i] = MFMA32(Kf, Qf[ks], S[i]); }
        }
        float m = sink;
#pragma unroll
        for (int i = 0; i < 5; ++i)
#pragma unroll
            for (int r = 0; r < 16; ++r) { const int kk = 32 * i + crow(r, h); float sv = S[i][r] + tab[kk];
                if (n == 0 && 32 * kb0 + kk < 128) sv = -1e30f;
                S[i][r] = sv; m = fmaxf(m, sv); }
        m = fmaxf(m, __shfl_xor(m, 32));
        float lsum = 0.f;
#pragma unroll
        for (int i = 0; i < 5; ++i)
#pragma unroll
            for (int r = 0; r < 16; ++r) { const float pe = __expf(S[i][r] - m); S[i][r] = pe; lsum += pe; }
        lsum += __shfl_xor(lsum, 32);
        f32x16 O[2];
#pragma unroll
        for (int db = 0; db < 2; ++db)
#pragma unroll
            for (int r = 0; r < 16; ++r) O[db][r] = 0.f;
#pragma unroll
        for (int i = 0; i < 5; ++i)
#pragma unroll
            for (int s2 = 0; s2 < 2; ++s2) { const bf16x8 Pf = pack_step(S[i], s2); const int k0 = 32 * (kb0 + i) + 16 * s2;
#pragma unroll
                for (int db = 0; db < 2; ++db) { const bf16x8 Vf = tr_frag(l3 + SWA_VIMG + db * 16384, k0 + 4 * h, k0 + 8 + 4 * h, lane); O[db] = MFMA32(Vf, Pf, O[db]); } }
        const float inv = 1.f / (lsum + __expf(sink - m));
#pragma unroll
        for (int db = 0; db < 2; ++db)
#pragma unroll
            for (int gq = 0; gq < 4; ++gq) { uint2 w; w.x = pkbf(O[db][4 * gq] * inv, O[db][4 * gq + 1] * inv); w.y = pkbf(O[db][4 * gq + 2] * inv, O[db][4 * gq + 3] * inv);
                *(uint2*)(qptr + 32 * db + 8 * gq + 4 * h) = w; }
    }
}

constexpr int XA_KIMG = 0, XA_VIMG = 256 * 272;
__device__ __forceinline__ void xattn_mfma_unit(const LB& L, int u, LAS unsigned char* l3) {
    int tid_l = threadIdx.x; asm volatile("" : "+v"(tid_l)); const int tid = tid_l, lane = tid & 63, wave = tid >> 6, h = lane >> 5, ql = lane & 31;
    const int qb = u & 7, hx = (u >> 3) & 3, b = u >> 5;
    __syncthreads();
#pragma unroll
    for (int i = 0; i < 8; ++i) {
        const int c = tid + 512 * i, row = c >> 4, cc = c & 15;
        const bf16_t* src = L.memkv + (size_t)(b * MEMLEN + row) * 1024 + hx * 128 + cc * 8;
        const u32x4 kv = *(const u32x4*)src, vv = *(const u32x4*)(src + 512);
        *(LAS u32x4*)(l3 + XA_KIMG + row * 272 + cc * 16) = kv;
        *(LAS u32x4*)(l3 + XA_VIMG + (cc >> 2) * 16384 + row * 64 + (cc & 3) * 16) = vv;
    }
    bf16_t* qptr = L.xq + (size_t)(b * T + qb * 256 + wave * 32 + ql) * 512 + hx * 128;
    bf16x8 Qf[8];
#pragma unroll
    for (int ks = 0; ks < 8; ++ks) Qf[ks] = *(const bf16x8*)(qptr + 16 * ks + 8 * h);
    __syncthreads();
    f32x16 S[8];
    {
#pragma unroll
        for (int i = 0; i < 8; ++i) {
#pragma unroll
            for (int r = 0; r < 16; ++r) S[i][r] = 0.f;
#pragma unroll
            for (int ks = 0; ks < 8; ++ks) { const bf16x8 Kf = *(const LAS bf16x8*)(l3 + XA_KIMG + (32 * i + ql) * 272 + 32 * ks + 16 * h); S[i] = MFMA32(Kf, Qf[ks], S[i]); }
        }
    }
    float m = -1e30f;
#pragma unroll
    for (int i = 0; i < 8; ++i)
#pragma unroll
        for (int r = 0; r < 16; ++r) m = fmaxf(m, S[i][r]);
    m = fmaxf(m, __shfl_xor(m, 32));
    float lsum = 0.f;
#pragma unroll
    for (int i = 0; i < 8; ++i)
#pragma unroll
        for (int r = 0; r < 16; ++r) { const float pe = __expf(S[i][r] - m); S[i][r] = pe; lsum += pe; }
    lsum += __shfl_xor(lsum, 32);
    f32x16 O[4];
#pragma unroll
    for (int db = 0; db < 4; ++db)
#pragma unroll
        for (int r = 0; r < 16; ++r) O[db][r] = 0.f;
#pragma unroll
    for (int i = 0; i < 8; ++i)
#pragma unroll
        for (int s2 = 0; s2 < 2; ++s2) { const bf16x8 Pf = pack_step(S[i], s2); const int k0 = 32 * i + 16 * s2;
#pragma unroll
            for (int db = 0; db < 4; ++db) { const bf16x8 Vf = tr_frag(l3 + XA_VIMG + db * 16384, k0 + 4 * h, k0 + 8 + 4 * h, lane); O[db] = MFMA32(Vf, Pf, O[db]); } }
    const float inv = 1.f / lsum;
#pragma unroll
    for (int db = 0; db < 4; ++db)
#pragma unroll
        for (int gq = 0; gq < 4; ++gq) { uint2 w; w.x = pkbf(O[db][4 * gq] * inv, O[db][4 * gq + 1] * inv); w.y = pkbf(O[db][4 * gq + 2] * inv, O[db][4 * gq + 3] * inv);
            *(uint2*)(qptr + 32 * db + 8 * gq + 4 * h) = w; }
}


__device__ __forceinline__ float log_sigmoid_f(float x) { return x >= 0.f ? -log1pf(expf(-x)) : x - log1pf(expf(x)); }
__device__ __forceinline__ void mlstm_gates_wave(const P& p, const LB& L, int l, int b, int c, int hh, int lane, float& bcum, float& ig) {
    const size_t row = (size_t)b * T + c * 64 + lane;
    ig = L.iff[row * 16 + hh] + p.b_i[l * 8 + hh];
    float v = log_sigmoid_f(L.iff[row * 16 + 8 + hh] + p.b_f[l * 8 + hh]);
#pragma unroll
    for (int o = 1; o < 64; o <<= 1) { const float t = __shfl_up(v, o); if (lane >= o) v += t; }
    bcum = v;
}
constexpr int MA_SLOT = 18368, MA_XK = 0, MA_VIMG = 8704, MA_T0 = 16896;
__device__ __forceinline__ void mlstm_A_mfma_unit(const P& p, const LB& L, int l, int u, LAS unsigned char* l3) {
    int tid_l = threadIdx.x; asm volatile("" : "+v"(tid_l)); const int tid = tid_l, lane = tid & 63, hh = tid >> 6, h = lane >> 5, ql = lane & 31;
    const int c = u & 31, b = u >> 5, uh = u * 8 + hh;
    LAS unsigned char* wl = l3 + hh * MA_SLOT;
    const float* cw = p.conv_w + (size_t)l * 4 * 1024;
    __syncthreads();
    for (int idx = lane; idx < 67 * 8; idx += 64) { const int row = idx >> 3, cc = idx & 7, t = c * 64 - 3 + row; u32x4 v = (u32x4){0u, 0u, 0u, 0u};
        if (t >= 0) v = *(const u32x4*)(L.mqk + (size_t)(b * T + t) * 1024 + 512 + hh * 64 + cc * 8);
        *(LAS u32x4*)(wl + MA_XK + row * 128 + cc * 16) = v; }
#pragma unroll
    for (int i = 0; i < 8; ++i) { const int s = (lane >> 3) + 8 * i, cc = lane & 7;
        const u32x4 v = *(const u32x4*)(L.mv + (size_t)(b * T + c * 64 + s) * 512 + hh * 64 + cc * 8);
        *(LAS u32x4*)(wl + MA_VIMG + (cc >> 2) * 4096 + s * 64 + (cc & 3) * 16) = v; }
    float bcum, ig; mlstm_gates_wave(p, L, l, b, c, hh, lane, bcum, ig);
    const float g = __shfl(bcum, 63), alog = g - bcum + ig, ml = wave_max(alog);
    ((LAS float*)(wl + MA_T0))[lane] = __expf(alog - ml);
    __syncthreads();
    f32x16 acc[2][2];
#pragma unroll
    for (int a = 0; a < 2; ++a)
#pragma unroll
        for (int d = 0; d < 2; ++d)
#pragma unroll
            for (int r = 0; r < 16; ++r) acc[a][d][r] = 0.f;
    float dnacc[2] = {0.f, 0.f};
    float cwr[2][4];
#pragma unroll
    for (int dkb = 0; dkb < 2; ++dkb)
#pragma unroll
        for (int tap = 0; tap < 4; ++tap) cwr[dkb][tap] = cw[tap * 1024 + 512 + hh * 64 + 32 * dkb + ql];
#pragma unroll
    for (int ks = 0; ks < 4; ++ks) {
        const int s0 = 16 * ks + 8 * h;
        const f32x4 we0 = *(const LAS f32x4*)(wl + MA_T0 + s0 * 4), we1 = *(const LAS f32x4*)(wl + MA_T0 + s0 * 4 + 16);
        const float we[8] = {we0[0], we0[1], we0[2], we0[3], we1[0], we1[1], we1[2], we1[3]};
        bf16x8 WKf[2];
#pragma unroll
        for (int dkb = 0; dkb < 2; ++dkb) {
            float x[11];
#pragma unroll
            for (int r = 0; r < 11; ++r) x[r] = bf2f(*(const LAS unsigned short*)(wl + MA_XK + (s0 + r) * 128 + (32 * dkb + ql) * 2));
            float wk[8];
#pragma unroll
            for (int j = 0; j < 8; ++j) { const float cv = fmaf(cwr[dkb][3], x[j + 3], fmaf(cwr[dkb][2], x[j + 2], fmaf(cwr[dkb][1], x[j + 1], cwr[dkb][0] * x[j])));
                wk[j] = cv * 0.125f * __builtin_amdgcn_rcpf(1.f + __expf(-cv)) * we[j]; dnacc[dkb] += wk[j]; }
            u32x4 w; w.x = pkbf(wk[0], wk[1]); w.y = pkbf(wk[2], wk[3]); w.z = pkbf(wk[4], wk[5]); w.w = pkbf(wk[6], wk[7]);
            WKf[dkb] = __builtin_bit_cast(bf16x8, w);
        }
#pragma unroll
        for (int dvb = 0; dvb < 2; ++dvb) { const bf16x8 Vf = tr_frag(wl + MA_VIMG + dvb * 4096, s0, s0 + 4, lane);
#pragma unroll
            for (int dkb = 0; dkb < 2; ++dkb) acc[dkb][dvb] = MFMA32(WKf[dkb], Vf, acc[dkb][dvb]); }
    }
    bf16_t* st = L.state + (size_t)uh * 4096;
#pragma unroll
    for (int dkb = 0; dkb < 2; ++dkb)
#pragma unroll
        for (int dvb = 0; dvb < 2; ++dvb)
#pragma unroll
            for (int gq = 0; gq < 4; ++gq) { uint2 w; w.x = pkbf(acc[dkb][dvb][4 * gq], acc[dkb][dvb][4 * gq + 1]); w.y = pkbf(acc[dkb][dvb][4 * gq + 2], acc[dkb][dvb][4 * gq + 3]);
                *(uint2*)(st + (32 * dvb + ql) * 64 + 32 * dkb + 8 * gq + 4 * h) = w; }
#pragma unroll
    for (int dkb = 0; dkb < 2; ++dkb) { const float t = dnacc[dkb] + __shfl_xor(dnacc[dkb], 32); if (h == 0) ws_f(p.ws, WS_DN)[(size_t)uh * 64 + 32 * dkb + ql] = t; }
    if (lane == 0) { ws_f(p.ws, WS_G)[uh] = g; ws_f(p.ws, WS_ML)[uh] = ml; }
}
__device__ __forceinline__ void mlstm_scan2_unit(const P& p, const LB& L, int u) {
    int tid_l = threadIdx.x; asm volatile("" : "+v"(tid_l)); const int tid = tid_l, bh = u >> 2, b = bh >> 3, hh = bh & 7, e = (u & 3) * 1024 + 2 * tid;
    const bool first = (u & 3) == 0; const bool do_n = first && tid < 64;
    float *G = ws_f(p.ws, WS_G), *ML = ws_f(p.ws, WS_ML), *MIN = ws_f(p.ws, WS_MIN), *DN = ws_f(p.ws, WS_DN);
    unsigned d[NCH]; float dn[NCH];
#pragma unroll
    for (int c = 0; c < NCH; ++c) { const int idx = (b * NCH + c) * 8 + hh; d[c] = *(const unsigned*)(L.state + (size_t)idx * 4096 + e); dn[c] = do_n ? DN[(size_t)idx * 64 + tid] : 0.f; }
    float m = 0.f, n = 0.f, C0 = 0.f, C1 = 0.f;
#pragma unroll
    for (int c = 0; c < NCH; ++c) { const int idx = (b * NCH + c) * 8 + hh; const float g = G[idx], ml = ML[idx], mn = fmaxf(g + m, ml), a = __expf(g + m - mn), sc = __expf(ml - mn);
        *(unsigned*)(L.state + (size_t)idx * 4096 + e) = pkbf(C0, C1);
        C0 = fmaf(C0, a, sc * __uint_as_float(d[c] << 16)); C1 = fmaf(C1, a, sc * __uint_as_float(d[c] & 0xffff0000u));
        if (do_n) { DN[(size_t)idx * 64 + tid] = n; n = a * n + sc * dn[c]; }
        if (first && tid == 0) MIN[idx] = m;
        m = mn; }
}
constexpr int MC_SLOT = 31232, MC_XQ = 0, MC_XK = 9728, MC_VIMG = 19456, MC_CW = 27648, MC_T0 = 29696, MC_T1 = 29952, MC_T2 = 30208, MC_T3 = 30464, MC_T4 = 30720  , MC_T5 = 30976  ;
__device__ __forceinline__ bf16x8 conv_frag_lds(const LAS unsigned char* img, int tok, int ch0, const LAS float* cwl, float scale) {
    float a[8] = {0.f, 0.f, 0.f, 0.f, 0.f, 0.f, 0.f, 0.f};
#pragma unroll
    for (int tap = 0; tap < 4; ++tap) {
        float xf[8]; unpack8(__builtin_bit_cast(uint4, *(const LAS u32x4*)(img + (tok + tap) * 144 + ch0 * 2)), xf);
        const f32x4 w0 = *(const LAS f32x4*)(cwl + tap * 128 + ch0), w1 = *(const LAS f32x4*)(cwl + tap * 128 + ch0 + 4);
        a[0] = fmaf(w0[0], xf[0], a[0]); a[1] = fmaf(w0[1], xf[1], a[1]); a[2] = fmaf(w0[2], xf[2], a[2]); a[3] = fmaf(w0[3], xf[3], a[3]);
        a[4] = fmaf(w1[0], xf[4], a[4]); a[5] = fmaf(w1[1], xf[5], a[5]); a[6] = fmaf(w1[2], xf[6], a[6]); a[7] = fmaf(w1[3], xf[7], a[7]);
    }
#pragma unroll
    for (int j = 0; j < 8; ++j) a[j] = a[j] * scale * __builtin_amdgcn_rcpf(1.f + __expf(-a[j]));
    u32x4 w; w.x = pkbf(a[0], a[1]); w.y = pkbf(a[2], a[3]); w.z = pkbf(a[4], a[5]); w.w = pkbf(a[6], a[7]);
    return __builtin_bit_cast(bf16x8, w);
}
template <int TB>
__device__ __forceinline__ void mlstm_C_block(const LB& L, int b, int c, int hh, int lane, int h, int ql, LAS unsigned char* wl, const bf16x8 (&Cf)[2][4], const uint2 (&mo)[2][4]) {
    const LAS float* cwl = (const LAS float*)(wl + MC_CW);
    bf16x8 Qf[4]; float qn = 0.f;
#pragma unroll
    for (int ks = 0; ks < 4; ++ks) { const int ch0 = 16 * ks + 8 * h;
        Qf[ks] = conv_frag_lds(wl + MC_XQ, 32 * TB + ql, ch0, cwl, 1.f);
        const f32x4 n0 = *(const LAS f32x4*)(wl + MC_T4 + ch0 * 4), n1 = *(const LAS f32x4*)(wl + MC_T4 + ch0 * 4 + 16);
        float qv[8]; unpack8(__builtin_bit_cast(uint4, Qf[ks]), qv);
#pragma unroll
        for (int j = 0; j < 4; ++j) { qn = fmaf(qv[j], n0[j], qn); qn = fmaf(qv[j + 4], n1[j], qn); } }
    f32x16 S0, S1;
#pragma unroll
    for (int r = 0; r < 16; ++r) { S0[r] = 0.f; S1[r] = 0.f; }
#pragma unroll
    for (int ks = 0; ks < 4; ++ks) { const int ch0 = 16 * ks + 8 * h;
        S0 = MFMA32(conv_frag_lds(wl + MC_XK, ql, ch0, cwl + 64, 0.125f), Qf[ks], S0);
        if (TB == 1) S1 = MFMA32(conv_frag_lds(wl + MC_XK, 32 + ql, ch0, cwl + 64, 0.125f), Qf[ks], S1); }
    const float Mt = ((const LAS float*)(wl + MC_T1))[32 * TB + ql];
    float dsum = 0.f;
#pragma unroll
    for (int gq = 0; gq < 4; ++gq) {
        const f32x4 a0 = *(const LAS f32x4*)(wl + MC_T0 + (8 * gq + 4 * h) * 4), a1 = *(const LAS f32x4*)(wl + MC_T0 + (32 + 8 * gq + 4 * h) * 4);
#pragma unroll
        for (int j = 0; j < 4; ++j) { const int r = 4 * gq + j, sl = 8 * gq + 4 * h + j;
            if (TB == 0) { const float v = sl <= ql ? S0[r] * __expf(a0[j] - Mt) : 0.f; S0[r] = v; dsum += v; }
            else { const float v0 = S0[r] * __expf(a0[j] - Mt); S0[r] = v0; const float v1 = sl <= ql ? S1[r] * __expf(a1[j] - Mt) : 0.f; S1[r] = v1; dsum += v0 + v1; } }
    }
    f32x16 acc[2];
#pragma unroll
    for (int d = 0; d < 2; ++d)
#pragma unroll
        for (int r = 0; r < 16; ++r) acc[d][r] = 0.f;
#pragma unroll
    for (int ks = 0; ks < 4; ++ks)
#pragma unroll
        for (int dvb = 0; dvb < 2; ++dvb) acc[dvb] = MFMA32(Cf[dvb][ks], Qf[ks], acc[dvb]);
    const float iw = ((const LAS float*)(wl + MC_T2))[32 * TB + ql];
#pragma unroll
    for (int dvb = 0; dvb < 2; ++dvb)
#pragma unroll
        for (int r = 0; r < 16; ++r) acc[dvb][r] *= iw;
#pragma unroll
    for (int s2 = 0; s2 < 2; ++s2) {
        const bf16x8 P0 = pack_step(S0, s2), P1 = pack_step(S1, s2);
#pragma unroll
        for (int dvb = 0; dvb < 2; ++dvb) {
            acc[dvb] = MFMA32(tr_frag(wl + MC_VIMG + dvb * 4096, 16 * s2 + 4 * h, 16 * s2 + 8 + 4 * h, lane), P0, acc[dvb]);
            if (TB == 1) acc[dvb] = MFMA32(tr_frag(wl + MC_VIMG + dvb * 4096, 32 + 16 * s2 + 4 * h, 32 + 16 * s2 + 8 + 4 * h, lane), P1, acc[dvb]); }
    }
    dsum += __shfl_xor(dsum, 32); qn += __shfl_xor(qn, 32);
    const float den = dsum + iw * qn, mt = ((const LAS float*)(wl + MC_T3))[32 * TB + ql];
    const float sc = 1.f / fmaxf(fabsf(den), __expf(-mt));
    float sum = 0.f;
#pragma unroll
    for (int dvb = 0; dvb < 2; ++dvb)
#pragma unroll
        for (int r = 0; r < 16; ++r) { const float v = acc[dvb][r] * sc; acc[dvb][r] = v; sum += v; }
    sum += __shfl_xor(sum, 32); const float mu = sum * (1.f / 64.f);
    float var = 0.f;
#pragma unroll
    for (int dvb = 0; dvb < 2; ++dvb)
#pragma unroll
        for (int r = 0; r < 16; ++r) { const float dlt = acc[dvb][r] - mu; var += dlt * dlt; }
    var += __shfl_xor(var, 32); const float rstd = rsqrtf(var * (1.f / 64.f) + EPS);
    bf16_t* op = L.mo + (size_t)(b * T + c * 64 + 32 * TB + ql) * 512 + hh * 64;
#pragma unroll
    for (int dvb = 0; dvb < 2; ++dvb)
#pragma unroll
        for (int gq = 0; gq < 4; ++gq) { const int dv = 32 * dvb + 8 * gq + 4 * h; const f32x4 ng = *(const LAS f32x4*)(wl + MC_T5 + dv * 4);
            const uint2 mg = mo[dvb][gq];
            const float y0 = (acc[dvb][4 * gq] - mu) * rstd * ng[0] * __uint_as_float(mg.x << 16), y1 = (acc[dvb][4 * gq + 1] - mu) * rstd * ng[1] * __uint_as_float(mg.x & 0xffff0000u);
            const float y2 = (acc[dvb][4 * gq + 2] - mu) * rstd * ng[2] * __uint_as_float(mg.y << 16), y3 = (acc[dvb][4 * gq + 3] - mu) * rstd * ng[3] * __uint_as_float(mg.y & 0xffff0000u);
            uint2 w; w.x = pkbf(y0, y1); w.y = pkbf(y2, y3); *(uint2*)(op + dv) = w; }
}
__device__ __forceinline__ void mlstm_C_mfma_unit(const P& p, const LB& L, int l, int u, LAS unsigned char* l3) {
    int tid_l = threadIdx.x; asm volatile("" : "+v"(tid_l)); const int tid = tid_l, lane = tid & 63, wave = tid >> 6, h = lane >> 5, ql = lane & 31;
    const int hg = u & 1, c = (u >> 1) & 31, b = u >> 6, hh = 4 * hg + (wave >> 1), tb = wave & 1, uh = (b * 32 + c) * 8 + hh, l128 = tid & 127;
    LAS unsigned char* wl = l3 + (wave >> 1) * MC_SLOT;
    const float* cw = p.conv_w + (size_t)l * 4 * 1024;
    bf16x8 Cf[2][4]; uint2 mo[2][4];
    {
        const bf16_t* st = L.state + (size_t)uh * 4096; const bf16_t* op = L.mo + (size_t)(b * T + c * 64 + 32 * tb + ql) * 512 + hh * 64;
#pragma unroll
        for (int dvb = 0; dvb < 2; ++dvb) {
#pragma unroll
            for (int ks = 0; ks < 4; ++ks) Cf[dvb][ks] = *(const bf16x8*)(st + (32 * dvb + ql) * 64 + 16 * ks + 8 * h);
#pragma unroll
            for (int gq = 0; gq < 4; ++gq) mo[dvb][gq] = *(const uint2*)(op + 32 * dvb + 8 * gq + 4 * h);
        }
    }
    __syncthreads();
    for (int idx = l128; idx < 67 * 8; idx += 128) { const int row = idx >> 3, cc = idx & 7, t = c * 64 - 3 + row; u32x4 vq = (u32x4){0u, 0u, 0u, 0u}, vk = vq;
        if (t >= 0) { const bf16_t* src = L.mqk + (size_t)(b * T + t) * 1024 + hh * 64 + cc * 8; vq = *(const u32x4*)src; vk = *(const u32x4*)(src + 512); }
        *(LAS u32x4*)(wl + MC_XQ + row * 144 + cc * 16) = vq; *(LAS u32x4*)(wl + MC_XK + row * 144 + cc * 16) = vk; }
#pragma unroll
    for (int i = 0; i < 4; ++i) { const int s = (l128 >> 3) + 16 * i, cc = l128 & 7;
        const u32x4 v = *(const u32x4*)(L.mv + (size_t)(b * T + c * 64 + s) * 512 + hh * 64 + cc * 8);
        *(LAS u32x4*)(wl + MC_VIMG + (cc >> 2) * 4096 + s * 64 + (cc & 3) * 16) = v; }
#pragma unroll
    for (int i = 0; i < 4; ++i) { const int e = l128 + 128 * i, tap = e >> 7, wch = e & 127;
        ((LAS float*)(wl + MC_CW))[e] = cw[tap * 1024 + (wch >> 6) * 512 + hh * 64 + (wch & 63)]; }
    {
        float bcum, ig; mlstm_gates_wave(p, L, l, b, c, hh, lane, bcum, ig);
        const float a = ig - bcum; float v = a;
#pragma unroll
        for (int o = 1; o < 64; o <<= 1) { const float t = __shfl_up(v, o); if (lane >= o) v = fmaxf(v, t); }
        const float m_in = ws_f(p.ws, WS_MIN)[uh], Mt = fmaxf(v, m_in);
        if (tb == 1) { ((LAS float*)(wl + MC_T4))[lane] = ws_f(p.ws, WS_DN)[(size_t)uh * 64 + lane]; ((LAS float*)(wl + MC_T5))[lane] = p.norm_g[l * 512 + hh * 64 + lane]; }
        if (tb == 0) { ((LAS float*)(wl + MC_T0))[lane] = a; ((LAS float*)(wl + MC_T1))[lane] = Mt; ((LAS float*)(wl + MC_T2))[lane] = __expf(m_in - Mt); ((LAS float*)(wl + MC_T3))[lane] = bcum + Mt; }
    }
    __syncthreads();
    if (tb == 0) mlstm_C_block<0>(L, b, c, hh, lane, h, ql, wl, Cf, mo);
    else mlstm_C_block<1>(L, b, c, hh, lane, h, ql, wl, Cf, mo);
}

#define XB_TMO      128
#define XB_XCNT(j)  (256  + 64 * (j))
#define XB_XSUB(j)  (1280 + 64 * (j))
#define XB_XGEN(j)  (2304 + 64 * (j))
#define XB_TOP      3328
#define XB_TOPGEN   3392
#define XCD_BAR_WORDS 3456
#define XB_SPIN_CAP (1u << 18)

__device__ __forceinline__ unsigned xb_ld(unsigned* p)              { return __hip_atomic_load(p, __ATOMIC_RELAXED, __HIP_MEMORY_SCOPE_AGENT); }
__device__ __forceinline__ unsigned xb_add(unsigned* p, unsigned v) { return __hip_atomic_fetch_add(p, v, __ATOMIC_RELAXED, __HIP_MEMORY_SCOPE_AGENT); }
__device__ __forceinline__ unsigned xb_xcc_id() { return (unsigned)__builtin_amdgcn_s_getreg((3 << 11) | 20) & 0xFu; }
#define XB_SPIN(cond, bar) do { unsigned _sp = 0; while (cond) { __builtin_amdgcn_s_sleep(1); \
    if ((++_sp & 255u) == 0u) { if (xb_ld(&(bar)[XB_TMO])) break; if (_sp > XB_SPIN_CAP) { atomicAdd(&(bar)[XB_TMO], 1u); break; } } } } while (0)

struct XcdBarrier {
    unsigned* bar; unsigned x;
    volatile LAS unsigned* st;
};

__device__ __forceinline__ XcdBarrier xcd_barrier_post(unsigned* bar, volatile LAS unsigned* st) {
    XcdBarrier b; b.bar = bar; b.x = xb_xcc_id(); b.st = st;
    if (threadIdx.x == 0) (void)xb_add(&bar[XB_XCNT(b.x)], 1u);
    return b;
}
__device__ __forceinline__ void xcd_barrier_complete(unsigned* bar, unsigned x, unsigned& nloc, unsigned& nx) {
    const unsigned G = gridDim.x * gridDim.y * gridDim.z;
    unsigned sum, cnt, mine, sp = 0u;
    for (;;) {
        sum = 0u; cnt = 0u; mine = 0u;
#pragma unroll
        for (unsigned j = 0; j < 16; ++j) { const unsigned c = xb_ld(&bar[XB_XCNT(j)]); sum += c; cnt += (c > 0u) ? 1u : 0u; mine = (j == x) ? c : mine; }
        if (sum == G) break;
        __builtin_amdgcn_s_sleep(1);
        if ((++sp & 255u) == 0u) { if (xb_ld(&bar[XB_TMO])) break; if (sp > XB_SPIN_CAP) { atomicAdd(&bar[XB_TMO], 1u); break; } }
    }
    nloc = mine > 0u ? mine : 1u; nx = cnt > 0u ? cnt : 1u;
}

__device__ __forceinline__ void xcd_barrier(const XcdBarrier& b) {
    asm volatile("s_waitcnt vmcnt(0)" ::: "memory");
    __syncthreads();
    if (threadIdx.x == 0) {
        unsigned* bar = b.bar;
        __builtin_amdgcn_s_waitcnt(0);
        unsigned nloc = b.st[0], nx = b.st[1];
        if (nloc == 0u) { xcd_barrier_complete(bar, b.x, nloc, nx); b.st[0] = nloc; b.st[1] = nx; }
        const unsigned old = xb_add(&bar[XB_XSUB(b.x)], 1u);
        const unsigned gen = old / nloc;
        if (old + 1u == (gen + 1u) * nloc) {
            __builtin_amdgcn_fence(__ATOMIC_RELEASE, "agent");
            asm volatile("s_waitcnt vmcnt(0)" ::: "memory");
            const unsigned og = xb_add(&bar[XB_TOP], 1u);
            const unsigned tg = og / nx;
            if (og + 1u == (tg + 1u) * nx) xb_add(&bar[XB_TOPGEN], 1u);
            else XB_SPIN(xb_ld(&bar[XB_TOPGEN]) == tg, bar);
            __builtin_amdgcn_fence(__ATOMIC_ACQUIRE, "agent");
            xb_add(&bar[XB_XGEN(b.x)], 1u);
            asm volatile("s_waitcnt vmcnt(0)" ::: "memory");
        } else {
            XB_SPIN(xb_ld(&bar[XB_XGEN(b.x)]) == gen, bar);
            __builtin_amdgcn_fence(__ATOMIC_ACQUIRE, "agent");
            asm volatile("s_waitcnt vmcnt(0)" ::: "memory");
        }
    }
    __syncthreads();
}

__global__ void __launch_bounds__(512, 2) mk_fwd(P p) {
    extern __shared__ __attribute__((aligned(16))) unsigned char lds[];
    LAS unsigned char* l3 = (LAS unsigned char*)lds;
    float* fl = (float*)lds;
    const int G = gridDim.x, bx = blockIdx.x;
    if (threadIdx.x < 64) ((LAS unsigned*)(l3 + LDS_CTL))[threadIdx.x] = 0u;
    __syncthreads();
    (void)xcd_barrier_post((unsigned*)(p.ws + WS_BAR), (volatile LAS unsigned*)(l3 + LDS_CTL + 32));
#define PR_T0 (*(volatile LAS unsigned long long*)(l3 + LDS_CTL + 64))
#define PR_ACC (*(volatile LAS unsigned long long*)(l3 + LDS_CTL + 72))
#define PH_BEGIN(id) do { if ((PROBE_MASK >> (id)) & 1) { if (bx == 0 && threadIdx.x == 0) PR_T0 = __builtin_amdgcn_s_memrealtime(); } } while (0)
#define PH_END(id) do { if ((PROBE_MASK >> (id)) & 1) { if (bx == 0 && threadIdx.x == 0) PR_ACC = PR_ACC + (__builtin_amdgcn_s_memrealtime() - PR_T0); } } while (0)
#define GRID_BAR() do { XcdBarrier b_; b_.bar = (unsigned*)(p.ws + WS_BAR); b_.x = xb_xcc_id(); b_.st = (volatile LAS unsigned*)(l3 + LDS_CTL + 32); xcd_barrier(b_); } while (0)
#define WAVE_IDS() int tid_w = threadIdx.x; asm volatile("" : "+v"(tid_w)); const int lane = tid_w & 63, gw = bx * 8 + (tid_w >> 6), ngw = G * 8

        PH_BEGIN(0);
    {
        WAVE_IDS();
        for (int it = gw; it < 2 * CV_ITEMS_LAYER; it += ngw) convert_item(p, it, fl + (tid_w >> 6) * (64 * 65), lane);
        rowstat_rows(p.x, M, layer_buf(p.ws, p.out, 0).xbin, ws_f(p.ws, WS_ROWSS), gw, ngw, lane);
        rowstat_rows(p.mem, MM, (bf16_t*)(p.ws + WS_MEMB), ws_f(p.ws, WS_ROWSS_MEM), gw, ngw, lane);
    }
    GRID_BAR();
        PH_END(0);

#pragma unroll 1
    for (int l = 0; l < 2; ++l) {
        PH_BEGIN(1);
        {
            const LB L = layer_buf(p.ws, p.out, l);
            pg8::Gemm g{L.xbin, L.win, M, 6656, D, (const bf16_t*)(p.ws + WS_MEMB)};
            SchedRounds S{G, bx, 6, 0, 1, 3};
            Unit u0, u3; S.next(0, u0); const bool has_tail = S.next(6, u3);
            fill_rstd_table(ws_f(p.ws, WS_ROWSS) + (size_t)(2 * l) * M * 16, u0.rm, (LAS float*)(l3 + LDS_RSTD0));
            if (has_tail) fill_rstd_table(u3.kind == 1 ? ws_f(p.ws, WS_ROWSS_MEM) : ws_f(p.ws, WS_ROWSS) + (size_t)(2 * l) * M * 16, u3.rm, (LAS float*)(l3 + LDS_RSTD1));
            __syncthreads();
            EpiProjMK E{L, (const LAS float*)(l3 + LDS_RSTD0), (const LAS float*)(l3 + LDS_RSTD1), u0.rm};
            pg8::gemm_phase<EpiProjMK, SchedRounds, true, true>(l3, g, S, E);
        }
        GRID_BAR();
        PH_END(1);
        PH_BEGIN(2);
        {
            const LB L = layer_buf(p.ws, p.out, l);
            PH_BEGIN(10); for (int u = bx; u < NB * 16 * 2; u += G) swa_mfma_unit(p, L, l, u, l3); PH_END(10);
            PH_BEGIN(11); for (int u = bx; u < NB * 4 * 8; u += G) xattn_mfma_unit(L, u, l3); PH_END(11);
            PH_BEGIN(12); for (int u = bx; u < NB * NCH; u += G) mlstm_A_mfma_unit(p, L, l, u, l3); PH_END(12);
        }
        GRID_BAR();
        PH_END(2);
        PH_BEGIN(3);
        {
            const LB L = layer_buf(p.ws, p.out, l);
            for (int u = bx; u < 256; u += G) mlstm_scan2_unit(p, L, u);
        }
        GRID_BAR();
        PH_END(3);
        PH_BEGIN(4);
        {
            const LB L = layer_buf(p.ws, p.out, l);
            for (int u = bx; u < NB * NCH * 2; u += G) mlstm_C_mfma_unit(p, L, l, u, l3);
        }
        GRID_BAR();
        PH_END(4);
        PH_BEGIN(6);
        {
            const LB L = layer_buf(p.ws, p.out, l);
            pg8::Gemm g{L.sq, L.wbr, 3 * M, 3 * D, 512, nullptr};
            SchedMerged S{G, bx};
            EpiMergedMK E{L.gates, L.merged};
            pg8::gemm_phase<EpiMergedMK, SchedMerged, true, true>(l3, g, S, E);
        }
        GRID_BAR();
        PH_END(6);
        PH_BEGIN(7);
        {
            const LB L = layer_buf(p.ws, p.out, l);
            pg8::Gemm g{L.merged, L.wout, M, D, D, nullptr};
            SchedRounds S{G, bx, 1, 0, 0, 99};
            EpiResidMK E{L.xbin, L.xbmid, ws_f(p.ws, WS_ROWSS) + (size_t)(2 * l + 1) * M * 16};
            pg8::gemm_phase<EpiResidMK, SchedRounds, true, true>(l3, g, S, E);
        }
        GRID_BAR();
        PH_END(7);
        PH_BEGIN(8);
        {
            const LB L = layer_buf(p.ws, p.out, l);
            pg8::Gemm g{L.xbmid, L.wff1, M, DFF, D, nullptr};
            SchedRounds S{G, bx, 4, 0, 0, 99};
            Unit u0; S.next(0, u0);
            fill_rstd_table(ws_f(p.ws, WS_ROWSS) + (size_t)(2 * l + 1) * M * 16, u0.rm, (LAS float*)(l3 + LDS_RSTD0));
            __syncthreads();
            EpiFF1MK E{L.hff, (const LAS float*)(l3 + LDS_RSTD0)};
            pg8::gemm_phase<EpiFF1MK, SchedRounds, true, true>(l3, g, S, E);
        }
        GRID_BAR();
        PH_END(8);
        PH_BEGIN(9);
        {
            const LB L = layer_buf(p.ws, p.out, l);
            pg8::Gemm g{L.hff, L.wff2, M, D, DFF, nullptr};
            SchedRounds S{G, bx, 1, 0, 0, 99};
            EpiResidMK E{L.xbmid, L.xbnext, ws_f(p.ws, WS_ROWSS) + (size_t)(2 * l + 2) * M * 16};
            pg8::gemm_phase<EpiResidMK, SchedRounds, true, true>(l3, g, S, E);
        }
        GRID_BAR();
        PH_END(9);
    }
    {
        WAVE_IDS();
        finalnorm_rows(layer_buf(p.ws, p.out, 1).xbnext, p.out, ws_f(p.ws, WS_ROWSS) + (size_t)4 * M * 16, p.g_final, gw, ngw, lane);
    }
    if (PROBE_MASK != 0 && bx == 0 && threadIdx.x == 0) { const unsigned long long te = __builtin_amdgcn_s_memrealtime(); const unsigned long long acc_ = PR_ACC; while (__builtin_amdgcn_s_memrealtime() - te < 10ull * acc_) __builtin_amdgcn_s_sleep(8); }
}
}

extern "C" void kernel_launch(void* const* d_in, const int* in_sizes, int n_in, void* d_out, int out_size, void* d_ws, size_t ws_size, hipStream_t stream) {
    static int grid = 0;
    if (grid == 0) {
        if (n_in != 20 || out_size != M * D || ws_size < WS_END) { fprintf(stderr, "kernel_launch: unexpected shapes (n_in %d out %d ws %zu)\n", n_in, out_size, ws_size); grid = -1; return; }
        int dev = 0, cus = 0, per_cu = 0;
        if (hipGetDevice(&dev) != hipSuccess || hipDeviceGetAttribute(&cus, hipDeviceAttributeMultiprocessorCount, dev) != hipSuccess) { fprintf(stderr, "kernel_launch: device query failed\n"); grid = -1; return; }
        if (hipFuncSetAttribute((const void*)mk_fwd, hipFuncAttributeMaxDynamicSharedMemorySize, LDS_BYTES) != hipSuccess) { fprintf(stderr, "kernel_launch: hipFuncSetAttribute failed\n"); grid = -1; return; }
        if (hipOccupancyMaxActiveBlocksPerMultiprocessor(&per_cu, (const void*)mk_fwd, 512, LDS_BYTES) != hipSuccess || per_cu < 1) { fprintf(stderr, "kernel_launch: occupancy query says %d blocks per CU\n", per_cu); grid = -1; return; }
        grid = cus;
    }
    if (grid < 0) return;
    P p{};
    const float** pf = (const float**)&p;
    for (int i = 0; i < 20; ++i) pf[i] = (const float*)d_in[i];
    p.out = (float*)d_out; p.ws = (unsigned char*)d_ws;
    if (hipMemsetAsync(d_ws, 0, WS_ZERO_BYTES, stream) != hipSuccess) { fprintf(stderr, "kernel_launch: memset failed\n"); return; }
    void* args[] = {&p};
    const hipError_t e = hipLaunchCooperativeKernel((const void*)mk_fwd, dim3(grid), dim3(512), args, LDS_BYTES, stream);
    if (e != hipSuccess) fprintf(stderr, "kernel_launch: cooperative launch failed: %s (grid %d)\n", hipGetErrorString(e), grid);
}
```

```cpp
#include <hip/hip_runtime.h>
#include <cstdio>
#include <cstdint>
#ifndef PROBE_MASK
#define PROBE_MASK 0
#endif

namespace pg8 {
#define PG8_LAS __attribute__((address_space(3)))
typedef unsigned short bf16_t;
typedef short bf16x8 __attribute__((ext_vector_type(8)));
typedef float f32x4 __attribute__((ext_vector_type(4)));
typedef unsigned u32x4 __attribute__((ext_vector_type(4)));
constexpr int BM = 256, BK = 64, HALF = 128, HTB = HALF * BK * 2  , STAGE_BYTES = 8 * HTB, NXCD = 8, WGM = 8;

__host__ __device__ __forceinline__ int lds_byte(int r, int c) { const int st = (r >> 4) * 2 + (c >> 5), rr = r & 15, cc = c & 31, ob = rr * 64 + cc * 2; return st * 1024 + (ob ^ (((ob >> 9) & 1) << 5)); }
__host__ __device__ __forceinline__ void stage_rc(int b, int& R, int& C) { const int st = b / 1024, sb = b % 1024, swz = sb ^ (((sb >> 9) & 1) << 5); R = (st >> 1) * 16 + swz / 64; C = (st & 1) * 32 + (swz % 64) / 2; }
__host__ __device__ __forceinline__ int perm32(int rho) { const int n = rho >> 4, i = rho & 15; return 8 * (i >> 2) + 4 * n + (i & 3); }
struct Unit { int pm, pn, rm, kind, asel; };
struct Gemm { const bf16_t* A; const bf16_t* Bt; int M, N, K; const bf16_t* A2; };
__device__ __forceinline__ unsigned cvt_pk_bf16(float lo, float hi) { unsigned r; asm volatile("v_cvt_pk_bf16_f32 %0, %1, %2" : "=v"(r) : "v"(lo), "v"(hi)); return r; }
template <class Epi, class Sched, bool ALIGN_EPI = false, bool SP2 = false>
__device__ __forceinline__ void gemm_phase(PG8_LAS unsigned char* lds, const Gemm g, const Sched& S, const Epi& E) {
    int tid_l = threadIdx.x; asm volatile("" : "+v"(tid_l));
    const int tid = tid_l, wid = __builtin_amdgcn_readfirstlane(tid >> 6), lane = tid & 63, wr = wid >> 2, wc = wid & 3, fr = lane & 15, fq = lane >> 4;
    const int K = g.K, nt = K / BK;
    unsigned voffA[2], voffB[2];
#pragma unroll
    for (int i = 0; i < 2; ++i) { int R, C; stage_rc(tid * 16 + i * 8192, R, C); const int Rb = Epi::PERM ? ((R & ~31) + perm32(R & 31)) : R;
        voffA[i] = (unsigned)(R * K + C) * 2u; voffB[i] = (unsigned)(Rb * K + C) * 2u; }
    const size_t kstep = (size_t)(BK * 2);
    const size_t hstep = (size_t)HALF * K * 2;
    const size_t tstep = 2 * hstep;
    const unsigned ldsw = (unsigned)wid * 1024u;
    const int aoff = lds_byte(wr * 64 + fr, fq * 8), boff = lds_byte(wc * 32 + fr, fq * 8);
#define PG8_SA(b, h) (((b) * 2 + (h)) * HTB)
#define PG8_SB(b, h) ((4 + (b) * 2 + (h)) * HTB)
#define PG8_STAGE(bufoff, gbase, voff) do { _Pragma("unroll") for (int _i = 0; _i < 2; ++_i) \
        __builtin_amdgcn_global_load_lds((const unsigned*)((const char*)(gbase) + (voff)[_i]), (PG8_LAS unsigned*)(lds + (bufoff) + ldsw + _i * 8192), 16, 0, 0); } while (0)
#define PG8_LDA(dst, b, h) do { _Pragma("unroll") for (int m = 0; m < 4; ++m) _Pragma("unroll") for (int k = 0; k < 2; ++k) dst[m][k] = *(const PG8_LAS bf16x8*)(lds + PG8_SA(b, h) + aoff + m * 2048 + k * 1024); } while (0)
#define PG8_LDB(dst, b, h) do { _Pragma("unroll") for (int n = 0; n < 2; ++n) _Pragma("unroll") for (int k = 0; k < 2; ++k) dst[n][k] = *(const PG8_LAS bf16x8*)(lds + PG8_SB(b, h) + boff + n * 2048 + k * 1024); } while (0)
#define PG8_MMA(ai, bj, At, Bt) do { __builtin_amdgcn_s_setprio(1); _Pragma("unroll") for (int m = 0; m < 4; ++m) _Pragma("unroll") for (int n = 0; n < 2; ++n) _Pragma("unroll") for (int k = 0; k < 2; ++k) \
        acc[ai][bj][m][n] = __builtin_amdgcn_mfma_f32_16x16x32_bf16(Bt[n][k], At[m][k], acc[ai][bj][m][n], 0, 0, 0); __builtin_amdgcn_s_setprio(0); } while (0)
#define PG8_WAIT_V(n) asm volatile("s_waitcnt vmcnt(" #n ")" ::: "memory")
#define PG8_WAIT_L(n) asm volatile("s_waitcnt lgkmcnt(" #n ")" ::: "memory")
#define PG8_BAR __builtin_amdgcn_s_barrier()
#define PG8_SCHED __builtin_amdgcn_sched_barrier(0)
    Unit cur, nxt; int ui = 0;
    if (!S.next(0, cur)) return;
    f32x4 acc[2][2][4][2];
#pragma unroll
    for (int a = 0; a < 2; ++a)
#pragma unroll
        for (int b = 0; b < 2; ++b)
#pragma unroll
            for (int m = 0; m < 4; ++m)
#pragma unroll
                for (int n = 0; n < 2; ++n) acc[a][b][m][n] = (f32x4){0.f, 0.f, 0.f, 0.f};
    bf16x8 At[4][2], B0[2][2], B1[2][2];
    const char* cA = (const char*)(cur.asel ? g.A2 : g.A) + (size_t)cur.pm * tstep; const char* cB = (const char*)g.Bt + (size_t)cur.pn * tstep;
    S.a_ready(cur);
    if constexpr (SP2) {
        PG8_STAGE(PG8_SB(0, 0), cB, voffB); PG8_STAGE(PG8_SB(0, 1), cB + hstep, voffB); PG8_STAGE(PG8_SA(0, 0), cA, voffA); PG8_STAGE(PG8_SA(0, 1), cA + hstep, voffA);
        if (wr == 1) PG8_BAR;
        PG8_WAIT_V(2); PG8_BAR;
        PG8_STAGE(PG8_SB(1, 0), cB + kstep, voffB); PG8_STAGE(PG8_SA(1, 0), cA + kstep, voffA); PG8_STAGE(PG8_SB(1, 1), cB + hstep + kstep, voffB);
        PG8_WAIT_V(6); PG8_BAR;
    } else {
        PG8_STAGE(PG8_SB(0, 0), cB, voffB); PG8_STAGE(PG8_SA(0, 0), cA, voffA); PG8_STAGE(PG8_SB(0, 1), cB + hstep, voffB); PG8_STAGE(PG8_SA(0, 1), cA + hstep, voffA);
        if (wr == 1) PG8_BAR;
        PG8_WAIT_V(4); PG8_BAR;
        PG8_STAGE(PG8_SB(1, 0), cB + kstep, voffB); PG8_STAGE(PG8_SA(1, 0), cA + kstep, voffA); PG8_STAGE(PG8_SB(1, 1), cB + hstep + kstep, voffB);
        PG8_WAIT_V(6); PG8_BAR;
    }
    for (;;) {
        const bool has_next = S.next(ui + 1, nxt);
        const char* nA = has_next ? (const char*)(nxt.asel ? g.A2 : g.A) + (size_t)nxt.pm * tstep : cA; const char* nB = has_next ? (const char*)g.Bt + (size_t)nxt.pn * tstep : cB;
        for (int t = 0; t < nt; t += 2) {
            const bool last = (t == nt - 2);
            const char* a1 = cA + (size_t)(t + 1) * kstep;
            const char* a2 = last ? nA : cA + (size_t)(t + 2) * kstep; const char* b2 = last ? nB : cB + (size_t)(t + 2) * kstep;
            const char* a3 = a2 + kstep; const char* b3 = b2 + kstep;
            if (last && has_next) S.a_ready(nxt);
            if constexpr (SP2) {
            PG8_LDB(B0, 0, 0); PG8_LDB(B1, 0, 1); PG8_SCHED; PG8_LDA(At, 0, 0); PG8_STAGE(PG8_SA(1, 1), a1 + hstep, voffA);
            PG8_WAIT_V(8); PG8_WAIT_L(0); PG8_BAR; PG8_MMA(0, 0, At, B0); PG8_MMA(0, 1, At, B1); PG8_BAR; PG8_SCHED;
            PG8_LDA(At, 0, 1); PG8_STAGE(PG8_SB(0, 0), b2, voffB); PG8_STAGE(PG8_SB(0, 1), b2 + hstep, voffB); PG8_STAGE(PG8_SA(0, 0), a2, voffA);
            PG8_WAIT_V(8); PG8_WAIT_L(0); PG8_BAR; PG8_MMA(1, 0, At, B0); PG8_MMA(1, 1, At, B1); PG8_BAR; PG8_SCHED;
            PG8_LDB(B0, 1, 0); PG8_LDB(B1, 1, 1); PG8_SCHED; PG8_LDA(At, 1, 0); PG8_STAGE(PG8_SA(0, 1), a2 + hstep, voffA);
            PG8_WAIT_V(8); PG8_WAIT_L(0); PG8_BAR; PG8_MMA(0, 0, At, B0); PG8_MMA(0, 1, At, B1); PG8_BAR; PG8_SCHED;
            PG8_LDA(At, 1, 1); PG8_STAGE(PG8_SB(1, 0), b3, voffB); PG8_STAGE(PG8_SB(1, 1), b3 + hstep, voffB); PG8_STAGE(PG8_SA(1, 0), a3, voffA);
            PG8_WAIT_V(8); PG8_WAIT_L(0); PG8_BAR; PG8_MMA(1, 0, At, B0); PG8_MMA(1, 1, At, B1); PG8_BAR; PG8_SCHED;
            } else {
            PG8_LDB(B0, 0, 0); PG8_SCHED; PG8_LDA(At, 0, 0); PG8_STAGE(PG8_SA(1, 1), a1 + hstep, voffA);
            PG8_WAIT_L(8); PG8_BAR; PG8_WAIT_L(0); PG8_MMA(0, 0, At, B0); PG8_BAR; PG8_SCHED;
            PG8_LDB(B1, 0, 1); PG8_STAGE(PG8_SB(0, 0), b2, voffB);
            PG8_BAR; PG8_WAIT_L(0); PG8_MMA(0, 1, At, B1); PG8_BAR;
            PG8_LDA(At, 0, 1); PG8_STAGE(PG8_SA(0, 0), a2, voffA);
            PG8_BAR; PG8_WAIT_L(0); PG8_MMA(1, 0, At, B0); PG8_BAR; PG8_SCHED;
            PG8_STAGE(PG8_SB(0, 1), b2 + hstep, voffB);
            PG8_WAIT_V(6); PG8_BAR; PG8_MMA(1, 1, At, B1); PG8_BAR;
            PG8_LDB(B0, 1, 0); PG8_SCHED; PG8_LDA(At, 1, 0); PG8_STAGE(PG8_SA(0, 1), a2 + hstep, voffA);
            PG8_WAIT_L(8); PG8_BAR; PG8_WAIT_L(0); PG8_MMA(0, 0, At, B0); PG8_BAR; PG8_SCHED;
            PG8_LDB(B1, 1, 1); PG8_STAGE(PG8_SB(1, 0), b3, voffB);
            PG8_BAR; PG8_WAIT_L(0); PG8_MMA(0, 1, At, B1); PG8_BAR;
            PG8_LDA(At, 1, 1); PG8_STAGE(PG8_SA(1, 0), a3, voffA);
            PG8_BAR; PG8_WAIT_L(0); PG8_MMA(1, 0, At, B0); PG8_BAR; PG8_SCHED;
            PG8_STAGE(PG8_SB(1, 1), b3 + hstep, voffB);
            PG8_WAIT_V(6); PG8_BAR; PG8_MMA(1, 1, At, B1); PG8_BAR;
            }
        }
        if constexpr (ALIGN_EPI) { if (wr == 0) PG8_BAR; }
        if constexpr (!Epi::AFTER_DRAIN) { E(acc, cur, wr, wc, fr, fq); S.done(cur); }
        const bool keep_acc = E.keep(cur);
        if (!has_next) break;
        if (!keep_acc) {
#pragma unroll
        for (int a = 0; a < 2; ++a)
#pragma unroll
            for (int b = 0; b < 2; ++b)
#pragma unroll
                for (int m = 0; m < 4; ++m)
#pragma unroll
                    for (int n = 0; n < 2; ++n) acc[a][b][m][n] = (f32x4){0.f, 0.f, 0.f, 0.f};
        }
        cur = nxt; cA = nA; cB = nB; ++ui;
        if constexpr (ALIGN_EPI) { if (wr == 1) PG8_BAR; }
    }
    PG8_WAIT_V(0);
    if constexpr (!ALIGN_EPI) { if (wr == 0) PG8_BAR; }
    PG8_BAR;
    if constexpr (Epi::AFTER_DRAIN) { E.fused(acc, cur, wr, wc, fr, fq, lds, wid, lane); S.done(cur); }
#undef PG8_SA
#undef PG8_SB
#undef PG8_STAGE
#undef PG8_LDA
#undef PG8_LDB
#undef PG8_MMA
#undef PG8_WAIT_V
#undef PG8_WAIT_L
#undef PG8_BAR
#undef PG8_SCHED
}
}

namespace {
using pg8::bf16_t; using pg8::f32x4; using pg8::u32x4; using pg8::Unit;
#define LAS __attribute__((address_space(3)))
constexpr int M = 16384, D = 1024, T = 2048, NB = 8, MEMLEN = 256, MM = NB * MEMLEN;
constexpr int INC = 6416, DFF = 4096, NCH = 32, NH = 8;
constexpr float EPS = 1e-6f;
constexpr size_t MiB = 1u << 20;
constexpr size_t WS_POOL_C = 77u << 20;
constexpr size_t WS_BAR = 0;
constexpr size_t WS_ROWSS = WS_POOL_C + 174 * (1u << 20);
constexpr size_t WS_ZERO_BYTES = 64 * 1024;
constexpr size_t WS_ROWSS_MEM = WS_POOL_C + 173 * (1u << 20);
constexpr size_t WS_G = 400 * 1024, WS_ML = 408 * 1024, WS_MIN = 416 * 1024;
constexpr size_t WS_DN = 512 * 1024;
constexpr size_t WS_WT = 1 * MiB;
constexpr size_t WT_WIN = 0, WT_WMEM = (size_t)6656 * D * 2, WT_WBR = WT_WMEM + (size_t)D * D * 2, WT_WOUT = WT_WBR + (size_t)3 * D * 512 * 2,
                 WT_FF1 = WT_WOUT + (size_t)D * D * 2, WT_FF2 = WT_FF1 + (size_t)DFF * D * 2, WT_LAYER = WT_FF2 + (size_t)D * DFF * 2;
constexpr size_t WS_MEMB = 73 * MiB, WS_POOL = 77 * MiB, WS_END = 256 * MiB;
static_assert(WS_WT + 2 * WT_LAYER <= WS_MEMB && WS_POOL_C == WS_POOL, "weights fit");
constexpr int LDS_RING = 131072, LDS_BYTES = 147456, LDS_CTL = LDS_BYTES - 256, LDS_RSTD0 = LDS_RING, LDS_RSTD1 = LDS_RING + 1024;

struct P {
    const float *x, *mem, *rel_bias, *g_mix, *w_in, *conv_w, *b_i, *b_f, *norm_g, *sinks, *g_mem, *w_mem_kv, *w_br0, *w_br1, *w_br2, *w_out, *g_ffn, *w_ff1, *w_ff2, *g_final;
    float* out; unsigned char* ws;
};
struct LB {
    bf16_t *xbin, *sq, *mo, *xq, *skv, *mqk, *mv, *memkv, *merged, *xbmid, *hff, *xbnext;
    unsigned char* gates;
    float* iff; bf16_t* state;
    const bf16_t *win, *wmem, *wbr, *wout, *wff1, *wff2;
};
__host__ __device__ inline LB layer_buf(unsigned char* ws, float* out, int l) {
    LB b; unsigned char* pool = ws + WS_POOL; unsigned char* breg = pool;
    b.xbin = (bf16_t*)out; b.xbmid = (bf16_t*)((unsigned char*)out + 32 * MiB); b.xbnext = l == 1 ? (bf16_t*)(pool + 128 * MiB) : (bf16_t*)out;
    b.merged = (bf16_t*)(pool + 48 * MiB); b.hff = (bf16_t*)pool;
    b.sq = (bf16_t*)breg; b.mo = (bf16_t*)(breg + 16 * MiB); b.xq = (bf16_t*)(breg + 32 * MiB);
    b.gates = pool + 125 * MiB;
    b.skv = (bf16_t*)(breg + 48 * MiB); b.mqk = (bf16_t*)(breg + 56 * MiB); b.mv = (bf16_t*)(breg + 88 * MiB);
    b.iff = (float*)(breg + 104 * MiB); b.memkv = (bf16_t*)(breg + 105 * MiB); b.state = (bf16_t*)(breg + 109 * MiB);
    unsigned char* wt = ws + WS_WT + (size_t)l * WT_LAYER;
    b.win = (const bf16_t*)(wt + WT_WIN); b.wmem = (const bf16_t*)(wt + WT_WMEM); b.wbr = (const bf16_t*)(wt + WT_WBR);
    b.wout = (const bf16_t*)(wt + WT_WOUT); b.wff1 = (const bf16_t*)(wt + WT_FF1); b.wff2 = (const bf16_t*)(wt + WT_FF2);
    return b;
}
__device__ __forceinline__ float* ws_f(unsigned char* ws, size_t off) { return (float*)(ws + off); }

__device__ __forceinline__ float bf2f(bf16_t h) { return __uint_as_float(((unsigned)h) << 16); }
__device__ __forceinline__ bf16_t f2bf(float f) { unsigned u = __float_as_uint(f); u = (u + 0x7fffu + ((u >> 16) & 1u)) >> 16; return (bf16_t)u; }
__device__ __forceinline__ unsigned pk2(float lo, float hi) { return (unsigned)f2bf(lo) | ((unsigned)f2bf(hi) << 16); }
__device__ __forceinline__ float sigmoidf_(float v) { return 1.f / (1.f + expf(-v)); }
__device__ __forceinline__ float fsigmoid(float v) { return __builtin_amdgcn_rcpf(1.f + __expf(-v)); }
__device__ __forceinline__ float wave_sum(float v) {
#pragma unroll
    for (int o = 1; o < 64; o <<= 1) v += __shfl_xor(v, o);
    return v;
}
__device__ __forceinline__ float wave_max(float v) {
#pragma unroll
    for (int o = 1; o < 64; o <<= 1) v = fmaxf(v, __shfl_xor(v, o));
    return v;
}
__device__ __forceinline__ void unpack8(const uint4 a, float (&f)[8]) {
    f[0] = __uint_as_float(a.x << 16); f[1] = __uint_as_float(a.x & 0xffff0000u); f[2] = __uint_as_float(a.y << 16); f[3] = __uint_as_float(a.y & 0xffff0000u);
    f[4] = __uint_as_float(a.z << 16); f[5] = __uint_as_float(a.z & 0xffff0000u); f[6] = __uint_as_float(a.w << 16); f[7] = __uint_as_float(a.w & 0xffff0000u);
}
__device__ const unsigned char T5_BUCKET[128] = {0, 1, 2, 3, 4, 5, 6, 7, 8, 9, 10, 11, 12, 13, 14, 15, 16, 16, 16, 17, 17, 18, 18, 18, 19, 19, 19, 20, 20, 20, 20, 21, 21, 21, 21, 22, 22, 22, 22, 22, 23, 23, 23, 23, 23, 23, 24, 24, 24, 24, 24, 24, 25, 25, 25, 25, 25, 25, 25, 26, 26, 26, 26, 26, 26, 26, 26, 27, 27, 27, 27, 27, 27, 27, 27, 27, 27, 28, 28, 28, 28, 28, 28, 28, 28, 28, 28, 29, 29, 29, 29, 29, 29, 29, 29, 29, 29, 29, 29, 30, 30, 30, 30, 30, 30, 30, 30, 30, 30, 30, 30, 30, 30, 31, 31, 31, 31, 31, 31, 31, 31, 31, 31, 31, 31, 31, 31, 31};

__device__ __forceinline__ float rstd_of(const float* rp, int row) {
    const f32x4* q = (const f32x4*)(rp + (size_t)row * 16); const f32x4 a = q[0], b = q[1], c = q[2], d = q[3];
    const float ss = ((a[0] + a[1]) + (a[2] + a[3])) + ((b[0] + b[1]) + (b[2] + b[3])) + (((c[0] + c[1]) + (c[2] + c[3])) + ((d[0] + d[1]) + (d[2] + d[3])));
    return rsqrtf(ss * (1.f / D) + EPS);
}
__device__ __forceinline__ void fill_rstd_table(const float* rp, int rm, LAS float* tab) {
    const int t = threadIdx.x; if (t < 256) tab[t] = rstd_of(rp, rm * 256 + t);
}
struct SchedRounds {
    int G, c, nfull, pn_base, tail, skip_at;
    __device__ __forceinline__ bool next(int i, Unit& u) const {
        const int L = i * G + c;
        if (L < nfull * 256) { const int r = L >> 8, w = L & 255, x = w & 7, j = w >> 3; u.pm = u.rm = 8 * x + (j & 7); u.pn = pn_base + 4 * r + (j >> 3) + (r >= skip_at ? 1 : 0); u.kind = 0; u.asel = 0; return true; }
        if (!tail) return false;
        const int t = L - nfull * 256;
        if (t < 64) { u.pm = u.rm = t; u.pn = 12; u.kind = 0; u.asel = 0; return true; }
        if (t < 128) { u.pm = u.rm = t - 64; u.pn = 25; u.kind = 0; u.asel = 0; return true; }
        if (t < 160) { const int q = t - 128; u.pm = u.rm = q >> 2; u.pn = 26 + (q & 3); u.kind = 1; u.asel = 1; return true; }
        return false;
    }
    __device__ __forceinline__ void a_ready(const Unit&) const {}
    __device__ __forceinline__ void done(const Unit&) const {}
};
struct SchedMerged {
    int G, c;
    __device__ __forceinline__ bool next(int i, Unit& u) const {
        const int tt = (i / 3) * G + c, seg = i % 3; if (tt >= 256) return false;
        const int x = tt & 7, j = tt >> 3; u.rm = 8 * x + (j & 7); u.pm = seg * 64 + u.rm; u.pn = seg * 4 + (j >> 3); u.kind = seg; u.asel = 0; return true;
    }
    __device__ __forceinline__ void a_ready(const Unit&) const {}
    __device__ __forceinline__ void done(const Unit&) const {}
};

__device__ __forceinline__ u32x4 pack8(f32x4 a, f32x4 b) { u32x4 w; w.x = pg8::cvt_pk_bf16(a[0], a[1]); w.y = pg8::cvt_pk_bf16(a[2], a[3]); w.z = pg8::cvt_pk_bf16(b[0], b[1]); w.w = pg8::cvt_pk_bf16(b[2], b[3]); return w; }
__device__ __forceinline__ f32x4 sig4(f32x4 v) { f32x4 r; r[0] = fsigmoid(v[0]); r[1] = fsigmoid(v[1]); r[2] = fsigmoid(v[2]); r[3] = fsigmoid(v[3]); return r; }
struct EpiProjMK {
    static constexpr bool PERM = true, AFTER_DRAIN = false;
    LB L; const LAS float* tab0; const LAS float* tab1; int rm0;
    __device__ __forceinline__ bool keep(const Unit&) const { return false; }
    __device__ __forceinline__ void operator()(f32x4 (&acc)[2][2][4][2], const Unit& u, int wr, int wc, int fr, int fq) const {
        const int rbase = u.rm * 256 + wr * 64 + fr, cin = wc * 32 + 8 * fq, rloc = wr * 64 + fr;
        const LAS float* rs = (u.kind == 0 && u.rm == rm0) ? tab0 : tab1; bf16_t* dst; int ld, coff; bool sig = false; const int tile = u.pn;
        if (u.kind == 1) { dst = L.memkv; ld = 1024; coff = (tile - 26) * 256; }
        else if (tile < 2) { dst = L.sq; ld = 512; coff = tile * 256; }
        else if (tile < 3) { dst = L.skv; ld = 256; coff = 0; }
        else if (tile < 7) { dst = L.mqk; ld = 1024; coff = (tile - 3) * 256; }
        else if (tile < 9) { dst = L.mv; ld = 512; coff = (tile - 7) * 256; }
        else if (tile < 11) { dst = L.mo; ld = 512; coff = (tile - 9) * 256; sig = true; }
        else if (tile < 13) { dst = L.xq; ld = 512; coff = (tile - 11) * 256; }
        else { dst = nullptr; ld = 0; coff = 0; }
#pragma unroll
        for (int ai = 0; ai < 2; ++ai)
#pragma unroll
            for (int m = 0; m < 4; ++m) {
                const int row = rbase + ai * 128 + m * 16; const float rstd = rs[rloc + ai * 128 + m * 16];
#pragma unroll
                for (int bj = 0; bj < 2; ++bj) {
                    f32x4 v0 = acc[ai][bj][m][0] * rstd, v1 = acc[ai][bj][m][1] * rstd;
                    if (dst) { if (sig) { v0 = sig4(v0); v1 = sig4(v1); }
                        *(u32x4*)(dst + (size_t)row * ld + coff + bj * 128 + cin) = pack8(v0, v1); }
                    else if (tile < 25) {
                        v0 = sig4(v0) * 256.f; v1 = sig4(v1) * 256.f; uint2 w;
                        w.x = (unsigned)fminf(v0[0], 255.f) | ((unsigned)fminf(v0[1], 255.f) << 8) | ((unsigned)fminf(v0[2], 255.f) << 16) | ((unsigned)fminf(v0[3], 255.f) << 24);
                        w.y = (unsigned)fminf(v1[0], 255.f) | ((unsigned)fminf(v1[1], 255.f) << 8) | ((unsigned)fminf(v1[2], 255.f) << 16) | ((unsigned)fminf(v1[3], 255.f) << 24);
                        *(uint2*)(L.gates + (size_t)row * 3072 + (tile - 13) * 256 + bj * 128 + cin) = w; }
                    else if (bj == 0 && cin < 16) { *(f32x4*)(L.iff + (size_t)row * 16 + cin) = v0; *(f32x4*)(L.iff + (size_t)row * 16 + cin + 4) = v1; }
                }
            }
    }
};
struct EpiMergedMK {
    static constexpr bool PERM = true, AFTER_DRAIN = false;
    const unsigned char* gates; bf16_t* merged;
    __device__ __forceinline__ bool keep(const Unit& u) const { return u.kind < 2; }
    __device__ __forceinline__ static void deq8(uint2 w, float (&g)[8]) {
        g[0] = (float)(w.x & 255u) + 0.5f; g[1] = (float)((w.x >> 8) & 255u) + 0.5f; g[2] = (float)((w.x >> 16) & 255u) + 0.5f; g[3] = (float)(w.x >> 24) + 0.5f;
        g[4] = (float)(w.y & 255u) + 0.5f; g[5] = (float)((w.y >> 8) & 255u) + 0.5f; g[6] = (float)((w.y >> 16) & 255u) + 0.5f; g[7] = (float)(w.y >> 24) + 0.5f; }
    __device__ __forceinline__ void operator()(f32x4 (&acc)[2][2][4][2], const Unit& u, int wr, int wc, int fr, int fq) const {
        const int rbase = u.rm * 256 + wr * 64 + fr, col0 = (u.pn & 3) * 256 + wc * 32 + 8 * fq, seg = u.kind;
#pragma unroll
        for (int ai = 0; ai < 2; ++ai) {
            uint2 gs[4][2], gn[4][2];
#pragma unroll
            for (int m = 0; m < 4; ++m)
#pragma unroll
                for (int bj = 0; bj < 2; ++bj) { const unsigned char* gp = gates + (size_t)(rbase + ai * 128 + m * 16) * 3072 + seg * 1024 + col0 + bj * 128;
                    gs[m][bj] = *(const uint2*)gp; gn[m][bj] = seg < 2 ? *(const uint2*)(gp + 1024) : make_uint2(0u, 0u); }
#pragma unroll
            for (int m = 0; m < 4; ++m) {
                const int row = rbase + ai * 128 + m * 16;
#pragma unroll
                for (int bj = 0; bj < 2; ++bj) {
                    const int col = col0 + bj * 128;
                    float g[8]; deq8(gs[m][bj], g);
                    if (seg < 2) { float gd[8]; deq8(gn[m][bj], gd);
#pragma unroll
                        for (int j = 0; j < 8; ++j) g[j] = g[j] * __builtin_amdgcn_rcpf(gd[j]); }
                    else {
#pragma unroll
                        for (int j = 0; j < 8; ++j) g[j] *= (1.f / 256.f); }
                    f32x4 v0 = acc[ai][bj][m][0], v1 = acc[ai][bj][m][1];
                    v0[0] *= g[0]; v0[1] *= g[1]; v0[2] *= g[2]; v0[3] *= g[3]; v1[0] *= g[4]; v1[1] *= g[5]; v1[2] *= g[6]; v1[3] *= g[7];
                    acc[ai][bj][m][0] = v0; acc[ai][bj][m][1] = v1;
                    if (seg == 2) *(u32x4*)(merged + (size_t)row * D + col) = pack8(v0, v1);
                }
            }
            asm volatile("" ::: "memory");
        }
    }
};
struct EpiResidMK {
    static constexpr bool PERM = true, AFTER_DRAIN = false;
    const bf16_t* xold; bf16_t* xnew; float* rowss;
    __device__ __forceinline__ bool keep(const Unit&) const { return false; }
    __device__ __forceinline__ void operator()(f32x4 (&acc)[2][2][4][2], const Unit& u, int wr, int wc, int fr, int fq) const {
        const int rbase = u.rm * 256 + wr * 64 + fr, col0 = u.pn * 256 + wc * 32 + 8 * fq;
#pragma unroll
        for (int ai = 0; ai < 2; ++ai) {
            uint4 xo[4][2];
#pragma unroll
            for (int m = 0; m < 4; ++m)
#pragma unroll
                for (int bj = 0; bj < 2; ++bj) xo[m][bj] = *(const uint4*)(xold + (size_t)(rbase + ai * 128 + m * 16) * D + col0 + bj * 128);
#pragma unroll
            for (int m = 0; m < 4; ++m) {
                const int row = rbase + ai * 128 + m * 16; const size_t off = (size_t)row * D + col0; float ss = 0.f;
#pragma unroll
                for (int bj = 0; bj < 2; ++bj) {
                    float o[8]; unpack8(xo[m][bj], o);
                    f32x4 v0 = acc[ai][bj][m][0], v1 = acc[ai][bj][m][1];
                    v0[0] += o[0]; v0[1] += o[1]; v0[2] += o[2]; v0[3] += o[3]; v1[0] += o[4]; v1[1] += o[5]; v1[2] += o[6]; v1[3] += o[7];
                    const u32x4 w = pack8(v0, v1); *(u32x4*)(xnew + off + bj * 128) = w;
                    float r[8]; unpack8(__builtin_bit_cast(uint4, w), r);
#pragma unroll
                    for (int j = 0; j < 8; ++j) ss = fmaf(r[j], r[j], ss);
                }
                ss += __shfl_xor(ss, 16); ss += __shfl_xor(ss, 32);
                if (fq == 0) rowss[(size_t)row * 16 + (u.pn & 3) * 4 + wc] = ss;
            }
            asm volatile("" ::: "memory");
        }
    }
};
struct EpiFF1MK {
    static constexpr bool PERM = true, AFTER_DRAIN = false;
    bf16_t* h; const LAS float* tab0;
    __device__ __forceinline__ bool keep(const Unit&) const { return false; }
    __device__ __forceinline__ void operator()(f32x4 (&acc)[2][2][4][2], const Unit& u, int wr, int wc, int fr, int fq) const {
        const int rbase = u.rm * 256 + wr * 64 + fr, col0 = u.pn * 256 + wc * 32 + 8 * fq, rloc = wr * 64 + fr;
#pragma unroll
        for (int ai = 0; ai < 2; ++ai)
#pragma unroll
            for (int m = 0; m < 4; ++m) {
                const int row = rbase + ai * 128 + m * 16; const float rstd = tab0[rloc + ai * 128 + m * 16];
#pragma unroll
                for (int bj = 0; bj < 2; ++bj) {
                    f32x4 v0 = acc[ai][bj][m][0] * rstd, v1 = acc[ai][bj][m][1] * rstd;
#pragma unroll
                    for (int j = 0; j < 4; ++j) { v0[j] = fmaxf(v0[j], 0.f); v0[j] *= v0[j]; v1[j] = fmaxf(v1[j], 0.f); v1[j] *= v1[j]; }
                    *(u32x4*)(h + (size_t)row * DFF + col0 + bj * 128) = pack8(v0, v1);
                }
            }
    }
};

__device__ __forceinline__ void convert_tile_w(const float* src, int ldsrc, int col0, int ncols, int k0, const float* gain, float scale, bf16_t* dst, int K, float* tile, int lane) {
    const int n4 = (lane & 15) * 4;
    f32x4 v[16];
#pragma unroll
    for (int i = 0; i < 16; ++i) { const int kk = (lane >> 4) + 4 * i; v[i] = n4 < ncols ? *(const f32x4*)(src + (size_t)(k0 + kk) * ldsrc + col0 + n4) : (f32x4){0.f, 0.f, 0.f, 0.f}; }
#pragma unroll
    for (int i = 0; i < 16; ++i) { const int kk = (lane >> 4) + 4 * i; const f32x4 w = v[i] * ((gain ? gain[k0 + kk] : 1.f) * scale);
        tile[kk * 65 + n4] = w[0]; tile[kk * 65 + n4 + 1] = w[1]; tile[kk * 65 + n4 + 2] = w[2]; tile[kk * 65 + n4 + 3] = w[3]; }
    asm volatile("s_waitcnt lgkmcnt(0)" ::: "memory");
    const int kc = lane & 7;
#pragma unroll
    for (int i = 0; i < 8; ++i) { const int n = (lane >> 3) + 8 * i; const float* tp = tile + (8 * kc) * 65 + n;
        u32x4 w; w.x = pk2(tp[0], tp[65]); w.y = pk2(tp[130], tp[195]); w.z = pk2(tp[260], tp[325]); w.w = pk2(tp[390], tp[455]);
        if (n < ncols) *(u32x4*)(dst + (size_t)n * K + k0 + 8 * kc) = w; }
    asm volatile("s_waitcnt lgkmcnt(0)" ::: "memory");
}
constexpr int CV_ITEMS_LAYER = 4560;
__device__ __forceinline__ void convert_item(const P& p, int item, float* tile, int lane) {
    const int l = item / CV_ITEMS_LAYER; int r = item % CV_ITEMS_LAYER;
    unsigned char* wt = p.ws + WS_WT + (size_t)l * WT_LAYER;
    const float* src; const float* gain = nullptr; int ld, col0, ncols, K; float sc = 1.f; bf16_t* dst;
    if (r < 1616) {
        const float* win = p.w_in + (size_t)l * D * INC; src = win; ld = INC; K = D; gain = p.g_mix + l * D; int dr;
        if (r < 128) { col0 = 0; ncols = 512; dr = 0; sc = 0.125f; }
        else if ((r -= 128) < 448) { col0 = 512; ncols = 1792; dr = 512; }
        else if ((r -= 448) < 128) { col0 = 2320; ncols = 512; dr = 2304; }
        else if ((r -= 128) < 128) { col0 = 2832; ncols = 512; dr = 2816; sc = 0.08838834764831845f; }
        else if ((r -= 128) < 768) { col0 = 3344; ncols = 3072; dr = 3328; }
        else { r -= 768; col0 = 2304; ncols = 16; dr = 6400; }
        dst = (bf16_t*)(wt + WT_WIN) + (size_t)dr * D;
    } else if ((r -= 1616) < 256) { src = p.w_mem_kv + (size_t)l * D * 1024; ld = 1024; col0 = 0; ncols = 1024; K = D; gain = p.g_mem + l * D; dst = (bf16_t*)(wt + WT_WMEM); }
    else if ((r -= 256) < 384) { const int sg = r / 128; r -= sg * 128; src = (sg == 0 ? p.w_br0 : sg == 1 ? p.w_br1 : p.w_br2) + (size_t)l * 512 * 1024; ld = 1024; col0 = 0; ncols = 1024; K = 512; dst = (bf16_t*)(wt + WT_WBR) + (size_t)sg * 1024 * 512; }
    else if ((r -= 384) < 256) { src = p.w_out + (size_t)l * D * D; ld = 1024; col0 = 0; ncols = 1024; K = D; dst = (bf16_t*)(wt + WT_WOUT); }
    else if ((r -= 256) < 1024) { src = p.w_ff1 + (size_t)l * D * DFF; ld = DFF; col0 = 0; ncols = DFF; K = D; gain = p.g_ffn + l * D; dst = (bf16_t*)(wt + WT_FF1); }
    else { r -= 1024; src = p.w_ff2 + (size_t)l * DFF * D; ld = D; col0 = 0; ncols = D; K = DFF; dst = (bf16_t*)(wt + WT_FF2); }
    const int nnb = (ncols + 63) / 64, kb = r / nnb, nb = r % nnb, c0 = nb * 64, nc = (ncols - c0) < 64 ? (ncols - c0) : 64;
    convert_tile_w(src, ld, col0 + c0, nc, kb * 64, gain, sc, dst + (size_t)c0 * K, K, tile, lane);
}
__device__ __forceinline__ void rowstat_rows(const float* src, int rows, bf16_t* xb, float* rowss, int gw, int ngw, int lane) {
    for (int r = gw; r < rows; r += 2 * ngw) {
        const int r1 = r + ngw; const bool two = r1 < rows;
        const float4* s0 = (const float4*)(src + (size_t)r * D); const float4* s1 = (const float4*)(src + (size_t)(two ? r1 : r) * D);
        float4 a[4], b[4];
#pragma unroll
        for (int j = 0; j < 4; ++j) { a[j] = s0[lane + 64 * j]; b[j] = s1[lane + 64 * j]; }
        float ssa = 0.f, ssb = 0.f;
#pragma unroll
        for (int j = 0; j < 4; ++j) { ssa += a[j].x * a[j].x + a[j].y * a[j].y + a[j].z * a[j].z + a[j].w * a[j].w; ssb += b[j].x * b[j].x + b[j].y * b[j].y + b[j].z * b[j].z + b[j].w * b[j].w;
            uint2 o; o.x = pk2(a[j].x, a[j].y); o.y = pk2(a[j].z, a[j].w); *(uint2*)(xb + (size_t)r * D + 4 * (lane + 64 * j)) = o;
            if (two) { uint2 o1; o1.x = pk2(b[j].x, b[j].y); o1.y = pk2(b[j].z, b[j].w); *(uint2*)(xb + (size_t)r1 * D + 4 * (lane + 64 * j)) = o1; } }
        ssa = wave_sum(ssa); ssb = wave_sum(ssb);
        if (lane < 16) { rowss[(size_t)r * 16 + lane] = lane == 0 ? ssa : 0.f; if (two) rowss[(size_t)r1 * 16 + lane] = lane == 0 ? ssb : 0.f; }
    }
}
__device__ __forceinline__ void finalnorm_rows(const bf16_t* xb, float* out, const float* rowss, const float* g, int gw, int ngw, int lane) {
    for (int r = gw; r < M; r += ngw) {
        const float rstd = rstd_of(rowss, r);
#pragma unroll
        for (int j = 0; j < 2; ++j) { float x[8]; unpack8(*(const uint4*)(xb + (size_t)r * D + 8 * (lane + 64 * j)), x);
            const float4 g0 = *(const float4*)(g + 8 * (lane + 64 * j)), g1 = *(const float4*)(g + 8 * (lane + 64 * j) + 4);
            float4 o0, o1; o0.x = x[0] * rstd * g0.x; o0.y = x[1] * rstd * g0.y; o0.z = x[2] * rstd * g0.z; o0.w = x[3] * rstd * g0.w;
            o1.x = x[4] * rstd * g1.x; o1.y = x[5] * rstd * g1.y; o1.z = x[6] * rstd * g1.z; o1.w = x[7] * rstd * g1.w;
            *(float4*)(out + (size_t)r * D + 8 * (lane + 64 * j)) = o0; *(float4*)(out + (size_t)r * D + 8 * (lane + 64 * j) + 4) = o1; }
    }
}

typedef short bf16x8 __attribute__((ext_vector_type(8)));
typedef short s16x4 __attribute__((ext_vector_type(4)));
typedef float f32x16 __attribute__((ext_vector_type(16)));
typedef float f32x2 __attribute__((ext_vector_type(2)));
typedef __bf16 bf16x2v __attribute__((ext_vector_type(2)));
#define MFMA32(a, b, c) __builtin_amdgcn_mfma_f32_32x32x16_bf16((a), (b), (c), 0, 0, 0)
__device__ __forceinline__ int crow(int reg, int h) { return (reg & 3) + 8 * (reg >> 2) + 4 * h; }
__device__ __forceinline__ unsigned pkbf(float a, float b) { return __builtin_bit_cast(unsigned, __builtin_convertvector((f32x2){a, b}, bf16x2v)); }
__device__ __forceinline__ bf16x8 pack_step(const f32x16& x, int s) {
    u32x4 p; p.x = pkbf(x[8 * s], x[8 * s + 1]); p.y = pkbf(x[8 * s + 2], x[8 * s + 3]); p.z = pkbf(x[8 * s + 4], x[8 * s + 5]); p.w = pkbf(x[8 * s + 6], x[8 * s + 7]);
    return __builtin_bit_cast(bf16x8, p);
}
__device__ __forceinline__ bf16x8 tr_frag(const LAS unsigned char* img, int row_lo, int row_hi, int lane) {
    const int i16 = lane & 15, q = i16 >> 2, p = i16 & 3, blk = (lane >> 4) & 1;
    const s16x4 lo = __builtin_amdgcn_ds_read_tr16_b64_v4i16((LAS s16x4*)(img + (row_lo + q) * 64 + 32 * blk + 8 * p));
    const s16x4 hi = __builtin_amdgcn_ds_read_tr16_b64_v4i16((LAS s16x4*)(img + (row_hi + q) * 64 + 32 * blk + 8 * p));
    return __builtin_shufflevector(lo, hi, 0, 1, 2, 3, 4, 5, 6, 7);
}

constexpr int SWA_KIMG = 0, SWA_VIMG = 256 * 144, SWA_TAB = SWA_VIMG + 2 * 16384;
__device__ __forceinline__ void swa_mfma_unit(const P& p, const LB& L, int l, int u, LAS unsigned char* l3) {
    int tid_l = threadIdx.x; asm volatile("" : "+v"(tid_l)); const int tid = tid_l, lane = tid & 63, wave = tid >> 6, h = lane >> 5, ql = lane & 31;
    const int hkv = u & 1, n = (u >> 1) & 15, b = u >> 5;
    __syncthreads();
#pragma unroll
    for (int i = 0; i < 4; ++i) {
        const int c = tid + 512 * i, row = c >> 3, cc = c & 7, t = 128 * (n - 1) + row;
        u32x4 kv = (u32x4){0u, 0u, 0u, 0u}, vv = (u32x4){0u, 0u, 0u, 0u};
        if (t >= 0) { const bf16_t* src = L.skv + (size_t)(b * T + t) * 256 + hkv * 64 + cc * 8; kv = *(const u32x4*)src; vv = *(const u32x4*)(src + 128); }
        *(LAS u32x4*)(l3 + SWA_KIMG + row * 144 + cc * 16) = kv;
        *(LAS u32x4*)(l3 + SWA_VIMG + (cc >> 2) * 16384 + row * 64 + (cc & 3) * 16) = vv;
    }
    for (int idx = tid; idx < 4 * 192; idx += 512) { const int g = idx / 192, e = idx % 192, dist = 159 - e;
        ((LAS float*)(l3 + SWA_TAB))[idx] = (dist >= 0 && dist < 128) ? p.rel_bias[(int)T5_BUCKET[dist] * 8 + hkv * 4 + g] : -1e30f; }
    __syncthreads();
    const int g = wave >> 1, half = wave & 1, hq = hkv * 4 + g;
    const float sink = p.sinks[l * 8 + hq];
    const LAS float* tab = (const LAS float*)(l3 + SWA_TAB) + g * 192 + 31 - ql;
#pragma unroll 1
    for (int sb = 0; sb < 2; ++sb) {
        const int r0 = 64 * half + 32 * sb, kb0 = 2 * half + sb;
        bf16_t* qptr = L.sq + (size_t)(b * T + 128 * n + r0 + ql) * 512 + hq * 64;
        bf16x8 Qf[4];
#pragma unroll
        for (int ks = 0; ks < 4; ++ks) Qf[ks] = *(const bf16x8*)(qptr + 16 * ks + 8 * h);
        f32x16 S[5];
#pragma unroll
        for (int i = 0; i < 5; ++i) {
#pragma unroll
            for (int r = 0; r < 16; ++r) S[i][r] = 0.f;
#pragma unroll
            for (int ks = 0; ks < 4; ++ks) { const bf16x8 Kf = *(const LAS bf16x8*)(l3 + SWA_KIMG + (32 * (kb0 + i) + ql) * 144 + 32 * ks + 16 * h); S[i] = MFMA32(Kf, Qf[ks], S[i]); }
        }
        float m = sink;
#pragma unroll
        for (int i = 0; i < 5; ++i)
#pragma unroll
            for (int r = 0; r < 16; ++r) { const int kk = 32 * i + crow(r, h); float sv = S[i][r] + tab[kk];
                if (n == 0 && 32 * kb0 + kk < 128) sv = -1e30f;
                S[i][r] = sv; m = fmaxf(m, sv); }
        m = fmaxf(m, __shfl_xor(m, 32));
        float lsum = 0.f;
#pragma unroll
        for (int i = 0; i < 5; ++i)
#pragma unroll
            for (int r = 0; r < 16; ++r) { const float pe = __expf(S[i][r] - m); S[i][r] = pe; lsum += pe; }
        lsum += __shfl_xor(lsum, 32);
        f32x16 O[2];
#pragma unroll
        for (int db = 0; db < 2; ++db)
#pragma unroll
            for (int r = 0; r < 16; ++r) O[db][r] = 0.f;
#pragma unroll
        for (int i = 0; i < 5; ++i)
#pragma unroll
            for (int s2 = 0; s2 < 2; ++s2) { const bf16x8 Pf = pack_step(S[i], s2); const int k0 = 32 * (kb0 + i) + 16 * s2;
#pragma unroll
                for (int db = 0; db < 2; ++db) { const bf16x8 Vf = tr_frag(l3 + SWA_VIMG + db * 16384, k0 + 4 * h, k0 + 8 + 4 * h, lane); O[db] = MFMA32(Vf, Pf, O[db]); } }
        const float inv = 1.f / (lsum + __expf(sink - m));
#pragma unroll
        for (int db = 0; db < 2; ++db)
#pragma unroll
            for (int gq = 0; gq < 4; ++gq) { uint2 w; w.x = pkbf(O[db][4 * gq] * inv, O[db][4 * gq + 1] * inv); w.y = pkbf(O[db][4 * gq + 2] * inv, O[db][4 * gq + 3] * inv);
                *(uint2*)(qptr + 32 * db + 8 * gq + 4 * h) = w; }
    }
}

constexpr int XA_KIMG = 0, XA_VIMG = 256 * 272;
__device__ __forceinline__ void xattn_mfma_unit(const LB& L, int u, LAS unsigned char* l3) {
    int tid_l = threadIdx.x; asm volatile("" : "+v"(tid_l)); const int tid = tid_l, lane = tid & 63, wave = tid >> 6, h = lane >> 5, ql = lane & 31;
    const int qb = u & 7, hx = (u >> 3) & 3, b = u >> 5;
    __syncthreads();
#pragma unroll
    for (int i = 0; i < 8; ++i) {
        const int c = tid + 512 * i, row = c >> 4, cc = c & 15;
        const bf16_t* src = L.memkv + (size_t)(b * MEMLEN + row) * 1024 + hx * 128 + cc * 8;
        const u32x4 kv = *(const u32x4*)src, vv = *(const u32x4*)(src + 512);
        *(LAS u32x4*)(l3 + XA_KIMG + row * 272 + cc * 16) = kv;
        *(LAS u32x4*)(l3 + XA_VIMG + (cc >> 2) * 16384 + row * 64 + (cc & 3) * 16) = vv;
    }
    bf16_t* qptr = L.xq + (size_t)(b * T + qb * 256 + wave * 32 + ql) * 512 + hx * 128;
    bf16x8 Qf[8];
#pragma unroll
    for (int ks = 0; ks < 8; ++ks) Qf[ks] = *(const bf16x8*)(qptr + 16 * ks + 8 * h);
    __syncthreads();
    f32x16 S[8];
    {
#pragma unroll
        for (int i = 0; i < 8; ++i) {
#pragma unroll
            for (int r = 0; r < 16; ++r) S[i][r] = 0.f;
#pragma unroll
            for (int ks = 0; ks < 8; ++ks) { const bf16x8 Kf = *(const LAS bf16x8*)(l3 + XA_KIMG + (32 * i + ql) * 272 + 32 * ks + 16 * h); S[i] = MFMA32(Kf, Qf[ks], S[i]); }
        }
    }
    float m = -1e30f;
#pragma unroll
    for (int i = 0; i < 8; ++i)
#pragma unroll
        for (int r = 0; r < 16; ++r) m = fmaxf(m, S[i][r]);
    m = fmaxf(m, __shfl_xor(m, 32));
    float lsum = 0.f;
#pragma unroll
    for (int i = 0; i < 8; ++i)
#pragma unroll
        for (int r = 0; r < 16; ++r) { const float pe = __expf(S[i][r] - m); S[i][r] = pe; lsum += pe; }
    lsum += __shfl_xor(lsum, 32);
    f32x16 O[4];
#pragma unroll
    for (int db = 0; db < 4; ++db)
#pragma unroll
        for (int r = 0; r < 16; ++r) O[db][r] = 0.f;
#pragma unroll
    for (int i = 0; i < 8; ++i)
#pragma unroll
        for (int s2 = 0; s2 < 2; ++s2) { const bf16x8 Pf = pack_step(S[i], s2); const int k0 = 32 * i + 16 * s2;
#pragma unroll
            for (int db = 0; db < 4; ++db) { const bf16x8 Vf = tr_frag(l3 + XA_VIMG + db * 16384, k0 + 4 * h, k0 + 8 + 4 * h, lane); O[db] = MFMA32(Vf, Pf, O[db]); } }
    const float inv = 1.f / lsum;
#pragma unroll
    for (int db = 0; db < 4; ++db)
#pragma unroll
        for (int gq = 0; gq < 4; ++gq) { uint2 w; w.x = pkbf(O[db][4 * gq] * inv, O[db][4 * gq + 1] * inv); w.y = pkbf(O[db][4 * gq + 2] * inv, O[db][4 * gq + 3] * inv);
            *(uint2*)(qptr + 32 * db + 8 * gq + 4 * h) = w; }
}


__device__ __forceinline__ float log_sigmoid_f(float x) { return x >= 0.f ? -log1pf(expf(-x)) : x - log1pf(expf(x)); }
__device__ __forceinline__ void mlstm_gates_wave(const P& p, const LB& L, int l, int b, int c, int hh, int lane, float& bcum, float& ig) {
    const size_t row = (size_t)b * T + c * 64 + lane;
    ig = L.iff[row * 16 + hh] + p.b_i[l * 8 + hh];
    float v = log_sigmoid_f(L.iff[row * 16 + 8 + hh] + p.b_f[l * 8 + hh]);
#pragma unroll
    for (int o = 1; o < 64; o <<= 1) { const float t = __shfl_up(v, o); if (lane >= o) v += t; }
    bcum = v;
}
constexpr int MA_SLOT = 18368, MA_XK = 0, MA_VIMG = 8704, MA_T0 = 16896;
__device__ __forceinline__ void mlstm_A_mfma_unit(const P& p, const LB& L, int l, int u, LAS unsigned char* l3) {
    int tid_l = threadIdx.x; asm volatile("" : "+v"(tid_l)); const int tid = tid_l, lane = tid & 63, hh = tid >> 6, h = lane >> 5, ql = lane & 31;
    const int c = u & 31, b = u >> 5, uh = u * 8 + hh;
    LAS unsigned char* wl = l3 + hh * MA_SLOT;
    const float* cw = p.conv_w + (size_t)l * 4 * 1024;
    __syncthreads();
    for (int idx = lane; idx < 67 * 8; idx += 64) { const int row = idx >> 3, cc = idx & 7, t = c * 64 - 3 + row; u32x4 v = (u32x4){0u, 0u, 0u, 0u};
        if (t >= 0) v = *(const u32x4*)(L.mqk + (size_t)(b * T + t) * 1024 + 512 + hh * 64 + cc * 8);
        *(LAS u32x4*)(wl + MA_XK + row * 128 + cc * 16) = v; }
#pragma unroll
    for (int i = 0; i < 8; ++i) { const int s = (lane >> 3) + 8 * i, cc = lane & 7;
        const u32x4 v = *(const u32x4*)(L.mv + (size_t)(b * T + c * 64 + s) * 512 + hh * 64 + cc * 8);
        *(LAS u32x4*)(wl + MA_VIMG + (cc >> 2) * 4096 + s * 64 + (cc & 3) * 16) = v; }
    float bcum, ig; mlstm_gates_wave(p, L, l, b, c, hh, lane, bcum, ig);
    const float g = __shfl(bcum, 63), alog = g - bcum + ig, ml = wave_max(alog);
    ((LAS float*)(wl + MA_T0))[lane] = __expf(alog - ml);
    __syncthreads();
    f32x16 acc[2][2];
#pragma unroll
    for (int a = 0; a < 2; ++a)
#pragma unroll
        for (int d = 0; d < 2; ++d)
#pragma unroll
            for (int r = 0; r < 16; ++r) acc[a][d][r] = 0.f;
    float dnacc[2] = {0.f, 0.f};
    float cwr[2][4];
#pragma unroll
    for (int dkb = 0; dkb < 2; ++dkb)
#pragma unroll
        for (int tap = 0; tap < 4; ++tap) cwr[dkb][tap] = cw[tap * 1024 + 512 + hh * 64 + 32 * dkb + ql];
#pragma unroll
    for (int ks = 0; ks < 4; ++ks) {
        const int s0 = 16 * ks + 8 * h;
        const f32x4 we0 = *(const LAS f32x4*)(wl + MA_T0 + s0 * 4), we1 = *(const LAS f32x4*)(wl + MA_T0 + s0 * 4 + 16);
        const float we[8] = {we0[0], we0[1], we0[2], we0[3], we1[0], we1[1], we1[2], we1[3]};
        bf16x8 WKf[2];
#pragma unroll
        for (int dkb = 0; dkb < 2; ++dkb) {
            float x[11];
#pragma unroll
            for (int r = 0; r < 11; ++r) x[r] = bf2f(*(const LAS unsigned short*)(wl + MA_XK + (s0 + r) * 128 + (32 * dkb + ql) * 2));
            float wk[8];
#pragma unroll
            for (int j = 0; j < 8; ++j) { const float cv = fmaf(cwr[dkb][3], x[j + 3], fmaf(cwr[dkb][2], x[j + 2], fmaf(cwr[dkb][1], x[j + 1], cwr[dkb][0] * x[j])));
                wk[j] = cv * 0.125f * __builtin_amdgcn_rcpf(1.f + __expf(-cv)) * we[j]; dnacc[dkb] += wk[j]; }
            u32x4 w; w.x = pkbf(wk[0], wk[1]); w.y = pkbf(wk[2], wk[3]); w.z = pkbf(wk[4], wk[5]); w.w = pkbf(wk[6], wk[7]);
            WKf[dkb] = __builtin_bit_cast(bf16x8, w);
        }
#pragma unroll
        for (int dvb = 0; dvb < 2; ++dvb) { const bf16x8 Vf = tr_frag(wl + MA_VIMG + dvb * 4096, s0, s0 + 4, lane);
#pragma unroll
            for (int dkb = 0; dkb < 2; ++dkb) acc[dkb][dvb] = MFMA32(WKf[dkb], Vf, acc[dkb][dvb]); }
    }
    bf16_t* st = L.state + (size_t)uh * 4096;
#pragma unroll
    for (int dkb = 0; dkb < 2; ++dkb)
#pragma unroll
        for (int dvb = 0; dvb < 2; ++dvb)
#pragma unroll
            for (int gq = 0; gq < 4; ++gq) { uint2 w; w.x = pkbf(acc[dkb][dvb][4 * gq], acc[dkb][dvb][4 * gq + 1]); w.y = pkbf(acc[dkb][dvb][4 * gq + 2], acc[dkb][dvb][4 * gq + 3]);
                *(uint2*)(st + (32 * dvb + ql) * 64 + 32 * dkb + 8 * gq + 4 * h) = w; }
#pragma unroll
    for (int dkb = 0; dkb < 2; ++dkb) { const float t = dnacc[dkb] + __shfl_xor(dnacc[dkb], 32); if (h == 0) ws_f(p.ws, WS_DN)[(size_t)uh * 64 + 32 * dkb + ql] = t; }
    if (lane == 0) { ws_f(p.ws, WS_G)[uh] = g; ws_f(p.ws, WS_ML)[uh] = ml; }
}
__device__ __forceinline__ void mlstm_scan2_unit(const P& p, const LB& L, int u) {
    int tid_l = threadIdx.x; asm volatile("" : "+v"(tid_l)); const int tid = tid_l, bh = u >> 2, b = bh >> 3, hh = bh & 7, e = (u & 3) * 1024 + 2 * tid;
    const bool first = (u & 3) == 0; const bool do_n = first && tid < 64;
    float *G = ws_f(p.ws, WS_G), *ML = ws_f(p.ws, WS_ML), *MIN = ws_f(p.ws, WS_MIN), *DN = ws_f(p.ws, WS_DN);
    unsigned d[NCH]; float dn[NCH];
#pragma unroll
    for (int c = 0; c < NCH; ++c) { const int idx = (b * NCH + c) * 8 + hh; d[c] = *(const unsigned*)(L.state + (size_t)idx * 4096 + e); dn[c] = do_n ? DN[(size_t)idx * 64 + tid] : 0.f; }
    float m = 0.f, n = 0.f, C0 = 0.f, C1 = 0.f;
#pragma unroll
    for (int c = 0; c < NCH; ++c) { const int idx = (b * NCH + c) * 8 + hh; const float g = G[idx], ml = ML[idx], mn = fmaxf(g + m, ml), a = __expf(g + m - mn), sc = __expf(ml - mn);
        *(unsigned*)(L.state + (size_t)idx * 4096 + e) = pkbf(C0, C1);
        C0 = fmaf(C0, a, sc * __uint_as_float(d[c] << 16)); C1 = fmaf(C1, a, sc * __uint_as_float(d[c] & 0xffff0000u));
        if (do_n) { DN[(size_t)idx * 64 + tid] = n; n = a * n + sc * dn[c]; }
        if (first && tid == 0) MIN[idx] = m;
        m = mn; }
}
constexpr int MC_SLOT = 31232, MC_XQ = 0, MC_XK = 9728, MC_VIMG = 19456, MC_CW = 27648, MC_T0 = 29696, MC_T1 = 29952, MC_T2 = 30208, MC_T3 = 30464, MC_T4 = 30720  , MC_T5 = 30976  ;
__device__ __forceinline__ bf16x8 conv_frag_lds(const LAS unsigned char* img, int tok, int ch0, const LAS float* cwl, float scale) {
    float a[8] = {0.f, 0.f, 0.f, 0.f, 0.f, 0.f, 0.f, 0.f};
#pragma unroll
    for (int tap = 0; tap < 4; ++tap) {
        float xf[8]; unpack8(__builtin_bit_cast(uint4, *(const LAS u32x4*)(img + (tok + tap) * 144 + ch0 * 2)), xf);
        const f32x4 w0 = *(const LAS f32x4*)(cwl + tap * 128 + ch0), w1 = *(const LAS f32x4*)(cwl + tap * 128 + ch0 + 4);
        a[0] = fmaf(w0[0], xf[0], a[0]); a[1] = fmaf(w0[1], xf[1], a[1]); a[2] = fmaf(w0[2], xf[2], a[2]); a[3] = fmaf(w0[3], xf[3], a[3]);
        a[4] = fmaf(w1[0], xf[4], a[4]); a[5] = fmaf(w1[1], xf[5], a[5]); a[6] = fmaf(w1[2], xf[6], a[6]); a[7] = fmaf(w1[3], xf[7], a[7]);
    }
#pragma unroll
    for (int j = 0; j < 8; ++j) a[j] = a[j] * scale * __builtin_amdgcn_rcpf(1.f + __expf(-a[j]));
    u32x4 w; w.x = pkbf(a[0], a[1]); w.y = pkbf(a[2], a[3]); w.z = pkbf(a[4], a[5]); w.w = pkbf(a[6], a[7]);
    return __builtin_bit_cast(bf16x8, w);
}
template <int TB>
__device__ __forceinline__ void mlstm_C_block(const LB& L, int b, int c, int hh, int lane, int h, int ql, LAS unsigned char* wl, const bf16x8 (&Cf)[2][4], const uint2 (&mo)[2][4]) {
    const LAS float* cwl = (const LAS float*)(wl + MC_CW);
    bf16x8 Qf[4]; float qn = 0.f;
#pragma unroll
    for (int ks = 0; ks < 4; ++ks) { const int ch0 = 16 * ks + 8 * h;
        Qf[ks] = conv_frag_lds(wl + MC_XQ, 32 * TB + ql, ch0, cwl, 1.f);
        const f32x4 n0 = *(const LAS f32x4*)(wl + MC_T4 + ch0 * 4), n1 = *(const LAS f32x4*)(wl + MC_T4 + ch0 * 4 + 16);
        float qv[8]; unpack8(__builtin_bit_cast(uint4, Qf[ks]), qv);
#pragma unroll
        for (int j = 0; j < 4; ++j) { qn = fmaf(qv[j], n0[j], qn); qn = fmaf(qv[j + 4], n1[j], qn); } }
    f32x16 S0, S1;
#pragma unroll
    for (int r = 0; r < 16; ++r) { S0[r] = 0.f; S1[r] = 0.f; }
#pragma unroll
    for (int ks = 0; ks < 4; ++ks) { const int ch0 = 16 * ks + 8 * h;
        S0 = MFMA32(conv_frag_lds(wl + MC_XK, ql, ch0, cwl + 64, 0.125f), Qf[ks], S0);
        if (TB == 1) S1 = MFMA32(conv_frag_lds(wl + MC_XK, 32 + ql, ch0, cwl + 64, 0.125f), Qf[ks], S1); }
    const float Mt = ((const LAS float*)(wl + MC_T1))[32 * TB + ql];
    float dsum = 0.f;
#pragma unroll
    for (int gq = 0; gq < 4; ++gq) {
        const f32x4 a0 = *(const LAS f32x4*)(wl + MC_T0 + (8 * gq + 4 * h) * 4), a1 = *(const LAS f32x4*)(wl + MC_T0 + (32 + 8 * gq + 4 * h) * 4);
#pragma unroll
        for (int j = 0; j < 4; ++j) { const int r = 4 * gq + j, sl = 8 * gq + 4 * h + j;
            if (TB == 0) { const float v = sl <= ql ? S0[r] * __expf(a0[j] - Mt) : 0.f; S0[r] = v; dsum += v; }
            else { const float v0 = S0[r] * __expf(a0[j] - Mt); S0[r] = v0; const float v1 = sl <= ql ? S1[r] * __expf(a1[j] - Mt) : 0.f; S1[r] = v1; dsum += v0 + v1; } }
    }
    f32x16 acc[2];
#pragma unroll
    for (int d = 0; d < 2; ++d)
#pragma unroll
        for (int r = 0; r < 16; ++r) acc[d][r] = 0.f;
#pragma unroll
    for (int ks = 0; ks < 4; ++ks)
#pragma unroll
        for (int dvb = 0; dvb < 2; ++dvb) acc[dvb] = MFMA32(Cf[dvb][ks], Qf[ks], acc[dvb]);
    const float iw = ((const LAS float*)(wl + MC_T2))[32 * TB + ql];
#pragma unroll
    for (int dvb = 0; dvb < 2; ++dvb)
#pragma unroll
        for (int r = 0; r < 16; ++r) acc[dvb][r] *= iw;
#pragma unroll
    for (int s2 = 0; s2 < 2; ++s2) {
        const bf16x8 P0 = pack_step(S0, s2), P1 = pack_step(S1, s2);
#pragma unroll
        for (int dvb = 0; dvb < 2; ++dvb) {
            acc[dvb] = MFMA32(tr_frag(wl + MC_VIMG + dvb * 4096, 16 * s2 + 4 * h, 16 * s2 + 8 + 4 * h, lane), P0, acc[dvb]);
            if (TB == 1) acc[dvb] = MFMA32(tr_frag(wl + MC_VIMG + dvb * 4096, 32 + 16 * s2 + 4 * h, 32 + 16 * s2 + 8 + 4 * h, lane), P1, acc[dvb]); }
    }
    dsum += __shfl_xor(dsum, 32); qn += __shfl_xor(qn, 32);
    const float den = dsum + iw * qn, mt = ((const LAS float*)(wl + MC_T3))[32 * TB + ql];
    const float sc = 1.f / fmaxf(fabsf(den), __expf(-mt));
    float sum = 0.f;
#pragma unroll
    for (int dvb = 0; dvb < 2; ++dvb)
#pragma unroll
        for (int r = 0; r < 16; ++r) { const float v = acc[dvb][r] * sc; acc[dvb][r] = v; sum += v; }
    sum += __shfl_xor(sum, 32); const float mu = sum * (1.f / 64.f);
    float var = 0.f;
#pragma unroll
    for (int dvb = 0; dvb < 2; ++dvb)
#pragma unroll
        for (int r = 0; r < 16; ++r) { const float dlt = acc[dvb][r] - mu; var += dlt * dlt; }
    var += __shfl_xor(var, 32); const float rstd = rsqrtf(var * (1.f / 64.f) + EPS);
    bf16_t* op = L.mo + (size_t)(b * T + c * 64 + 32 * TB + ql) * 512 + hh * 64;
#pragma unroll
    for (int dvb = 0; dvb < 2; ++dvb)
#pragma unroll
        for (int gq = 0; gq < 4; ++gq) { const int dv = 32 * dvb + 8 * gq + 4 * h; const f32x4 ng = *(const LAS f32x4*)(wl + MC_T5 + dv * 4);
            const uint2 mg = mo[dvb][gq];
            const float y0 = (acc[dvb][4 * gq] - mu) * rstd * ng[0] * __uint_as_float(mg.x << 16), y1 = (acc[dvb][4 * gq + 1] - mu) * rstd * ng[1] * __uint_as_float(mg.x & 0xffff0000u);
            const float y2 = (acc[dvb][4 * gq + 2] - mu) * rstd * ng[2] * __uint_as_float(mg.y << 16), y3 = (acc[dvb][4 * gq + 3] - mu) * rstd * ng[3] * __uint_as_float(mg.y & 0xffff0000u);
            uint2 w; w.x = pkbf(y0, y1); w.y = pkbf(y2, y3); *(uint2*)(op + dv) = w; }
}
__device__ __forceinline__ void mlstm_C_mfma_unit(const P& p, const LB& L, int l, int u, LAS unsigned char* l3) {
    int tid_l = threadIdx.x; asm volatile("" : "+v"(tid_l)); const int tid = tid_l, lane = tid & 63, wave = tid >> 6, h = lane >> 5, ql = lane & 31;
    const int hg = u & 1, c = (u >> 1) & 31, b = u >> 6, hh = 4 * hg + (wave >> 1), tb = wave & 1, uh = (b * 32 + c) * 8 + hh, l128 = tid & 127;
    LAS unsigned char* wl = l3 + (wave >> 1) * MC_SLOT;
    const float* cw = p.conv_w + (size_t)l * 4 * 1024;
    bf16x8 Cf[2][4]; uint2 mo[2][4];
    {
        const bf16_t* st = L.state + (size_t)uh * 4096; const bf16_t* op = L.mo + (size_t)(b * T + c * 64 + 32 * tb + ql) * 512 + hh * 64;
#pragma unroll
        for (int dvb = 0; dvb < 2; ++dvb) {
#pragma unroll
            for (int ks = 0; ks < 4; ++ks) Cf[dvb][ks] = *(const bf16x8*)(st + (32 * dvb + ql) * 64 + 16 * ks + 8 * h);
#pragma unroll
            for (int gq = 0; gq < 4; ++gq) mo[dvb][gq] = *(const uint2*)(op + 32 * dvb + 8 * gq + 4 * h);
        }
    }
    __syncthreads();
    for (int idx = l128; idx < 67 * 8; idx += 128) { const int row = idx >> 3, cc = idx & 7, t = c * 64 - 3 + row; u32x4 vq = (u32x4){0u, 0u, 0u, 0u}, vk = vq;
        if (t >= 0) { const bf16_t* src = L.mqk + (size_t)(b * T + t) * 1024 + hh * 64 + cc * 8; vq = *(const u32x4*)src; vk = *(const u32x4*)(src + 512); }
        *(LAS u32x4*)(wl + MC_XQ + row * 144 + cc * 16) = vq; *(LAS u32x4*)(wl + MC_XK + row * 144 + cc * 16) = vk; }
#pragma unroll
    for (int i = 0; i < 4; ++i) { const int s = (l128 >> 3) + 16 * i, cc = l128 & 7;
        const u32x4 v = *(const u32x4*)(L.mv + (size_t)(b * T + c * 64 + s) * 512 + hh * 64 + cc * 8);
        *(LAS u32x4*)(wl + MC_VIMG + (cc >> 2) * 4096 + s * 64 + (cc & 3) * 16) = v; }
#pragma unroll
    for (int i = 0; i < 4; ++i) { const int e = l128 + 128 * i, tap = e >> 7, wch = e & 127;
        ((LAS float*)(wl + MC_CW))[e] = cw[tap * 1024 + (wch >> 6) * 512 + hh * 64 + (wch & 63)]; }
    {
        float bcum, ig; mlstm_gates_wave(p, L, l, b, c, hh, lane, bcum, ig);
        const float a = ig - bcum; float v = a;
#pragma unroll
        for (int o = 1; o < 64; o <<= 1) { const float t = __shfl_up(v, o); if (lane >= o) v = fmaxf(v, t); }
        const float m_in = ws_f(p.ws, WS_MIN)[uh], Mt = fmaxf(v, m_in);
        if (tb == 1) { ((LAS float*)(wl + MC_T4))[lane] = ws_f(p.ws, WS_DN)[(size_t)uh * 64 + lane]; ((LAS float*)(wl + MC_T5))[lane] = p.norm_g[l * 512 + hh * 64 + lane]; }
        if (tb == 0) { ((LAS float*)(wl + MC_T0))[lane] = a; ((LAS float*)(wl + MC_T1))[lane] = Mt; ((LAS float*)(wl + MC_T2))[lane] = __expf(m_in - Mt); ((LAS float*)(wl + MC_T3))[lane] = bcum + Mt; }
    }
    __syncthreads();
    if (tb == 0) mlstm_C_block<0>(L, b, c, hh, lane, h, ql, wl, Cf, mo);
    else mlstm_C_block<1>(L, b, c, hh, lane, h, ql, wl, Cf, mo);
}

#define XB_TMO      128
#define XB_XCNT(j)  (256  + 64 * (j))
#define XB_XSUB(j)  (1280 + 64 * (j))
#define XB_XGEN(j)  (2304 + 64 * (j))
#define XB_TOP      3328
#define XB_TOPGEN   3392
#define XCD_BAR_WORDS 3456
#define XB_SPIN_CAP (1u << 18)

__device__ __forceinline__ unsigned xb_ld(unsigned* p)              { return __hip_atomic_load(p, __ATOMIC_RELAXED, __HIP_MEMORY_SCOPE_AGENT); }
__device__ __forceinline__ unsigned xb_add(unsigned* p, unsigned v) { return __hip_atomic_fetch_add(p, v, __ATOMIC_RELAXED, __HIP_MEMORY_SCOPE_AGENT); }
__device__ __forceinline__ unsigned xb_xcc_id() { return (unsigned)__builtin_amdgcn_s_getreg((3 << 11) | 20) & 0xFu; }
#define XB_SPIN(cond, bar) do { unsigned _sp = 0; while (cond) { __builtin_amdgcn_s_sleep(1); \
    if ((++_sp & 255u) == 0u) { if (xb_ld(&(bar)[XB_TMO])) break; if (_sp > XB_SPIN_CAP) { atomicAdd(&(bar)[XB_TMO], 1u); break; } } } } while (0)

struct XcdBarrier {
    unsigned* bar; unsigned x;
    volatile LAS unsigned* st;
};

__device__ __forceinline__ XcdBarrier xcd_barrier_post(unsigned* bar, volatile LAS unsigned* st) {
    XcdBarrier b; b.bar = bar; b.x = xb_xcc_id(); b.st = st;
    if (threadIdx.x == 0) (void)xb_add(&bar[XB_XCNT(b.x)], 1u);
    return b;
}
__device__ __forceinline__ void xcd_barrier_complete(unsigned* bar, unsigned x, unsigned& nloc, unsigned& nx) {
    const unsigned G = gridDim.x * gridDim.y * gridDim.z;
    unsigned sum, cnt, mine, sp = 0u;
    for (;;) {
        sum = 0u; cnt = 0u; mine = 0u;
#pragma unroll
        for (unsigned j = 0; j < 16; ++j) { const unsigned c = xb_ld(&bar[XB_XCNT(j)]); sum += c; cnt += (c > 0u) ? 1u : 0u; mine = (j == x) ? c : mine; }
        if (sum == G) break;
        __builtin_amdgcn_s_sleep(1);
        if ((++sp & 255u) == 0u) { if (xb_ld(&bar[XB_TMO])) break; if (sp > XB_SPIN_CAP) { atomicAdd(&bar[XB_TMO], 1u); break; } }
    }
    nloc = mine > 0u ? mine : 1u; nx = cnt > 0u ? cnt : 1u;
}

__device__ __forceinline__ void xcd_barrier(const XcdBarrier& b) {
    asm volatile("s_waitcnt vmcnt(0)" ::: "memory");
    __syncthreads();
    if (threadIdx.x == 0) {
        unsigned* bar = b.bar;
        __builtin_amdgcn_s_waitcnt(0);
        unsigned nloc = b.st[0], nx = b.st[1];
        if (nloc == 0u) { xcd_barrier_complete(bar, b.x, nloc, nx); b.st[0] = nloc; b.st[1] = nx; }
        const unsigned old = xb_add(&bar[XB_XSUB(b.x)], 1u);
        const unsigned gen = old / nloc;
        if (old + 1u == (gen + 1u) * nloc) {
            __builtin_amdgcn_fence(__ATOMIC_RELEASE, "agent");
            asm volatile("s_waitcnt vmcnt(0)" ::: "memory");
            const unsigned og = xb_add(&bar[XB_TOP], 1u);
            const unsigned tg = og / nx;
            if (og + 1u == (tg + 1u) * nx) xb_add(&bar[XB_TOPGEN], 1u);
            else XB_SPIN(xb_ld(&bar[XB_TOPGEN]) == tg, bar);
            __builtin_amdgcn_fence(__ATOMIC_ACQUIRE, "agent");
            xb_add(&bar[XB_XGEN(b.x)], 1u);
            asm volatile("s_waitcnt vmcnt(0)" ::: "memory");
        } else {
            XB_SPIN(xb_ld(&bar[XB_XGEN(b.x)]) == gen, bar);
            __builtin_amdgcn_fence(__ATOMIC_ACQUIRE, "agent");
            asm volatile("s_waitcnt vmcnt(0)" ::: "memory");
        }
    }
    __syncthreads();
}

__global__ void __launch_bounds__(512, 2) mk_fwd(P p) {
    extern __shared__ __attribute__((aligned(16))) unsigned char lds[];
    LAS unsigned char* l3 = (LAS unsigned char*)lds;
    float* fl = (float*)lds;
    const int G = gridDim.x, bx = blockIdx.x;
    if (threadIdx.x < 64) ((LAS unsigned*)(l3 + LDS_CTL))[threadIdx.x] = 0u;
    __syncthreads();
    (void)xcd_barrier_post((unsigned*)(p.ws + WS_BAR), (volatile LAS unsigned*)(l3 + LDS_CTL + 32));
#define PR_T0 (*(volatile LAS unsigned long long*)(l3 + LDS_CTL + 64))
#define PR_ACC (*(volatile LAS unsigned long long*)(l3 + LDS_CTL + 72))
#define PH_BEGIN(id) do { if ((PROBE_MASK >> (id)) & 1) { if (bx == 0 && threadIdx.x == 0) PR_T0 = __builtin_amdgcn_s_memrealtime(); } } while (0)
#define PH_END(id) do { if ((PROBE_MASK >> (id)) & 1) { if (bx == 0 && threadIdx.x == 0) PR_ACC = PR_ACC + (__builtin_amdgcn_s_memrealtime() - PR_T0); } } while (0)
#define GRID_BAR() do { XcdBarrier b_; b_.bar = (unsigned*)(p.ws + WS_BAR); b_.x = xb_xcc_id(); b_.st = (volatile LAS unsigned*)(l3 + LDS_CTL + 32); xcd_barrier(b_); } while (0)
#define WAVE_IDS() int tid_w = threadIdx.x; asm volatile("" : "+v"(tid_w)); const int lane = tid_w & 63, gw = bx * 8 + (tid_w >> 6), ngw = G * 8

        PH_BEGIN(0);
    {
        WAVE_IDS();
        for (int it = gw; it < 2 * CV_ITEMS_LAYER; it += ngw) convert_item(p, it, fl + (tid_w >> 6) * (64 * 65), lane);
        rowstat_rows(p.x, M, layer_buf(p.ws, p.out, 0).xbin, ws_f(p.ws, WS_ROWSS), gw, ngw, lane);
        rowstat_rows(p.mem, MM, (bf16_t*)(p.ws + WS_MEMB), ws_f(p.ws, WS_ROWSS_MEM), gw, ngw, lane);
    }
    GRID_BAR();
        PH_END(0);

#pragma unroll 1
    for (int l = 0; l < 2; ++l) {
        PH_BEGIN(1);
        {
            const LB L = layer_buf(p.ws, p.out, l);
            pg8::Gemm g{L.xbin, L.win, M, 6656, D, (const bf16_t*)(p.ws + WS_MEMB)};
            SchedRounds S{G, bx, 6, 0, 1, 3};
            Unit u0, u3; S.next(0, u0); const bool has_tail = S.next(6, u3);
            fill_rstd_table(ws_f(p.ws, WS_ROWSS) + (size_t)(2 * l) * M * 16, u0.rm, (LAS float*)(l3 + LDS_RSTD0));
            if (has_tail) fill_rstd_table(u3.kind == 1 ? ws_f(p.ws, WS_ROWSS_MEM) : ws_f(p.ws, WS_ROWSS) + (size_t)(2 * l) * M * 16, u3.rm, (LAS float*)(l3 + LDS_RSTD1));
            __syncthreads();
            EpiProjMK E{L, (const LAS float*)(l3 + LDS_RSTD0), (const LAS float*)(l3 + LDS_RSTD1), u0.rm};
            pg8::gemm_phase<EpiProjMK, SchedRounds, true, true>(l3, g, S, E);
        }
        GRID_BAR();
        PH_END(1);
        PH_BEGIN(2);
        {
            const LB L = layer_buf(p.ws, p.out, l);
            PH_BEGIN(10); for (int u = bx; u < NB * 16 * 2; u += G) swa_mfma_unit(p, L, l, u, l3); PH_END(10);
            PH_BEGIN(11); for (int u = bx; u < NB * 4 * 8; u += G) xattn_mfma_unit(L, u, l3); PH_END(11);
            PH_BEGIN(12); for (int u = bx; u < NB * NCH; u += G) mlstm_A_mfma_unit(p, L, l, u, l3); PH_END(12);
        }
        GRID_BAR();
        PH_END(2);
        PH_BEGIN(3);
        {
            const LB L = layer_buf(p.ws, p.out, l);
            for (int u = bx; u < 256; u += G) mlstm_scan2_unit(p, L, u);
        }
        GRID_BAR();
        PH_END(3);
        PH_BEGIN(4);
        {
            const LB L = layer_buf(p.ws, p.out, l);
            for (int u = bx; u < NB * NCH * 2; u += G) mlstm_C_mfma_unit(p, L, l, u, l3);
        }
        GRID_BAR();
        PH_END(4);
        PH_BEGIN(6);
        {
            const LB L = layer_buf(p.ws, p.out, l);
            pg8::Gemm g{L.sq, L.wbr, 3 * M, 3 * D, 512, nullptr};
            SchedMerged S{G, bx};
            EpiMergedMK E{L.gates, L.merged};
            pg8::gemm_phase<EpiMergedMK, SchedMerged, true, true>(l3, g, S, E);
        }
        GRID_BAR();
        PH_END(6);
        PH_BEGIN(7);
        {
            const LB L = layer_buf(p.ws, p.out, l);
            pg8::Gemm g{L.merged, L.wout, M, D, D, nullptr};
            SchedRounds S{G, bx, 1, 0, 0, 99};
            EpiResidMK E{L.xbin, L.xbmid, ws_f(p.ws, WS_ROWSS) + (size_t)(2 * l + 1) * M * 16};
            pg8::gemm_phase<EpiResidMK, SchedRounds, true, true>(l3, g, S, E);
        }
        GRID_BAR();
        PH_END(7);
        PH_BEGIN(8);
        {
            const LB L = layer_buf(p.ws, p.out, l);
            pg8::Gemm g{L.xbmid, L.wff1, M, DFF, D, nullptr};
            SchedRounds S{G, bx, 4, 0, 0, 99};
            Unit u0; S.next(0, u0);
            fill_rstd_table(ws_f(p.ws, WS_ROWSS) + (size_t)(2 * l + 1) * M * 16, u0.rm, (LAS float*)(l3 + LDS_RSTD0));
            __syncthreads();
            EpiFF1MK E{L.hff, (const LAS float*)(l3 + LDS_RSTD0)};
            pg8::gemm_phase<EpiFF1MK, SchedRounds, true, true>(l3, g, S, E);
        }
        GRID_BAR();
        PH_END(8);
        PH_BEGIN(9);
        {
            const LB L = layer_buf(p.ws, p.out, l);
            pg8::Gemm g{L.hff, L.wff2, M, D, DFF, nullptr};
            SchedRounds S{G, bx, 1, 0, 0, 99};
            EpiResidMK E{L.xbmid, L.xbnext, ws_f(p.ws, WS_ROWSS) + (size_t)(2 * l + 2) * M * 16};
            pg8::gemm_phase<EpiResidMK, SchedRounds, true, true>(l3, g, S, E);
        }
        GRID_BAR();
        PH_END(9);
    }
    {
        WAVE_IDS();
        finalnorm_rows(layer_buf(p.ws, p.out, 1).xbnext, p.out, ws_f(p.ws, WS_ROWSS) + (size_t)4 * M * 16, p.g_final, gw, ngw, lane);
    }
    if (PROBE_MASK != 0 && bx == 0 && threadIdx.x == 0) { const unsigned long long te = __builtin_amdgcn_s_memrealtime(); const unsigned long long acc_ = PR_ACC; while (__builtin_amdgcn_s_memrealtime() - te < 10ull * acc_) __builtin_amdgcn_s_sleep(8); }
}
}

extern "C" void kernel_launch(void* const* d_in, const int* in_sizes, int n_in, void* d_out, int out_size, void* d_ws, size_t ws_size, hipStream_t stream) {
    static int grid = 0;
    if (grid == 0) {
        if (n_in != 20 || out_size != M * D || ws_size < WS_END) { fprintf(stderr, "kernel_launch: unexpected shapes (n_in %d out %d ws %zu)\n", n_in, out_size, ws_size); grid = -1; return; }
        int dev = 0, cus = 0, per_cu = 0;
        if (hipGetDevice(&dev) != hipSuccess || hipDeviceGetAttribute(&cus, hipDeviceAttributeMultiprocessorCount, dev) != hipSuccess) { fprintf(stderr, "kernel_launch: device query failed\n"); grid = -1; return; }
        if (hipFuncSetAttribute((const void*)mk_fwd, hipFuncAttributeMaxDynamicSharedMemorySize, LDS_BYTES) != hipSuccess) { fprintf(stderr, "kernel_launch: hipFuncSetAttribute failed\n"); grid = -1; return; }
        if (hipOccupancyMaxActiveBlocksPerMultiprocessor(&per_cu, (const void*)mk_fwd, 512, LDS_BYTES) != hipSuccess || per_cu < 1) { fprintf(stderr, "kernel_launch: occupancy query says %d blocks per CU\n", per_cu); grid = -1; return; }
        if (cus != 256) { fprintf(stderr, "kernel_launch: built for a 256-CU device (unit orders assume 256 workgroups); found %d CUs\n", cus); grid = -1; return; }
        grid = cus * (per_cu >= 1 ? 1 : 0);
    }
    if (grid < 0) return;
    P p{};
    const float** pf = (const float**)&p;
    for (int i = 0; i < 20; ++i) pf[i] = (const float*)d_in[i];
    p.out = (float*)d_out; p.ws = (unsigned char*)d_ws;
    if (hipMemsetAsync(d_ws, 0, WS_ZERO_BYTES, stream) != hipSuccess) { fprintf(stderr, "kernel_launch: memset failed\n"); return; }
    void* args[] = {&p};
    const hipError_t e = hipLaunchCooperativeKernel((const void*)mk_fwd, dim3(grid), dim3(512), args, LDS_BYTES, stream);
    if (e != hipSuccess) fprintf(stderr, "kernel_launch: cooperative launch failed: %s (grid %d)\n", hipGetErrorString(e), grid);
}
```

```cpp
#include <hip/hip_runtime.h>
#include <cstdio>
#include <cstdint>
#ifndef PROBE_MASK
#define PROBE_MASK 0
#endif

namespace pg8 {
#define PG8_LAS __attribute__((address_space(3)))
typedef unsigned short bf16_t;
typedef short bf16x8 __attribute__((ext_vector_type(8)));
typedef float f32x4 __attribute__((ext_vector_type(4)));
typedef unsigned u32x4 __attribute__((ext_vector_type(4)));
constexpr int BM = 256, BK = 64, HALF = 128, HTB = HALF * BK * 2  , STAGE_BYTES = 8 * HTB, NXCD = 8, WGM = 8;

__host__ __device__ __forceinline__ int lds_byte(int r, int c) { const int st = (r >> 4) * 2 + (c >> 5), rr = r & 15, cc = c & 31, ob = rr * 64 + cc * 2; return st * 1024 + (ob ^ (((ob >> 9) & 1) << 5)); }
__host__ __device__ __forceinline__ void stage_rc(int b, int& R, int& C) { const int st = b / 1024, sb = b % 1024, swz = sb ^ (((sb >> 9) & 1) << 5); R = (st >> 1) * 16 + swz / 64; C = (st & 1) * 32 + (swz % 64) / 2; }
__host__ __device__ __forceinline__ int perm32(int rho) { const int n = rho >> 4, i = rho & 15; return 8 * (i >> 2) + 4 * n + (i & 3); }
struct Unit { int pm, pn, rm, kind, asel; };
struct Gemm { const bf16_t* A; const bf16_t* Bt; int M, N, K; const bf16_t* A2; };
__device__ __forceinline__ unsigned cvt_pk_bf16(float lo, float hi) { unsigned r; asm volatile("v_cvt_pk_bf16_f32 %0, %1, %2" : "=v"(r) : "v"(lo), "v"(hi)); return r; }
template <class Epi, class Sched, bool ALIGN_EPI = false, bool SP2 = false>
__device__ __forceinline__ void gemm_phase(PG8_LAS unsigned char* lds, const Gemm g, const Sched& S, const Epi& E) {
    int tid_l = threadIdx.x; asm volatile("" : "+v"(tid_l));
    const int tid = tid_l, wid = __builtin_amdgcn_readfirstlane(tid >> 6), lane = tid & 63, wr = wid >> 2, wc = wid & 3, fr = lane & 15, fq = lane >> 4;
    const int K = g.K, nt = K / BK;
    unsigned voffA[2], voffB[2];
#pragma unroll
    for (int i = 0; i < 2; ++i) { int R, C; stage_rc(tid * 16 + i * 8192, R, C); const int Rb = Epi::PERM ? ((R & ~31) + perm32(R & 31)) : R;
        voffA[i] = (unsigned)(R * K + C) * 2u; voffB[i] = (unsigned)(Rb * K + C) * 2u; }
    const size_t kstep = (size_t)(BK * 2);
    const size_t hstep = (size_t)HALF * K * 2;
    const size_t tstep = 2 * hstep;
    const unsigned ldsw = (unsigned)wid * 1024u;
    const int aoff = lds_byte(wr * 64 + fr, fq * 8), boff = lds_byte(wc * 32 + fr, fq * 8);
#define PG8_SA(b, h) (((b) * 2 + (h)) * HTB)
#define PG8_SB(b, h) ((4 + (b) * 2 + (h)) * HTB)
#define PG8_STAGE(bufoff, gbase, voff) do { _Pragma("unroll") for (int _i = 0; _i < 2; ++_i) \
        __builtin_amdgcn_global_load_lds((const unsigned*)((const char*)(gbase) + (voff)[_i]), (PG8_LAS unsigned*)(lds + (bufoff) + ldsw + _i * 8192), 16, 0, 0); } while (0)
#define PG8_LDA(dst, b, h) do { _Pragma("unroll") for (int m = 0; m < 4; ++m) _Pragma("unroll") for (int k = 0; k < 2; ++k) dst[m][k] = *(const PG8_LAS bf16x8*)(lds + PG8_SA(b, h) + aoff + m * 2048 + k * 1024); } while (0)
#define PG8_LDB(dst, b, h) do { _Pragma("unroll") for (int n = 0; n < 2; ++n) _Pragma("unroll") for (int k = 0; k < 2; ++k) dst[n][k] = *(const PG8_LAS bf16x8*)(lds + PG8_SB(b, h) + boff + n * 2048 + k * 1024); } while (0)
#define PG8_MMA(ai, bj, At, Bt) do { __builtin_amdgcn_s_setprio(1); _Pragma("unroll") for (int m = 0; m < 4; ++m) _Pragma("unroll") for (int n = 0; n < 2; ++n) _Pragma("unroll") for (int k = 0; k < 2; ++k) \
        acc[ai][bj][m][n] = __builtin_amdgcn_mfma_f32_16x16x32_bf16(Bt[n][k], At[m][k], acc[ai][bj][m][n], 0, 0, 0); __builtin_amdgcn_s_setprio(0); } while (0)
#define PG8_WAIT_V(n) asm volatile("s_waitcnt vmcnt(" #n ")" ::: "memory")
#define PG8_WAIT_L(n) asm volatile("s_waitcnt lgkmcnt(" #n ")" ::: "memory")
#define PG8_BAR __builtin_amdgcn_s_barrier()
#define PG8_SCHED __builtin_amdgcn_sched_barrier(0)
    Unit cur, nxt; int ui = 0;
    if (!S.next(0, cur)) return;
    f32x4 acc[2][2][4][2];
#pragma unroll
    for (int a = 0; a < 2; ++a)
#pragma unroll
        for (int b = 0; b < 2; ++b)
#pragma unroll
            for (int m = 0; m < 4; ++m)
#pragma unroll
                for (int n = 0; n < 2; ++n) acc[a][b][m][n] = (f32x4){0.f, 0.f, 0.f, 0.f};
    bf16x8 At[4][2], B0[2][2], B1[2][2];
    const char* cA = (const char*)(cur.asel ? g.A2 : g.A) + (size_t)cur.pm * tstep; const char* cB = (const char*)g.Bt + (size_t)cur.pn * tstep;
    S.a_ready(cur);
    if constexpr (SP2) {
        PG8_STAGE(PG8_SB(0, 0), cB, voffB); PG8_STAGE(PG8_SB(0, 1), cB + hstep, voffB); PG8_STAGE(PG8_SA(0, 0), cA, voffA); PG8_STAGE(PG8_SA(0, 1), cA + hstep, voffA);
        if (wr == 1) PG8_BAR;
        PG8_WAIT_V(2); PG8_BAR;
        PG8_STAGE(PG8_SB(1, 0), cB + kstep, voffB); PG8_STAGE(PG8_SA(1, 0), cA + kstep, voffA); PG8_STAGE(PG8_SB(1, 1), cB + hstep + kstep, voffB);
        PG8_WAIT_V(6); PG8_BAR;
    } else {
        PG8_STAGE(PG8_SB(0, 0), cB, voffB); PG8_STAGE(PG8_SA(0, 0), cA, voffA); PG8_STAGE(PG8_SB(0, 1), cB + hstep, voffB); PG8_STAGE(PG8_SA(0, 1), cA + hstep, voffA);
        if (wr == 1) PG8_BAR;
        PG8_WAIT_V(4); PG8_BAR;
        PG8_STAGE(PG8_SB(1, 0), cB + kstep, voffB); PG8_STAGE(PG8_SA(1, 0), cA + kstep, voffA); PG8_STAGE(PG8_SB(1, 1), cB + hstep + kstep, voffB);
        PG8_WAIT_V(6); PG8_BAR;
    }
    for (;;) {
        const bool has_next = S.next(ui + 1, nxt);
        const char* nA = has_next ? (const char*)(nxt.asel ? g.A2 : g.A) + (size_t)nxt.pm * tstep : cA; const char* nB = has_next ? (const char*)g.Bt + (size_t)nxt.pn * tstep : cB;
        for (int t = 0; t < nt; t += 2) {
            const bool last = (t == nt - 2);
            const char* a1 = cA + (size_t)(t + 1) * kstep;
            const char* a2 = last ? nA : cA + (size_t)(t + 2) * kstep; const char* b2 = last ? nB : cB + (size_t)(t + 2) * kstep;
            const char* a3 = a2 + kstep; const char* b3 = b2 + kstep;
            if (last && has_next) S.a_ready(nxt);
            if constexpr (SP2) {
            PG8_LDB(B0, 0, 0); PG8_LDB(B1, 0, 1); PG8_SCHED; PG8_LDA(At, 0, 0); PG8_STAGE(PG8_SA(1, 1), a1 + hstep, voffA);
            PG8_WAIT_V(8); PG8_WAIT_L(0); PG8_BAR; PG8_MMA(0, 0, At, B0); PG8_MMA(0, 1, At, B1); PG8_BAR; PG8_SCHED;
            PG8_LDA(At, 0, 1); PG8_STAGE(PG8_SB(0, 0), b2, voffB); PG8_STAGE(PG8_SB(0, 1), b2 + hstep, voffB); PG8_STAGE(PG8_SA(0, 0), a2, voffA);
            PG8_WAIT_V(8); PG8_WAIT_L(0); PG8_BAR; PG8_MMA(1, 0, At, B0); PG8_MMA(1, 1, At, B1); PG8_BAR; PG8_SCHED;
            PG8_LDB(B0, 1, 0); PG8_LDB(B1, 1, 1); PG8_SCHED; PG8_LDA(At, 1, 0); PG8_STAGE(PG8_SA(0, 1), a2 + hstep, voffA);
            PG8_WAIT_V(8); PG8_WAIT_L(0); PG8_BAR; PG8_MMA(0, 0, At, B0); PG8_MMA(0, 1, At, B1); PG8_BAR; PG8_SCHED;
            PG8_LDA(At, 1, 1); PG8_STAGE(PG8_SB(1, 0), b3, voffB); PG8_STAGE(PG8_SB(1, 1), b3 + hstep, voffB); PG8_STAGE(PG8_SA(1, 0), a3, voffA);
            PG8_WAIT_V(8); PG8_WAIT_L(0); PG8_BAR; PG8_MMA(1, 0, At, B0); PG8_MMA(1, 1, At, B1); PG8_BAR; PG8_SCHED;
            } else {
            PG8_LDB(B0, 0, 0); PG8_SCHED; PG8_LDA(At, 0, 0); PG8_STAGE(PG8_SA(1, 1), a1 + hstep, voffA);
            PG8_WAIT_L(8); PG8_BAR; PG8_WAIT_L(0); PG8_MMA(0, 0, At, B0); PG8_BAR; PG8_SCHED;
            PG8_LDB(B1, 0, 1); PG8_STAGE(PG8_SB(0, 0), b2, voffB);
            PG8_BAR; PG8_WAIT_L(0); PG8_MMA(0, 1, At, B1); PG8_BAR;
            PG8_LDA(At, 0, 1); PG8_STAGE(PG8_SA(0, 0), a2, voffA);
            PG8_BAR; PG8_WAIT_L(0); PG8_MMA(1, 0, At, B0); PG8_BAR; PG8_SCHED;
            PG8_STAGE(PG8_SB(0, 1), b2 + hstep, voffB);
            PG8_WAIT_V(6); PG8_BAR; PG8_MMA(1, 1, At, B1); PG8_BAR;
            PG8_LDB(B0, 1, 0); PG8_SCHED; PG8_LDA(At, 1, 0); PG8_STAGE(PG8_SA(0, 1), a2 + hstep, voffA);
            PG8_WAIT_L(8); PG8_BAR; PG8_WAIT_L(0); PG8_MMA(0, 0, At, B0); PG8_BAR; PG8_SCHED;
            PG8_LDB(B1, 1, 1); PG8_STAGE(PG8_SB(1, 0), b3, voffB);
            PG8_BAR; PG8_WAIT_L(0); PG8_MMA(0, 1, At, B1); PG8_BAR;
            PG8_LDA(At, 1, 1); PG8_STAGE(PG8_SA(1, 0), a3, voffA);
            PG8_BAR; PG8_WAIT_L(0); PG8_MMA(1, 0, At, B0); PG8_BAR; PG8_SCHED;
            PG8_STAGE(PG8_SB(1, 1), b3 + hstep, voffB);
            PG8_WAIT_V(6); PG8_BAR; PG8_MMA(1, 1, At, B1); PG8_BAR;
            }
        }
        if constexpr (ALIGN_EPI) { if (wr == 0) PG8_BAR; }
        if constexpr (!Epi::AFTER_DRAIN) { E(acc, cur, wr, wc, fr, fq); S.done(cur); }
        const bool keep_acc = E.keep(cur);
        if (!has_next) break;
        if (!keep_acc) {
#pragma unroll
        for (int a = 0; a < 2; ++a)
#pragma unroll
            for (int b = 0; b < 2; ++b)
#pragma unroll
                for (int m = 0; m < 4; ++m)
#pragma unroll
                    for (int n = 0; n < 2; ++n) acc[a][b][m][n] = (f32x4){0.f, 0.f, 0.f, 0.f};
        }
        cur = nxt; cA = nA; cB = nB; ++ui;
        if constexpr (ALIGN_EPI) { if (wr == 1) PG8_BAR; }
    }
    PG8_WAIT_V(0);
    if constexpr (!ALIGN_EPI) { if (wr == 0) PG8_BAR; }
    PG8_BAR;
    if constexpr (Epi::AFTER_DRAIN) { E.fused(acc, cur, wr, wc, fr, fq, lds, wid, lane); S.done(cur); }
#undef PG8_SA
#undef PG8_SB
#undef PG8_STAGE
#undef PG8_LDA
#undef PG8_LDB
#undef PG8_MMA
#undef PG8_WAIT_V
#undef PG8_WAIT_L
#undef PG8_BAR
#undef PG8_SCHED
}
}

namespace {
using pg8::bf16_t; using pg8::f32x4; using pg8::u32x4; using pg8::Unit;
#define LAS __attribute__((address_space(3)))
constexpr int M = 16384, D = 1024, T = 2048, NB = 8, MEMLEN = 256, MM = NB * MEMLEN;
constexpr int INC = 6416, DFF = 4096, NCH = 32, NH = 8;
constexpr float EPS = 1e-6f;
constexpr size_t MiB = 1u << 20;
constexpr size_t WS_POOL_C = 77u << 20;
constexpr size_t WS_BAR = 0;
constexpr size_t WS_ROWSS = WS_POOL_C + 174 * (1u << 20);
constexpr size_t WS_ZERO_BYTES = 64 * 1024;
constexpr size_t WS_ROWSS_MEM = WS_POOL_C + 173 * (1u << 20);
constexpr size_t WS_G = 400 * 1024, WS_ML = 408 * 1024, WS_MIN = 416 * 1024;
constexpr size_t WS_DN = 512 * 1024;
constexpr size_t WS_WT = 1 * MiB;
constexpr size_t WT_WIN = 0, WT_WMEM = (size_t)6656 * D * 2, WT_WBR = WT_WMEM + (size_t)D * D * 2, WT_WOUT = WT_WBR + (size_t)3 * D * 512 * 2,
                 WT_FF1 = WT_WOUT + (size_t)D * D * 2, WT_FF2 = WT_FF1 + (size_t)DFF * D * 2, WT_LAYER = WT_FF2 + (size_t)D * DFF * 2;
constexpr size_t WS_MEMB = 73 * MiB, WS_POOL = 77 * MiB, WS_END = 256 * MiB;
static_assert(WS_WT + 2 * WT_LAYER <= WS_MEMB && WS_POOL_C == WS_POOL, "weights fit");
constexpr int LDS_RING = 131072, LDS_BYTES = 147456, LDS_CTL = LDS_BYTES - 256, LDS_RSTD0 = LDS_RING, LDS_RSTD1 = LDS_RING + 1024;

struct P {
    const float *x, *mem, *rel_bias, *g_mix, *w_in, *conv_w, *b_i, *b_f, *norm_g, *sinks, *g_mem, *w_mem_kv, *w_br0, *w_br1, *w_br2, *w_out, *g_ffn, *w_ff1, *w_ff2, *g_final;
    float* out; unsigned char* ws;
};
struct LB {
    bf16_t *xbin, *sq, *mo, *xq, *skv, *mqk, *mv, *memkv, *merged, *xbmid, *hff, *xbnext;
    unsigned char* gates;
    float* iff; bf16_t* state;
    const bf16_t *win, *wmem, *wbr, *wout, *wff1, *wff2;
};
__host__ __device__ inline LB layer_buf(unsigned char* ws, float* out, int l) {
    LB b; unsigned char* pool = ws + WS_POOL; unsigned char* breg = pool;
    b.xbin = (bf16_t*)out; b.xbmid = (bf16_t*)((unsigned char*)out + 32 * MiB); b.xbnext = l == 1 ? (bf16_t*)(pool + 128 * MiB) : (bf16_t*)out;
    b.merged = (bf16_t*)(pool + 48 * MiB); b.hff = (bf16_t*)pool;
    b.sq = (bf16_t*)breg; b.mo = (bf16_t*)(breg + 16 * MiB); b.xq = (bf16_t*)(breg + 32 * MiB);
    b.gates = pool + 125 * MiB;
    b.skv = (bf16_t*)(breg + 48 * MiB); b.mqk = (bf16_t*)(breg + 56 * MiB); b.mv = (bf16_t*)(breg + 88 * MiB);
    b.iff = (float*)(breg + 104 * MiB); b.memkv = (bf16_t*)(breg + 105 * MiB); b.state = (bf16_t*)(breg + 109 * MiB);
    unsigned char* wt = ws + WS_WT + (size_t)l * WT_LAYER;
    b.win = (const bf16_t*)(wt + WT_WIN); b.wmem = (const bf16_t*)(wt + WT_WMEM); b.wbr = (const bf16_t*)(wt + WT_WBR);
    b.wout = (const bf16_t*)(wt + WT_WOUT); b.wff1 = (const bf16_t*)(wt + WT_FF1); b.wff2 = (const bf16_t*)(wt + WT_FF2);
    return b;
}
__device__ __forceinline__ float* ws_f(unsigned char* ws, size_t off) { return (float*)(ws + off); }

__device__ __forceinline__ float bf2f(bf16_t h) { return __uint_as_float(((unsigned)h) << 16); }
__device__ __forceinline__ bf16_t f2bf(float f) { unsigned u = __float_as_uint(f); u = (u + 0x7fffu + ((u >> 16) & 1u)) >> 16; return (bf16_t)u; }
__device__ __forceinline__ unsigned pk2(float lo, float hi) { return (unsigned)f2bf(lo) | ((unsigned)f2bf(hi) << 16); }
__device__ __forceinline__ float sigmoidf_(float v) { return 1.f / (1.f + expf(-v)); }
__device__ __forceinline__ float fsigmoid(float v) { return __builtin_amdgcn_rcpf(1.f + __expf(-v)); }
__device__ __forceinline__ float wave_sum(float v) {
#pragma unroll
    for (int o = 1; o < 64; o <<= 1) v += __shfl_xor(v, o);
    return v;
}
__device__ __forceinline__ float wave_max(float v) {
#pragma unroll
    for (int o = 1; o < 64; o <<= 1) v = fmaxf(v, __shfl_xor(v, o));
    return v;
}
__device__ __forceinline__ void unpack8(const uint4 a, float (&f)[8]) {
    f[0] = __uint_as_float(a.x << 16); f[1] = __uint_as_float(a.x & 0xffff0000u); f[2] = __uint_as_float(a.y << 16); f[3] = __uint_as_float(a.y & 0xffff0000u);
    f[4] = __uint_as_float(a.z << 16); f[5] = __uint_as_float(a.z & 0xffff0000u); f[6] = __uint_as_float(a.w << 16); f[7] = __uint_as_float(a.w & 0xffff0000u);
}
__device__ const unsigned char T5_BUCKET[128] = {0, 1, 2, 3, 4, 5, 6, 7, 8, 9, 10, 11, 12, 13, 14, 15, 16, 16, 16, 17, 17, 18, 18, 18, 19, 19, 19, 20, 20, 20, 20, 21, 21, 21, 21, 22, 22, 22, 22, 22, 23, 23, 23, 23, 23, 23, 24, 24, 24, 24, 24, 24, 25, 25, 25, 25, 25, 25, 25, 26, 26, 26, 26, 26, 26, 26, 26, 27, 27, 27, 27, 27, 27, 27, 27, 27, 27, 28, 28, 28, 28, 28, 28, 28, 28, 28, 28, 29, 29, 29, 29, 29, 29, 29, 29, 29, 29, 29, 29, 30, 30, 30, 30, 30, 30, 30, 30, 30, 30, 30, 30, 30, 30, 31, 31, 31, 31, 31, 31, 31, 31, 31, 31, 31, 31, 31, 31, 31};

__device__ __forceinline__ float rstd_of(const float* rp, int row) {
    const f32x4* q = (const f32x4*)(rp + (size_t)row * 16); const f32x4 a = q[0], b = q[1], c = q[2], d = q[3];
    const float ss = ((a[0] + a[1]) + (a[2] + a[3])) + ((b[0] + b[1]) + (b[2] + b[3])) + (((c[0] + c[1]) + (c[2] + c[3])) + ((d[0] + d[1]) + (d[2] + d[3])));
    return rsqrtf(ss * (1.f / D) + EPS);
}
__device__ __forceinline__ void fill_rstd_table(const float* rp, int rm, LAS float* tab) {
    const int t = threadIdx.x; if (t < 256) tab[t] = rstd_of(rp, rm * 256 + t);
}
struct SchedRounds {
    int G, c, nfull, pn_base, tail, skip_at;
    __device__ __forceinline__ bool next(int i, Unit& u) const {
        const int L = i * G + c;
        if (L < nfull * 256) { const int r = L >> 8, w = L & 255, x = w & 7, j = w >> 3; u.pm = u.rm = 8 * x + (j & 7); u.pn = pn_base + 4 * r + (j >> 3) + (r >= skip_at ? 1 : 0); u.kind = 0; u.asel = 0; return true; }
        if (!tail) return false;
        const int t = L - nfull * 256;
        if (t < 64) { u.pm = u.rm = t; u.pn = 12; u.kind = 0; u.asel = 0; return true; }
        if (t < 128) { u.pm = u.rm = t - 64; u.pn = 25; u.kind = 0; u.asel = 0; return true; }
        if (t < 160) { const int q = t - 128; u.pm = u.rm = q >> 2; u.pn = 26 + (q & 3); u.kind = 1; u.asel = 1; return true; }
        return false;
    }
    __device__ __forceinline__ void a_ready(const Unit&) const {}
    __device__ __forceinline__ void done(const Unit&) const {}
};
struct SchedMerged {
    int G, c;
    __device__ __forceinline__ bool next(int i, Unit& u) const {
        const int tt = (i / 3) * G + c, seg = i % 3; if (tt >= 256) return false;
        const int x = tt & 7, j = tt >> 3; u.rm = 8 * x + (j & 7); u.pm = seg * 64 + u.rm; u.pn = seg * 4 + (j >> 3); u.kind = seg; u.asel = 0; return true;
    }
    __device__ __forceinline__ void a_ready(const Unit&) const {}
    __device__ __forceinline__ void done(const Unit&) const {}
};

__device__ __forceinline__ u32x4 pack8(f32x4 a, f32x4 b) { u32x4 w; w.x = pg8::cvt_pk_bf16(a[0], a[1]); w.y = pg8::cvt_pk_bf16(a[2], a[3]); w.z = pg8::cvt_pk_bf16(b[0], b[1]); w.w = pg8::cvt_pk_bf16(b[2], b[3]); return w; }
__device__ __forceinline__ f32x4 sig4(f32x4 v) { f32x4 r; r[0] = fsigmoid(v[0]); r[1] = fsigmoid(v[1]); r[2] = fsigmoid(v[2]); r[3] = fsigmoid(v[3]); return r; }
struct EpiProjMK {
    static constexpr bool PERM = true, AFTER_DRAIN = false;
    LB L; const LAS float* tab0; const LAS float* tab1; int rm0;
    __device__ __forceinline__ bool keep(const Unit&) const { return false; }
    __device__ __forceinline__ void operator()(f32x4 (&acc)[2][2][4][2], const Unit& u, int wr, int wc, int fr, int fq) const {
        const int rbase = u.rm * 256 + wr * 64 + fr, cin = wc * 32 + 8 * fq, rloc = wr * 64 + fr;
        const LAS float* rs = (u.kind == 0 && u.rm == rm0) ? tab0 : tab1; bf16_t* dst; int ld, coff; bool sig = false; const int tile = u.pn;
        if (u.kind == 1) { dst = L.memkv; ld = 1024; coff = (tile - 26) * 256; }
        else if (tile < 2) { dst = L.sq; ld = 512; coff = tile * 256; }
        else if (tile < 3) { dst = L.skv; ld = 256; coff = 0; }
        else if (tile < 7) { dst = L.mqk; ld = 1024; coff = (tile - 3) * 256; }
        else if (tile < 9) { dst = L.mv; ld = 512; coff = (tile - 7) * 256; }
        else if (tile < 11) { dst = L.mo; ld = 512; coff = (tile - 9) * 256; sig = true; }
        else if (tile < 13) { dst = L.xq; ld = 512; coff = (tile - 11) * 256; }
        else { dst = nullptr; ld = 0; coff = 0; }
#pragma unroll
        for (int ai = 0; ai < 2; ++ai)
#pragma unroll
            for (int m = 0; m < 4; ++m) {
                const int row = rbase + ai * 128 + m * 16; const float rstd = rs[rloc + ai * 128 + m * 16];
#pragma unroll
                for (int bj = 0; bj < 2; ++bj) {
                    f32x4 v0 = acc[ai][bj][m][0] * rstd, v1 = acc[ai][bj][m][1] * rstd;
                    if (dst) { if (sig) { v0 = sig4(v0); v1 = sig4(v1); }
                        *(u32x4*)(dst + (size_t)row * ld + coff + bj * 128 + cin) = pack8(v0, v1); }
                    else if (tile < 25) {
                        v0 = sig4(v0) * 256.f; v1 = sig4(v1) * 256.f; uint2 w;
                        w.x = (unsigned)fminf(v0[0], 255.f) | ((unsigned)fminf(v0[1], 255.f) << 8) | ((unsigned)fminf(v0[2], 255.f) << 16) | ((unsigned)fminf(v0[3], 255.f) << 24);
                        w.y = (unsigned)fminf(v1[0], 255.f) | ((unsigned)fminf(v1[1], 255.f) << 8) | ((unsigned)fminf(v1[2], 255.f) << 16) | ((unsigned)fminf(v1[3], 255.f) << 24);
                        *(uint2*)(L.gates + (size_t)row * 3072 + (tile - 13) * 256 + bj * 128 + cin) = w; }
                    else if (bj == 0 && cin < 16) { *(f32x4*)(L.iff + (size_t)row * 16 + cin) = v0; *(f32x4*)(L.iff + (size_t)row * 16 + cin + 4) = v1; }
                }
            }
    }
};
struct EpiMergedMK {
    static constexpr bool PERM = true, AFTER_DRAIN = false;
    const unsigned char* gates; bf16_t* merged;
    __device__ __forceinline__ bool keep(const Unit& u) const { return u.kind < 2; }
    __device__ __forceinline__ static void deq8(uint2 w, float (&g)[8]) {
        g[0] = (float)(w.x & 255u) + 0.5f; g[1] = (float)((w.x >> 8) & 255u) + 0.5f; g[2] = (float)((w.x >> 16) & 255u) + 0.5f; g[3] = (float)(w.x >> 24) + 0.5f;
        g[4] = (float)(w.y & 255u) + 0.5f; g[5] = (float)((w.y >> 8) & 255u) + 0.5f; g[6] = (float)((w.y >> 16) & 255u) + 0.5f; g[7] = (float)(w.y >> 24) + 0.5f; }
    __device__ __forceinline__ void operator()(f32x4 (&acc)[2][2][4][2], const Unit& u, int wr, int wc, int fr, int fq) const {
        const int rbase = u.rm * 256 + wr * 64 + fr, col0 = (u.pn & 3) * 256 + wc * 32 + 8 * fq, seg = u.kind;
#pragma unroll
        for (int ai = 0; ai < 2; ++ai) {
            uint2 gs[4][2], gn[4][2];
#pragma unroll
            for (int m = 0; m < 4; ++m)
#pragma unroll
                for (int bj = 0; bj < 2; ++bj) { const unsigned char* gp = gates + (size_t)(rbase + ai * 128 + m * 16) * 3072 + seg * 1024 + col0 + bj * 128;
                    gs[m][bj] = *(const uint2*)gp; gn[m][bj] = seg < 2 ? *(const uint2*)(gp + 1024) : make_uint2(0u, 0u); }
#pragma unroll
            for (int m = 0; m < 4; ++m) {
                const int row = rbase + ai * 128 + m * 16;
#pragma unroll
                for (int bj = 0; bj < 2; ++bj) {
                    const int col = col0 + bj * 128;
                    float g[8]; deq8(gs[m][bj], g);
                    if (seg < 2) { float gd[8]; deq8(gn[m][bj], gd);
#pragma unroll
                        for (int j = 0; j < 8; ++j) g[j] = g[j] * __builtin_amdgcn_rcpf(gd[j]); }
                    else {
#pragma unroll
                        for (int j = 0; j < 8; ++j) g[j] *= (1.f / 256.f); }
                    f32x4 v0 = acc[ai][bj][m][0], v1 = acc[ai][bj][m][1];
                    v0[0] *= g[0]; v0[1] *= g[1]; v0[2] *= g[2]; v0[3] *= g[3]; v1[0] *= g[4]; v1[1] *= g[5]; v1[2] *= g[6]; v1[3] *= g[7];
                    acc[ai][bj][m][0] = v0; acc[ai][bj][m][1] = v1;
                    if (seg == 2) *(u32x4*)(merged + (size_t)row * D + col) = pack8(v0, v1);
                }
            }
            asm volatile("" ::: "memory");
        }
    }
};
struct EpiResidMK {
    static constexpr bool PERM = true, AFTER_DRAIN = false;
    const bf16_t* xold; bf16_t* xnew; float* rowss;
    __device__ __forceinline__ bool keep(const Unit&) const { return false; }
    __device__ __forceinline__ void operator()(f32x4 (&acc)[2][2][4][2], const Unit& u, int wr, int wc, int fr, int fq) const {
        const int rbase = u.rm * 256 + wr * 64 + fr, col0 = u.pn * 256 + wc * 32 + 8 * fq;
#pragma unroll
        for (int ai = 0; ai < 2; ++ai) {
            uint4 xo[4][2];
#pragma unroll
            for (int m = 0; m < 4; ++m)
#pragma unroll
                for (int bj = 0; bj < 2; ++bj) xo[m][bj] = *(const uint4*)(xold + (size_t)(rbase + ai * 128 + m * 16) * D + col0 + bj * 128);
#pragma unroll
            for (int m = 0; m < 4; ++m) {
                const int row = rbase + ai * 128 + m * 16; const size_t off = (size_t)row * D + col0; float ss = 0.f;
#pragma unroll
                for (int bj = 0; bj < 2; ++bj) {
                    float o[8]; unpack8(xo[m][bj], o);
                    f32x4 v0 = acc[ai][bj][m][0], v1 = acc[ai][bj][m][1];
                    v0[0] += o[0]; v0[1] += o[1]; v0[2] += o[2]; v0[3] += o[3]; v1[0] += o[4]; v1[1] += o[5]; v1[2] += o[6]; v1[3] += o[7];
                    const u32x4 w = pack8(v0, v1); *(u32x4*)(xnew + off + bj * 128) = w;
                    float r[8]; unpack8(__builtin_bit_cast(uint4, w), r);
#pragma unroll
                    for (int j = 0; j < 8; ++j) ss = fmaf(r[j], r[j], ss);
                }
                ss += __shfl_xor(ss, 16); ss += __shfl_xor(ss, 32);
                if (fq == 0) rowss[(size_t)row * 16 + (u.pn & 3) * 4 + wc] = ss;
            }
            asm volatile("" ::: "memory");
        }
    }
};
struct EpiFF1MK {
    static constexpr bool PERM = true, AFTER_DRAIN = false;
    bf16_t* h; const LAS float* tab0;
    __device__ __forceinline__ bool keep(const Unit&) const { return false; }
    __device__ __forceinline__ void operator()(f32x4 (&acc)[2][2][4][2], const Unit& u, int wr, int wc, int fr, int fq) const {
        const int rbase = u.rm * 256 + wr * 64 + fr, col0 = u.pn * 256 + wc * 32 + 8 * fq, rloc = wr * 64 + fr;
#pragma unroll
        for (int ai = 0; ai < 2; ++ai)
#pragma unroll
            for (int m = 0; m < 4; ++m) {
                const int row = rbase + ai * 128 + m * 16; const float rstd = tab0[rloc + ai * 128 + m * 16];
#pragma unroll
                for (int bj = 0; bj < 2; ++bj) {
                    f32x4 v0 = acc[ai][bj][m][0] * rstd, v1 = acc[ai][bj][m][1] * rstd;
#pragma unroll
                    for (int j = 0; j < 4; ++j) { v0[j] = fmaxf(v0[j], 0.f); v0[j] *= v0[j]; v1[j] = fmaxf(v1[j], 0.f); v1[j] *= v1[j]; }
                    *(u32x4*)(h + (size_t)row * DFF + col0 + bj * 128) = pack8(v0, v1);
                }
            }
    }
};

__device__ __forceinline__ void convert_tile_w(const float* src, int ldsrc, int col0, int ncols, int k0, const float* gain, float scale, bf16_t* dst, int K, float* tile, int lane) {
    const int n4 = (lane & 15) * 4;
    f32x4 v[16];
#pragma unroll
    for (int i = 0; i < 16; ++i) { const int kk = (lane >> 4) + 4 * i; v[i] = n4 < ncols ? *(const f32x4*)(src + (size_t)(k0 + kk) * ldsrc + col0 + n4) : (f32x4){0.f, 0.f, 0.f, 0.f}; }
#pragma unroll
    for (int i = 0; i < 16; ++i) { const int kk = (lane >> 4) + 4 * i; const f32x4 w = v[i] * ((gain ? gain[k0 + kk] : 1.f) * scale);
        tile[kk * 65 + n4] = w[0]; tile[kk * 65 + n4 + 1] = w[1]; tile[kk * 65 + n4 + 2] = w[2]; tile[kk * 65 + n4 + 3] = w[3]; }
    asm volatile("s_waitcnt lgkmcnt(0)" ::: "memory");
    const int kc = lane & 7;
#pragma unroll
    for (int i = 0; i < 8; ++i) { const int n = (lane >> 3) + 8 * i; const float* tp = tile + (8 * kc) * 65 + n;
        u32x4 w; w.x = pk2(tp[0], tp[65]); w.y = pk2(tp[130], tp[195]); w.z = pk2(tp[260], tp[325]); w.w = pk2(tp[390], tp[455]);
        if (n < ncols) *(u32x4*)(dst + (size_t)n * K + k0 + 8 * kc) = w; }
    asm volatile("s_waitcnt lgkmcnt(0)" ::: "memory");
}
constexpr int CV_ITEMS_LAYER = 4560;
__device__ __forceinline__ void convert_item(const P& p, int item, float* tile, int lane) {
    const int l = item / CV_ITEMS_LAYER; int r = item % CV_ITEMS_LAYER;
    unsigned char* wt = p.ws + WS_WT + (size_t)l * WT_LAYER;
    const float* src; const float* gain = nullptr; int ld, col0, ncols, K; float sc = 1.f; bf16_t* dst;
    if (r < 1616) {
        const float* win = p.w_in + (size_t)l * D * INC; src = win; ld = INC; K = D; gain = p.g_mix + l * D; int dr;
        if (r < 128) { col0 = 0; ncols = 512; dr = 0; sc = 0.125f; }
        else if ((r -= 128) < 448) { col0 = 512; ncols = 1792; dr = 512; }
        else if ((r -= 448) < 128) { col0 = 2320; ncols = 512; dr = 2304; }
        else if ((r -= 128) < 128) { col0 = 2832; ncols = 512; dr = 2816; sc = 0.08838834764831845f; }
        else if ((r -= 128) < 768) { col0 = 3344; ncols = 3072; dr = 3328; }
        else { r -= 768; col0 = 2304; ncols = 16; dr = 6400; }
        dst = (bf16_t*)(wt + WT_WIN) + (size_t)dr * D;
    } else if ((r -= 1616) < 256) { src = p.w_mem_kv + (size_t)l * D * 1024; ld = 1024; col0 = 0; ncols = 1024; K = D; gain = p.g_mem + l * D; dst = (bf16_t*)(wt + WT_WMEM); }
    else if ((r -= 256) < 384) { const int sg = r / 128; r -= sg * 128; src = (sg == 0 ? p.w_br0 : sg == 1 ? p.w_br1 : p.w_br2) + (size_t)l * 512 * 1024; ld = 1024; col0 = 0; ncols = 1024; K = 512; dst = (bf16_t*)(wt + WT_WBR) + (size_t)sg * 1024 * 512; }
    else if ((r -= 384) < 256) { src = p.w_out + (size_t)l * D * D; ld = 1024; col0 = 0; ncols = 1024; K = D; dst = (bf16_t*)(wt + WT_WOUT); }
    else if ((r -= 256) < 1024) { src = p.w_ff1 + (size_t)l * D * DFF; ld = DFF; col0 = 0; ncols = DFF; K = D; gain = p.g_ffn + l * D; dst = (bf16_t*)(wt + WT_FF1); }
    else { r -= 1024; src = p.w_ff2 + (size_t)l * DFF * D; ld = D; col0 = 0; ncols = D; K = DFF; dst = (bf16_t*)(wt + WT_FF2); }
    const int nnb = (ncols + 63) / 64, kb = r / nnb, nb = r % nnb, c0 = nb * 64, nc = (ncols - c0) < 64 ? (ncols - c0) : 64;
    convert_tile_w(src, ld, col0 + c0, nc, kb * 64, gain, sc, dst + (size_t)c0 * K, K, tile, lane);
}
__device__ __forceinline__ void rowstat_rows(const float* src, int rows, bf16_t* xb, float* rowss, int gw, int ngw, int lane) {
    for (int r = gw; r < rows; r += 2 * ngw) {
        const int r1 = r + ngw; const bool two = r1 < rows;
        const float4* s0 = (const float4*)(src + (size_t)r * D); const float4* s1 = (const float4*)(src + (size_t)(two ? r1 : r) * D);
        float4 a[4], b[4];
#pragma unroll
        for (int j = 0; j < 4; ++j) { a[j] = s0[lane + 64 * j]; b[j] = s1[lane + 64 * j]; }
        float ssa = 0.f, ssb = 0.f;
#pragma unroll
        for (int j = 0; j < 4; ++j) { ssa += a[j].x * a[j].x + a[j].y * a[j].y + a[j].z * a[j].z + a[j].w * a[j].w; ssb += b[j].x * b[j].x + b[j].y * b[j].y + b[j].z * b[j].z + b[j].w * b[j].w;
            uint2 o; o.x = pk2(a[j].x, a[j].y); o.y = pk2(a[j].z, a[j].w); *(uint2*)(xb + (size_t)r * D + 4 * (lane + 64 * j)) = o;
            if (two) { uint2 o1; o1.x = pk2(b[j].x, b[j].y); o1.y = pk2(b[j].z, b[j].w); *(uint2*)(xb + (size_t)r1 * D + 4 * (lane + 64 * j)) = o1; } }
        ssa = wave_sum(ssa); ssb = wave_sum(ssb);
        if (lane < 16) { rowss[(size_t)r * 16 + lane] = lane == 0 ? ssa : 0.f; if (two) rowss[(size_t)r1 * 16 + lane] = lane == 0 ? ssb : 0.f; }
    }
}
__device__ __forceinline__ void finalnorm_rows(const bf16_t* xb, float* out, const float* rowss, const float* g, int gw, int ngw, int lane) {
    for (int r = gw; r < M; r += ngw) {
        const float rstd = rstd_of(rowss, r);
#pragma unroll
        for (int j = 0; j < 2; ++j) { float x[8]; unpack8(*(const uint4*)(xb + (size_t)r * D + 8 * (lane + 64 * j)), x);
            const float4 g0 = *(const float4*)(g + 8 * (lane + 64 * j)), g1 = *(const float4*)(g + 8 * (lane + 64 * j) + 4);
            float4 o0, o1; o0.x = x[0] * rstd * g0.x; o0.y = x[1] * rstd * g0.y; o0.z = x[2] * rstd * g0.z; o0.w = x[3] * rstd * g0.w;
            o1.x = x[4] * rstd * g1.x; o1.y = x[5] * rstd * g1.y; o1.z = x[6] * rstd * g1.z; o1.w = x[7] * rstd * g1.w;
            *(float4*)(out + (size_t)r * D + 8 * (lane + 64 * j)) = o0; *(float4*)(out + (size_t)r * D + 8 * (lane + 64 * j) + 4) = o1; }
    }
}

typedef short bf16x8 __attribute__((ext_vector_type(8)));
typedef short s16x4 __attribute__((ext_vector_type(4)));
typedef float f32x16 __attribute__((ext_vector_type(16)));
typedef float f32x2 __attribute__((ext_vector_type(2)));
typedef __bf16 bf16x2v __attribute__((ext_vector_type(2)));
#define MFMA32(a, b, c) __builtin_amdgcn_mfma_f32_32x32x16_bf16((a), (b), (c), 0, 0, 0)
__device__ __forceinline__ int crow(int reg, int h) { return (reg & 3) + 8 * (reg >> 2) + 4 * h; }
__device__ __forceinline__ unsigned pkbf(float a, float b) { return __builtin_bit_cast(unsigned, __builtin_convertvector((f32x2){a, b}, bf16x2v)); }
__device__ __forceinline__ bf16x8 pack_step(const f32x16& x, int s) {
    u32x4 p; p.x = pkbf(x[8 * s], x[8 * s + 1]); p.y = pkbf(x[8 * s + 2], x[8 * s + 3]); p.z = pkbf(x[8 * s + 4], x[8 * s + 5]); p.w = pkbf(x[8 * s + 6], x[8 * s + 7]);
    return __builtin_bit_cast(bf16x8, p);
}
__device__ __forceinline__ bf16x8 tr_frag(const LAS unsigned char* img, int row_lo, int row_hi, int lane) {
    const int i16 = lane & 15, q = i16 >> 2, p = i16 & 3, blk = (lane >> 4) & 1;
    const s16x4 lo = __builtin_amdgcn_ds_read_tr16_b64_v4i16((LAS s16x4*)(img + (row_lo + q) * 64 + 32 * blk + 8 * p));
    const s16x4 hi = __builtin_amdgcn_ds_read_tr16_b64_v4i16((LAS s16x4*)(img + (row_hi + q) * 64 + 32 * blk + 8 * p));
    return __builtin_shufflevector(lo, hi, 0, 1, 2, 3, 4, 5, 6, 7);
}

constexpr int SWA_KIMG = 0, SWA_VIMG = 256 * 144, SWA_TAB = SWA_VIMG + 2 * 16384;
__device__ __forceinline__ void swa_mfma_unit(const P& p, const LB& L, int l, int u, LAS unsigned char* l3) {
    int tid_l = threadIdx.x; asm volatile("" : "+v"(tid_l)); const int tid = tid_l, lane = tid & 63, wave = tid >> 6, h = lane >> 5, ql = lane & 31;
    const int hkv = u & 1, n = (u >> 1) & 15, b = u >> 5;
    __syncthreads();
#pragma unroll
    for (int i = 0; i < 4; ++i) {
        const int c = tid + 512 * i, row = c >> 3, cc = c & 7, t = 128 * (n - 1) + row;
        u32x4 kv = (u32x4){0u, 0u, 0u, 0u}, vv = (u32x4){0u, 0u, 0u, 0u};
        if (t >= 0) { const bf16_t* src = L.skv + (size_t)(b * T + t) * 256 + hkv * 64 + cc * 8; kv = *(const u32x4*)src; vv = *(const u32x4*)(src + 128); }
        *(LAS u32x4*)(l3 + SWA_KIMG + row * 144 + cc * 16) = kv;
        *(LAS u32x4*)(l3 + SWA_VIMG + (cc >> 2) * 16384 + row * 64 + (cc & 3) * 16) = vv;
    }
    for (int idx = tid; idx < 4 * 192; idx += 512) { const int g = idx / 192, e = idx % 192, dist = 159 - e;
        ((LAS float*)(l3 + SWA_TAB))[idx] = (dist >= 0 && dist < 128) ? p.rel_bias[(int)T5_BUCKET[dist] * 8 + hkv * 4 + g] : -1e30f; }
    __syncthreads();
    const int g = wave >> 1, half = wave & 1, hq = hkv * 4 + g;
    const float sink = p.sinks[l * 8 + hq];
    const LAS float* tab = (const LAS float*)(l3 + SWA_TAB) + g * 192 + 31 - ql;
#pragma unroll 1
    for (int sb = 0; sb < 2; ++sb) {
        const int r0 = 64 * half + 32 * sb, kb0 = 2 * half + sb;
        bf16_t* qptr = L.sq + (size_t)(b * T + 128 * n + r0 + ql) * 512 + hq * 64;
        bf16x8 Qf[4];
#pragma unroll
        for (int ks = 0; ks < 4; ++ks) Qf[ks] = *(const bf16x8*)(qptr + 16 * ks + 8 * h);
        f32x16 S[5];
#pragma unroll
        for (int i = 0; i < 5; ++i) {
#pragma unroll
            for (int r = 0; r < 16; ++r) S[i][r] = 0.f;
#pragma unroll
            for (int ks = 0; ks < 4; ++ks) { const bf16x8 Kf = *(const LAS bf16x8*)(l3 + SWA_KIMG + (32 * (kb0 + i) + ql) * 144 + 32 * ks + 16 * h); S[i] = MFMA32(Kf, Qf[ks], S[i]); }
        }
        float m = sink;
#pragma unroll
        for (int i = 0; i < 5; ++i)
#pragma unroll
            for (int r = 0; r < 16; ++r) { const int kk = 32 * i + crow(r, h); float sv = S[i][r] + tab[kk];
                if (n == 0 && 32 * kb0 + kk < 128) sv = -1e30f;
                S[i][r] = sv; m = fmaxf(m, sv); }
        m = fmaxf(m, __shfl_xor(m, 32));
        float lsum = 0.f;
#pragma unroll
        for (int i = 0; i < 5; ++i)
#pragma unroll
            for (int r = 0; r < 16; ++r) { const float pe = __expf(S[i][r] - m); S[i][r] = pe; lsum += pe; }
        lsum += __shfl_xor(lsum, 32);
        f32x16 O[2];
#pragma unroll
        for (int db = 0; db < 2; ++db)
#pragma unroll
            for (int r = 0; r < 16; ++r) O[db][r] = 0.f;
#pragma unroll
        for (int i = 0; i < 5; ++i)
#pragma unroll
            for (int s2 = 0; s2 < 2; ++s2) { const bf16x8 Pf = pack_step(S[i], s2); const int k0 = 32 * (kb0 + i) + 16 * s2;
#pragma unroll
                for (int db = 0; db < 2; ++db) { const bf16x8 Vf = tr_frag(l3 + SWA_VIMG + db * 16384, k0 + 4 * h, k0 + 8 + 4 * h, lane); O[db] = MFMA32(Vf, Pf, O[db]); } }
        const float inv = 1.f / (lsum + __expf(sink - m));
#pragma unroll
        for (int db = 0; db < 2; ++db)
#pragma unroll
            for (int gq = 0; gq < 4; ++gq) { uint2 w; w.x = pkbf(O[db][4 * gq] * inv, O[db][4 * gq + 1] * inv); w.y = pkbf(O[db][4 * gq + 2] * inv, O[db][4 * gq + 3] * inv);
                *(uint2*)(qptr + 32 * db + 8 * gq + 4 * h) = w; }
    }
}

constexpr int XA_KIMG = 0, XA_VIMG = 256 * 272;
__device__ __forceinline__ void xattn_mfma_unit(const LB& L, int u, LAS unsigned char* l3) {
    int tid_l = threadIdx.x; asm volatile("" : "+v"(tid_l)); const int tid = tid_l, lane = tid & 63, wave = tid >> 6, h = lane >> 5, ql = lane & 31;
    const int qb = u & 7, hx = (u >> 3) & 3, b = u >> 5;
    __syncthreads();
#pragma unroll
    for (int i = 0; i < 8; ++i) {
        const int c = tid + 512 * i, row = c >> 4, cc = c & 15;
        const bf16_t* src = L.memkv + (size_t)(b * MEMLEN + row) * 1024 + hx * 128 + cc * 8;
        const u32x4 kv = *(const u32x4*)src, vv = *(const u32x4*)(src + 512);
        *(LAS u32x4*)(l3 + XA_KIMG + row * 272 + cc * 16) = kv;
        *(LAS u32x4*)(l3 + XA_VIMG + (cc >> 2) * 16384 + row * 64 + (cc & 3) * 16) = vv;
    }
    bf16_t* qptr = L.xq + (size_t)(b * T + qb * 256 + wave * 32 + ql) * 512 + hx * 128;
    bf16x8 Qf[8];
#pragma unroll
    for (int ks = 0; ks < 8; ++ks) Qf[ks] = *(const bf16x8*)(qptr + 16 * ks + 8 * h);
    __syncthreads();
    f32x16 S[8];
    {
#pragma unroll
        for (int i = 0; i < 8; ++i) {
#pragma unroll
            for (int r = 0; r < 16; ++r) S[i][r] = 0.f;
#pragma unroll
            for (int ks = 0; ks < 8; ++ks) { const bf16x8 Kf = *(const LAS bf16x8*)(l3 + XA_KIMG + (32 * i + ql) * 272 + 32 * ks + 16 * h); S[i] = MFMA32(Kf, Qf[ks], S[i]); }
        }
    }
    float m = -1e30f;
#pragma unroll
    for (int i = 0; i < 8; ++i)
#pragma unroll
        for (int r = 0; r < 16; ++r) m = fmaxf(m, S[i][r]);
    m = fmaxf(m, __shfl_xor(m, 32));
    float lsum = 0.f;
#pragma unroll
    for (int i = 0; i < 8; ++i)
#pragma unroll
        for (int r = 0; r < 16; ++r) { const float pe = __expf(S[i][r] - m); S[i][r] = pe; lsum += pe; }
    lsum += __shfl_xor(lsum, 32);
    f32x16 O[4];
#pragma unroll
    for (int db = 0; db < 4; ++db)
#pragma unroll
        for (int r = 0; r < 16; ++r) O[db][r] = 0.f;
#pragma unroll
    for (int i = 0; i < 8; ++i)
#pragma unroll
        for (int s2 = 0; s2 < 2; ++s2) { const bf16x8 Pf = pack_step(S[i], s2); const int k0 = 32 * i + 16 * s2;
#pragma unroll
            for (int db = 0; db < 4; ++db) { const bf16x8 Vf = tr_frag(l3 + XA_VIMG + db * 16384, k0 + 4 * h, k0 + 8 + 4 * h, lane); O[db] = MFMA32(Vf, Pf, O[db]); } }
    const float inv = 1.f / lsum;
#pragma unroll
    for (int db = 0; db < 4; ++db)
#pragma unroll
        for (int gq = 0; gq < 4; ++gq) { uint2 w; w.x = pkbf(O[db][4 * gq] * inv, O[db][4 * gq + 1] * inv); w.y = pkbf(O[db][4 * gq + 2] * inv, O[db][4 * gq + 3] * inv);
            *(uint2*)(qptr + 32 * db + 8 * gq + 4 * h) = w; }
}


__device__ __forceinline__ float log_sigmoid_f(float x) { return x >= 0.f ? -log1pf(expf(-x)) : x - log1pf(expf(x)); }
__device__ __forceinline__ void mlstm_gates_wave(const P& p, const LB& L, int l, int b, int c, int hh, int lane, float& bcum, float& ig) {
    const size_t row = (size_t)b * T + c * 64 + lane;
    ig = L.iff[row * 16 + hh] + p.b_i[l * 8 + hh];
    float v = log_sigmoid_f(L.iff[row * 16 + 8 + hh] + p.b_f[l * 8 + hh]);
#pragma unroll
    for (int o = 1; o < 64; o <<= 1) { const float t = __shfl_up(v, o); if (lane >= o) v += t; }
    bcum = v;
}
constexpr int MA_SLOT = 18368, MA_XK = 0, MA_VIMG = 8704, MA_T0 = 16896;
__device__ __forceinline__ void mlstm_A_mfma_unit(const P& p, const LB& L, int l, int u, LAS unsigned char* l3) {
    int tid_l = threadIdx.x; asm volatile("" : "+v"(tid_l)); const int tid = tid_l, lane = tid & 63, hh = tid >> 6, h = lane >> 5, ql = lane & 31;
    const int c = u & 31, b = u >> 5, uh = u * 8 + hh;
    LAS unsigned char* wl = l3 + hh * MA_SLOT;
    const float* cw = p.conv_w + (size_t)l * 4 * 1024;
    __syncthreads();
    {
        u32x4 xk[9], vv[8];
#pragma unroll
        for (int i = 0; i < 9; ++i) { const int idx = lane + 64 * i, ic = idx < 67 * 8 ? idx : 67 * 8 - 1, row = ic >> 3, cc = ic & 7, t = c * 64 - 3 + row;
            xk[i] = *(const u32x4*)(L.mqk + (size_t)(b * T + (t >= 0 ? t : 0)) * 1024 + 512 + hh * 64 + cc * 8); }
#pragma unroll
        for (int i = 0; i < 8; ++i) { const int s = (lane >> 3) + 8 * i, cc = lane & 7; vv[i] = *(const u32x4*)(L.mv + (size_t)(b * T + c * 64 + s) * 512 + hh * 64 + cc * 8); }
#pragma unroll
        for (int i = 0; i < 9; ++i) { const int idx = lane + 64 * i, row = idx >> 3, cc = idx & 7, t = c * 64 - 3 + row;
            if (idx < 67 * 8) *(LAS u32x4*)(wl + MA_XK + row * 128 + cc * 16) = t >= 0 ? xk[i] : (u32x4){0u, 0u, 0u, 0u}; }
#pragma unroll
        for (int i = 0; i < 8; ++i) { const int s = (lane >> 3) + 8 * i, cc = lane & 7; *(LAS u32x4*)(wl + MA_VIMG + (cc >> 2) * 4096 + s * 64 + (cc & 3) * 16) = vv[i]; }
    }
    float bcum, ig; mlstm_gates_wave(p, L, l, b, c, hh, lane, bcum, ig);
    const float g = __shfl(bcum, 63), alog = g - bcum + ig, ml = wave_max(alog);
    ((LAS float*)(wl + MA_T0))[lane] = __expf(alog - ml);
    __syncthreads();
    f32x16 acc[2][2];
#pragma unroll
    for (int a = 0; a < 2; ++a)
#pragma unroll
        for (int d = 0; d < 2; ++d)
#pragma unroll
            for (int r = 0; r < 16; ++r) acc[a][d][r] = 0.f;
    float dnacc[2] = {0.f, 0.f};
    float cwr[2][4];
#pragma unroll
    for (int dkb = 0; dkb < 2; ++dkb)
#pragma unroll
        for (int tap = 0; tap < 4; ++tap) cwr[dkb][tap] = cw[tap * 1024 + 512 + hh * 64 + 32 * dkb + ql];
#pragma unroll
    for (int ks = 0; ks < 4; ++ks) {
        const int s0 = 16 * ks + 8 * h;
        const f32x4 we0 = *(const LAS f32x4*)(wl + MA_T0 + s0 * 4), we1 = *(const LAS f32x4*)(wl + MA_T0 + s0 * 4 + 16);
        const float we[8] = {we0[0], we0[1], we0[2], we0[3], we1[0], we1[1], we1[2], we1[3]};
        bf16x8 WKf[2];
#pragma unroll
        for (int dkb = 0; dkb < 2; ++dkb) {
            float x[11];
#pragma unroll
            for (int r = 0; r < 11; ++r) x[r] = bf2f(*(const LAS unsigned short*)(wl + MA_XK + (s0 + r) * 128 + (32 * dkb + ql) * 2));
            float wk[8];
#pragma unroll
            for (int j = 0; j < 8; ++j) { const float cv = fmaf(cwr[dkb][3], x[j + 3], fmaf(cwr[dkb][2], x[j + 2], fmaf(cwr[dkb][1], x[j + 1], cwr[dkb][0] * x[j])));
                wk[j] = cv * 0.125f * __builtin_amdgcn_rcpf(1.f + __expf(-cv)) * we[j]; dnacc[dkb] += wk[j]; }
            u32x4 w; w.x = pkbf(wk[0], wk[1]); w.y = pkbf(wk[2], wk[3]); w.z = pkbf(wk[4], wk[5]); w.w = pkbf(wk[6], wk[7]);
            WKf[dkb] = __builtin_bit_cast(bf16x8, w);
        }
#pragma unroll
        for (int dvb = 0; dvb < 2; ++dvb) { const bf16x8 Vf = tr_frag(wl + MA_VIMG + dvb * 4096, s0, s0 + 4, lane);
#pragma unroll
            for (int dkb = 0; dkb < 2; ++dkb) acc[dkb][dvb] = MFMA32(WKf[dkb], Vf, acc[dkb][dvb]); }
    }
    bf16_t* st = L.state + (size_t)uh * 4096;
#pragma unroll
    for (int dkb = 0; dkb < 2; ++dkb)
#pragma unroll
        for (int dvb = 0; dvb < 2; ++dvb)
#pragma unroll
            for (int gq = 0; gq < 4; ++gq) { uint2 w; w.x = pkbf(acc[dkb][dvb][4 * gq], acc[dkb][dvb][4 * gq + 1]); w.y = pkbf(acc[dkb][dvb][4 * gq + 2], acc[dkb][dvb][4 * gq + 3]);
                *(uint2*)(st + (32 * dvb + ql) * 64 + 32 * dkb + 8 * gq + 4 * h) = w; }
#pragma unroll
    for (int dkb = 0; dkb < 2; ++dkb) { const float t = dnacc[dkb] + __shfl_xor(dnacc[dkb], 32); if (h == 0) ws_f(p.ws, WS_DN)[(size_t)uh * 64 + 32 * dkb + ql] = t; }
    if (lane == 0) { ws_f(p.ws, WS_G)[uh] = g; ws_f(p.ws, WS_ML)[uh] = ml; }
}
__device__ __forceinline__ void mlstm_scan2_unit(const P& p, const LB& L, int u) {
    int tid_l = threadIdx.x; asm volatile("" : "+v"(tid_l)); const int tid = tid_l, bh = u >> 2, b = bh >> 3, hh = bh & 7, e = (u & 3) * 1024 + 2 * tid;
    const bool first = (u & 3) == 0; const bool do_n = first && tid < 64;
    float *G = ws_f(p.ws, WS_G), *ML = ws_f(p.ws, WS_ML), *MIN = ws_f(p.ws, WS_MIN), *DN = ws_f(p.ws, WS_DN);
    unsigned d[NCH]; float dn[NCH];
#pragma unroll
    for (int c = 0; c < NCH; ++c) { const int idx = (b * NCH + c) * 8 + hh; d[c] = *(const unsigned*)(L.state + (size_t)idx * 4096 + e); dn[c] = do_n ? DN[(size_t)idx * 64 + tid] : 0.f; }
    float m = 0.f, n = 0.f, C0 = 0.f, C1 = 0.f;
#pragma unroll
    for (int c = 0; c < NCH; ++c) { const int idx = (b * NCH + c) * 8 + hh; const float g = G[idx], ml = ML[idx], mn = fmaxf(g + m, ml), a = __expf(g + m - mn), sc = __expf(ml - mn);
        *(unsigned*)(L.state + (size_t)idx * 4096 + e) = pkbf(C0, C1);
        C0 = fmaf(C0, a, sc * __uint_as_float(d[c] << 16)); C1 = fmaf(C1, a, sc * __uint_as_float(d[c] & 0xffff0000u));
        if (do_n) { DN[(size_t)idx * 64 + tid] = n; n = a * n + sc * dn[c]; }
        if (first && tid == 0) MIN[idx] = m;
        m = mn; }
}
constexpr int MC_SLOT = 31232, MC_XQ = 0, MC_XK = 9728, MC_VIMG = 19456, MC_CW = 27648, MC_T0 = 29696, MC_T1 = 29952, MC_T2 = 30208, MC_T3 = 30464, MC_T4 = 30720  , MC_T5 = 30976  ;
__device__ __forceinline__ bf16x8 conv_frag_lds(const LAS unsigned char* img, int tok, int ch0, const LAS float* cwl, float scale) {
    float a[8] = {0.f, 0.f, 0.f, 0.f, 0.f, 0.f, 0.f, 0.f};
#pragma unroll
    for (int tap = 0; tap < 4; ++tap) {
        float xf[8]; unpack8(__builtin_bit_cast(uint4, *(const LAS u32x4*)(img + (tok + tap) * 144 + ch0 * 2)), xf);
        const f32x4 w0 = *(const LAS f32x4*)(cwl + tap * 128 + ch0), w1 = *(const LAS f32x4*)(cwl + tap * 128 + ch0 + 4);
        a[0] = fmaf(w0[0], xf[0], a[0]); a[1] = fmaf(w0[1], xf[1], a[1]); a[2] = fmaf(w0[2], xf[2], a[2]); a[3] = fmaf(w0[3], xf[3], a[3]);
        a[4] = fmaf(w1[0], xf[4], a[4]); a[5] = fmaf(w1[1], xf[5], a[5]); a[6] = fmaf(w1[2], xf[6], a[6]); a[7] = fmaf(w1[3], xf[7], a[7]);
    }
#pragma unroll
    for (int j = 0; j < 8; ++j) a[j] = a[j] * scale * __builtin_amdgcn_rcpf(1.f + __expf(-a[j]));
    u32x4 w; w.x = pkbf(a[0], a[1]); w.y = pkbf(a[2], a[3]); w.z = pkbf(a[4], a[5]); w.w = pkbf(a[6], a[7]);
    return __builtin_bit_cast(bf16x8, w);
}
template <int TB>
__device__ __forceinline__ void mlstm_C_block(const LB& L, int b, int c, int hh, int lane, int h, int ql, LAS unsigned char* wl, const bf16x8 (&Cf)[2][4], const uint2 (&mo)[2][4]) {
    const LAS float* cwl = (const LAS float*)(wl + MC_CW);
    bf16x8 Qf[4]; float qn = 0.f;
#pragma unroll
    for (int ks = 0; ks < 4; ++ks) { const int ch0 = 16 * ks + 8 * h;
        Qf[ks] = conv_frag_lds(wl + MC_XQ, 32 * TB + ql, ch0, cwl, 1.f);
        const f32x4 n0 = *(const LAS f32x4*)(wl + MC_T4 + ch0 * 4), n1 = *(const LAS f32x4*)(wl + MC_T4 + ch0 * 4 + 16);
        float qv[8]; unpack8(__builtin_bit_cast(uint4, Qf[ks]), qv);
#pragma unroll
        for (int j = 0; j < 4; ++j) { qn = fmaf(qv[j], n0[j], qn); qn = fmaf(qv[j + 4], n1[j], qn); } }
    f32x16 S0, S1;
#pragma unroll
    for (int r = 0; r < 16; ++r) { S0[r] = 0.f; S1[r] = 0.f; }
#pragma unroll
    for (int ks = 0; ks < 4; ++ks) { const int ch0 = 16 * ks + 8 * h;
        S0 = MFMA32(conv_frag_lds(wl + MC_XK, ql, ch0, cwl + 64, 0.125f), Qf[ks], S0);
        if (TB == 1) S1 = MFMA32(conv_frag_lds(wl + MC_XK, 32 + ql, ch0, cwl + 64, 0.125f), Qf[ks], S1); }
    const float Mt = ((const LAS float*)(wl + MC_T1))[32 * TB + ql];
    float dsum = 0.f;
#pragma unroll
    for (int gq = 0; gq < 4; ++gq) {
        const f32x4 a0 = *(const LAS f32x4*)(wl + MC_T0 + (8 * gq + 4 * h) * 4), a1 = *(const LAS f32x4*)(wl + MC_T0 + (32 + 8 * gq + 4 * h) * 4);
#pragma unroll
        for (int j = 0; j < 4; ++j) { const int r = 4 * gq + j, sl = 8 * gq + 4 * h + j;
            if (TB == 0) { const float v = sl <= ql ? S0[r] * __expf(a0[j] - Mt) : 0.f; S0[r] = v; dsum += v; }
            else { const float v0 = S0[r] * __expf(a0[j] - Mt); S0[r] = v0; const float v1 = sl <= ql ? S1[r] * __expf(a1[j] - Mt) : 0.f; S1[r] = v1; dsum += v0 + v1; } }
    }
    f32x16 acc[2];
#pragma unroll
    for (int d = 0; d < 2; ++d)
#pragma unroll
        for (int r = 0; r < 16; ++r) acc[d][r] = 0.f;
#pragma unroll
    for (int ks = 0; ks < 4; ++ks)
#pragma unroll
        for (int dvb = 0; dvb < 2; ++dvb) acc[dvb] = MFMA32(Cf[dvb][ks], Qf[ks], acc[dvb]);
    const float iw = ((const LAS float*)(wl + MC_T2))[32 * TB + ql];
#pragma unroll
    for (int dvb = 0; dvb < 2; ++dvb)
#pragma unroll
        for (int r = 0; r < 16; ++r) acc[dvb][r] *= iw;
#pragma unroll
    for (int s2 = 0; s2 < 2; ++s2) {
        const bf16x8 P0 = pack_step(S0, s2), P1 = pack_step(S1, s2);
#pragma unroll
        for (int dvb = 0; dvb < 2; ++dvb) {
            acc[dvb] = MFMA32(tr_frag(wl + MC_VIMG + dvb * 4096, 16 * s2 + 4 * h, 16 * s2 + 8 + 4 * h, lane), P0, acc[dvb]);
            if (TB == 1) acc[dvb] = MFMA32(tr_frag(wl + MC_VIMG + dvb * 4096, 32 + 16 * s2 + 4 * h, 32 + 16 * s2 + 8 + 4 * h, lane), P1, acc[dvb]); }
    }
    dsum += __shfl_xor(dsum, 32); qn += __shfl_xor(qn, 32);
    const float den = dsum + iw * qn, mt = ((const LAS float*)(wl + MC_T3))[32 * TB + ql];
    const float sc = 1.f / fmaxf(fabsf(den), __expf(-mt));
    float sum = 0.f;
#pragma unroll
    for (int dvb = 0; dvb < 2; ++dvb)
#pragma unroll
        for (int r = 0; r < 16; ++r) { const float v = acc[dvb][r] * sc; acc[dvb][r] = v; sum += v; }
    sum += __shfl_xor(sum, 32); const float mu = sum * (1.f / 64.f);
    float var = 0.f;
#pragma unroll
    for (int dvb = 0; dvb < 2; ++dvb)
#pragma unroll
        for (int r = 0; r < 16; ++r) { const float dlt = acc[dvb][r] - mu; var += dlt * dlt; }
    var += __shfl_xor(var, 32); const float rstd = rsqrtf(var * (1.f / 64.f) + EPS);
    bf16_t* op = L.mo + (size_t)(b * T + c * 64 + 32 * TB + ql) * 512 + hh * 64;
#pragma unroll
    for (int dvb = 0; dvb < 2; ++dvb)
#pragma unroll
        for (int gq = 0; gq < 4; ++gq) { const int dv = 32 * dvb + 8 * gq + 4 * h; const f32x4 ng = *(const LAS f32x4*)(wl + MC_T5 + dv * 4);
            const uint2 mg = mo[dvb][gq];
            const float y0 = (acc[dvb][4 * gq] - mu) * rstd * ng[0] * __uint_as_float(mg.x << 16), y1 = (acc[dvb][4 * gq + 1] - mu) * rstd * ng[1] * __uint_as_float(mg.x & 0xffff0000u);
            const float y2 = (acc[dvb][4 * gq + 2] - mu) * rstd * ng[2] * __uint_as_float(mg.y << 16), y3 = (acc[dvb][4 * gq + 3] - mu) * rstd * ng[3] * __uint_as_float(mg.y & 0xffff0000u);
            uint2 w; w.x = pkbf(y0, y1); w.y = pkbf(y2, y3); *(uint2*)(op + dv) = w; }
}
__device__ __forceinline__ void mlstm_C_mfma_unit(const P& p, const LB& L, int l, int u, LAS unsigned char* l3) {
    int tid_l = threadIdx.x; asm volatile("" : "+v"(tid_l)); const int tid = tid_l, lane = tid & 63, wave = tid >> 6, h = lane >> 5, ql = lane & 31;
    const int hg = u & 1, c = (u >> 1) & 31, b = u >> 6, hh = 4 * hg + (wave >> 1), tb = wave & 1, uh = (b * 32 + c) * 8 + hh, l128 = tid & 127;
    LAS unsigned char* wl = l3 + (wave >> 1) * MC_SLOT;
    const float* cw = p.conv_w + (size_t)l * 4 * 1024;
    bf16x8 Cf[2][4]; uint2 mo[2][4];
    {
        const bf16_t* st = L.state + (size_t)uh * 4096; const bf16_t* op = L.mo + (size_t)(b * T + c * 64 + 32 * tb + ql) * 512 + hh * 64;
#pragma unroll
        for (int dvb = 0; dvb < 2; ++dvb) {
#pragma unroll
            for (int ks = 0; ks < 4; ++ks) Cf[dvb][ks] = *(const bf16x8*)(st + (32 * dvb + ql) * 64 + 16 * ks + 8 * h);
#pragma unroll
            for (int gq = 0; gq < 4; ++gq) mo[dvb][gq] = *(const uint2*)(op + 32 * dvb + 8 * gq + 4 * h);
        }
    }
    __syncthreads();
    {
        u32x4 xq[5], xk[5], vv[4]; float cwv[4];
#pragma unroll
        for (int i = 0; i < 5; ++i) { const int idx = l128 + 128 * i, ic = idx < 67 * 8 ? idx : 67 * 8 - 1, row = ic >> 3, cc = ic & 7, t = c * 64 - 3 + row;
            const bf16_t* src = L.mqk + (size_t)(b * T + (t >= 0 ? t : 0)) * 1024 + hh * 64 + cc * 8; xq[i] = *(const u32x4*)src; xk[i] = *(const u32x4*)(src + 512); }
#pragma unroll
        for (int i = 0; i < 4; ++i) { const int s = (l128 >> 3) + 16 * i, cc = l128 & 7; vv[i] = *(const u32x4*)(L.mv + (size_t)(b * T + c * 64 + s) * 512 + hh * 64 + cc * 8); }
#pragma unroll
        for (int i = 0; i < 4; ++i) { const int e = l128 + 128 * i, tap = e >> 7, wch = e & 127; cwv[i] = cw[tap * 1024 + (wch >> 6) * 512 + hh * 64 + (wch & 63)]; }
#pragma unroll
        for (int i = 0; i < 5; ++i) { const int idx = l128 + 128 * i, row = idx >> 3, cc = idx & 7, t = c * 64 - 3 + row; const u32x4 z = (u32x4){0u, 0u, 0u, 0u};
            if (idx < 67 * 8) { *(LAS u32x4*)(wl + MC_XQ + row * 144 + cc * 16) = t >= 0 ? xq[i] : z; *(LAS u32x4*)(wl + MC_XK + row * 144 + cc * 16) = t >= 0 ? xk[i] : z; } }
#pragma unroll
        for (int i = 0; i < 4; ++i) { const int s = (l128 >> 3) + 16 * i, cc = l128 & 7; *(LAS u32x4*)(wl + MC_VIMG + (cc >> 2) * 4096 + s * 64 + (cc & 3) * 16) = vv[i]; }
#pragma unroll
        for (int i = 0; i < 4; ++i) ((LAS float*)(wl + MC_CW))[l128 + 128 * i] = cwv[i];
    }
    {
        float bcum, ig; mlstm_gates_wave(p, L, l, b, c, hh, lane, bcum, ig);
        const float a = ig - bcum; float v = a;
#pragma unroll
        for (int o = 1; o < 64; o <<= 1) { const float t = __shfl_up(v, o); if (lane >= o) v = fmaxf(v, t); }
        const float m_in = ws_f(p.ws, WS_MIN)[uh], Mt = fmaxf(v, m_in);
        if (tb == 1) { ((LAS float*)(wl + MC_T4))[lane] = ws_f(p.ws, WS_DN)[(size_t)uh * 64 + lane]; ((LAS float*)(wl + MC_T5))[lane] = p.norm_g[l * 512 + hh * 64 + lane]; }
        if (tb == 0) { ((LAS float*)(wl + MC_T0))[lane] = a; ((LAS float*)(wl + MC_T1))[lane] = Mt; ((LAS float*)(wl + MC_T2))[lane] = __expf(m_in - Mt); ((LAS float*)(wl + MC_T3))[lane] = bcum + Mt; }
    }
    __syncthreads();
    if (tb == 0) mlstm_C_block<0>(L, b, c, hh, lane, h, ql, wl, Cf, mo);
    else mlstm_C_block<1>(L, b, c, hh, lane, h, ql, wl, Cf, mo);
}

#define XB_TMO      128
#define XB_XCNT(j)  (256  + 64 * (j))
#define XB_XSUB(j)  (1280 + 64 * (j))
#define XB_XGEN(j)  (2304 + 64 * (j))
#define XB_TOP      3328
#define XB_TOPGEN   3392
#define XCD_BAR_WORDS 3456
#define XB_SPIN_CAP (1u << 18)

__device__ __forceinline__ unsigned xb_ld(unsigned* p)              { return __hip_atomic_load(p, __ATOMIC_RELAXED, __HIP_MEMORY_SCOPE_AGENT); }
__device__ __forceinline__ unsigned xb_add(unsigned* p, unsigned v) { return __hip_atomic_fetch_add(p, v, __ATOMIC_RELAXED, __HIP_MEMORY_SCOPE_AGENT); }
__device__ __forceinline__ unsigned xb_xcc_id() { return (unsigned)__builtin_amdgcn_s_getreg((3 << 11) | 20) & 0xFu; }
#define XB_SPIN(cond, bar) do { unsigned _sp = 0; while (cond) { __builtin_amdgcn_s_sleep(1); \
    if ((++_sp & 255u) == 0u) { if (xb_ld(&(bar)[XB_TMO])) break; if (_sp > XB_SPIN_CAP) { atomicAdd(&(bar)[XB_TMO], 1u); break; } } } } while (0)

struct XcdBarrier {
    unsigned* bar; unsigned x;
    volatile LAS unsigned* st;
};

__device__ __forceinline__ XcdBarrier xcd_barrier_post(unsigned* bar, volatile LAS unsigned* st) {
    XcdBarrier b; b.bar = bar; b.x = xb_xcc_id(); b.st = st;
    if (threadIdx.x == 0) (void)xb_add(&bar[XB_XCNT(b.x)], 1u);
    return b;
}
__device__ __forceinline__ void xcd_barrier_complete(unsigned* bar, unsigned x, unsigned& nloc, unsigned& nx) {
    const unsigned G = gridDim.x * gridDim.y * gridDim.z;
    unsigned sum, cnt, mine, sp = 0u;
    for (;;) {
        sum = 0u; cnt = 0u; mine = 0u;
#pragma unroll
        for (unsigned j = 0; j < 16; ++j) { const unsigned c = xb_ld(&bar[XB_XCNT(j)]); sum += c; cnt += (c > 0u) ? 1u : 0u; mine = (j == x) ? c : mine; }
        if (sum == G) break;
        __builtin_amdgcn_s_sleep(1);
        if ((++sp & 255u) == 0u) { if (xb_ld(&bar[XB_TMO])) break; if (sp > XB_SPIN_CAP) { atomicAdd(&bar[XB_TMO], 1u); break; } }
    }
    nloc = mine > 0u ? mine : 1u; nx = cnt > 0u ? cnt : 1u;
}

__device__ __forceinline__ void xcd_barrier(const XcdBarrier& b) {
    asm volatile("s_waitcnt vmcnt(0)" ::: "memory");
    __syncthreads();
    if (threadIdx.x == 0) {
        unsigned* bar = b.bar;
        __builtin_amdgcn_s_waitcnt(0);
        unsigned nloc = b.st[0], nx = b.st[1];
        if (nloc == 0u) { xcd_barrier_complete(bar, b.x, nloc, nx); b.st[0] = nloc; b.st[1] = nx; }
        const unsigned old = xb_add(&bar[XB_XSUB(b.x)], 1u);
        const unsigned gen = old / nloc;
        if (old + 1u == (gen + 1u) * nloc) {
            __builtin_amdgcn_fence(__ATOMIC_RELEASE, "agent");
            asm volatile("s_waitcnt vmcnt(0)" ::: "memory");
            const unsigned og = xb_add(&bar[XB_TOP], 1u);
            const unsigned tg = og / nx;
            if (og + 1u == (tg + 1u) * nx) xb_add(&bar[XB_TOPGEN], 1u);
            else XB_SPIN(xb_ld(&bar[XB_TOPGEN]) == tg, bar);
            __builtin_amdgcn_fence(__ATOMIC_ACQUIRE, "agent");
            xb_add(&bar[XB_XGEN(b.x)], 1u);
            asm volatile("s_waitcnt vmcnt(0)" ::: "memory");
        } else {
            XB_SPIN(xb_ld(&bar[XB_XGEN(b.x)]) == gen, bar);
            __builtin_amdgcn_fence(__ATOMIC_ACQUIRE, "agent");
            asm volatile("s_waitcnt vmcnt(0)" ::: "memory");
        }
    }
    __syncthreads();
}

__global__ void __launch_bounds__(512, 2) mk_fwd(P p) {
    extern __shared__ __attribute__((aligned(16))) unsigned char lds[];
    LAS unsigned char* l3 = (LAS unsigned char*)lds;
    float* fl = (float*)lds;
    const int G = gridDim.x, bx = blockIdx.x;
    if (threadIdx.x < 64) ((LAS unsigned*)(l3 + LDS_CTL))[threadIdx.x] = 0u;
    __syncthreads();
    (void)xcd_barrier_post((unsigned*)(p.ws + WS_BAR), (volatile LAS unsigned*)(l3 + LDS_CTL + 32));
#define PR_T0 (*(volatile LAS unsigned long long*)(l3 + LDS_CTL + 64))
#define PR_ACC (*(volatile LAS unsigned long long*)(l3 + LDS_CTL + 72))
#define PH_BEGIN(id) do { if ((PROBE_MASK >> (id)) & 1) { if (bx == 0 && threadIdx.x == 0) PR_T0 = __builtin_amdgcn_s_memrealtime(); } } while (0)
#define PH_END(id) do { if ((PROBE_MASK >> (id)) & 1) { if (bx == 0 && threadIdx.x == 0) PR_ACC = PR_ACC + (__builtin_amdgcn_s_memrealtime() - PR_T0); } } while (0)
#define GRID_BAR() do { XcdBarrier b_; b_.bar = (unsigned*)(p.ws + WS_BAR); b_.x = xb_xcc_id(); b_.st = (volatile LAS unsigned*)(l3 + LDS_CTL + 32); xcd_barrier(b_); } while (0)
#define WAVE_IDS() int tid_w = threadIdx.x; asm volatile("" : "+v"(tid_w)); const int lane = tid_w & 63, gw = bx * 8 + (tid_w >> 6), ngw = G * 8

        PH_BEGIN(0);
    {
        WAVE_IDS();
        for (int it = gw; it < 2 * CV_ITEMS_LAYER; it += ngw) convert_item(p, it, fl + (tid_w >> 6) * (64 * 65), lane);
        rowstat_rows(p.x, M, layer_buf(p.ws, p.out, 0).xbin, ws_f(p.ws, WS_ROWSS), gw, ngw, lane);
        rowstat_rows(p.mem, MM, (bf16_t*)(p.ws + WS_MEMB), ws_f(p.ws, WS_ROWSS_MEM), gw, ngw, lane);
    }
    GRID_BAR();
        PH_END(0);

#pragma unroll 1
    for (int l = 0; l < 2; ++l) {
        PH_BEGIN(1);
        {
            const LB L = layer_buf(p.ws, p.out, l);
            pg8::Gemm g{L.xbin, L.win, M, 6656, D, (const bf16_t*)(p.ws + WS_MEMB)};
            SchedRounds S{G, bx, 6, 0, 1, 3};
            Unit u0, u3; S.next(0, u0); const bool has_tail = S.next(6, u3);
            fill_rstd_table(ws_f(p.ws, WS_ROWSS) + (size_t)(2 * l) * M * 16, u0.rm, (LAS float*)(l3 + LDS_RSTD0));
            if (has_tail) fill_rstd_table(u3.kind == 1 ? ws_f(p.ws, WS_ROWSS_MEM) : ws_f(p.ws, WS_ROWSS) + (size_t)(2 * l) * M * 16, u3.rm, (LAS float*)(l3 + LDS_RSTD1));
            __syncthreads();
            EpiProjMK E{L, (const LAS float*)(l3 + LDS_RSTD0), (const LAS float*)(l3 + LDS_RSTD1), u0.rm};
            pg8::gemm_phase<EpiProjMK, SchedRounds, true, true>(l3, g, S, E);
        }
        GRID_BAR();
        PH_END(1);
        PH_BEGIN(2);
        {
            const LB L = layer_buf(p.ws, p.out, l);
            PH_BEGIN(10); for (int u = bx; u < NB * 16 * 2; u += G) swa_mfma_unit(p, L, l, u, l3); PH_END(10);
            PH_BEGIN(11); for (int u = bx; u < NB * 4 * 8; u += G) xattn_mfma_unit(L, u, l3); PH_END(11);
            PH_BEGIN(12); for (int u = bx; u < NB * NCH; u += G) mlstm_A_mfma_unit(p, L, l, u, l3); PH_END(12);
        }
        GRID_BAR();
        PH_END(2);
        PH_BEGIN(3);
        {
            const LB L = layer_buf(p.ws, p.out, l);
            for (int u = bx; u < 256; u += G) mlstm_scan2_unit(p, L, u);
        }
        GRID_BAR();
        PH_END(3);
        PH_BEGIN(4);
        {
            const LB L = layer_buf(p.ws, p.out, l);
            for (int u = bx; u < NB * NCH * 2; u += G) mlstm_C_mfma_unit(p, L, l, u, l3);
        }
        GRID_BAR();
        PH_END(4);
        PH_BEGIN(6);
        {
            const LB L = layer_buf(p.ws, p.out, l);
            pg8::Gemm g{L.sq, L.wbr, 3 * M, 3 * D, 512, nullptr};
            SchedMerged S{G, bx};
            EpiMergedMK E{L.gates, L.merged};
            pg8::gemm_phase<EpiMergedMK, SchedMerged, true, true>(l3, g, S, E);
        }
        GRID_BAR();
        PH_END(6);
        PH_BEGIN(7);
        {
            const LB L = layer_buf(p.ws, p.out, l);
            pg8::Gemm g{L.merged, L.wout, M, D, D, nullptr};
            SchedRounds S{G, bx, 1, 0, 0, 99};
            EpiResidMK E{L.xbin, L.xbmid, ws_f(p.ws, WS_ROWSS) + (size_t)(2 * l + 1) * M * 16};
            pg8::gemm_phase<EpiResidMK, SchedRounds, true, true>(l3, g, S, E);
        }
        GRID_BAR();
        PH_END(7);
        PH_BEGIN(8);
        {
            const LB L = layer_buf(p.ws, p.out, l);
            pg8::Gemm g{L.xbmid, L.wff1, M, DFF, D, nullptr};
            SchedRounds S{G, bx, 4, 0, 0, 99};
            Unit u0; S.next(0, u0);
            fill_rstd_table(ws_f(p.ws, WS_ROWSS) + (size_t)(2 * l + 1) * M * 16, u0.rm, (LAS float*)(l3 + LDS_RSTD0));
            __syncthreads();
            EpiFF1MK E{L.hff, (const LAS float*)(l3 + LDS_RSTD0)};
            pg8::gemm_phase<EpiFF1MK, SchedRounds, true, true>(l3, g, S, E);
        }
        GRID_BAR();
        PH_END(8);
        PH_BEGIN(9);
        {
            const LB L = layer_buf(p.ws, p.out, l);
            pg8::Gemm g{L.hff, L.wff2, M, D, DFF, nullptr};
            SchedRounds S{G, bx, 1, 0, 0, 99};
            EpiResidMK E{L.xbmid, L.xbnext, ws_f(p.ws, WS_ROWSS) + (size_t)(2 * l + 2) * M * 16};
            pg8::gemm_phase<EpiResidMK, SchedRounds, true, true>(l3, g, S, E);
        }
        GRID_BAR();
        PH_END(9);
    }
    {
        WAVE_IDS();
        finalnorm_rows(layer_buf(p.ws, p.out, 1).xbnext, p.out, ws_f(p.ws, WS_ROWSS) + (size_t)4 * M * 16, p.g_final, gw, ngw, lane);
    }
    if (PROBE_MASK != 0 && bx == 0 && threadIdx.x == 0) { const unsigned long long te = __builtin_amdgcn_s_memrealtime(); const unsigned long long acc_ = PR_ACC; while (__builtin_amdgcn_s_memrealtime() - te < 10ull * acc_) __builtin_amdgcn_s_sleep(8); }
}
}

extern "C" void kernel_launch(void* const* d_in, const int* in_sizes, int n_in, void* d_out, int out_size, void* d_ws, size_t ws_size, hipStream_t stream) {
    static int grid = 0;
    if (grid == 0) {
        if (n_in != 20 || out_size != M * D || ws_size < WS_END) { fprintf(stderr, "kernel_launch: unexpected shapes (n_in %d out %d ws %zu)\n", n_in, out_size, ws_size); grid = -1; return; }
        int dev = 0, cus = 0, per_cu = 0;
        if (hipGetDevice(&dev) != hipSuccess || hipDeviceGetAttribute(&cus, hipDeviceAttributeMultiprocessorCount, dev) != hipSuccess) { fprintf(stderr, "kernel_launch: device query failed\n"); grid = -1; return; }
        if (hipFuncSetAttribute((const void*)mk_fwd, hipFuncAttributeMaxDynamicSharedMemorySize, LDS_BYTES) != hipSuccess) { fprintf(stderr, "kernel_launch: hipFuncSetAttribute failed\n"); grid = -1; return; }
        if (hipOccupancyMaxActiveBlocksPerMultiprocessor(&per_cu, (const void*)mk_fwd, 512, LDS_BYTES) != hipSuccess || per_cu < 1) { fprintf(stderr, "kernel_launch: occupancy query says %d blocks per CU\n", per_cu); grid = -1; return; }
        if (cus != 256) { fprintf(stderr, "kernel_launch: built for a 256-CU device (unit orders assume 256 workgroups); found %d CUs\n", cus); grid = -1; return; }
        grid = cus * (per_cu >= 1 ? 1 : 0);
    }
    if (grid < 0) return;
    P p{};
    const float** pf = (const float**)&p;
    for (int i = 0; i < 20; ++i) pf[i] = (const float*)d_in[i];
    p.out = (float*)d_out; p.ws = (unsigned char*)d_ws;
    if (hipMemsetAsync(d_ws, 0, WS_ZERO_BYTES, stream) != hipSuccess) { fprintf(stderr, "kernel_launch: memset failed\n"); return; }
    void* args[] = {&p};
    const hipError_t e = hipLaunchCooperativeKernel((const void*)mk_fwd, dim3(grid), dim3(512), args, LDS_BYTES, stream);
    if (e != hipSuccess) fprintf(stderr, "kernel_launch: cooperative launch failed: %s (grid %d)\n", hipGetErrorString(e), grid);
}
```

```cpp
#include <hip/hip_runtime.h>
#include <cstdio>
#include <cstdint>
#ifndef PROBE_MASK
#define PROBE_MASK 0
#endif

namespace pg8 {
#define PG8_LAS __attribute__((address_space(3)))
typedef unsigned short bf16_t;
typedef short bf16x8 __attribute__((ext_vector_type(8)));
typedef float f32x4 __attribute__((ext_vector_type(4)));
typedef unsigned u32x4 __attribute__((ext_vector_type(4)));
constexpr int BM = 256, BK = 64, HALF = 128, HTB = HALF * BK * 2  , STAGE_BYTES = 8 * HTB, NXCD = 8, WGM = 8;

__host__ __device__ __forceinline__ int lds_byte(int r, int c) { const int st = (r >> 4) * 2 + (c >> 5), rr = r & 15, cc = c & 31, ob = rr * 64 + cc * 2; return st * 1024 + (ob ^ (((ob >> 9) & 1) << 5)); }
__host__ __device__ __forceinline__ void stage_rc(int b, int& R, int& C) { const int st = b / 1024, sb = b % 1024, swz = sb ^ (((sb >> 9) & 1) << 5); R = (st >> 1) * 16 + swz / 64; C = (st & 1) * 32 + (swz % 64) / 2; }
__host__ __device__ __forceinline__ int perm32(int rho) { const int n = rho >> 4, i = rho & 15; return 8 * (i >> 2) + 4 * n + (i & 3); }
struct Unit { int pm, pn, rm, kind, asel; };
struct Gemm { const bf16_t* A; const bf16_t* Bt; int M, N, K; const bf16_t* A2; };
__device__ __forceinline__ unsigned cvt_pk_bf16(float lo, float hi) { unsigned r; asm volatile("v_cvt_pk_bf16_f32 %0, %1, %2" : "=v"(r) : "v"(lo), "v"(hi)); return r; }
template <class Epi, class Sched, bool ALIGN_EPI = false, bool SP2 = false>
__device__ __forceinline__ void gemm_phase(PG8_LAS unsigned char* lds, const Gemm g, const Sched& S, const Epi& E) {
    int tid_l = threadIdx.x; asm volatile("" : "+v"(tid_l));
    const int tid = tid_l, wid = __builtin_amdgcn_readfirstlane(tid >> 6), lane = tid & 63, wr = wid >> 2, wc = wid & 3, fr = lane & 15, fq = lane >> 4;
    const int K = g.K, nt = K / BK;
    unsigned voffA[2], voffB[2];
#pragma unroll
    for (int i = 0; i < 2; ++i) { int R, C; stage_rc(tid * 16 + i * 8192, R, C); const int Rb = Epi::PERM ? ((R & ~31) + perm32(R & 31)) : R;
        voffA[i] = (unsigned)(R * K + C) * 2u; voffB[i] = (unsigned)(Rb * K + C) * 2u; }
    const size_t kstep = (size_t)(BK * 2);
    const size_t hstep = (size_t)HALF * K * 2;
    const size_t tstep = 2 * hstep;
    const unsigned ldsw = (unsigned)wid * 1024u;
    const int aoff = lds_byte(wr * 64 + fr, fq * 8), boff = lds_byte(wc * 32 + fr, fq * 8);
#define PG8_SA(b, h) (((b) * 2 + (h)) * HTB)
#define PG8_SB(b, h) ((4 + (b) * 2 + (h)) * HTB)
#define PG8_STAGE(bufoff, gbase, voff) do { _Pragma("unroll") for (int _i = 0; _i < 2; ++_i) \
        __builtin_amdgcn_global_load_lds((const unsigned*)((const char*)(gbase) + (voff)[_i]), (PG8_LAS unsigned*)(lds + (bufoff) + ldsw + _i * 8192), 16, 0, 0); } while (0)
#define PG8_LDA(dst, b, h) do { _Pragma("unroll") for (int m = 0; m < 4; ++m) _Pragma("unroll") for (int k = 0; k < 2; ++k) dst[m][k] = *(const PG8_LAS bf16x8*)(lds + PG8_SA(b, h) + aoff + m * 2048 + k * 1024); } while (0)
#define PG8_LDB(dst, b, h) do { _Pragma("unroll") for (int n = 0; n < 2; ++n) _Pragma("unroll") for (int k = 0; k < 2; ++k) dst[n][k] = *(const PG8_LAS bf16x8*)(lds + PG8_SB(b, h) + boff + n * 2048 + k * 1024); } while (0)
#define PG8_MMA(ai, bj, At, Bt) do { __builtin_amdgcn_s_setprio(1); _Pragma("unroll") for (int m = 0; m < 4; ++m) _Pragma("unroll") for (int n = 0; n < 2; ++n) _Pragma("unroll") for (int k = 0; k < 2; ++k) \
        acc[ai][bj][m][n] = __builtin_amdgcn_mfma_f32_16x16x32_bf16(Bt[n][k], At[m][k], acc[ai][bj][m][n], 0, 0, 0); __builtin_amdgcn_s_setprio(0); } while (0)
#define PG8_WAIT_V(n) asm volatile("s_waitcnt vmcnt(" #n ")" ::: "memory")
#define PG8_WAIT_L(n) asm volatile("s_waitcnt lgkmcnt(" #n ")" ::: "memory")
#define PG8_BAR __builtin_amdgcn_s_barrier()
#define PG8_SCHED __builtin_amdgcn_sched_barrier(0)
    Unit cur, nxt; int ui = 0;
    if (!S.next(0, cur)) return;
    f32x4 acc[2][2][4][2];
#pragma unroll
    for (int a = 0; a < 2; ++a)
#pragma unroll
        for (int b = 0; b < 2; ++b)
#pragma unroll
            for (int m = 0; m < 4; ++m)
#pragma unroll
                for (int n = 0; n < 2; ++n) acc[a][b][m][n] = (f32x4){0.f, 0.f, 0.f, 0.f};
    bf16x8 At[4][2], B0[2][2], B1[2][2];
    const char* cA = (const char*)(cur.asel ? g.A2 : g.A) + (size_t)cur.pm * tstep; const char* cB = (const char*)g.Bt + (size_t)cur.pn * tstep;
    S.a_ready(cur);
    if constexpr (SP2) {
        PG8_STAGE(PG8_SB(0, 0), cB, voffB); PG8_STAGE(PG8_SB(0, 1), cB + hstep, voffB); PG8_STAGE(PG8_SA(0, 0), cA, voffA); PG8_STAGE(PG8_SA(0, 1), cA + hstep, voffA);
        if (wr == 1) PG8_BAR;
        PG8_WAIT_V(2); PG8_BAR;
        PG8_STAGE(PG8_SB(1, 0), cB + kstep, voffB); PG8_STAGE(PG8_SA(1, 0), cA + kstep, voffA); PG8_STAGE(PG8_SB(1, 1), cB + hstep + kstep, voffB);
        PG8_WAIT_V(6); PG8_BAR;
    } else {
        PG8_STAGE(PG8_SB(0, 0), cB, voffB); PG8_STAGE(PG8_SA(0, 0), cA, voffA); PG8_STAGE(PG8_SB(0, 1), cB + hstep, voffB); PG8_STAGE(PG8_SA(0, 1), cA + hstep, voffA);
        if (wr == 1) PG8_BAR;
        PG8_WAIT_V(4); PG8_BAR;
        PG8_STAGE(PG8_SB(1, 0), cB + kstep, voffB); PG8_STAGE(PG8_SA(1, 0), cA + kstep, voffA); PG8_STAGE(PG8_SB(1, 1), cB + hstep + kstep, voffB);
        PG8_WAIT_V(6); PG8_BAR;
    }
    for (;;) {
        const bool has_next = S.next(ui + 1, nxt);
        const char* nA = has_next ? (const char*)(nxt.asel ? g.A2 : g.A) + (size_t)nxt.pm * tstep : cA; const char* nB = has_next ? (const char*)g.Bt + (size_t)nxt.pn * tstep : cB;
        for (int t = 0; t < nt; t += 2) {
            const bool last = (t == nt - 2);
            const char* a1 = cA + (size_t)(t + 1) * kstep;
            const char* a2 = last ? nA : cA + (size_t)(t + 2) * kstep; const char* b2 = last ? nB : cB + (size_t)(t + 2) * kstep;
            const char* a3 = a2 + kstep; const char* b3 = b2 + kstep;
            if (last && has_next) S.a_ready(nxt);
            if constexpr (SP2) {
            PG8_LDB(B0, 0, 0); PG8_LDB(B1, 0, 1); PG8_SCHED; PG8_LDA(At, 0, 0); PG8_STAGE(PG8_SA(1, 1), a1 + hstep, voffA);
            PG8_WAIT_V(8); PG8_WAIT_L(0); PG8_BAR; PG8_MMA(0, 0, At, B0); PG8_MMA(0, 1, At, B1); PG8_BAR; PG8_SCHED;
            PG8_LDA(At, 0, 1); PG8_STAGE(PG8_SB(0, 0), b2, voffB); PG8_STAGE(PG8_SB(0, 1), b2 + hstep, voffB); PG8_STAGE(PG8_SA(0, 0), a2, voffA);
            PG8_WAIT_V(8); PG8_WAIT_L(0); PG8_BAR; PG8_MMA(1, 0, At, B0); PG8_MMA(1, 1, At, B1); PG8_BAR; PG8_SCHED;
            PG8_LDB(B0, 1, 0); PG8_LDB(B1, 1, 1); PG8_SCHED; PG8_LDA(At, 1, 0); PG8_STAGE(PG8_SA(0, 1), a2 + hstep, voffA);
            PG8_WAIT_V(8); PG8_WAIT_L(0); PG8_BAR; PG8_MMA(0, 0, At, B0); PG8_MMA(0, 1, At, B1); PG8_BAR; PG8_SCHED;
            PG8_LDA(At, 1, 1); PG8_STAGE(PG8_SB(1, 0), b3, voffB); PG8_STAGE(PG8_SB(1, 1), b3 + hstep, voffB); PG8_STAGE(PG8_SA(1, 0), a3, voffA);
            PG8_WAIT_V(8); PG8_WAIT_L(0); PG8_BAR; PG8_MMA(1, 0, At, B0); PG8_MMA(1, 1, At, B1); PG8_BAR; PG8_SCHED;
            } else {
            PG8_LDB(B0, 0, 0); PG8_SCHED; PG8_LDA(At, 0, 0); PG8_STAGE(PG8_SA(1, 1), a1 + hstep, voffA);
            PG8_WAIT_L(8); PG8_BAR; PG8_WAIT_L(0); PG8_MMA(0, 0, At, B0); PG8_BAR; PG8_SCHED;
            PG8_LDB(B1, 0, 1); PG8_STAGE(PG8_SB(0, 0), b2, voffB);
            PG8_BAR; PG8_WAIT_L(0); PG8_MMA(0, 1, At, B1); PG8_BAR;
            PG8_LDA(At, 0, 1); PG8_STAGE(PG8_SA(0, 0), a2, voffA);
            PG8_BAR; PG8_WAIT_L(0); PG8_MMA(1, 0, At, B0); PG8_BAR; PG8_SCHED;
            PG8_STAGE(PG8_SB(0, 1), b2 + hstep, voffB);
            PG8_WAIT_V(6); PG8_BAR; PG8_MMA(1, 1, At, B1); PG8_BAR;
            PG8_LDB(B0, 1, 0); PG8_SCHED; PG8_LDA(At, 1, 0); PG8_STAGE(PG8_SA(0, 1), a2 + hstep, voffA);
            PG8_WAIT_L(8); PG8_BAR; PG8_WAIT_L(0); PG8_MMA(0, 0, At, B0); PG8_BAR; PG8_SCHED;
            PG8_LDB(B1, 1, 1); PG8_STAGE(PG8_SB(1, 0), b3, voffB);
            PG8_BAR; PG8_WAIT_L(0); PG8_MMA(0, 1, At, B1); PG8_BAR;
            PG8_LDA(At, 1, 1); PG8_STAGE(PG8_SA(1, 0), a3, voffA);
            PG8_BAR; PG8_WAIT_L(0); PG8_MMA(1, 0, At, B0); PG8_BAR; PG8_SCHED;
            PG8_STAGE(PG8_SB(1, 1), b3 + hstep, voffB);
            PG8_WAIT_V(6); PG8_BAR; PG8_MMA(1, 1, At, B1); PG8_BAR;
            }
        }
        if constexpr (ALIGN_EPI) { if (wr == 0) PG8_BAR; }
        if constexpr (!Epi::AFTER_DRAIN) { E(acc, cur, wr, wc, fr, fq); S.done(cur); }
        const bool keep_acc = E.keep(cur);
        if (!has_next) break;
        if (!keep_acc) {
#pragma unroll
        for (int a = 0; a < 2; ++a)
#pragma unroll
            for (int b = 0; b < 2; ++b)
#pragma unroll
                for (int m = 0; m < 4; ++m)
#pragma unroll
                    for (int n = 0; n < 2; ++n) acc[a][b][m][n] = (f32x4){0.f, 0.f, 0.f, 0.f};
        }
        cur = nxt; cA = nA; cB = nB; ++ui;
        if constexpr (ALIGN_EPI) { if (wr == 1) PG8_BAR; }
    }
    PG8_WAIT_V(0);
    if constexpr (!ALIGN_EPI) { if (wr == 0) PG8_BAR; }
    PG8_BAR;
    if constexpr (Epi::AFTER_DRAIN) { E.fused(acc, cur, wr, wc, fr, fq, lds, wid, lane); S.done(cur); }
#undef PG8_SA
#undef PG8_SB
#undef PG8_STAGE
#undef PG8_LDA
#undef PG8_LDB
#undef PG8_MMA
#undef PG8_WAIT_V
#undef PG8_WAIT_L
#undef PG8_BAR
#undef PG8_SCHED
}
}

namespace {
using pg8::bf16_t; using pg8::f32x4; using pg8::u32x4; using pg8::Unit;
#define LAS __attribute__((address_space(3)))
constexpr int M = 16384, D = 1024, T = 2048, NB = 8, MEMLEN = 256, MM = NB * MEMLEN;
constexpr int INC = 6416, DFF = 4096, NCH = 32, NH = 8;
constexpr float EPS = 1e-6f;
constexpr size_t MiB = 1u << 20;
constexpr size_t WS_POOL_C = 77u << 20;
constexpr size_t WS_BAR = 0;
constexpr size_t WS_ROWSS = WS_POOL_C + 174 * (1u << 20);
constexpr size_t WS_ZERO_BYTES = 64 * 1024;
constexpr size_t WS_ROWSS_MEM = WS_POOL_C + 173 * (1u << 20);
constexpr size_t WS_G = 400 * 1024, WS_ML = 408 * 1024, WS_MIN = 416 * 1024;
constexpr size_t WS_DN = 512 * 1024;
constexpr size_t WS_WT = 1 * MiB;
constexpr size_t WT_WIN = 0, WT_WMEM = (size_t)6656 * D * 2, WT_WBR = WT_WMEM + (size_t)D * D * 2, WT_WOUT = WT_WBR + (size_t)3 * D * 512 * 2,
                 WT_FF1 = WT_WOUT + (size_t)D * D * 2, WT_FF2 = WT_FF1 + (size_t)DFF * D * 2, WT_LAYER = WT_FF2 + (size_t)D * DFF * 2;
constexpr size_t WS_MEMB = 73 * MiB, WS_POOL = 77 * MiB, WS_END = 256 * MiB;
static_assert(WS_WT + 2 * WT_LAYER <= WS_MEMB && WS_POOL_C == WS_POOL, "weights fit");
constexpr int LDS_RING = 131072, LDS_BYTES = 147456, LDS_CTL = LDS_BYTES - 256, LDS_RSTD0 = LDS_RING, LDS_RSTD1 = LDS_RING + 1024;

struct P {
    const float *x, *mem, *rel_bias, *g_mix, *w_in, *conv_w, *b_i, *b_f, *norm_g, *sinks, *g_mem, *w_mem_kv, *w_br0, *w_br1, *w_br2, *w_out, *g_ffn, *w_ff1, *w_ff2, *g_final;
    float* out; unsigned char* ws;
};
struct LB {
    bf16_t *xbin, *sq, *mo, *xq, *skv, *mqk, *mv, *memkv, *merged, *xbmid, *hff, *xbnext;
    unsigned char* gates;
    float* iff; bf16_t* state;
    const bf16_t *win, *wmem, *wbr, *wout, *wff1, *wff2;
};
__host__ __device__ inline LB layer_buf(unsigned char* ws, float* out, int l) {
    LB b; unsigned char* pool = ws + WS_POOL; unsigned char* breg = pool;
    b.xbin = (bf16_t*)out; b.xbmid = (bf16_t*)((unsigned char*)out + 32 * MiB); b.xbnext = l == 1 ? (bf16_t*)(pool + 128 * MiB) : (bf16_t*)out;
    b.merged = (bf16_t*)(pool + 48 * MiB); b.hff = (bf16_t*)pool;
    b.sq = (bf16_t*)breg; b.mo = (bf16_t*)(breg + 16 * MiB); b.xq = (bf16_t*)(breg + 32 * MiB);
    b.gates = pool + 125 * MiB;
    b.skv = (bf16_t*)(breg + 48 * MiB); b.mqk = (bf16_t*)(breg + 56 * MiB); b.mv = (bf16_t*)(breg + 88 * MiB);
    b.iff = (float*)(breg + 104 * MiB); b.memkv = (bf16_t*)(breg + 105 * MiB); b.state = (bf16_t*)(breg + 109 * MiB);
    unsigned char* wt = ws + WS_WT + (size_t)l * WT_LAYER;
    b.win = (const bf16_t*)(wt + WT_WIN); b.wmem = (const bf16_t*)(wt + WT_WMEM); b.wbr = (const bf16_t*)(wt + WT_WBR);
    b.wout = (const bf16_t*)(wt + WT_WOUT); b.wff1 = (const bf16_t*)(wt + WT_FF1); b.wff2 = (const bf16_t*)(wt + WT_FF2);
    return b;
}
__device__ __forceinline__ float* ws_f(unsigned char* ws, size_t off) { return (float*)(ws + off); }

__device__ __forceinline__ float bf2f(bf16_t h) { return __uint_as_float(((unsigned)h) << 16); }
__device__ __forceinline__ bf16_t f2bf(float f) { unsigned u = __float_as_uint(f); u = (u + 0x7fffu + ((u >> 16) & 1u)) >> 16; return (bf16_t)u; }
__device__ __forceinline__ unsigned pk2(float lo, float hi) { return (unsigned)f2bf(lo) | ((unsigned)f2bf(hi) << 16); }
__device__ __forceinline__ float sigmoidf_(float v) { return 1.f / (1.f + expf(-v)); }
__device__ __forceinline__ float fsigmoid(float v) { return __builtin_amdgcn_rcpf(1.f + __expf(-v)); }
__device__ __forceinline__ float wave_sum(float v) {
#pragma unroll
    for (int o = 1; o < 64; o <<= 1) v += __shfl_xor(v, o);
    return v;
}
__device__ __forceinline__ float wave_max(float v) {
#pragma unroll
    for (int o = 1; o < 64; o <<= 1) v = fmaxf(v, __shfl_xor(v, o));
    return v;
}
__device__ __forceinline__ void unpack8(const uint4 a, float (&f)[8]) {
    f[0] = __uint_as_float(a.x << 16); f[1] = __uint_as_float(a.x & 0xffff0000u); f[2] = __uint_as_float(a.y << 16); f[3] = __uint_as_float(a.y & 0xffff0000u);
    f[4] = __uint_as_float(a.z << 16); f[5] = __uint_as_float(a.z & 0xffff0000u); f[6] = __uint_as_float(a.w << 16); f[7] = __uint_as_float(a.w & 0xffff0000u);
}
__device__ const unsigned char T5_BUCKET[128] = {0, 1, 2, 3, 4, 5, 6, 7, 8, 9, 10, 11, 12, 13, 14, 15, 16, 16, 16, 17, 17, 18, 18, 18, 19, 19, 19, 20, 20, 20, 20, 21, 21, 21, 21, 22, 22, 22, 22, 22, 23, 23, 23, 23, 23, 23, 24, 24, 24, 24, 24, 24, 25, 25, 25, 25, 25, 25, 25, 26, 26, 26, 26, 26, 26, 26, 26, 27, 27, 27, 27, 27, 27, 27, 27, 27, 27, 28, 28, 28, 28, 28, 28, 28, 28, 28, 28, 29, 29, 29, 29, 29, 29, 29, 29, 29, 29, 29, 29, 30, 30, 30, 30, 30, 30, 30, 30, 30, 30, 30, 30, 30, 30, 31, 31, 31, 31, 31, 31, 31, 31, 31, 31, 31, 31, 31, 31, 31};

__device__ __forceinline__ float rstd_of(const float* rp, int row) {
    const f32x4* q = (const f32x4*)(rp + (size_t)row * 16); const f32x4 a = q[0], b = q[1], c = q[2], d = q[3];
    const float ss = ((a[0] + a[1]) + (a[2] + a[3])) + ((b[0] + b[1]) + (b[2] + b[3])) + (((c[0] + c[1]) + (c[2] + c[3])) + ((d[0] + d[1]) + (d[2] + d[3])));
    return rsqrtf(ss * (1.f / D) + EPS);
}
__device__ __forceinline__ void fill_rstd_table(const float* rp, int rm, LAS float* tab) {
    const int t = threadIdx.x; if (t < 256) tab[t] = rstd_of(rp, rm * 256 + t);
}
struct SchedRounds {
    int G, c, nfull, pn_base, tail, skip_at;
    __device__ __forceinline__ bool next(int i, Unit& u) const {
        const int L = i * G + c;
        if (L < nfull * 256) { const int r = L >> 8, w = L & 255, x = w & 7, j = w >> 3; u.pm = u.rm = 8 * x + (j & 7); u.pn = pn_base + 4 * r + (j >> 3) + (r >= skip_at ? 1 : 0); u.kind = 0; u.asel = 0; return true; }
        if (!tail) return false;
        const int t = L - nfull * 256;
        if (t < 64) { u.pm = u.rm = t; u.pn = 12; u.kind = 0; u.asel = 0; return true; }
        if (t < 128) { u.pm = u.rm = t - 64; u.pn = 25; u.kind = 0; u.asel = 0; return true; }
        if (t < 160) { const int q = t - 128; u.pm = u.rm = q >> 2; u.pn = 26 + (q & 3); u.kind = 1; u.asel = 1; return true; }
        return false;
    }
    __device__ __forceinline__ void a_ready(const Unit&) const {}
    __device__ __forceinline__ void done(const Unit&) const {}
};
struct SchedMerged {
    int G, c;
    __device__ __forceinline__ bool next(int i, Unit& u) const {
        const int tt = (i / 3) * G + c, seg = i % 3; if (tt >= 256) return false;
        const int x = tt & 7, j = tt >> 3; u.rm = 8 * x + (j & 7); u.pm = seg * 64 + u.rm; u.pn = seg * 4 + (j >> 3); u.kind = seg; u.asel = 0; return true;
    }
    __device__ __forceinline__ void a_ready(const Unit&) const {}
    __device__ __forceinline__ void done(const Unit&) const {}
};

__device__ __forceinline__ u32x4 pack8(f32x4 a, f32x4 b) { u32x4 w; w.x = pg8::cvt_pk_bf16(a[0], a[1]); w.y = pg8::cvt_pk_bf16(a[2], a[3]); w.z = pg8::cvt_pk_bf16(b[0], b[1]); w.w = pg8::cvt_pk_bf16(b[2], b[3]); return w; }
__device__ __forceinline__ f32x4 sig4(f32x4 v) { f32x4 r; r[0] = fsigmoid(v[0]); r[1] = fsigmoid(v[1]); r[2] = fsigmoid(v[2]); r[3] = fsigmoid(v[3]); return r; }
struct EpiProjMK {
    static constexpr bool PERM = true, AFTER_DRAIN = false;
    LB L; const LAS float* tab0; const LAS float* tab1; int rm0;
    __device__ __forceinline__ bool keep(const Unit&) const { return false; }
    __device__ __forceinline__ void operator()(f32x4 (&acc)[2][2][4][2], const Unit& u, int wr, int wc, int fr, int fq) const {
        const int rbase = u.rm * 256 + wr * 64 + fr, cin = wc * 32 + 8 * fq, rloc = wr * 64 + fr;
        const LAS float* rs = (u.kind == 0 && u.rm == rm0) ? tab0 : tab1; bf16_t* dst; int ld, coff; bool sig = false; const int tile = u.pn;
        if (u.kind == 1) { dst = L.memkv; ld = 1024; coff = (tile - 26) * 256; }
        else if (tile < 2) { dst = L.sq; ld = 512; coff = tile * 256; }
        else if (tile < 3) { dst = L.skv; ld = 256; coff = 0; }
        else if (tile < 7) { dst = L.mqk; ld = 1024; coff = (tile - 3) * 256; }
        else if (tile < 9) { dst = L.mv; ld = 512; coff = (tile - 7) * 256; }
        else if (tile < 11) { dst = L.mo; ld = 512; coff = (tile - 9) * 256; sig = true; }
        else if (tile < 13) { dst = L.xq; ld = 512; coff = (tile - 11) * 256; }
        else { dst = nullptr; ld = 0; coff = 0; }
#pragma unroll
        for (int ai = 0; ai < 2; ++ai)
#pragma unroll
            for (int m = 0; m < 4; ++m) {
                const int row = rbase + ai * 128 + m * 16; const float rstd = rs[rloc + ai * 128 + m * 16];
#pragma unroll
                for (int bj = 0; bj < 2; ++bj) {
                    if (dst == nullptr && tile < 25) {
                        const float nsc = rstd * -1.4426950408889634f; const f32x4 a0 = acc[ai][bj][m][0], a1 = acc[ai][bj][m][1]; uint2 w; w.x = 0u; w.y = 0u;
#pragma unroll
                        for (int j = 0; j < 4; ++j) {
                            w.x = __builtin_amdgcn_cvt_pk_u8_f32(floorf(__builtin_amdgcn_rcpf(1.f + __builtin_amdgcn_exp2f(a0[j] * nsc)) * 256.f), j, w.x);
                            w.y = __builtin_amdgcn_cvt_pk_u8_f32(floorf(__builtin_amdgcn_rcpf(1.f + __builtin_amdgcn_exp2f(a1[j] * nsc)) * 256.f), j, w.y); }
                        *(uint2*)(L.gates + (size_t)row * 3072 + (tile - 13) * 256 + bj * 128 + cin) = w; continue; }
                    f32x4 v0, v1;
                    if (sig) { const float nsc = rstd * -1.4426950408889634f; const f32x4 a0 = acc[ai][bj][m][0], a1 = acc[ai][bj][m][1];
#pragma unroll
                        for (int j = 0; j < 4; ++j) { v0[j] = __builtin_amdgcn_rcpf(1.f + __builtin_amdgcn_exp2f(a0[j] * nsc)); v1[j] = __builtin_amdgcn_rcpf(1.f + __builtin_amdgcn_exp2f(a1[j] * nsc)); } }
                    else { v0 = acc[ai][bj][m][0] * rstd; v1 = acc[ai][bj][m][1] * rstd; }
                    if (dst) *(u32x4*)((unsigned char*)dst + (unsigned)((row * ld + coff + bj * 128 + cin) * 2)) = pack8(v0, v1);
                    else if (bj == 0 && cin < 16) { *(f32x4*)(L.iff + (size_t)row * 16 + cin) = v0; *(f32x4*)(L.iff + (size_t)row * 16 + cin + 4) = v1; }
                }
            }
    }
};
struct EpiMergedMK {
    static constexpr bool PERM = true, AFTER_DRAIN = false;
    const unsigned char* gates; bf16_t* merged;
    __device__ __forceinline__ bool keep(const Unit& u) const { return u.kind < 2; }
    __device__ __forceinline__ static void deq8(uint2 w, float (&g)[8]) {
        g[0] = (float)(w.x & 255u) + 0.5f; g[1] = (float)((w.x >> 8) & 255u) + 0.5f; g[2] = (float)((w.x >> 16) & 255u) + 0.5f; g[3] = (float)(w.x >> 24) + 0.5f;
        g[4] = (float)(w.y & 255u) + 0.5f; g[5] = (float)((w.y >> 8) & 255u) + 0.5f; g[6] = (float)((w.y >> 16) & 255u) + 0.5f; g[7] = (float)(w.y >> 24) + 0.5f; }
    __device__ __forceinline__ void operator()(f32x4 (&acc)[2][2][4][2], const Unit& u, int wr, int wc, int fr, int fq) const {
        const int rbase = u.rm * 256 + wr * 64 + fr, col0 = (u.pn & 3) * 256 + wc * 32 + 8 * fq, seg = u.kind;
#pragma unroll
        for (int ai = 0; ai < 2; ++ai) {
            uint2 gs[4][2], gn[4][2];
#pragma unroll
            for (int m = 0; m < 4; ++m)
#pragma unroll
                for (int bj = 0; bj < 2; ++bj) { const unsigned char* gp = gates + (size_t)(rbase + ai * 128 + m * 16) * 3072 + seg * 1024 + col0 + bj * 128;
                    gs[m][bj] = *(const uint2*)gp; gn[m][bj] = seg < 2 ? *(const uint2*)(gp + 1024) : make_uint2(0u, 0u); }
#pragma unroll
            for (int m = 0; m < 4; ++m) {
                const int row = rbase + ai * 128 + m * 16;
#pragma unroll
                for (int bj = 0; bj < 2; ++bj) {
                    const int col = col0 + bj * 128;
                    float g[8]; deq8(gs[m][bj], g);
                    if (seg < 2) { float gd[8]; deq8(gn[m][bj], gd);
#pragma unroll
                        for (int j = 0; j < 8; ++j) g[j] = g[j] * __builtin_amdgcn_rcpf(gd[j]); }
                    else {
#pragma unroll
                        for (int j = 0; j < 8; ++j) g[j] *= (1.f / 256.f); }
                    f32x4 v0 = acc[ai][bj][m][0], v1 = acc[ai][bj][m][1];
                    v0[0] *= g[0]; v0[1] *= g[1]; v0[2] *= g[2]; v0[3] *= g[3]; v1[0] *= g[4]; v1[1] *= g[5]; v1[2] *= g[6]; v1[3] *= g[7];
                    acc[ai][bj][m][0] = v0; acc[ai][bj][m][1] = v1;
                    if (seg == 2) *(u32x4*)(merged + (size_t)row * D + col) = pack8(v0, v1);
                }
            }
            asm volatile("" ::: "memory");
        }
    }
};
struct EpiResidMK {
    static constexpr bool PERM = true, AFTER_DRAIN = false;
    const bf16_t* xold; bf16_t* xnew; float* rowss;
    __device__ __forceinline__ bool keep(const Unit&) const { return false; }
    __device__ __forceinline__ void operator()(f32x4 (&acc)[2][2][4][2], const Unit& u, int wr, int wc, int fr, int fq) const {
        const int rbase = u.rm * 256 + wr * 64 + fr, col0 = u.pn * 256 + wc * 32 + 8 * fq;
#pragma unroll
        for (int ai = 0; ai < 2; ++ai) {
            uint4 xo[4][2];
#pragma unroll
            for (int m = 0; m < 4; ++m)
#pragma unroll
                for (int bj = 0; bj < 2; ++bj) xo[m][bj] = *(const uint4*)(xold + (size_t)(rbase + ai * 128 + m * 16) * D + col0 + bj * 128);
#pragma unroll
            for (int m = 0; m < 4; ++m) {
                const int row = rbase + ai * 128 + m * 16; const size_t off = (size_t)row * D + col0; float ss = 0.f;
#pragma unroll
                for (int bj = 0; bj < 2; ++bj) {
                    float o[8]; unpack8(xo[m][bj], o);
                    f32x4 v0 = acc[ai][bj][m][0], v1 = acc[ai][bj][m][1];
                    v0[0] += o[0]; v0[1] += o[1]; v0[2] += o[2]; v0[3] += o[3]; v1[0] += o[4]; v1[1] += o[5]; v1[2] += o[6]; v1[3] += o[7];
                    const u32x4 w = pack8(v0, v1); *(u32x4*)(xnew + off + bj * 128) = w;
                    float r[8]; unpack8(__builtin_bit_cast(uint4, w), r);
#pragma unroll
                    for (int j = 0; j < 8; ++j) ss = fmaf(r[j], r[j], ss);
                }
                ss += __shfl_xor(ss, 16); ss += __shfl_xor(ss, 32);
                if (fq == 0) rowss[(size_t)row * 16 + (u.pn & 3) * 4 + wc] = ss;
            }
            asm volatile("" ::: "memory");
        }
    }
};
struct EpiFF1MK {
    static constexpr bool PERM = true, AFTER_DRAIN = false;
    bf16_t* h; const LAS float* tab0;
    __device__ __forceinline__ bool keep(const Unit&) const { return false; }
    __device__ __forceinline__ void operator()(f32x4 (&acc)[2][2][4][2], const Unit& u, int wr, int wc, int fr, int fq) const {
        const int rbase = u.rm * 256 + wr * 64 + fr, col0 = u.pn * 256 + wc * 32 + 8 * fq, rloc = wr * 64 + fr;
#pragma unroll
        for (int ai = 0; ai < 2; ++ai)
#pragma unroll
            for (int m = 0; m < 4; ++m) {
                const int row = rbase + ai * 128 + m * 16; const float rstd = tab0[rloc + ai * 128 + m * 16];
#pragma unroll
                for (int bj = 0; bj < 2; ++bj) {
                    f32x4 v0 = acc[ai][bj][m][0] * rstd, v1 = acc[ai][bj][m][1] * rstd;
#pragma unroll
                    for (int j = 0; j < 4; ++j) { v0[j] = fmaxf(v0[j], 0.f); v0[j] *= v0[j]; v1[j] = fmaxf(v1[j], 0.f); v1[j] *= v1[j]; }
                    *(u32x4*)((unsigned char*)h + (unsigned)((row * DFF + col0 + bj * 128) * 2)) = pack8(v0, v1);
                }
            }
    }
};

__device__ __forceinline__ void convert_tile_w(const float* src, int ldsrc, int col0, int ncols, int k0, const float* gain, float scale, bf16_t* dst, int K, float* tile, int lane) {
    const int n4 = (lane & 15) * 4;
    f32x4 v[16];
#pragma unroll
    for (int i = 0; i < 16; ++i) { const int kk = (lane >> 4) + 4 * i; v[i] = n4 < ncols ? *(const f32x4*)(src + (size_t)(k0 + kk) * ldsrc + col0 + n4) : (f32x4){0.f, 0.f, 0.f, 0.f}; }
#pragma unroll
    for (int i = 0; i < 16; ++i) { const int kk = (lane >> 4) + 4 * i; const f32x4 w = v[i] * ((gain ? gain[k0 + kk] : 1.f) * scale);
        tile[kk * 65 + n4] = w[0]; tile[kk * 65 + n4 + 1] = w[1]; tile[kk * 65 + n4 + 2] = w[2]; tile[kk * 65 + n4 + 3] = w[3]; }
    asm volatile("s_waitcnt lgkmcnt(0)" ::: "memory");
    const int kc = lane & 7;
#pragma unroll
    for (int i = 0; i < 8; ++i) { const int n = (lane >> 3) + 8 * i; const float* tp = tile + (8 * kc) * 65 + n;
        u32x4 w; w.x = pk2(tp[0], tp[65]); w.y = pk2(tp[130], tp[195]); w.z = pk2(tp[260], tp[325]); w.w = pk2(tp[390], tp[455]);
        if (n < ncols) *(u32x4*)(dst + (size_t)n * K + k0 + 8 * kc) = w; }
    asm volatile("s_waitcnt lgkmcnt(0)" ::: "memory");
}
constexpr int CV_ITEMS_LAYER = 4560;
__device__ __forceinline__ void convert_item(const P& p, int item, float* tile, int lane) {
    const int l = item / CV_ITEMS_LAYER; int r = item % CV_ITEMS_LAYER;
    unsigned char* wt = p.ws + WS_WT + (size_t)l * WT_LAYER;
    const float* src; const float* gain = nullptr; int ld, col0, ncols, K; float sc = 1.f; bf16_t* dst;
    if (r < 1616) {
        const float* win = p.w_in + (size_t)l * D * INC; src = win; ld = INC; K = D; gain = p.g_mix + l * D; int dr;
        if (r < 128) { col0 = 0; ncols = 512; dr = 0; sc = 0.125f; }
        else if ((r -= 128) < 448) { col0 = 512; ncols = 1792; dr = 512; }
        else if ((r -= 448) < 128) { col0 = 2320; ncols = 512; dr = 2304; }
        else if ((r -= 128) < 128) { col0 = 2832; ncols = 512; dr = 2816; sc = 0.08838834764831845f; }
        else if ((r -= 128) < 768) { col0 = 3344; ncols = 3072; dr = 3328; }
        else { r -= 768; col0 = 2304; ncols = 16; dr = 6400; }
        dst = (bf16_t*)(wt + WT_WIN) + (size_t)dr * D;
    } else if ((r -= 1616) < 256) { src = p.w_mem_kv + (size_t)l * D * 1024; ld = 1024; col0 = 0; ncols = 1024; K = D; gain = p.g_mem + l * D; dst = (bf16_t*)(wt + WT_WMEM); }
    else if ((r -= 256) < 384) { const int sg = r / 128; r -= sg * 128; src = (sg == 0 ? p.w_br0 : sg == 1 ? p.w_br1 : p.w_br2) + (size_t)l * 512 * 1024; ld = 1024; col0 = 0; ncols = 1024; K = 512; dst = (bf16_t*)(wt + WT_WBR) + (size_t)sg * 1024 * 512; }
    else if ((r -= 384) < 256) { src = p.w_out + (size_t)l * D * D; ld = 1024; col0 = 0; ncols = 1024; K = D; dst = (bf16_t*)(wt + WT_WOUT); }
    else if ((r -= 256) < 1024) { src = p.w_ff1 + (size_t)l * D * DFF; ld = DFF; col0 = 0; ncols = DFF; K = D; gain = p.g_ffn + l * D; dst = (bf16_t*)(wt + WT_FF1); }
    else { r -= 1024; src = p.w_ff2 + (size_t)l * DFF * D; ld = D; col0 = 0; ncols = D; K = DFF; dst = (bf16_t*)(wt + WT_FF2); }
    const int nnb = (ncols + 63) / 64, kb = r / nnb, nb = r % nnb, c0 = nb * 64, nc = (ncols - c0) < 64 ? (ncols - c0) : 64;
    convert_tile_w(src, ld, col0 + c0, nc, kb * 64, gain, sc, dst + (size_t)c0 * K, K, tile, lane);
}
__device__ __forceinline__ void rowstat_rows(const float* src, int rows, bf16_t* xb, float* rowss, int gw, int ngw, int lane) {
    for (int r = gw; r < rows; r += 2 * ngw) {
        const int r1 = r + ngw; const bool two = r1 < rows;
        const float4* s0 = (const float4*)(src + (size_t)r * D); const float4* s1 = (const float4*)(src + (size_t)(two ? r1 : r) * D);
        float4 a[4], b[4];
#pragma unroll
        for (int j = 0; j < 4; ++j) { a[j] = s0[lane + 64 * j]; b[j] = s1[lane + 64 * j]; }
        float ssa = 0.f, ssb = 0.f;
#pragma unroll
        for (int j = 0; j < 4; ++j) { ssa += a[j].x * a[j].x + a[j].y * a[j].y + a[j].z * a[j].z + a[j].w * a[j].w; ssb += b[j].x * b[j].x + b[j].y * b[j].y + b[j].z * b[j].z + b[j].w * b[j].w;
            uint2 o; o.x = pk2(a[j].x, a[j].y); o.y = pk2(a[j].z, a[j].w); *(uint2*)(xb + (size_t)r * D + 4 * (lane + 64 * j)) = o;
            if (two) { uint2 o1; o1.x = pk2(b[j].x, b[j].y); o1.y = pk2(b[j].z, b[j].w); *(uint2*)(xb + (size_t)r1 * D + 4 * (lane + 64 * j)) = o1; } }
        ssa = wave_sum(ssa); ssb = wave_sum(ssb);
        if (lane < 16) { rowss[(size_t)r * 16 + lane] = lane == 0 ? ssa : 0.f; if (two) rowss[(size_t)r1 * 16 + lane] = lane == 0 ? ssb : 0.f; }
    }
}
__device__ __forceinline__ void finalnorm_rows(const bf16_t* xb, float* out, const float* rowss, const float* g, int gw, int ngw, int lane) {
    for (int r = gw; r < M; r += ngw) {
        const float rstd = rstd_of(rowss, r);
#pragma unroll
        for (int j = 0; j < 2; ++j) { float x[8]; unpack8(*(const uint4*)(xb + (size_t)r * D + 8 * (lane + 64 * j)), x);
            const float4 g0 = *(const float4*)(g + 8 * (lane + 64 * j)), g1 = *(const float4*)(g + 8 * (lane + 64 * j) + 4);
            float4 o0, o1; o0.x = x[0] * rstd * g0.x; o0.y = x[1] * rstd * g0.y; o0.z = x[2] * rstd * g0.z; o0.w = x[3] * rstd * g0.w;
            o1.x = x[4] * rstd * g1.x; o1.y = x[5] * rstd * g1.y; o1.z = x[6] * rstd * g1.z; o1.w = x[7] * rstd * g1.w;
            *(float4*)(out + (size_t)r * D + 8 * (lane + 64 * j)) = o0; *(float4*)(out + (size_t)r * D + 8 * (lane + 64 * j) + 4) = o1; }
    }
}

typedef short bf16x8 __attribute__((ext_vector_type(8)));
typedef short s16x4 __attribute__((ext_vector_type(4)));
typedef float f32x16 __attribute__((ext_vector_type(16)));
typedef float f32x2 __attribute__((ext_vector_type(2)));
typedef __bf16 bf16x2v __attribute__((ext_vector_type(2)));
#define MFMA32(a, b, c) __builtin_amdgcn_mfma_f32_32x32x16_bf16((a), (b), (c), 0, 0, 0)
__device__ __forceinline__ int crow(int reg, int h) { return (reg & 3) + 8 * (reg >> 2) + 4 * h; }
__device__ __forceinline__ unsigned pkbf(float a, float b) { return __builtin_bit_cast(unsigned, __builtin_convertvector((f32x2){a, b}, bf16x2v)); }
__device__ __forceinline__ bf16x8 pack_step(const f32x16& x, int s) {
    u32x4 p; p.x = pkbf(x[8 * s], x[8 * s + 1]); p.y = pkbf(x[8 * s + 2], x[8 * s + 3]); p.z = pkbf(x[8 * s + 4], x[8 * s + 5]); p.w = pkbf(x[8 * s + 6], x[8 * s + 7]);
    return __builtin_bit_cast(bf16x8, p);
}
__device__ __forceinline__ bf16x8 tr_frag(const LAS unsigned char* img, int row_lo, int row_hi, int lane) {
    const int i16 = lane & 15, q = i16 >> 2, p = i16 & 3, blk = (lane >> 4) & 1;
    const s16x4 lo = __builtin_amdgcn_ds_read_tr16_b64_v4i16((LAS s16x4*)(img + (row_lo + q) * 64 + 32 * blk + 8 * p));
    const s16x4 hi = __builtin_amdgcn_ds_read_tr16_b64_v4i16((LAS s16x4*)(img + (row_hi + q) * 64 + 32 * blk + 8 * p));
    return __builtin_shufflevector(lo, hi, 0, 1, 2, 3, 4, 5, 6, 7);
}

constexpr int SWA_KIMG = 0, SWA_VIMG = 256 * 144, SWA_TAB = SWA_VIMG + 2 * 16384;
__device__ __forceinline__ void swa_mfma_unit(const P& p, const LB& L, int l, int u, LAS unsigned char* l3) {
    int tid_l = threadIdx.x; asm volatile("" : "+v"(tid_l)); const int tid = tid_l, lane = tid & 63, wave = tid >> 6, h = lane >> 5, ql = lane & 31;
    const int hkv = u & 1, n = (u >> 1) & 15, b = u >> 5;
    __syncthreads();
#pragma unroll
    for (int i = 0; i < 4; ++i) {
        const int c = tid + 512 * i, row = c >> 3, cc = c & 7, t = 128 * (n - 1) + row;
        u32x4 kv = (u32x4){0u, 0u, 0u, 0u}, vv = (u32x4){0u, 0u, 0u, 0u};
        if (t >= 0) { const bf16_t* src = L.skv + (size_t)(b * T + t) * 256 + hkv * 64 + cc * 8; kv = *(const u32x4*)src; vv = *(const u32x4*)(src + 128); }
        *(LAS u32x4*)(l3 + SWA_KIMG + row * 144 + cc * 16) = kv;
        *(LAS u32x4*)(l3 + SWA_VIMG + (cc >> 2) * 16384 + row * 64 + (cc & 3) * 16) = vv;
    }
    for (int idx = tid; idx < 4 * 192; idx += 512) { const int g = idx / 192, e = idx % 192, dist = 159 - e;
        ((LAS float*)(l3 + SWA_TAB))[idx] = (dist >= 0 && dist < 128) ? p.rel_bias[(int)T5_BUCKET[dist] * 8 + hkv * 4 + g] : -1e30f; }
    __syncthreads();
    const int g = wave >> 1, half = wave & 1, hq = hkv * 4 + g;
    const float sink = p.sinks[l * 8 + hq];
    const LAS float* tab = (const LAS float*)(l3 + SWA_TAB) + g * 192 + 31 - ql;
#pragma unroll 1
    for (int sb = 0; sb < 2; ++sb) {
        const int r0 = 64 * half + 32 * sb, kb0 = 2 * half + sb;
        bf16_t* qptr = L.sq + (size_t)(b * T + 128 * n + r0 + ql) * 512 + hq * 64;
        bf16x8 Qf[4];
#pragma unroll
        for (int ks = 0; ks < 4; ++ks) Qf[ks] = *(const bf16x8*)(qptr + 16 * ks + 8 * h);
        f32x16 S[5];
#pragma unroll
        for (int i = 0; i < 5; ++i) {
#pragma unroll
            for (int r = 0; r < 16; ++r) S[i][r] = 0.f;
#pragma unroll
            for (int ks = 0; ks < 4; ++ks) { const bf16x8 Kf = *(const LAS bf16x8*)(l3 + SWA_KIMG + (32 * (kb0 + i) + ql) * 144 + 32 * ks + 16 * h); S[i] = MFMA32(Kf, Qf[ks], S[i]); }
        }
        float m = sink;
#pragma unroll
        for (int i = 0; i < 5; ++i)
#pragma unroll
            for (int r = 0; r < 16; ++r) { const int kk = 32 * i + crow(r, h); float sv = S[i][r] + tab[kk];
                if (n == 0 && 32 * kb0 + kk < 128) sv = -1e30f;
                S[i][r] = sv; m = fmaxf(m, sv); }
        m = fmaxf(m, __shfl_xor(m, 32));
        float lsum = 0.f;
#pragma unroll
        for (int i = 0; i < 5; ++i)
#pragma unroll
            for (int r = 0; r < 16; ++r) { const float pe = __expf(S[i][r] - m); S[i][r] = pe; lsum += pe; }
        lsum += __shfl_xor(lsum, 32);
        f32x16 O[2];
#pragma unroll
        for (int db = 0; db < 2; ++db)
#pragma unroll
            for (int r = 0; r < 16; ++r) O[db][r] = 0.f;
#pragma unroll
        for (int i = 0; i < 5; ++i)
#pragma unroll
            for (int s2 = 0; s2 < 2; ++s2) { const bf16x8 Pf = pack_step(S[i], s2); const int k0 = 32 * (kb0 + i) + 16 * s2;
#pragma unroll
                for (int db = 0; db < 2; ++db) { const bf16x8 Vf = tr_frag(l3 + SWA_VIMG + db * 16384, k0 + 4 * h, k0 + 8 + 4 * h, lane); O[db] = MFMA32(Vf, Pf, O[db]); } }
        const float inv = 1.f / (lsum + __expf(sink - m));
#pragma unroll
        for (int db = 0; db < 2; ++db)
#pragma unroll
            for (int gq = 0; gq < 4; ++gq) { uint2 w; w.x = pkbf(O[db][4 * gq] * inv, O[db][4 * gq + 1] * inv); w.y = pkbf(O[db][4 * gq + 2] * inv, O[db][4 * gq + 3] * inv);
                *(uint2*)(qptr + 32 * db + 8 * gq + 4 * h) = w; }
    }
}

constexpr int XA_KIMG = 0, XA_VIMG = 256 * 272;
__device__ __forceinline__ void xattn_mfma_unit(const LB& L, int u, LAS unsigned char* l3) {
    int tid_l = threadIdx.x; asm volatile("" : "+v"(tid_l)); const int tid = tid_l, lane = tid & 63, wave = tid >> 6, h = lane >> 5, ql = lane & 31;
    const int qb = u & 7, hx = (u >> 3) & 3, b = u >> 5;
    __syncthreads();
#pragma unroll
    for (int i = 0; i < 8; ++i) {
        const int c = tid + 512 * i, row = c >> 4, cc = c & 15;
        const bf16_t* src = L.memkv + (size_t)(b * MEMLEN + row) * 1024 + hx * 128 + cc * 8;
        const u32x4 kv = *(const u32x4*)src, vv = *(const u32x4*)(src + 512);
        *(LAS u32x4*)(l3 + XA_KIMG + row * 272 + cc * 16) = kv;
        *(LAS u32x4*)(l3 + XA_VIMG + (cc >> 2) * 16384 + row * 64 + (cc & 3) * 16) = vv;
    }
    bf16_t* qptr = L.xq + (size_t)(b * T + qb * 256 + wave * 32 + ql) * 512 + hx * 128;
    bf16x8 Qf[8];
#pragma unroll
    for (int ks = 0; ks < 8; ++ks) Qf[ks] = *(const bf16x8*)(qptr + 16 * ks + 8 * h);
    __syncthreads();
    f32x16 S[8];
    {
#pragma unroll
        for (int i = 0; i < 8; ++i) {
#pragma unroll
            for (int r = 0; r < 16; ++r) S[i][r] = 0.f;
#pragma unroll
            for (int ks = 0; ks < 8; ++ks) { const bf16x8 Kf = *(const LAS bf16x8*)(l3 + XA_KIMG + (32 * i + ql) * 272 + 32 * ks + 16 * h); S[i] = MFMA32(Kf, Qf[ks], S[i]); }
        }
    }
    float m = -1e30f;
#pragma unroll
    for (int i = 0; i < 8; ++i)
#pragma unroll
        for (int r = 0; r < 16; ++r) m = fmaxf(m, S[i][r]);
    m = fmaxf(m, __shfl_xor(m, 32));
    float lsum = 0.f;
#pragma unroll
    for (int i = 0; i < 8; ++i)
#pragma unroll
        for (int r = 0; r < 16; ++r) { const float pe = __expf(S[i][r] - m); S[i][r] = pe; lsum += pe; }
    lsum += __shfl_xor(lsum, 32);
    f32x16 O[4];
#pragma unroll
    for (int db = 0; db < 4; ++db)
#pragma unroll
        for (int r = 0; r < 16; ++r) O[db][r] = 0.f;
#pragma unroll
    for (int i = 0; i < 8; ++i)
#pragma unroll
        for (int s2 = 0; s2 < 2; ++s2) { const bf16x8 Pf = pack_step(S[i], s2); const int k0 = 32 * i + 16 * s2;
#pragma unroll
            for (int db = 0; db < 4; ++db) { const bf16x8 Vf = tr_frag(l3 + XA_VIMG + db * 16384, k0 + 4 * h, k0 + 8 + 4 * h, lane); O[db] = MFMA32(Vf, Pf, O[db]); } }
    const float inv = 1.f / lsum;
#pragma unroll
    for (int db = 0; db < 4; ++db)
#pragma unroll
        for (int gq = 0; gq < 4; ++gq) { uint2 w; w.x = pkbf(O[db][4 * gq] * inv, O[db][4 * gq + 1] * inv); w.y = pkbf(O[db][4 * gq + 2] * inv, O[db][4 * gq + 3] * inv);
            *(uint2*)(qptr + 32 * db + 8 * gq + 4 * h) = w; }
}


__device__ __forceinline__ float log_sigmoid_f(float x) { return x >= 0.f ? -log1pf(expf(-x)) : x - log1pf(expf(x)); }
__device__ __forceinline__ void mlstm_gates_wave(const P& p, const LB& L, int l, int b, int c, int hh, int lane, float& bcum, float& ig) {
    const size_t row = (size_t)b * T + c * 64 + lane;
    ig = L.iff[row * 16 + hh] + p.b_i[l * 8 + hh];
    float v = log_sigmoid_f(L.iff[row * 16 + 8 + hh] + p.b_f[l * 8 + hh]);
#pragma unroll
    for (int o = 1; o < 64; o <<= 1) { const float t = __shfl_up(v, o); if (lane >= o) v += t; }
    bcum = v;
}
constexpr int MA_SLOT = 18368, MA_XK = 0, MA_VIMG = 8704, MA_T0 = 16896;
__device__ __forceinline__ void mlstm_A_mfma_unit(const P& p, const LB& L, int l, int u, LAS unsigned char* l3) {
    int tid_l = threadIdx.x; asm volatile("" : "+v"(tid_l)); const int tid = tid_l, lane = tid & 63, hh = tid >> 6, h = lane >> 5, ql = lane & 31;
    const int c = u & 31, b = u >> 5, uh = u * 8 + hh;
    LAS unsigned char* wl = l3 + hh * MA_SLOT;
    const float* cw = p.conv_w + (size_t)l * 4 * 1024;
    __syncthreads();
    {
        u32x4 xk[9], vv[8];
#pragma unroll
        for (int i = 0; i < 9; ++i) { const int idx = lane + 64 * i, ic = idx < 67 * 8 ? idx : 67 * 8 - 1, row = ic >> 3, cc = ic & 7, t = c * 64 - 3 + row;
            xk[i] = *(const u32x4*)(L.mqk + (size_t)(b * T + (t >= 0 ? t : 0)) * 1024 + 512 + hh * 64 + cc * 8); }
#pragma unroll
        for (int i = 0; i < 8; ++i) { const int s = (lane >> 3) + 8 * i, cc = lane & 7; vv[i] = *(const u32x4*)(L.mv + (size_t)(b * T + c * 64 + s) * 512 + hh * 64 + cc * 8); }
#pragma unroll
        for (int i = 0; i < 9; ++i) { const int idx = lane + 64 * i, row = idx >> 3, cc = idx & 7, t = c * 64 - 3 + row;
            if (idx < 67 * 8) *(LAS u32x4*)(wl + MA_XK + row * 128 + cc * 16) = t >= 0 ? xk[i] : (u32x4){0u, 0u, 0u, 0u}; }
#pragma unroll
        for (int i = 0; i < 8; ++i) { const int s = (lane >> 3) + 8 * i, cc = lane & 7; *(LAS u32x4*)(wl + MA_VIMG + (cc >> 2) * 4096 + s * 64 + (cc & 3) * 16) = vv[i]; }
    }
    float bcum, ig; mlstm_gates_wave(p, L, l, b, c, hh, lane, bcum, ig);
    const float g = __shfl(bcum, 63), alog = g - bcum + ig, ml = wave_max(alog);
    ((LAS float*)(wl + MA_T0))[lane] = __expf(alog - ml);
    __syncthreads();
    f32x16 acc[2][2];
#pragma unroll
    for (int a = 0; a < 2; ++a)
#pragma unroll
        for (int d = 0; d < 2; ++d)
#pragma unroll
            for (int r = 0; r < 16; ++r) acc[a][d][r] = 0.f;
    float dnacc[2] = {0.f, 0.f};
    float cwr[2][4];
#pragma unroll
    for (int dkb = 0; dkb < 2; ++dkb)
#pragma unroll
        for (int tap = 0; tap < 4; ++tap) cwr[dkb][tap] = cw[tap * 1024 + 512 + hh * 64 + 32 * dkb + ql];
#pragma unroll
    for (int ks = 0; ks < 4; ++ks) {
        const int s0 = 16 * ks + 8 * h;
        const f32x4 we0 = *(const LAS f32x4*)(wl + MA_T0 + s0 * 4), we1 = *(const LAS f32x4*)(wl + MA_T0 + s0 * 4 + 16);
        const float we[8] = {we0[0], we0[1], we0[2], we0[3], we1[0], we1[1], we1[2], we1[3]};
        bf16x8 WKf[2];
#pragma unroll
        for (int dkb = 0; dkb < 2; ++dkb) {
            float x[11];
#pragma unroll
            for (int r = 0; r < 11; ++r) x[r] = bf2f(*(const LAS unsigned short*)(wl + MA_XK + (s0 + r) * 128 + (32 * dkb + ql) * 2));
            float wk[8];
#pragma unroll
            for (int j = 0; j < 8; ++j) { const float cv = fmaf(cwr[dkb][3], x[j + 3], fmaf(cwr[dkb][2], x[j + 2], fmaf(cwr[dkb][1], x[j + 1], cwr[dkb][0] * x[j])));
                wk[j] = cv * 0.125f * __builtin_amdgcn_rcpf(1.f + __expf(-cv)) * we[j]; dnacc[dkb] += wk[j]; }
            u32x4 w; w.x = pkbf(wk[0], wk[1]); w.y = pkbf(wk[2], wk[3]); w.z = pkbf(wk[4], wk[5]); w.w = pkbf(wk[6], wk[7]);
            WKf[dkb] = __builtin_bit_cast(bf16x8, w);
        }
#pragma unroll
        for (int dvb = 0; dvb < 2; ++dvb) { const bf16x8 Vf = tr_frag(wl + MA_VIMG + dvb * 4096, s0, s0 + 4, lane);
#pragma unroll
            for (int dkb = 0; dkb < 2; ++dkb) acc[dkb][dvb] = MFMA32(WKf[dkb], Vf, acc[dkb][dvb]); }
    }
    bf16_t* st = L.state + (size_t)uh * 4096;
#pragma unroll
    for (int dkb = 0; dkb < 2; ++dkb)
#pragma unroll
        for (int dvb = 0; dvb < 2; ++dvb)
#pragma unroll
            for (int gq = 0; gq < 4; ++gq) { uint2 w; w.x = pkbf(acc[dkb][dvb][4 * gq], acc[dkb][dvb][4 * gq + 1]); w.y = pkbf(acc[dkb][dvb][4 * gq + 2], acc[dkb][dvb][4 * gq + 3]);
                *(uint2*)(st + (32 * dvb + ql) * 64 + 32 * dkb + 8 * gq + 4 * h) = w; }
#pragma unroll
    for (int dkb = 0; dkb < 2; ++dkb) { const float t = dnacc[dkb] + __shfl_xor(dnacc[dkb], 32); if (h == 0) ws_f(p.ws, WS_DN)[(size_t)uh * 64 + 32 * dkb + ql] = t; }
    if (lane == 0) { ws_f(p.ws, WS_G)[uh] = g; ws_f(p.ws, WS_ML)[uh] = ml; }
}
__device__ __forceinline__ void mlstm_scan2_unit(const P& p, const LB& L, int u) {
    int tid_l = threadIdx.x; asm volatile("" : "+v"(tid_l)); const int tid = tid_l, bh = u >> 2, b = bh >> 3, hh = bh & 7, e = (u & 3) * 1024 + 2 * tid;
    const bool first = (u & 3) == 0; const bool do_n = first && tid < 64;
    float *G = ws_f(p.ws, WS_G), *ML = ws_f(p.ws, WS_ML), *MIN = ws_f(p.ws, WS_MIN), *DN = ws_f(p.ws, WS_DN);
    unsigned d[NCH]; float dn[NCH];
#pragma unroll
    for (int c = 0; c < NCH; ++c) { const int idx = (b * NCH + c) * 8 + hh; d[c] = *(const unsigned*)(L.state + (size_t)idx * 4096 + e); dn[c] = do_n ? DN[(size_t)idx * 64 + tid] : 0.f; }
    float m = 0.f, n = 0.f, C0 = 0.f, C1 = 0.f;
#pragma unroll
    for (int c = 0; c < NCH; ++c) { const int idx = (b * NCH + c) * 8 + hh; const float g = G[idx], ml = ML[idx], mn = fmaxf(g + m, ml), a = __expf(g + m - mn), sc = __expf(ml - mn);
        *(unsigned*)(L.state + (size_t)idx * 4096 + e) = pkbf(C0, C1);
        C0 = fmaf(C0, a, sc * __uint_as_float(d[c] << 16)); C1 = fmaf(C1, a, sc * __uint_as_float(d[c] & 0xffff0000u));
        if (do_n) { DN[(size_t)idx * 64 + tid] = n; n = a * n + sc * dn[c]; }
        if (first && tid == 0) MIN[idx] = m;
        m = mn; }
}
constexpr int MC_SLOT = 31232, MC_XQ = 0, MC_XK = 9728, MC_VIMG = 19456, MC_CW = 27648, MC_T0 = 29696, MC_T1 = 29952, MC_T2 = 30208, MC_T3 = 30464, MC_T4 = 30720  , MC_T5 = 30976  ;
__device__ __forceinline__ bf16x8 conv_frag_lds(const LAS unsigned char* img, int tok, int ch0, const LAS float* cwl, float scale) {
    float a[8] = {0.f, 0.f, 0.f, 0.f, 0.f, 0.f, 0.f, 0.f};
#pragma unroll
    for (int tap = 0; tap < 4; ++tap) {
        float xf[8]; unpack8(__builtin_bit_cast(uint4, *(const LAS u32x4*)(img + (tok + tap) * 144 + ch0 * 2)), xf);
        const f32x4 w0 = *(const LAS f32x4*)(cwl + tap * 128 + ch0), w1 = *(const LAS f32x4*)(cwl + tap * 128 + ch0 + 4);
        a[0] = fmaf(w0[0], xf[0], a[0]); a[1] = fmaf(w0[1], xf[1], a[1]); a[2] = fmaf(w0[2], xf[2], a[2]); a[3] = fmaf(w0[3], xf[3], a[3]);
        a[4] = fmaf(w1[0], xf[4], a[4]); a[5] = fmaf(w1[1], xf[5], a[5]); a[6] = fmaf(w1[2], xf[6], a[6]); a[7] = fmaf(w1[3], xf[7], a[7]);
    }
#pragma unroll
    for (int j = 0; j < 8; ++j) a[j] = a[j] * scale * __builtin_amdgcn_rcpf(1.f + __expf(-a[j]));
    u32x4 w; w.x = pkbf(a[0], a[1]); w.y = pkbf(a[2], a[3]); w.z = pkbf(a[4], a[5]); w.w = pkbf(a[6], a[7]);
    return __builtin_bit_cast(bf16x8, w);
}
template <int TB>
__device__ __forceinline__ void mlstm_C_block(const LB& L, int b, int c, int hh, int lane, int h, int ql, LAS unsigned char* wl, const bf16x8 (&Cf)[2][4], const uint2 (&mo)[2][4]) {
    const LAS float* cwl = (const LAS float*)(wl + MC_CW);
    bf16x8 Qf[4]; float qn = 0.f;
#pragma unroll
    for (int ks = 0; ks < 4; ++ks) { const int ch0 = 16 * ks + 8 * h;
        Qf[ks] = conv_frag_lds(wl + MC_XQ, 32 * TB + ql, ch0, cwl, 1.f);
        const f32x4 n0 = *(const LAS f32x4*)(wl + MC_T4 + ch0 * 4), n1 = *(const LAS f32x4*)(wl + MC_T4 + ch0 * 4 + 16);
        float qv[8]; unpack8(__builtin_bit_cast(uint4, Qf[ks]), qv);
#pragma unroll
        for (int j = 0; j < 4; ++j) { qn = fmaf(qv[j], n0[j], qn); qn = fmaf(qv[j + 4], n1[j], qn); } }
    f32x16 S0, S1;
#pragma unroll
    for (int r = 0; r < 16; ++r) { S0[r] = 0.f; S1[r] = 0.f; }
#pragma unroll
    for (int ks = 0; ks < 4; ++ks) { const int ch0 = 16 * ks + 8 * h;
        S0 = MFMA32(conv_frag_lds(wl + MC_XK, ql, ch0, cwl + 64, 0.125f), Qf[ks], S0);
        if (TB == 1) S1 = MFMA32(conv_frag_lds(wl + MC_XK, 32 + ql, ch0, cwl + 64, 0.125f), Qf[ks], S1); }
    const float Mt = ((const LAS float*)(wl + MC_T1))[32 * TB + ql];
    float dsum = 0.f;
#pragma unroll
    for (int gq = 0; gq < 4; ++gq) {
        const f32x4 a0 = *(const LAS f32x4*)(wl + MC_T0 + (8 * gq + 4 * h) * 4), a1 = *(const LAS f32x4*)(wl + MC_T0 + (32 + 8 * gq + 4 * h) * 4);
#pragma unroll
        for (int j = 0; j < 4; ++j) { const int r = 4 * gq + j, sl = 8 * gq + 4 * h + j;
            if (TB == 0) { const float v = sl <= ql ? S0[r] * __expf(a0[j] - Mt) : 0.f; S0[r] = v; dsum += v; }
            else { const float v0 = S0[r] * __expf(a0[j] - Mt); S0[r] = v0; const float v1 = sl <= ql ? S1[r] * __expf(a1[j] - Mt) : 0.f; S1[r] = v1; dsum += v0 + v1; } }
    }
    f32x16 acc[2];
#pragma unroll
    for (int d = 0; d < 2; ++d)
#pragma unroll
        for (int r = 0; r < 16; ++r) acc[d][r] = 0.f;
#pragma unroll
    for (int ks = 0; ks < 4; ++ks)
#pragma unroll
        for (int dvb = 0; dvb < 2; ++dvb) acc[dvb] = MFMA32(Cf[dvb][ks], Qf[ks], acc[dvb]);
    const float iw = ((const LAS float*)(wl + MC_T2))[32 * TB + ql];
#pragma unroll
    for (int dvb = 0; dvb < 2; ++dvb)
#pragma unroll
        for (int r = 0; r < 16; ++r) acc[dvb][r] *= iw;
#pragma unroll
    for (int s2 = 0; s2 < 2; ++s2) {
        const bf16x8 P0 = pack_step(S0, s2), P1 = pack_step(S1, s2);
#pragma unroll
        for (int dvb = 0; dvb < 2; ++dvb) {
            acc[dvb] = MFMA32(tr_frag(wl + MC_VIMG + dvb * 4096, 16 * s2 + 4 * h, 16 * s2 + 8 + 4 * h, lane), P0, acc[dvb]);
            if (TB == 1) acc[dvb] = MFMA32(tr_frag(wl + MC_VIMG + dvb * 4096, 32 + 16 * s2 + 4 * h, 32 + 16 * s2 + 8 + 4 * h, lane), P1, acc[dvb]); }
    }
    dsum += __shfl_xor(dsum, 32); qn += __shfl_xor(qn, 32);
    const float den = dsum + iw * qn, mt = ((const LAS float*)(wl + MC_T3))[32 * TB + ql];
    const float sc = 1.f / fmaxf(fabsf(den), __expf(-mt));
    float sum = 0.f;
#pragma unroll
    for (int dvb = 0; dvb < 2; ++dvb)
#pragma unroll
        for (int r = 0; r < 16; ++r) { const float v = acc[dvb][r] * sc; acc[dvb][r] = v; sum += v; }
    sum += __shfl_xor(sum, 32); const float mu = sum * (1.f / 64.f);
    float var = 0.f;
#pragma unroll
    for (int dvb = 0; dvb < 2; ++dvb)
#pragma unroll
        for (int r = 0; r < 16; ++r) { const float dlt = acc[dvb][r] - mu; var += dlt * dlt; }
    var += __shfl_xor(var, 32); const float rstd = rsqrtf(var * (1.f / 64.f) + EPS);
    bf16_t* op = L.mo + (size_t)(b * T + c * 64 + 32 * TB + ql) * 512 + hh * 64;
#pragma unroll
    for (int dvb = 0; dvb < 2; ++dvb)
#pragma unroll
        for (int gq = 0; gq < 4; ++gq) { const int dv = 32 * dvb + 8 * gq + 4 * h; const f32x4 ng = *(const LAS f32x4*)(wl + MC_T5 + dv * 4);
            const uint2 mg = mo[dvb][gq];
            const float y0 = (acc[dvb][4 * gq] - mu) * rstd * ng[0] * __uint_as_float(mg.x << 16), y1 = (acc[dvb][4 * gq + 1] - mu) * rstd * ng[1] * __uint_as_float(mg.x & 0xffff0000u);
            const float y2 = (acc[dvb][4 * gq + 2] - mu) * rstd * ng[2] * __uint_as_float(mg.y << 16), y3 = (acc[dvb][4 * gq + 3] - mu) * rstd * ng[3] * __uint_as_float(mg.y & 0xffff0000u);
            uint2 w; w.x = pkbf(y0, y1); w.y = pkbf(y2, y3); *(uint2*)(op + dv) = w; }
}
__device__ __forceinline__ void mlstm_C_mfma_unit(const P& p, const LB& L, int l, int u, LAS unsigned char* l3) {
    int tid_l = threadIdx.x; asm volatile("" : "+v"(tid_l)); const int tid = tid_l, lane = tid & 63, wave = tid >> 6, h = lane >> 5, ql = lane & 31;
    const int hg = u & 1, c = (u >> 1) & 31, b = u >> 6, hh = 4 * hg + (wave >> 1), tb = wave & 1, uh = (b * 32 + c) * 8 + hh, l128 = tid & 127;
    LAS unsigned char* wl = l3 + (wave >> 1) * MC_SLOT;
    const float* cw = p.conv_w + (size_t)l * 4 * 1024;
    bf16x8 Cf[2][4]; uint2 mo[2][4];
    {
        const bf16_t* st = L.state + (size_t)uh * 4096; const bf16_t* op = L.mo + (size_t)(b * T + c * 64 + 32 * tb + ql) * 512 + hh * 64;
#pragma unroll
        for (int dvb = 0; dvb < 2; ++dvb) {
#pragma unroll
            for (int ks = 0; ks < 4; ++ks) Cf[dvb][ks] = *(const bf16x8*)(st + (32 * dvb + ql) * 64 + 16 * ks + 8 * h);
#pragma unroll
            for (int gq = 0; gq < 4; ++gq) mo[dvb][gq] = *(const uint2*)(op + 32 * dvb + 8 * gq + 4 * h);
        }
    }
    __syncthreads();
    {
        u32x4 xq[5], xk[5], vv[4]; float cwv[4];
#pragma unroll
        for (int i = 0; i < 5; ++i) { const int idx = l128 + 128 * i, ic = idx < 67 * 8 ? idx : 67 * 8 - 1, row = ic >> 3, cc = ic & 7, t = c * 64 - 3 + row;
            const bf16_t* src = L.mqk + (size_t)(b * T + (t >= 0 ? t : 0)) * 1024 + hh * 64 + cc * 8; xq[i] = *(const u32x4*)src; xk[i] = *(const u32x4*)(src + 512); }
#pragma unroll
        for (int i = 0; i < 4; ++i) { const int s = (l128 >> 3) + 16 * i, cc = l128 & 7; vv[i] = *(const u32x4*)(L.mv + (size_t)(b * T + c * 64 + s) * 512 + hh * 64 + cc * 8); }
#pragma unroll
        for (int i = 0; i < 4; ++i) { const int e = l128 + 128 * i, tap = e >> 7, wch = e & 127; cwv[i] = cw[tap * 1024 + (wch >> 6) * 512 + hh * 64 + (wch & 63)]; }
#pragma unroll
        for (int i = 0; i < 5; ++i) { const int idx = l128 + 128 * i, row = idx >> 3, cc = idx & 7, t = c * 64 - 3 + row; const u32x4 z = (u32x4){0u, 0u, 0u, 0u};
            if (idx < 67 * 8) { *(LAS u32x4*)(wl + MC_XQ + row * 144 + cc * 16) = t >= 0 ? xq[i] : z; *(LAS u32x4*)(wl + MC_XK + row * 144 + cc * 16) = t >= 0 ? xk[i] : z; } }
#pragma unroll
        for (int i = 0; i < 4; ++i) { const int s = (l128 >> 3) + 16 * i, cc = l128 & 7; *(LAS u32x4*)(wl + MC_VIMG + (cc >> 2) * 4096 + s * 64 + (cc & 3) * 16) = vv[i]; }
#pragma unroll
        for (int i = 0; i < 4; ++i) ((LAS float*)(wl + MC_CW))[l128 + 128 * i] = cwv[i];
    }
    {
        float bcum, ig; mlstm_gates_wave(p, L, l, b, c, hh, lane, bcum, ig);
        const float a = ig - bcum; float v = a;
#pragma unroll
        for (int o = 1; o < 64; o <<= 1) { const float t = __shfl_up(v, o); if (lane >= o) v = fmaxf(v, t); }
        const float m_in = ws_f(p.ws, WS_MIN)[uh], Mt = fmaxf(v, m_in);
        if (tb == 1) { ((LAS float*)(wl + MC_T4))[lane] = ws_f(p.ws, WS_DN)[(size_t)uh * 64 + lane]; ((LAS float*)(wl + MC_T5))[lane] = p.norm_g[l * 512 + hh * 64 + lane]; }
        if (tb == 0) { ((LAS float*)(wl + MC_T0))[lane] = a; ((LAS float*)(wl + MC_T1))[lane] = Mt; ((LAS float*)(wl + MC_T2))[lane] = __expf(m_in - Mt); ((LAS float*)(wl + MC_T3))[lane] = bcum + Mt; }
    }
    __syncthreads();
    if (tb == 0) mlstm_C_block<0>(L, b, c, hh, lane, h, ql, wl, Cf, mo);
    else mlstm_C_block<1>(L, b, c, hh, lane, h, ql, wl, Cf, mo);
}

#define XB_TMO      128
#define XB_XCNT(j)  (256  + 64 * (j))
#define XB_XSUB(j)  (1280 + 64 * (j))
#define XB_XGEN(j)  (2304 + 64 * (j))
#define XB_TOP      3328
#define XB_TOPGEN   3392
#define XCD_BAR_WORDS 3456
#define XB_SPIN_CAP (1u << 18)

__device__ __forceinline__ unsigned xb_ld(unsigned* p)              { return __hip_atomic_load(p, __ATOMIC_RELAXED, __HIP_MEMORY_SCOPE_AGENT); }
__device__ __forceinline__ unsigned xb_add(unsigned* p, unsigned v) { return __hip_atomic_fetch_add(p, v, __ATOMIC_RELAXED, __HIP_MEMORY_SCOPE_AGENT); }
__device__ __forceinline__ unsigned xb_xcc_id() { return (unsigned)__builtin_amdgcn_s_getreg((3 << 11) | 20) & 0xFu; }
#define XB_SPIN(cond, bar) do { unsigned _sp = 0; while (cond) { __builtin_amdgcn_s_sleep(1); \
    if ((++_sp & 255u) == 0u) { if (xb_ld(&(bar)[XB_TMO])) break; if (_sp > XB_SPIN_CAP) { atomicAdd(&(bar)[XB_TMO], 1u); break; } } } } while (0)

struct XcdBarrier {
    unsigned* bar; unsigned x;
    volatile LAS unsigned* st;
};

__device__ __forceinline__ XcdBarrier xcd_barrier_post(unsigned* bar, volatile LAS unsigned* st) {
    XcdBarrier b; b.bar = bar; b.x = xb_xcc_id(); b.st = st;
    if (threadIdx.x == 0) (void)xb_add(&bar[XB_XCNT(b.x)], 1u);
    return b;
}
__device__ __forceinline__ void xcd_barrier_complete(unsigned* bar, unsigned x, unsigned& nloc, unsigned& nx) {
    const unsigned G = gridDim.x * gridDim.y * gridDim.z;
    unsigned sum, cnt, mine, sp = 0u;
    for (;;) {
        sum = 0u; cnt = 0u; mine = 0u;
#pragma unroll
        for (unsigned j = 0; j < 16; ++j) { const unsigned c = xb_ld(&bar[XB_XCNT(j)]); sum += c; cnt += (c > 0u) ? 1u : 0u; mine = (j == x) ? c : mine; }
        if (sum == G) break;
        __builtin_amdgcn_s_sleep(1);
        if ((++sp & 255u) == 0u) { if (xb_ld(&bar[XB_TMO])) break; if (sp > XB_SPIN_CAP) { atomicAdd(&bar[XB_TMO], 1u); break; } }
    }
    nloc = mine > 0u ? mine : 1u; nx = cnt > 0u ? cnt : 1u;
}

__device__ __forceinline__ void xcd_barrier(const XcdBarrier& b) {
    asm volatile("s_waitcnt vmcnt(0)" ::: "memory");
    __syncthreads();
    if (threadIdx.x == 0) {
        unsigned* bar = b.bar;
        __builtin_amdgcn_s_waitcnt(0);
        unsigned nloc = b.st[0], nx = b.st[1];
        if (nloc == 0u) { xcd_barrier_complete(bar, b.x, nloc, nx); b.st[0] = nloc; b.st[1] = nx; }
        const unsigned old = xb_add(&bar[XB_XSUB(b.x)], 1u);
        const unsigned gen = old / nloc;
        if (old + 1u == (gen + 1u) * nloc) {
            __builtin_amdgcn_fence(__ATOMIC_RELEASE, "agent");
            asm volatile("s_waitcnt vmcnt(0)" ::: "memory");
            const unsigned og = xb_add(&bar[XB_TOP], 1u);
            const unsigned tg = og / nx;
            if (og + 1u == (tg + 1u) * nx) xb_add(&bar[XB_TOPGEN], 1u);
            else XB_SPIN(xb_ld(&bar[XB_TOPGEN]) == tg, bar);
            __builtin_amdgcn_fence(__ATOMIC_ACQUIRE, "agent");
            xb_add(&bar[XB_XGEN(b.x)], 1u);
            asm volatile("s_waitcnt vmcnt(0)" ::: "memory");
        } else {
            XB_SPIN(xb_ld(&bar[XB_XGEN(b.x)]) == gen, bar);
            __builtin_amdgcn_fence(__ATOMIC_ACQUIRE, "agent");
            asm volatile("s_waitcnt vmcnt(0)" ::: "memory");
        }
    }
    __syncthreads();
}

__global__ void __launch_bounds__(512, 2) mk_fwd(P p) {
    extern __shared__ __attribute__((aligned(16))) unsigned char lds[];
    LAS unsigned char* l3 = (LAS unsigned char*)lds;
    float* fl = (float*)lds;
    const int G = gridDim.x, bx = blockIdx.x;
    if (threadIdx.x < 64) ((LAS unsigned*)(l3 + LDS_CTL))[threadIdx.x] = 0u;
    __syncthreads();
    (void)xcd_barrier_post((unsigned*)(p.ws + WS_BAR), (volatile LAS unsigned*)(l3 + LDS_CTL + 32));
#define PR_T0 (*(volatile LAS unsigned long long*)(l3 + LDS_CTL + 64))
#define PR_ACC (*(volatile LAS unsigned long long*)(l3 + LDS_CTL + 72))
#define PH_BEGIN(id) do { if ((PROBE_MASK >> (id)) & 1) { if (bx == 0 && threadIdx.x == 0) PR_T0 = __builtin_amdgcn_s_memrealtime(); } } while (0)
#define PH_END(id) do { if ((PROBE_MASK >> (id)) & 1) { if (bx == 0 && threadIdx.x == 0) PR_ACC = PR_ACC + (__builtin_amdgcn_s_memrealtime() - PR_T0); } } while (0)
#define GRID_BAR() do { XcdBarrier b_; b_.bar = (unsigned*)(p.ws + WS_BAR); b_.x = xb_xcc_id(); b_.st = (volatile LAS unsigned*)(l3 + LDS_CTL + 32); xcd_barrier(b_); } while (0)
#define WAVE_IDS() int tid_w = threadIdx.x; asm volatile("" : "+v"(tid_w)); const int lane = tid_w & 63, gw = bx * 8 + (tid_w >> 6), ngw = G * 8

        PH_BEGIN(0);
    {
        WAVE_IDS();
        for (int it = gw; it < 2 * CV_ITEMS_LAYER; it += ngw) convert_item(p, it, fl + (tid_w >> 6) * (64 * 65), lane);
        rowstat_rows(p.x, M, layer_buf(p.ws, p.out, 0).xbin, ws_f(p.ws, WS_ROWSS), gw, ngw, lane);
        rowstat_rows(p.mem, MM, (bf16_t*)(p.ws + WS_MEMB), ws_f(p.ws, WS_ROWSS_MEM), gw, ngw, lane);
    }
    GRID_BAR();
        PH_END(0);

#pragma unroll 1
    for (int l = 0; l < 2; ++l) {
        PH_BEGIN(1);
        {
            const LB L = layer_buf(p.ws, p.out, l);
            pg8::Gemm g{L.xbin, L.win, M, 6656, D, (const bf16_t*)(p.ws + WS_MEMB)};
            SchedRounds S{G, bx, 6, 0, 1, 3};
            Unit u0, u3; S.next(0, u0); const bool has_tail = S.next(6, u3);
            fill_rstd_table(ws_f(p.ws, WS_ROWSS) + (size_t)(2 * l) * M * 16, u0.rm, (LAS float*)(l3 + LDS_RSTD0));
            if (has_tail) fill_rstd_table(u3.kind == 1 ? ws_f(p.ws, WS_ROWSS_MEM) : ws_f(p.ws, WS_ROWSS) + (size_t)(2 * l) * M * 16, u3.rm, (LAS float*)(l3 + LDS_RSTD1));
            __syncthreads();
            EpiProjMK E{L, (const LAS float*)(l3 + LDS_RSTD0), (const LAS float*)(l3 + LDS_RSTD1), u0.rm};
            pg8::gemm_phase<EpiProjMK, SchedRounds, true, true>(l3, g, S, E);
        }
        GRID_BAR();
        PH_END(1);
        PH_BEGIN(2);
        {
            const LB L = layer_buf(p.ws, p.out, l);
            PH_BEGIN(10); for (int u = bx; u < NB * 16 * 2; u += G) swa_mfma_unit(p, L, l, u, l3); PH_END(10);
            PH_BEGIN(11); for (int u = bx; u < NB * 4 * 8; u += G) xattn_mfma_unit(L, u, l3); PH_END(11);
            PH_BEGIN(12); for (int u = bx; u < NB * NCH; u += G) mlstm_A_mfma_unit(p, L, l, u, l3); PH_END(12);
        }
        GRID_BAR();
        PH_END(2);
        PH_BEGIN(3);
        {
            const LB L = layer_buf(p.ws, p.out, l);
            for (int u = bx; u < 256; u += G) mlstm_scan2_unit(p, L, u);
        }
        GRID_BAR();
        PH_END(3);
        PH_BEGIN(4);
        {
            const LB L = layer_buf(p.ws, p.out, l);
            for (int u = bx; u < NB * NCH * 2; u += G) mlstm_C_mfma_unit(p, L, l, u, l3);
        }
        GRID_BAR();
        PH_END(4);
        PH_BEGIN(6);
        {
            const LB L = layer_buf(p.ws, p.out, l);
            pg8::Gemm g{L.sq, L.wbr, 3 * M, 3 * D, 512, nullptr};
            SchedMerged S{G, bx};
            EpiMergedMK E{L.gates, L.merged};
            pg8::gemm_phase<EpiMergedMK, SchedMerged, true, true>(l3, g, S, E);
        }
        GRID_BAR();
        PH_END(6);
        PH_BEGIN(7);
        {
            const LB L = layer_buf(p.ws, p.out, l);
            pg8::Gemm g{L.merged, L.wout, M, D, D, nullptr};
            SchedRounds S{G, bx, 1, 0, 0, 99};
            EpiResidMK E{L.xbin, L.xbmid, ws_f(p.ws, WS_ROWSS) + (size_t)(2 * l + 1) * M * 16};
            pg8::gemm_phase<EpiResidMK, SchedRounds, true, true>(l3, g, S, E);
        }
        GRID_BAR();
        PH_END(7);
        PH_BEGIN(8);
        {
            const LB L = layer_buf(p.ws, p.out, l);
            pg8::Gemm g{L.xbmid, L.wff1, M, DFF, D, nullptr};
            SchedRounds S{G, bx, 4, 0, 0, 99};
            Unit u0; S.next(0, u0);
            fill_rstd_table(ws_f(p.ws, WS_ROWSS) + (size_t)(2 * l + 1) * M * 16, u0.rm, (LAS float*)(l3 + LDS_RSTD0));
            __syncthreads();
            EpiFF1MK E{L.hff, (const LAS float*)(l3 + LDS_RSTD0)};
            pg8::gemm_phase<EpiFF1MK, SchedRounds, true, true>(l3, g, S, E);
        }
        GRID_BAR();
        PH_END(8);
        PH_BEGIN(9);
        {
            const LB L = layer_buf(p.ws, p.out, l);
            pg8::Gemm g{L.hff, L.wff2, M, D, DFF, nullptr};
            SchedRounds S{G, bx, 1, 0, 0, 99};
            EpiResidMK E{L.xbmid, L.xbnext, ws_f(p.ws, WS_ROWSS) + (size_t)(2 * l + 2) * M * 16};
            pg8::gemm_phase<EpiResidMK, SchedRounds, true, true>(l3, g, S, E);
        }
        GRID_BAR();
        PH_END(9);
    }
    {
        WAVE_IDS();
        finalnorm_rows(layer_buf(p.ws, p.out, 1).xbnext, p.out, ws_f(p.ws, WS_ROWSS) + (size_t)4 * M * 16, p.g_final, gw, ngw, lane);
    }
    if (PROBE_MASK != 0 && bx == 0 && threadIdx.x == 0) { const unsigned long long te = __builtin_amdgcn_s_memrealtime(); const unsigned long long acc_ = PR_ACC; while (__builtin_amdgcn_s_memrealtime() - te < 10ull * acc_) __builtin_amdgcn_s_sleep(8); }
}
}

extern "C" void kernel_launch(void* const* d_in, const int* in_sizes, int n_in, void* d_out, int out_size, void* d_ws, size_t ws_size, hipStream_t stream) {
    static int grid = 0;
    if (grid == 0) {
        if (n_in != 20 || out_size != M * D || ws_size < WS_END) { fprintf(stderr, "kernel_launch: unexpected shapes (n_in %d out %d ws %zu)\n", n_in, out_size, ws_size); grid = -1; return; }
        int dev = 0, cus = 0, per_cu = 0;
        if (hipGetDevice(&dev) != hipSuccess || hipDeviceGetAttribute(&cus, hipDeviceAttributeMultiprocessorCount, dev) != hipSuccess) { fprintf(stderr, "kernel_launch: device query failed\n"); grid = -1; return; }
        if (hipFuncSetAttribute((const void*)mk_fwd, hipFuncAttributeMaxDynamicSharedMemorySize, LDS_BYTES) != hipSuccess) { fprintf(stderr, "kernel_launch: hipFuncSetAttribute failed\n"); grid = -1; return; }
        if (hipOccupancyMaxActiveBlocksPerMultiprocessor(&per_cu, (const void*)mk_fwd, 512, LDS_BYTES) != hipSuccess || per_cu < 1) { fprintf(stderr, "kernel_launch: occupancy query says %d blocks per CU\n", per_cu); grid = -1; return; }
        if (cus != 256) { fprintf(stderr, "kernel_launch: built for a 256-CU device (unit orders assume 256 workgroups); found %d CUs\n", cus); grid = -1; return; }
        grid = cus * (per_cu >= 1 ? 1 : 0);
    }
    if (grid < 0) return;
    P p{};
    const float** pf = (const float**)&p;
    for (int i = 0; i < 20; ++i) pf[i] = (const float*)d_in[i];
    p.out = (float*)d_out; p.ws = (unsigned char*)d_ws;
    if (hipMemsetAsync(d_ws, 0, WS_ZERO_BYTES, stream) != hipSuccess) { fprintf(stderr, "kernel_launch: memset failed\n"); return; }
    void* args[] = {&p};
    const hipError_t e = hipLaunchCooperativeKernel((const void*)mk_fwd, dim3(grid), dim3(512), args, LDS_BYTES, stream);
    if (e != hipSuccess) fprintf(stderr, "kernel_launch: cooperative launch failed: %s (grid %d)\n", hipGetErrorString(e), grid);
}
```

```cpp
#include <hip/hip_runtime.h>
#include <cstdio>
#include <cstdint>
#ifndef PROBE_MASK
#define PROBE_MASK 0
#endif

namespace pg8 {
#define PG8_LAS __attribute__((address_space(3)))
typedef unsigned short bf16_t;
typedef short bf16x8 __attribute__((ext_vector_type(8)));
typedef float f32x4 __attribute__((ext_vector_type(4)));
typedef unsigned u32x4 __attribute__((ext_vector_type(4)));
constexpr int BM = 256, BK = 64, HALF = 128, HTB = HALF * BK * 2  , STAGE_BYTES = 8 * HTB, NXCD = 8, WGM = 8;

__host__ __device__ __forceinline__ int lds_byte(int r, int c) { const int st = (r >> 4) * 2 + (c >> 5), rr = r & 15, cc = c & 31, ob = rr * 64 + cc * 2; return st * 1024 + (ob ^ (((ob >> 9) & 1) << 5)); }
__host__ __device__ __forceinline__ void stage_rc(int b, int& R, int& C) { const int st = b / 1024, sb = b % 1024, swz = sb ^ (((sb >> 9) & 1) << 5); R = (st >> 1) * 16 + swz / 64; C = (st & 1) * 32 + (swz % 64) / 2; }
__host__ __device__ __forceinline__ int perm32(int rho) { const int n = rho >> 4, i = rho & 15; return 8 * (i >> 2) + 4 * n + (i & 3); }
struct Unit { int pm, pn, rm, kind, asel; };
struct Gemm { const bf16_t* A; const bf16_t* Bt; int M, N, K; const bf16_t* A2; };
__device__ __forceinline__ unsigned cvt_pk_bf16(float lo, float hi) { unsigned r; asm volatile("v_cvt_pk_bf16_f32 %0, %1, %2" : "=v"(r) : "v"(lo), "v"(hi)); return r; }
template <class Epi, class Sched, bool ALIGN_EPI = false, bool SP2 = false>
__device__ __forceinline__ void gemm_phase(PG8_LAS unsigned char* lds, const Gemm g, const Sched& S, const Epi& E) {
    int tid_l = threadIdx.x; asm volatile("" : "+v"(tid_l));
    const int tid = tid_l, wid = __builtin_amdgcn_readfirstlane(tid >> 6), lane = tid & 63, wr = wid >> 2, wc = wid & 3, fr = lane & 15, fq = lane >> 4;
    const int K = g.K, nt = K / BK;
    unsigned voffA[2], voffB[2];
#pragma unroll
    for (int i = 0; i < 2; ++i) { int R, C; stage_rc(tid * 16 + i * 8192, R, C); const int Rb = Epi::PERM ? ((R & ~31) + perm32(R & 31)) : R;
        voffA[i] = (unsigned)(R * K + C) * 2u; voffB[i] = (unsigned)(Rb * K + C) * 2u; }
    const size_t kstep = (size_t)(BK * 2);
    const size_t hstep = (size_t)HALF * K * 2;
    const size_t tstep = 2 * hstep;
    const unsigned ldsw = (unsigned)wid * 1024u;
    const int aoff = lds_byte(wr * 64 + fr, fq * 8), boff = lds_byte(wc * 32 + fr, fq * 8);
#define PG8_SA(b, h) (((b) * 2 + (h)) * HTB)
#define PG8_SB(b, h) ((4 + (b) * 2 + (h)) * HTB)
#define PG8_STAGE(bufoff, gbase, voff) do { _Pragma("unroll") for (int _i = 0; _i < 2; ++_i) \
        __builtin_amdgcn_global_load_lds((const unsigned*)((const char*)(gbase) + (voff)[_i]), (PG8_LAS unsigned*)(lds + (bufoff) + ldsw + _i * 8192), 16, 0, 0); } while (0)
#define PG8_LDA(dst, b, h) do { _Pragma("unroll") for (int m = 0; m < 4; ++m) _Pragma("unroll") for (int k = 0; k < 2; ++k) dst[m][k] = *(const PG8_LAS bf16x8*)(lds + PG8_SA(b, h) + aoff + m * 2048 + k * 1024); } while (0)
#define PG8_LDB(dst, b, h) do { _Pragma("unroll") for (int n = 0; n < 2; ++n) _Pragma("unroll") for (int k = 0; k < 2; ++k) dst[n][k] = *(const PG8_LAS bf16x8*)(lds + PG8_SB(b, h) + boff + n * 2048 + k * 1024); } while (0)
#define PG8_MMA(ai, bj, At, Bt) do { __builtin_amdgcn_s_setprio(1); _Pragma("unroll") for (int m = 0; m < 4; ++m) _Pragma("unroll") for (int n = 0; n < 2; ++n) _Pragma("unroll") for (int k = 0; k < 2; ++k) \
        acc[ai][bj][m][n] = __builtin_amdgcn_mfma_f32_16x16x32_bf16(Bt[n][k], At[m][k], acc[ai][bj][m][n], 0, 0, 0); __builtin_amdgcn_s_setprio(0); } while (0)
#define PG8_WAIT_V(n) asm volatile("s_waitcnt vmcnt(" #n ")" ::: "memory")
#define PG8_WAIT_L(n) asm volatile("s_waitcnt lgkmcnt(" #n ")" ::: "memory")
#define PG8_BAR __builtin_amdgcn_s_barrier()
#define PG8_SCHED __builtin_amdgcn_sched_barrier(0)
    Unit cur, nxt; int ui = 0;
    if (!S.next(0, cur)) return;
    f32x4 acc[2][2][4][2];
#pragma unroll
    for (int a = 0; a < 2; ++a)
#pragma unroll
        for (int b = 0; b < 2; ++b)
#pragma unroll
            for (int m = 0; m < 4; ++m)
#pragma unroll
                for (int n = 0; n < 2; ++n) acc[a][b][m][n] = (f32x4){0.f, 0.f, 0.f, 0.f};
    bf16x8 At[4][2], B0[2][2], B1[2][2];
    const char* cA = (const char*)(cur.asel ? g.A2 : g.A) + (size_t)cur.pm * tstep; const char* cB = (const char*)g.Bt + (size_t)cur.pn * tstep;
    S.a_ready(cur);
    if constexpr (SP2) {
        PG8_STAGE(PG8_SB(0, 0), cB, voffB); PG8_STAGE(PG8_SB(0, 1), cB + hstep, voffB); PG8_STAGE(PG8_SA(0, 0), cA, voffA); PG8_STAGE(PG8_SA(0, 1), cA + hstep, voffA);
        if (wr == 1) PG8_BAR;
        PG8_WAIT_V(2); PG8_BAR;
        PG8_STAGE(PG8_SB(1, 0), cB + kstep, voffB); PG8_STAGE(PG8_SA(1, 0), cA + kstep, voffA); PG8_STAGE(PG8_SB(1, 1), cB + hstep + kstep, voffB);
        PG8_WAIT_V(6); PG8_BAR;
    } else {
        PG8_STAGE(PG8_SB(0, 0), cB, voffB); PG8_STAGE(PG8_SA(0, 0), cA, voffA); PG8_STAGE(PG8_SB(0, 1), cB + hstep, voffB); PG8_STAGE(PG8_SA(0, 1), cA + hstep, voffA);
        if (wr == 1) PG8_BAR;
        PG8_WAIT_V(4); PG8_BAR;
        PG8_STAGE(PG8_SB(1, 0), cB + kstep, voffB); PG8_STAGE(PG8_SA(1, 0), cA + kstep, voffA); PG8_STAGE(PG8_SB(1, 1), cB + hstep + kstep, voffB);
        PG8_WAIT_V(6); PG8_BAR;
    }
    for (;;) {
        const bool has_next = S.next(ui + 1, nxt);
        const char* nA = has_next ? (const char*)(nxt.asel ? g.A2 : g.A) + (size_t)nxt.pm * tstep : cA; const char* nB = has_next ? (const char*)g.Bt + (size_t)nxt.pn * tstep : cB;
        for (int t = 0; t < nt; t += 2) {
            const bool last = (t == nt - 2);
            const char* a1 = cA + (size_t)(t + 1) * kstep;
            const char* a2 = last ? nA : cA + (size_t)(t + 2) * kstep; const char* b2 = last ? nB : cB + (size_t)(t + 2) * kstep;
            const char* a3 = a2 + kstep; const char* b3 = b2 + kstep;
            if (last && has_next) S.a_ready(nxt);
            if constexpr (SP2) {
            PG8_LDB(B0, 0, 0); PG8_LDB(B1, 0, 1); PG8_SCHED; PG8_LDA(At, 0, 0); PG8_STAGE(PG8_SA(1, 1), a1 + hstep, voffA);
            PG8_WAIT_V(8); PG8_WAIT_L(0); PG8_BAR; PG8_MMA(0, 0, At, B0); PG8_MMA(0, 1, At, B1); PG8_BAR; PG8_SCHED;
            PG8_LDA(At, 0, 1); PG8_STAGE(PG8_SB(0, 0), b2, voffB); PG8_STAGE(PG8_SB(0, 1), b2 + hstep, voffB); PG8_STAGE(PG8_SA(0, 0), a2, voffA);
            PG8_WAIT_V(8); PG8_WAIT_L(0); PG8_BAR; PG8_MMA(1, 0, At, B0); PG8_MMA(1, 1, At, B1); PG8_BAR; PG8_SCHED;
            PG8_LDB(B0, 1, 0); PG8_LDB(B1, 1, 1); PG8_SCHED; PG8_LDA(At, 1, 0); PG8_STAGE(PG8_SA(0, 1), a2 + hstep, voffA);
            PG8_WAIT_V(8); PG8_WAIT_L(0); PG8_BAR; PG8_MMA(0, 0, At, B0); PG8_MMA(0, 1, At, B1); PG8_BAR; PG8_SCHED;
            PG8_LDA(At, 1, 1); PG8_STAGE(PG8_SB(1, 0), b3, voffB); PG8_STAGE(PG8_SB(1, 1), b3 + hstep, voffB); PG8_STAGE(PG8_SA(1, 0), a3, voffA);
            PG8_WAIT_V(8); PG8_WAIT_L(0); PG8_BAR; PG8_MMA(1, 0, At, B0); PG8_MMA(1, 1, At, B1); PG8_BAR; PG8_SCHED;
            } else {
            PG8_LDB(B0, 0, 0); PG8_SCHED; PG8_LDA(At, 0, 0); PG8_STAGE(PG8_SA(1, 1), a1 + hstep, voffA);
            PG8_WAIT_L(8); PG8_BAR; PG8_WAIT_L(0); PG8_MMA(0, 0, At, B0); PG8_BAR; PG8_SCHED;
            PG8_LDB(B1, 0, 1); PG8_STAGE(PG8_SB(0, 0), b2, voffB);
            PG8_BAR; PG8_WAIT_L(0); PG8_MMA(0, 1, At, B1); PG8_BAR;
            PG8_LDA(At, 0, 1); PG8_STAGE(PG8_SA(0, 0), a2, voffA);
            PG8_BAR; PG8_WAIT_L(0); PG8_MMA(1, 0, At, B0); PG8_BAR; PG8_SCHED;
            PG8_STAGE(PG8_SB(0, 1), b2 + hstep, voffB);
            PG8_WAIT_V(6); PG8_BAR; PG8_MMA(1, 1, At, B1); PG8_BAR;
            PG8_LDB(B0, 1, 0); PG8_SCHED; PG8_LDA(At, 1, 0); PG8_STAGE(PG8_SA(0, 1), a2 + hstep, voffA);
            PG8_WAIT_L(8); PG8_BAR; PG8_WAIT_L(0); PG8_MMA(0, 0, At, B0); PG8_BAR; PG8_SCHED;
            PG8_LDB(B1, 1, 1); PG8_STAGE(PG8_SB(1, 0), b3, voffB);
            PG8_BAR; PG8_WAIT_L(0); PG8_MMA(0, 1, At, B1); PG8_BAR;
            PG8_LDA(At, 1, 1); PG8_STAGE(PG8_SA(1, 0), a3, voffA);
            PG8_BAR; PG8_WAIT_L(0); PG8_MMA(1, 0, At, B0); PG8_BAR; PG8_SCHED;
            PG8_STAGE(PG8_SB(1, 1), b3 + hstep, voffB);
            PG8_WAIT_V(6); PG8_BAR; PG8_MMA(1, 1, At, B1); PG8_BAR;
            }
        }
        if constexpr (ALIGN_EPI) { if (wr == 0) PG8_BAR; }
        if constexpr (!Epi::AFTER_DRAIN) { E(acc, cur, wr, wc, fr, fq); S.done(cur); }
        const bool keep_acc = E.keep(cur);
        if (!has_next) break;
        if (!keep_acc) {
#pragma unroll
        for (int a = 0; a < 2; ++a)
#pragma unroll
            for (int b = 0; b < 2; ++b)
#pragma unroll
                for (int m = 0; m < 4; ++m)
#pragma unroll
                    for (int n = 0; n < 2; ++n) acc[a][b][m][n] = (f32x4){0.f, 0.f, 0.f, 0.f};
        }
        cur = nxt; cA = nA; cB = nB; ++ui;
        if constexpr (ALIGN_EPI) { if (wr == 1) PG8_BAR; }
    }
    PG8_WAIT_V(0);
    if constexpr (!ALIGN_EPI) { if (wr == 0) PG8_BAR; }
    PG8_BAR;
    if constexpr (Epi::AFTER_DRAIN) { E.fused(acc, cur, wr, wc, fr, fq, lds, wid, lane); S.done(cur); }
#undef PG8_SA
#undef PG8_SB
#undef PG8_STAGE
#undef PG8_LDA
#undef PG8_LDB
#undef PG8_MMA
#undef PG8_WAIT_V
#undef PG8_WAIT_L
#undef PG8_BAR
#undef PG8_SCHED
}
}

namespace {
using pg8::bf16_t; using pg8::f32x4; using pg8::u32x4; using pg8::Unit;
#define LAS __attribute__((address_space(3)))
constexpr int M = 16384, D = 1024, T = 2048, NB = 8, MEMLEN = 256, MM = NB * MEMLEN;
constexpr int INC = 6416, DFF = 4096, NCH = 32, NH = 8;
constexpr float EPS = 1e-6f;
constexpr size_t MiB = 1u << 20;
constexpr size_t WS_POOL_C = 77u << 20;
constexpr size_t WS_BAR = 0;
constexpr size_t WS_ROWSS = WS_POOL_C + 174 * (1u << 20);
constexpr size_t WS_ZERO_BYTES = 64 * 1024;
constexpr size_t WS_ROWSS_MEM = WS_POOL_C + 173 * (1u << 20);
constexpr size_t WS_G = 400 * 1024, WS_ML = 408 * 1024, WS_MIN = 416 * 1024;
constexpr size_t WS_DN = 512 * 1024;
constexpr size_t WS_WT = 1 * MiB;
constexpr size_t WT_WIN = 0, WT_WMEM = (size_t)6656 * D * 2, WT_WBR = WT_WMEM + (size_t)D * D * 2, WT_WOUT = WT_WBR + (size_t)3 * D * 512 * 2,
                 WT_FF1 = WT_WOUT + (size_t)D * D * 2, WT_FF2 = WT_FF1 + (size_t)DFF * D * 2, WT_LAYER = WT_FF2 + (size_t)D * DFF * 2;
constexpr size_t WS_MEMB = 73 * MiB, WS_POOL = 77 * MiB, WS_END = 256 * MiB;
static_assert(WS_WT + 2 * WT_LAYER <= WS_MEMB && WS_POOL_C == WS_POOL, "weights fit");
constexpr int LDS_RING = 131072, LDS_BYTES = 147456, LDS_CTL = LDS_BYTES - 256, LDS_RSTD0 = LDS_RING, LDS_RSTD1 = LDS_RING + 1024;

struct P {
    const float *x, *mem, *rel_bias, *g_mix, *w_in, *conv_w, *b_i, *b_f, *norm_g, *sinks, *g_mem, *w_mem_kv, *w_br0, *w_br1, *w_br2, *w_out, *g_ffn, *w_ff1, *w_ff2, *g_final;
    float* out; unsigned char* ws;
};
struct LB {
    bf16_t *xbin, *sq, *mo, *xq, *skv, *mqk, *mv, *memkv, *merged, *xbmid, *hff, *xbnext;
    unsigned char* gates;
    float* iff; bf16_t* state;
    const bf16_t *win, *wmem, *wbr, *wout, *wff1, *wff2;
};
__host__ __device__ inline LB layer_buf(unsigned char* ws, float* out, int l) {
    LB b; unsigned char* pool = ws + WS_POOL; unsigned char* breg = pool;
    b.xbin = (bf16_t*)out; b.xbmid = (bf16_t*)((unsigned char*)out + 32 * MiB); b.xbnext = l == 1 ? (bf16_t*)(pool + 128 * MiB) : (bf16_t*)out;
    b.merged = (bf16_t*)(pool + 48 * MiB); b.hff = (bf16_t*)pool;
    b.sq = (bf16_t*)breg; b.mo = (bf16_t*)(breg + 16 * MiB); b.xq = (bf16_t*)(breg + 32 * MiB);
    b.gates = pool + 125 * MiB;
    b.skv = (bf16_t*)(breg + 48 * MiB); b.mqk = (bf16_t*)(breg + 56 * MiB); b.mv = (bf16_t*)(breg + 88 * MiB);
    b.iff = (float*)(breg + 104 * MiB); b.memkv = (bf16_t*)(breg + 105 * MiB); b.state = (bf16_t*)(breg + 109 * MiB);
    unsigned char* wt = ws + WS_WT + (size_t)l * WT_LAYER;
    b.win = (const bf16_t*)(wt + WT_WIN); b.wmem = (const bf16_t*)(wt + WT_WMEM); b.wbr = (const bf16_t*)(wt + WT_WBR);
    b.wout = (const bf16_t*)(wt + WT_WOUT); b.wff1 = (const bf16_t*)(wt + WT_FF1); b.wff2 = (const bf16_t*)(wt + WT_FF2);
    return b;
}
__device__ __forceinline__ float* ws_f(unsigned char* ws, size_t off) { return (float*)(ws + off); }

__device__ __forceinline__ float bf2f(bf16_t h) { return __uint_as_float(((unsigned)h) << 16); }
__device__ __forceinline__ bf16_t f2bf(float f) { unsigned u = __float_as_uint(f); u = (u + 0x7fffu + ((u >> 16) & 1u)) >> 16; return (bf16_t)u; }
__device__ __forceinline__ unsigned pk2(float lo, float hi) { return (unsigned)f2bf(lo) | ((unsigned)f2bf(hi) << 16); }
__device__ __forceinline__ float sigmoidf_(float v) { return 1.f / (1.f + expf(-v)); }
__device__ __forceinline__ float fsigmoid(float v) { return __builtin_amdgcn_rcpf(1.f + __expf(-v)); }
__device__ __forceinline__ float wave_sum(float v) {
#pragma unroll
    for (int o = 1; o < 64; o <<= 1) v += __shfl_xor(v, o);
    return v;
}
__device__ __forceinline__ float wave_max(float v) {
#pragma unroll
    for (int o = 1; o < 64; o <<= 1) v = fmaxf(v, __shfl_xor(v, o));
    return v;
}
__device__ __forceinline__ void unpack8(const uint4 a, float (&f)[8]) {
    f[0] = __uint_as_float(a.x << 16); f[1] = __uint_as_float(a.x & 0xffff0000u); f[2] = __uint_as_float(a.y << 16); f[3] = __uint_as_float(a.y & 0xffff0000u);
    f[4] = __uint_as_float(a.z << 16); f[5] = __uint_as_float(a.z & 0xffff0000u); f[6] = __uint_as_float(a.w << 16); f[7] = __uint_as_float(a.w & 0xffff0000u);
}
__device__ const unsigned char T5_BUCKET[128] = {0, 1, 2, 3, 4, 5, 6, 7, 8, 9, 10, 11, 12, 13, 14, 15, 16, 16, 16, 17, 17, 18, 18, 18, 19, 19, 19, 20, 20, 20, 20, 21, 21, 21, 21, 22, 22, 22, 22, 22, 23, 23, 23, 23, 23, 23, 24, 24, 24, 24, 24, 24, 25, 25, 25, 25, 25, 25, 25, 26, 26, 26, 26, 26, 26, 26, 26, 27, 27, 27, 27, 27, 27, 27, 27, 27, 27, 28, 28, 28, 28, 28, 28, 28, 28, 28, 28, 29, 29, 29, 29, 29, 29, 29, 29, 29, 29, 29, 29, 30, 30, 30, 30, 30, 30, 30, 30, 30, 30, 30, 30, 30, 30, 31, 31, 31, 31, 31, 31, 31, 31, 31, 31, 31, 31, 31, 31, 31};

__device__ __forceinline__ float rstd_of(const float* rp, int row) {
    const f32x4* q = (const f32x4*)(rp + (size_t)row * 16); const f32x4 a = q[0], b = q[1], c = q[2], d = q[3];
    const float ss = ((a[0] + a[1]) + (a[2] + a[3])) + ((b[0] + b[1]) + (b[2] + b[3])) + (((c[0] + c[1]) + (c[2] + c[3])) + ((d[0] + d[1]) + (d[2] + d[3])));
    return rsqrtf(ss * (1.f / D) + EPS);
}
__device__ __forceinline__ void fill_rstd_table(const float* rp, int rm, LAS float* tab) {
    const int t = threadIdx.x; if (t < 256) tab[t] = rstd_of(rp, rm * 256 + t);
}
struct SchedRounds {
    int G, c, nfull, pn_base, tail, skip_at;
    __device__ __forceinline__ bool next(int i, Unit& u) const {
        const int L = i * G + c;
        if (L < nfull * 256) { const int r = L >> 8, w = L & 255, x = w & 7, j = w >> 3; u.pm = u.rm = 8 * x + (j & 7); u.pn = pn_base + 4 * r + (j >> 3) + (r >= skip_at ? 1 : 0); u.kind = 0; u.asel = 0; return true; }
        if (!tail) return false;
        const int t = L - nfull * 256;
        if (t < 64) { u.pm = u.rm = t; u.pn = 12; u.kind = 0; u.asel = 0; return true; }
        if (t < 128) { u.pm = u.rm = t - 64; u.pn = 25; u.kind = 0; u.asel = 0; return true; }
        if (t < 160) { const int q = t - 128; u.pm = u.rm = q >> 2; u.pn = 26 + (q & 3); u.kind = 1; u.asel = 1; return true; }
        return false;
    }
    __device__ __forceinline__ void a_ready(const Unit&) const {}
    __device__ __forceinline__ void done(const Unit&) const {}
};
struct SchedMerged {
    int G, c;
    __device__ __forceinline__ bool next(int i, Unit& u) const {
        const int tt = (i / 3) * G + c, seg = i % 3; if (tt >= 256) return false;
        const int x = tt & 7, j = tt >> 3; u.rm = 8 * x + (j & 7); u.pm = seg * 64 + u.rm; u.pn = seg * 4 + (j >> 3); u.kind = seg; u.asel = 0; return true;
    }
    __device__ __forceinline__ void a_ready(const Unit&) const {}
    __device__ __forceinline__ void done(const Unit&) const {}
};

__device__ __forceinline__ u32x4 pack8(f32x4 a, f32x4 b) { u32x4 w; w.x = pg8::cvt_pk_bf16(a[0], a[1]); w.y = pg8::cvt_pk_bf16(a[2], a[3]); w.z = pg8::cvt_pk_bf16(b[0], b[1]); w.w = pg8::cvt_pk_bf16(b[2], b[3]); return w; }
__device__ __forceinline__ f32x4 sig4(f32x4 v) { f32x4 r; r[0] = fsigmoid(v[0]); r[1] = fsigmoid(v[1]); r[2] = fsigmoid(v[2]); r[3] = fsigmoid(v[3]); return r; }
struct EpiProjMK {
    static constexpr bool PERM = true, AFTER_DRAIN = false;
    LB L; const LAS float* tab0; const LAS float* tab1; int rm0;
    __device__ __forceinline__ bool keep(const Unit&) const { return false; }
    __device__ __forceinline__ void operator()(f32x4 (&acc)[2][2][4][2], const Unit& u, int wr, int wc, int fr, int fq) const {
        const int rbase = u.rm * 256 + wr * 64 + fr, cin = wc * 32 + 8 * fq, rloc = wr * 64 + fr;
        const LAS float* rs = (u.kind == 0 && u.rm == rm0) ? tab0 : tab1; bf16_t* dst; int ld, coff; bool sig = false; const int tile = u.pn;
        if (u.kind == 1) { dst = L.memkv; ld = 1024; coff = (tile - 26) * 256; }
        else if (tile < 2) { dst = L.sq; ld = 512; coff = tile * 256; }
        else if (tile < 3) { dst = L.skv; ld = 256; coff = 0; }
        else if (tile < 7) { dst = L.mqk; ld = 1024; coff = (tile - 3) * 256; }
        else if (tile < 9) { dst = L.mv; ld = 512; coff = (tile - 7) * 256; }
        else if (tile < 11) { dst = L.mo; ld = 512; coff = (tile - 9) * 256; sig = true; }
        else if (tile < 13) { dst = L.xq; ld = 512; coff = (tile - 11) * 256; }
        else { dst = nullptr; ld = 0; coff = 0; }
#pragma unroll
        for (int ai = 0; ai < 2; ++ai)
#pragma unroll
            for (int m = 0; m < 4; ++m) {
                const int row = rbase + ai * 128 + m * 16; const float rstd = rs[rloc + ai * 128 + m * 16];
#pragma unroll
                for (int bj = 0; bj < 2; ++bj) {
                    if (dst == nullptr && tile < 25) {
                        const float nsc = rstd * -1.4426950408889634f; const f32x4 a0 = acc[ai][bj][m][0], a1 = acc[ai][bj][m][1]; uint2 w; w.x = 0u; w.y = 0u;
#pragma unroll
                        for (int j = 0; j < 4; ++j) {
                            w.x = __builtin_amdgcn_cvt_pk_u8_f32(floorf(__builtin_amdgcn_rcpf(1.f + __builtin_amdgcn_exp2f(a0[j] * nsc)) * 256.f), j, w.x);
                            w.y = __builtin_amdgcn_cvt_pk_u8_f32(floorf(__builtin_amdgcn_rcpf(1.f + __builtin_amdgcn_exp2f(a1[j] * nsc)) * 256.f), j, w.y); }
                        *(uint2*)(L.gates + (size_t)row * 3072 + (tile - 13) * 256 + bj * 128 + cin) = w; continue; }
                    f32x4 v0, v1;
                    if (sig) { const float nsc = rstd * -1.4426950408889634f; const f32x4 a0 = acc[ai][bj][m][0], a1 = acc[ai][bj][m][1];
#pragma unroll
                        for (int j = 0; j < 4; ++j) { v0[j] = __builtin_amdgcn_rcpf(1.f + __builtin_amdgcn_exp2f(a0[j] * nsc)); v1[j] = __builtin_amdgcn_rcpf(1.f + __builtin_amdgcn_exp2f(a1[j] * nsc)); } }
                    else { v0 = acc[ai][bj][m][0] * rstd; v1 = acc[ai][bj][m][1] * rstd; }
                    if (dst) *(u32x4*)((unsigned char*)dst + (unsigned)((row * ld + coff + bj * 128 + cin) * 2)) = pack8(v0, v1);
                    else if (bj == 0 && cin < 16) { *(f32x4*)(L.iff + (size_t)row * 16 + cin) = v0; *(f32x4*)(L.iff + (size_t)row * 16 + cin + 4) = v1; }
                }
            }
    }
};
struct EpiMergedMK {
    static constexpr bool PERM = true, AFTER_DRAIN = false;
    const unsigned char* gates; bf16_t* merged;
    __device__ __forceinline__ bool keep(const Unit& u) const { return u.kind < 2; }
    __device__ __forceinline__ static void deq8(uint2 w, float (&g)[8]) {
        g[0] = (float)(w.x & 255u) + 0.5f; g[1] = (float)((w.x >> 8) & 255u) + 0.5f; g[2] = (float)((w.x >> 16) & 255u) + 0.5f; g[3] = (float)(w.x >> 24) + 0.5f;
        g[4] = (float)(w.y & 255u) + 0.5f; g[5] = (float)((w.y >> 8) & 255u) + 0.5f; g[6] = (float)((w.y >> 16) & 255u) + 0.5f; g[7] = (float)(w.y >> 24) + 0.5f; }
    __device__ __forceinline__ void operator()(f32x4 (&acc)[2][2][4][2], const Unit& u, int wr, int wc, int fr, int fq) const {
        const int rbase = u.rm * 256 + wr * 64 + fr, col0 = (u.pn & 3) * 256 + wc * 32 + 8 * fq, seg = u.kind;
#pragma unroll
        for (int ai = 0; ai < 2; ++ai) {
            uint2 gs[4][2], gn[4][2];
#pragma unroll
            for (int m = 0; m < 4; ++m)
#pragma unroll
                for (int bj = 0; bj < 2; ++bj) { const unsigned char* gp = gates + (size_t)(rbase + ai * 128 + m * 16) * 3072 + seg * 1024 + col0 + bj * 128;
                    gs[m][bj] = *(const uint2*)gp; gn[m][bj] = seg < 2 ? *(const uint2*)(gp + 1024) : make_uint2(0u, 0u); }
#pragma unroll
            for (int m = 0; m < 4; ++m) {
                const int row = rbase + ai * 128 + m * 16;
#pragma unroll
                for (int bj = 0; bj < 2; ++bj) {
                    const int col = col0 + bj * 128;
                    float g[8]; deq8(gs[m][bj], g);
                    if (seg < 2) { float gd[8]; deq8(gn[m][bj], gd);
#pragma unroll
                        for (int j = 0; j < 8; ++j) g[j] = g[j] * __builtin_amdgcn_rcpf(gd[j]); }
                    else {
#pragma unroll
                        for (int j = 0; j < 8; ++j) g[j] *= (1.f / 256.f); }
                    f32x4 v0 = acc[ai][bj][m][0], v1 = acc[ai][bj][m][1];
                    v0[0] *= g[0]; v0[1] *= g[1]; v0[2] *= g[2]; v0[3] *= g[3]; v1[0] *= g[4]; v1[1] *= g[5]; v1[2] *= g[6]; v1[3] *= g[7];
                    acc[ai][bj][m][0] = v0; acc[ai][bj][m][1] = v1;
                    if (seg == 2) *(u32x4*)(merged + (size_t)row * D + col) = pack8(v0, v1);
                }
            }
            asm volatile("" ::: "memory");
        }
    }
};
struct EpiResidMK {
    static constexpr bool PERM = true, AFTER_DRAIN = false;
    const bf16_t* xold; bf16_t* xnew; float* rowss;
    __device__ __forceinline__ bool keep(const Unit&) const { return false; }
    __device__ __forceinline__ void operator()(f32x4 (&acc)[2][2][4][2], const Unit& u, int wr, int wc, int fr, int fq) const {
        const int rbase = u.rm * 256 + wr * 64 + fr, col0 = u.pn * 256 + wc * 32 + 8 * fq;
#pragma unroll
        for (int ai = 0; ai < 2; ++ai) {
            uint4 xo[4][2];
#pragma unroll
            for (int m = 0; m < 4; ++m)
#pragma unroll
                for (int bj = 0; bj < 2; ++bj) xo[m][bj] = *(const uint4*)(xold + (size_t)(rbase + ai * 128 + m * 16) * D + col0 + bj * 128);
#pragma unroll
            for (int m = 0; m < 4; ++m) {
                const int row = rbase + ai * 128 + m * 16; const size_t off = (size_t)row * D + col0; float ss = 0.f;
#pragma unroll
                for (int bj = 0; bj < 2; ++bj) {
                    float o[8]; unpack8(xo[m][bj], o);
                    f32x4 v0 = acc[ai][bj][m][0], v1 = acc[ai][bj][m][1];
                    v0[0] += o[0]; v0[1] += o[1]; v0[2] += o[2]; v0[3] += o[3]; v1[0] += o[4]; v1[1] += o[5]; v1[2] += o[6]; v1[3] += o[7];
                    const u32x4 w = pack8(v0, v1); *(u32x4*)(xnew + off + bj * 128) = w;
                    float r[8]; unpack8(__builtin_bit_cast(uint4, w), r);
#pragma unroll
                    for (int j = 0; j < 8; ++j) ss = fmaf(r[j], r[j], ss);
                }
                ss += __shfl_xor(ss, 16); ss += __shfl_xor(ss, 32);
                if (fq == 0) rowss[(size_t)row * 16 + (u.pn & 3) * 4 + wc] = ss;
            }
            asm volatile("" ::: "memory");
        }
    }
};
struct EpiFF1MK {
    static constexpr bool PERM = true, AFTER_DRAIN = false;
    bf16_t* h; const LAS float* tab0;
    __device__ __forceinline__ bool keep(const Unit&) const { return false; }
    __device__ __forceinline__ void operator()(f32x4 (&acc)[2][2][4][2], const Unit& u, int wr, int wc, int fr, int fq) const {
        const int rbase = u.rm * 256 + wr * 64 + fr, col0 = u.pn * 256 + wc * 32 + 8 * fq, rloc = wr * 64 + fr;
#pragma unroll
        for (int ai = 0; ai < 2; ++ai)
#pragma unroll
            for (int m = 0; m < 4; ++m) {
                const int row = rbase + ai * 128 + m * 16; const float rstd = tab0[rloc + ai * 128 + m * 16];
#pragma unroll
                for (int bj = 0; bj < 2; ++bj) {
                    f32x4 v0 = acc[ai][bj][m][0] * rstd, v1 = acc[ai][bj][m][1] * rstd;
#pragma unroll
                    for (int j = 0; j < 4; ++j) { v0[j] = fmaxf(v0[j], 0.f); v0[j] *= v0[j]; v1[j] = fmaxf(v1[j], 0.f); v1[j] *= v1[j]; }
                    *(u32x4*)((unsigned char*)h + (unsigned)((row * DFF + col0 + bj * 128) * 2)) = pack8(v0, v1);
                }
            }
    }
};

constexpr int CV_ITEMS_LAYER = 1152, CV_LD = 257;
struct CvItem { const float* src; const float* gain; bf16_t* dst; int ld, K, k0, ncols; float sc; };
__device__ __forceinline__ CvItem convert_decode(const P& p, int item) {
    CvItem c; const int l = item / CV_ITEMS_LAYER; int r = item % CV_ITEMS_LAYER;
    unsigned char* wt = p.ws + WS_WT + (size_t)l * WT_LAYER;
    const float* src; const float* gain = nullptr; int ld, col0, ncols, K; float sc = 1.f; bf16_t* dst;
    if (r < 416) {
        src = p.w_in + (size_t)l * D * INC; ld = INC; K = D; gain = p.g_mix + l * D; int dr;
        if (r < 32) { col0 = 0; ncols = 512; dr = 0; sc = 0.125f; }
        else if ((r -= 32) < 112) { col0 = 512; ncols = 1792; dr = 512; }
        else if ((r -= 112) < 32) { col0 = 2320; ncols = 512; dr = 2304; }
        else if ((r -= 32) < 32) { col0 = 2832; ncols = 512; dr = 2816; sc = 0.08838834764831845f; }
        else if ((r -= 32) < 192) { col0 = 3344; ncols = 3072; dr = 3328; }
        else { r -= 192; col0 = 2304; ncols = 16; dr = 6400; }
        dst = (bf16_t*)(wt + WT_WIN) + (size_t)dr * D;
    } else if ((r -= 416) < 64) { src = p.w_mem_kv + (size_t)l * D * 1024; ld = 1024; col0 = 0; ncols = 1024; K = D; gain = p.g_mem + l * D; dst = (bf16_t*)(wt + WT_WMEM); }
    else if ((r -= 64) < 96) { const int sg = r / 32; r -= sg * 32; src = (sg == 0 ? p.w_br0 : sg == 1 ? p.w_br1 : p.w_br2) + (size_t)l * 512 * 1024; ld = 1024; col0 = 0; ncols = 1024; K = 512; dst = (bf16_t*)(wt + WT_WBR) + (size_t)sg * 1024 * 512; }
    else if ((r -= 96) < 64) { src = p.w_out + (size_t)l * D * D; ld = 1024; col0 = 0; ncols = 1024; K = D; dst = (bf16_t*)(wt + WT_WOUT); }
    else if ((r -= 64) < 256) { src = p.w_ff1 + (size_t)l * D * DFF; ld = DFF; col0 = 0; ncols = DFF; K = D; gain = p.g_ffn + l * D; dst = (bf16_t*)(wt + WT_FF1); }
    else { r -= 256; src = p.w_ff2 + (size_t)l * DFF * D; ld = D; col0 = 0; ncols = D; K = DFF; dst = (bf16_t*)(wt + WT_FF2); }
    const int nnb = (ncols + 255) / 256, kb = r / nnb, nb = r % nnb, c0 = nb * 256;
    c.ncols = (ncols - c0) < 256 ? (ncols - c0) : 256; c.k0 = kb * 64; c.K = K; c.ld = ld; c.sc = sc; c.gain = gain;
    c.src = src + (size_t)c.k0 * ld + col0 + c0; c.dst = dst + (size_t)c0 * K + c.k0;
    return c;
}
__device__ __forceinline__ void convert_load(const CvItem& c, int tid, f32x4 (&v)[8]) {
    const int n4 = (tid & 63) * 4, kr = tid >> 6;
#pragma unroll
    for (int i = 0; i < 8; ++i) v[i] = n4 < c.ncols ? *(const f32x4*)(c.src + (size_t)(kr + 8 * i) * c.ld + n4) : (f32x4){0.f, 0.f, 0.f, 0.f};
}
__device__ __forceinline__ void convert_to_lds(const CvItem& c, int tid, const f32x4 (&v)[8], float* tile) {
    const int n4 = (tid & 63) * 4, kr = tid >> 6;
#pragma unroll
    for (int i = 0; i < 8; ++i) { const int kk = kr + 8 * i; const f32x4 w = v[i] * ((c.gain ? c.gain[c.k0 + kk] : 1.f) * c.sc);
        tile[kk * CV_LD + n4] = w[0]; tile[kk * CV_LD + n4 + 1] = w[1]; tile[kk * CV_LD + n4 + 2] = w[2]; tile[kk * CV_LD + n4 + 3] = w[3]; }
}
__device__ __forceinline__ void convert_store(const CvItem& c, int tid, const float* tile) {
    const int kc = tid & 7;
#pragma unroll
    for (int i = 0; i < 4; ++i) { const int n = (tid >> 3) + 64 * i; const float* tp = tile + (8 * kc) * CV_LD + n;
        u32x4 w; w.x = pk2(tp[0], tp[CV_LD]); w.y = pk2(tp[2 * CV_LD], tp[3 * CV_LD]); w.z = pk2(tp[4 * CV_LD], tp[5 * CV_LD]); w.w = pk2(tp[6 * CV_LD], tp[7 * CV_LD]);
        if (n < c.ncols) *(u32x4*)(c.dst + (size_t)n * c.K + 8 * kc) = w; }
}
__device__ __forceinline__ void convert_phase(const P& p, int bx, int G, float* tile) {
    int tid_l = threadIdx.x; asm volatile("" : "+v"(tid_l)); const int tid = tid_l;
    int it = bx; if (it >= 2 * CV_ITEMS_LAYER) return;
    CvItem c = convert_decode(p, it); f32x4 v[8]; convert_load(c, tid, v);
    for (;;) {
        convert_to_lds(c, tid, v, tile);
        const int nx = it + G; const bool more = nx < 2 * CV_ITEMS_LAYER; CvItem cn = c;
        if (more) { cn = convert_decode(p, nx); convert_load(cn, tid, v); }
        __syncthreads();
        convert_store(c, tid, tile);
        __syncthreads();
        if (!more) break;
        c = cn; it = nx;
    }
}
__device__ __forceinline__ void rowstat_rows(const float* src, int rows, bf16_t* xb, float* rowss, int gw, int ngw, int lane) {
    for (int r = gw; r < rows; r += 2 * ngw) {
        const int r1 = r + ngw; const bool two = r1 < rows;
        const float4* s0 = (const float4*)(src + (size_t)r * D); const float4* s1 = (const float4*)(src + (size_t)(two ? r1 : r) * D);
        float4 a[4], b[4];
#pragma unroll
        for (int j = 0; j < 4; ++j) { a[j] = s0[lane + 64 * j]; b[j] = s1[lane + 64 * j]; }
        float ssa = 0.f, ssb = 0.f;
#pragma unroll
        for (int j = 0; j < 4; ++j) { ssa += a[j].x * a[j].x + a[j].y * a[j].y + a[j].z * a[j].z + a[j].w * a[j].w; ssb += b[j].x * b[j].x + b[j].y * b[j].y + b[j].z * b[j].z + b[j].w * b[j].w;
            uint2 o; o.x = pk2(a[j].x, a[j].y); o.y = pk2(a[j].z, a[j].w); *(uint2*)(xb + (size_t)r * D + 4 * (lane + 64 * j)) = o;
            if (two) { uint2 o1; o1.x = pk2(b[j].x, b[j].y); o1.y = pk2(b[j].z, b[j].w); *(uint2*)(xb + (size_t)r1 * D + 4 * (lane + 64 * j)) = o1; } }
        ssa = wave_sum(ssa); ssb = wave_sum(ssb);
        if (lane < 16) { rowss[(size_t)r * 16 + lane] = lane == 0 ? ssa : 0.f; if (two) rowss[(size_t)r1 * 16 + lane] = lane == 0 ? ssb : 0.f; }
    }
}
__device__ __forceinline__ void finalnorm_rows(const bf16_t* xb, float* out, const float* rowss, const float* g, int gw, int ngw, int lane) {
    for (int r = gw; r < M; r += ngw) {
        const float rstd = rstd_of(rowss, r);
#pragma unroll
        for (int j = 0; j < 2; ++j) { float x[8]; unpack8(*(const uint4*)(xb + (size_t)r * D + 8 * (lane + 64 * j)), x);
            const float4 g0 = *(const float4*)(g + 8 * (lane + 64 * j)), g1 = *(const float4*)(g + 8 * (lane + 64 * j) + 4);
            float4 o0, o1; o0.x = x[0] * rstd * g0.x; o0.y = x[1] * rstd * g0.y; o0.z = x[2] * rstd * g0.z; o0.w = x[3] * rstd * g0.w;
            o1.x = x[4] * rstd * g1.x; o1.y = x[5] * rstd * g1.y; o1.z = x[6] * rstd * g1.z; o1.w = x[7] * rstd * g1.w;
            *(float4*)(out + (size_t)r * D + 8 * (lane + 64 * j)) = o0; *(float4*)(out + (size_t)r * D + 8 * (lane + 64 * j) + 4) = o1; }
    }
}

typedef short bf16x8 __attribute__((ext_vector_type(8)));
typedef short s16x4 __attribute__((ext_vector_type(4)));
typedef float f32x16 __attribute__((ext_vector_type(16)));
typedef float f32x2 __attribute__((ext_vector_type(2)));
typedef __bf16 bf16x2v __attribute__((ext_vector_type(2)));
#define MFMA32(a, b, c) __builtin_amdgcn_mfma_f32_32x32x16_bf16((a), (b), (c), 0, 0, 0)
__device__ __forceinline__ int crow(int reg, int h) { return (reg & 3) + 8 * (reg >> 2) + 4 * h; }
__device__ __forceinline__ unsigned pkbf(float a, float b) { return __builtin_bit_cast(unsigned, __builtin_convertvector((f32x2){a, b}, bf16x2v)); }
__device__ __forceinline__ bf16x8 pack_step(const f32x16& x, int s) {
    u32x4 p; p.x = pkbf(x[8 * s], x[8 * s + 1]); p.y = pkbf(x[8 * s + 2], x[8 * s + 3]); p.z = pkbf(x[8 * s + 4], x[8 * s + 5]); p.w = pkbf(x[8 * s + 6], x[8 * s + 7]);
    return __builtin_bit_cast(bf16x8, p);
}
__device__ __forceinline__ bf16x8 tr_frag(const LAS unsigned char* img, int row_lo, int row_hi, int lane) {
    const int i16 = lane & 15, q = i16 >> 2, p = i16 & 3, blk = (lane >> 4) & 1;
    const s16x4 lo = __builtin_amdgcn_ds_read_tr16_b64_v4i16((LAS s16x4*)(img + (row_lo + q) * 64 + 32 * blk + 8 * p));
    const s16x4 hi = __builtin_amdgcn_ds_read_tr16_b64_v4i16((LAS s16x4*)(img + (row_hi + q) * 64 + 32 * blk + 8 * p));
    return __builtin_shufflevector(lo, hi, 0, 1, 2, 3, 4, 5, 6, 7);
}

constexpr int SWA_KIMG = 0, SWA_VIMG = 256 * 144, SWA_TAB = SWA_VIMG + 2 * 16384;
__device__ __forceinline__ void swa_mfma_unit(const P& p, const LB& L, int l, int u, LAS unsigned char* l3) {
    int tid_l = threadIdx.x; asm volatile("" : "+v"(tid_l)); const int tid = tid_l, lane = tid & 63, wave = tid >> 6, h = lane >> 5, ql = lane & 31;
    const int hkv = u & 1, n = (u >> 1) & 15, b = u >> 5;
    __syncthreads();
#pragma unroll
    for (int i = 0; i < 4; ++i) {
        const int c = tid + 512 * i, row = c >> 3, cc = c & 7, t = 128 * (n - 1) + row;
        u32x4 kv = (u32x4){0u, 0u, 0u, 0u}, vv = (u32x4){0u, 0u, 0u, 0u};
        if (t >= 0) { const bf16_t* src = L.skv + (size_t)(b * T + t) * 256 + hkv * 64 + cc * 8; kv = *(const u32x4*)src; vv = *(const u32x4*)(src + 128); }
        *(LAS u32x4*)(l3 + SWA_KIMG + row * 144 + cc * 16) = kv;
        *(LAS u32x4*)(l3 + SWA_VIMG + (cc >> 2) * 16384 + row * 64 + (cc & 3) * 16) = vv;
    }
    for (int idx = tid; idx < 4 * 192; idx += 512) { const int g = idx / 192, e = idx % 192, dist = 159 - e;
        ((LAS float*)(l3 + SWA_TAB))[idx] = (dist >= 0 && dist < 128) ? p.rel_bias[(int)T5_BUCKET[dist] * 8 + hkv * 4 + g] : -1e30f; }
    __syncthreads();
    const int g = wave >> 1, half = wave & 1, hq = hkv * 4 + g;
    const float sink = p.sinks[l * 8 + hq];
    const LAS float* tab = (const LAS float*)(l3 + SWA_TAB) + g * 192 + 31 - ql;
#pragma unroll 1
    for (int sb = 0; sb < 2; ++sb) {
        const int r0 = 64 * half + 32 * sb, kb0 = 2 * half + sb;
        bf16_t* qptr = L.sq + (size_t)(b * T + 128 * n + r0 + ql) * 512 + hq * 64;
        bf16x8 Qf[4];
#pragma unroll
        for (int ks = 0; ks < 4; ++ks) Qf[ks] = *(const bf16x8*)(qptr + 16 * ks + 8 * h);
        f32x16 S[5];
#pragma unroll
        for (int i = 0; i < 5; ++i) {
#pragma unroll
            for (int r = 0; r < 16; ++r) S[i][r] = 0.f;
#pragma unroll
            for (int ks = 0; ks < 4; ++ks) { const bf16x8 Kf = *(const LAS bf16x8*)(l3 + SWA_KIMG + (32 * (kb0 + i) + ql) * 144 + 32 * ks + 16 * h); S[i] = MFMA32(Kf, Qf[ks], S[i]); }
        }
        float m = sink;
#pragma unroll
        for (int i = 0; i < 5; ++i)
#pragma unroll
            for (int r = 0; r < 16; ++r) { const int kk = 32 * i + crow(r, h); float sv = S[i][r] + tab[kk];
                if (n == 0 && 32 * kb0 + kk < 128) sv = -1e30f;
                S[i][r] = sv; m = fmaxf(m, sv); }
        m = fmaxf(m, __shfl_xor(m, 32));
        float lsum = 0.f;
#pragma unroll
        for (int i = 0; i < 5; ++i)
#pragma unroll
            for (int r = 0; r < 16; ++r) { const float pe = __expf(S[i][r] - m); S[i][r] = pe; lsum += pe; }
        lsum += __shfl_xor(lsum, 32);
        f32x16 O[2];
#pragma unroll
        for (int db = 0; db < 2; ++db)
#pragma unroll
            for (int r = 0; r < 16; ++r) O[db][r] = 0.f;
#pragma unroll
        for (int i = 0; i < 5; ++i)
#pragma unroll
            for (int s2 = 0; s2 < 2; ++s2) { const bf16x8 Pf = pack_step(S[i], s2); const int k0 = 32 * (kb0 + i) + 16 * s2;
#pragma unroll
                for (int db = 0; db < 2; ++db) { const bf16x8 Vf = tr_frag(l3 + SWA_VIMG + db * 16384, k0 + 4 * h, k0 + 8 + 4 * h, lane); O[db] = MFMA32(Vf, Pf, O[db]); } }
        const float inv = 1.f / (lsum + __expf(sink - m));
#pragma unroll
        for (int db = 0; db < 2; ++db)
#pragma unroll
            for (int gq = 0; gq < 4; ++gq) { uint2 w; w.x = pkbf(O[db][4 * gq] * inv, O[db][4 * gq + 1] * inv); w.y = pkbf(O[db][4 * gq + 2] * inv, O[db][4 * gq + 3] * inv);
                *(uint2*)(qptr + 32 * db + 8 * gq + 4 * h) = w; }
    }
}

constexpr int XA_KIMG = 0, XA_VIMG = 256 * 272;
__device__ __forceinline__ void xattn_mfma_unit(const LB& L, int u, LAS unsigned char* l3) {
    int tid_l = threadIdx.x; asm volatile("" : "+v"(tid_l)); const int tid = tid_l, lane = tid & 63, wave = tid >> 6, h = lane >> 5, ql = lane & 31;
    const int qb = u & 7, hx = (u >> 3) & 3, b = u >> 5;
    __syncthreads();
#pragma unroll
    for (int i = 0; i < 8; ++i) {
        const int c = tid + 512 * i, row = c >> 4, cc = c & 15;
        const bf16_t* src = L.memkv + (size_t)(b * MEMLEN + row) * 1024 + hx * 128 + cc * 8;
        const u32x4 kv = *(const u32x4*)src, vv = *(const u32x4*)(src + 512);
        *(LAS u32x4*)(l3 + XA_KIMG + row * 272 + cc * 16) = kv;
        *(LAS u32x4*)(l3 + XA_VIMG + (cc >> 2) * 16384 + row * 64 + (cc & 3) * 16) = vv;
    }
    bf16_t* qptr = L.xq + (size_t)(b * T + qb * 256 + wave * 32 + ql) * 512 + hx * 128;
    bf16x8 Qf[8];
#pragma unroll
    for (int ks = 0; ks < 8; ++ks) Qf[ks] = *(const bf16x8*)(qptr + 16 * ks + 8 * h);
    __syncthreads();
    f32x16 S[8];
    {
#pragma unroll
        for (int i = 0; i < 8; ++i) {
#pragma unroll
            for (int r = 0; r < 16; ++r) S[i][r] = 0.f;
#pragma unroll
            for (int ks = 0; ks < 8; ++ks) { const bf16x8 Kf = *(const LAS bf16x8*)(l3 + XA_KIMG + (32 * i + ql) * 272 + 32 * ks + 16 * h); S[i] = MFMA32(Kf, Qf[ks], S[i]); }
        }
    }
    float m = -1e30f;
#pragma unroll
    for (int i = 0; i < 8; ++i)
#pragma unroll
        for (int r = 0; r < 16; ++r) m = fmaxf(m, S[i][r]);
    m = fmaxf(m, __shfl_xor(m, 32));
    float lsum = 0.f;
#pragma unroll
    for (int i = 0; i < 8; ++i)
#pragma unroll
        for (int r = 0; r < 16; ++r) { const float pe = __expf(S[i][r] - m); S[i][r] = pe; lsum += pe; }
    lsum += __shfl_xor(lsum, 32);
    f32x16 O[4];
#pragma unroll
    for (int db = 0; db < 4; ++db)
#pragma unroll
        for (int r = 0; r < 16; ++r) O[db][r] = 0.f;
#pragma unroll
    for (int i = 0; i < 8; ++i)
#pragma unroll
        for (int s2 = 0; s2 < 2; ++s2) { const bf16x8 Pf = pack_step(S[i], s2); const int k0 = 32 * i + 16 * s2;
#pragma unroll
            for (int db = 0; db < 4; ++db) { const bf16x8 Vf = tr_frag(l3 + XA_VIMG + db * 16384, k0 + 4 * h, k0 + 8 + 4 * h, lane); O[db] = MFMA32(Vf, Pf, O[db]); } }
    const float inv = 1.f / lsum;
#pragma unroll
    for (int db = 0; db < 4; ++db)
#pragma unroll
        for (int gq = 0; gq < 4; ++gq) { uint2 w; w.x = pkbf(O[db][4 * gq] * inv, O[db][4 * gq + 1] * inv); w.y = pkbf(O[db][4 * gq + 2] * inv, O[db][4 * gq + 3] * inv);
            *(uint2*)(qptr + 32 * db + 8 * gq + 4 * h) = w; }
}


__device__ __forceinline__ float log_sigmoid_f(float x) { return x >= 0.f ? -log1pf(expf(-x)) : x - log1pf(expf(x)); }
__device__ __forceinline__ void mlstm_gates_wave(const P& p, const LB& L, int l, int b, int c, int hh, int lane, float& bcum, float& ig) {
    const size_t row = (size_t)b * T + c * 64 + lane;
    ig = L.iff[row * 16 + hh] + p.b_i[l * 8 + hh];
    float v = log_sigmoid_f(L.iff[row * 16 + 8 + hh] + p.b_f[l * 8 + hh]);
#pragma unroll
    for (int o = 1; o < 64; o <<= 1) { const float t = __shfl_up(v, o); if (lane >= o) v += t; }
    bcum = v;
}
constexpr int MA_SLOT = 18368, MA_XK = 0, MA_VIMG = 8704, MA_T0 = 16896;
__device__ __forceinline__ void mlstm_A_mfma_unit(const P& p, const LB& L, int l, int u, LAS unsigned char* l3) {
    int tid_l = threadIdx.x; asm volatile("" : "+v"(tid_l)); const int tid = tid_l, lane = tid & 63, hh = tid >> 6, h = lane >> 5, ql = lane & 31;
    const int c = u & 31, b = u >> 5, uh = u * 8 + hh;
    LAS unsigned char* wl = l3 + hh * MA_SLOT;
    const float* cw = p.conv_w + (size_t)l * 4 * 1024;
    __syncthreads();
    {
        u32x4 xk[9], vv[8];
#pragma unroll
        for (int i = 0; i < 9; ++i) { const int idx = lane + 64 * i, ic = idx < 67 * 8 ? idx : 67 * 8 - 1, row = ic >> 3, cc = ic & 7, t = c * 64 - 3 + row;
            xk[i] = *(const u32x4*)(L.mqk + (size_t)(b * T + (t >= 0 ? t : 0)) * 1024 + 512 + hh * 64 + cc * 8); }
#pragma unroll
        for (int i = 0; i < 8; ++i) { const int s = (lane >> 3) + 8 * i, cc = lane & 7; vv[i] = *(const u32x4*)(L.mv + (size_t)(b * T + c * 64 + s) * 512 + hh * 64 + cc * 8); }
#pragma unroll
        for (int i = 0; i < 9; ++i) { const int idx = lane + 64 * i, row = idx >> 3, cc = idx & 7, t = c * 64 - 3 + row;
            if (idx < 67 * 8) *(LAS u32x4*)(wl + MA_XK + row * 128 + cc * 16) = t >= 0 ? xk[i] : (u32x4){0u, 0u, 0u, 0u}; }
#pragma unroll
        for (int i = 0; i < 8; ++i) { const int s = (lane >> 3) + 8 * i, cc = lane & 7; *(LAS u32x4*)(wl + MA_VIMG + (cc >> 2) * 4096 + s * 64 + (cc & 3) * 16) = vv[i]; }
    }
    float bcum, ig; mlstm_gates_wave(p, L, l, b, c, hh, lane, bcum, ig);
    const float g = __shfl(bcum, 63), alog = g - bcum + ig, ml = wave_max(alog);
    ((LAS float*)(wl + MA_T0))[lane] = __expf(alog - ml);
    __syncthreads();
    f32x16 acc[2][2];
#pragma unroll
    for (int a = 0; a < 2; ++a)
#pragma unroll
        for (int d = 0; d < 2; ++d)
#pragma unroll
            for (int r = 0; r < 16; ++r) acc[a][d][r] = 0.f;
    float dnacc[2] = {0.f, 0.f};
    float cwr[2][4];
#pragma unroll
    for (int dkb = 0; dkb < 2; ++dkb)
#pragma unroll
        for (int tap = 0; tap < 4; ++tap) cwr[dkb][tap] = cw[tap * 1024 + 512 + hh * 64 + 32 * dkb + ql];
#pragma unroll
    for (int ks = 0; ks < 4; ++ks) {
        const int s0 = 16 * ks + 8 * h;
        const f32x4 we0 = *(const LAS f32x4*)(wl + MA_T0 + s0 * 4), we1 = *(const LAS f32x4*)(wl + MA_T0 + s0 * 4 + 16);
        const float we[8] = {we0[0], we0[1], we0[2], we0[3], we1[0], we1[1], we1[2], we1[3]};
        bf16x8 WKf[2];
#pragma unroll
        for (int dkb = 0; dkb < 2; ++dkb) {
            float x[11];
#pragma unroll
            for (int r = 0; r < 11; ++r) x[r] = bf2f(*(const LAS unsigned short*)(wl + MA_XK + (s0 + r) * 128 + (32 * dkb + ql) * 2));
            float wk[8];
#pragma unroll
            for (int j = 0; j < 8; ++j) { const float cv = fmaf(cwr[dkb][3], x[j + 3], fmaf(cwr[dkb][2], x[j + 2], fmaf(cwr[dkb][1], x[j + 1], cwr[dkb][0] * x[j])));
                wk[j] = cv * 0.125f * __builtin_amdgcn_rcpf(1.f + __expf(-cv)) * we[j]; dnacc[dkb] += wk[j]; }
            u32x4 w; w.x = pkbf(wk[0], wk[1]); w.y = pkbf(wk[2], wk[3]); w.z = pkbf(wk[4], wk[5]); w.w = pkbf(wk[6], wk[7]);
            WKf[dkb] = __builtin_bit_cast(bf16x8, w);
        }
#pragma unroll
        for (int dvb = 0; dvb < 2; ++dvb) { const bf16x8 Vf = tr_frag(wl + MA_VIMG + dvb * 4096, s0, s0 + 4, lane);
#pragma unroll
            for (int dkb = 0; dkb < 2; ++dkb) acc[dkb][dvb] = MFMA32(WKf[dkb], Vf, acc[dkb][dvb]); }
    }
    bf16_t* st = L.state + (size_t)uh * 4096;
#pragma unroll
    for (int dkb = 0; dkb < 2; ++dkb)
#pragma unroll
        for (int dvb = 0; dvb < 2; ++dvb)
#pragma unroll
            for (int gq = 0; gq < 4; ++gq) { uint2 w; w.x = pkbf(acc[dkb][dvb][4 * gq], acc[dkb][dvb][4 * gq + 1]); w.y = pkbf(acc[dkb][dvb][4 * gq + 2], acc[dkb][dvb][4 * gq + 3]);
                *(uint2*)(st + (32 * dvb + ql) * 64 + 32 * dkb + 8 * gq + 4 * h) = w; }
#pragma unroll
    for (int dkb = 0; dkb < 2; ++dkb) { const float t = dnacc[dkb] + __shfl_xor(dnacc[dkb], 32); if (h == 0) ws_f(p.ws, WS_DN)[(size_t)uh * 64 + 32 * dkb + ql] = t; }
    if (lane == 0) { ws_f(p.ws, WS_G)[uh] = g; ws_f(p.ws, WS_ML)[uh] = ml; }
}
__device__ __forceinline__ void mlstm_scan2_unit(const P& p, const LB& L, int u) {
    int tid_l = threadIdx.x; asm volatile("" : "+v"(tid_l)); const int tid = tid_l, bh = u >> 2, b = bh >> 3, hh = bh & 7, e = (u & 3) * 1024 + 2 * tid;
    const bool first = (u & 3) == 0; const bool do_n = first && tid < 64;
    float *G = ws_f(p.ws, WS_G), *ML = ws_f(p.ws, WS_ML), *MIN = ws_f(p.ws, WS_MIN), *DN = ws_f(p.ws, WS_DN);
    unsigned d[NCH]; float dn[NCH];
#pragma unroll
    for (int c = 0; c < NCH; ++c) { const int idx = (b * NCH + c) * 8 + hh; d[c] = *(const unsigned*)(L.state + (size_t)idx * 4096 + e); dn[c] = do_n ? DN[(size_t)idx * 64 + tid] : 0.f; }
    float m = 0.f, n = 0.f, C0 = 0.f, C1 = 0.f;
#pragma unroll
    for (int c = 0; c < NCH; ++c) { const int idx = (b * NCH + c) * 8 + hh; const float g = G[idx], ml = ML[idx], mn = fmaxf(g + m, ml), a = __expf(g + m - mn), sc = __expf(ml - mn);
        *(unsigned*)(L.state + (size_t)idx * 4096 + e) = pkbf(C0, C1);
        C0 = fmaf(C0, a, sc * __uint_as_float(d[c] << 16)); C1 = fmaf(C1, a, sc * __uint_as_float(d[c] & 0xffff0000u));
        if (do_n) { DN[(size_t)idx * 64 + tid] = n; n = a * n + sc * dn[c]; }
        if (first && tid == 0) MIN[idx] = m;
        m = mn; }
}
constexpr int MC_SLOT = 31232, MC_XQ = 0, MC_XK = 9728, MC_VIMG = 19456, MC_CW = 27648, MC_T0 = 29696, MC_T1 = 29952, MC_T2 = 30208, MC_T3 = 30464, MC_T4 = 30720  , MC_T5 = 30976  ;
__device__ __forceinline__ bf16x8 conv_frag_lds(const LAS unsigned char* img, int tok, int ch0, const LAS float* cwl, float scale) {
    float a[8] = {0.f, 0.f, 0.f, 0.f, 0.f, 0.f, 0.f, 0.f};
#pragma unroll
    for (int tap = 0; tap < 4; ++tap) {
        float xf[8]; unpack8(__builtin_bit_cast(uint4, *(const LAS u32x4*)(img + (tok + tap) * 144 + ch0 * 2)), xf);
        const f32x4 w0 = *(const LAS f32x4*)(cwl + tap * 128 + ch0), w1 = *(const LAS f32x4*)(cwl + tap * 128 + ch0 + 4);
        a[0] = fmaf(w0[0], xf[0], a[0]); a[1] = fmaf(w0[1], xf[1], a[1]); a[2] = fmaf(w0[2], xf[2], a[2]); a[3] = fmaf(w0[3], xf[3], a[3]);
        a[4] = fmaf(w1[0], xf[4], a[4]); a[5] = fmaf(w1[1], xf[5], a[5]); a[6] = fmaf(w1[2], xf[6], a[6]); a[7] = fmaf(w1[3], xf[7], a[7]);
    }
#pragma unroll
    for (int j = 0; j < 8; ++j) a[j] = a[j] * scale * __builtin_amdgcn_rcpf(1.f + __expf(-a[j]));
    u32x4 w; w.x = pkbf(a[0], a[1]); w.y = pkbf(a[2], a[3]); w.z = pkbf(a[4], a[5]); w.w = pkbf(a[6], a[7]);
    return __builtin_bit_cast(bf16x8, w);
}
template <int TB>
__device__ __forceinline__ void mlstm_C_block(const LB& L, int b, int c, int hh, int lane, int h, int ql, LAS unsigned char* wl, const bf16x8 (&Cf)[2][4], const uint2 (&mo)[2][4]) {
    const LAS float* cwl = (const LAS float*)(wl + MC_CW);
    bf16x8 Qf[4]; float qn = 0.f;
#pragma unroll
    for (int ks = 0; ks < 4; ++ks) { const int ch0 = 16 * ks + 8 * h;
        Qf[ks] = conv_frag_lds(wl + MC_XQ, 32 * TB + ql, ch0, cwl, 1.f);
        const f32x4 n0 = *(const LAS f32x4*)(wl + MC_T4 + ch0 * 4), n1 = *(const LAS f32x4*)(wl + MC_T4 + ch0 * 4 + 16);
        float qv[8]; unpack8(__builtin_bit_cast(uint4, Qf[ks]), qv);
#pragma unroll
        for (int j = 0; j < 4; ++j) { qn = fmaf(qv[j], n0[j], qn); qn = fmaf(qv[j + 4], n1[j], qn); } }
    f32x16 S0, S1;
#pragma unroll
    for (int r = 0; r < 16; ++r) { S0[r] = 0.f; S1[r] = 0.f; }
#pragma unroll
    for (int ks = 0; ks < 4; ++ks) { const int ch0 = 16 * ks + 8 * h;
        S0 = MFMA32(conv_frag_lds(wl + MC_XK, ql, ch0, cwl + 64, 0.125f), Qf[ks], S0);
        if (TB == 1) S1 = MFMA32(conv_frag_lds(wl + MC_XK, 32 + ql, ch0, cwl + 64, 0.125f), Qf[ks], S1); }
    const float Mt = ((const LAS float*)(wl + MC_T1))[32 * TB + ql];
    float dsum = 0.f;
#pragma unroll
    for (int gq = 0; gq < 4; ++gq) {
        const f32x4 a0 = *(const LAS f32x4*)(wl + MC_T0 + (8 * gq + 4 * h) * 4), a1 = *(const LAS f32x4*)(wl + MC_T0 + (32 + 8 * gq + 4 * h) * 4);
#pragma unroll
        for (int j = 0; j < 4; ++j) { const int r = 4 * gq + j, sl = 8 * gq + 4 * h + j;
            if (TB == 0) { const float v = sl <= ql ? S0[r] * __expf(a0[j] - Mt) : 0.f; S0[r] = v; dsum += v; }
            else { const float v0 = S0[r] * __expf(a0[j] - Mt); S0[r] = v0; const float v1 = sl <= ql ? S1[r] * __expf(a1[j] - Mt) : 0.f; S1[r] = v1; dsum += v0 + v1; } }
    }
    f32x16 acc[2];
#pragma unroll
    for (int d = 0; d < 2; ++d)
#pragma unroll
        for (int r = 0; r < 16; ++r) acc[d][r] = 0.f;
#pragma unroll
    for (int ks = 0; ks < 4; ++ks)
#pragma unroll
        for (int dvb = 0; dvb < 2; ++dvb) acc[dvb] = MFMA32(Cf[dvb][ks], Qf[ks], acc[dvb]);
    const float iw = ((const LAS float*)(wl + MC_T2))[32 * TB + ql];
#pragma unroll
    for (int dvb = 0; dvb < 2; ++dvb)
#pragma unroll
        for (int r = 0; r < 16; ++r) acc[dvb][r] *= iw;
#pragma unroll
    for (int s2 = 0; s2 < 2; ++s2) {
        const bf16x8 P0 = pack_step(S0, s2), P1 = pack_step(S1, s2);
#pragma unroll
        for (int dvb = 0; dvb < 2; ++dvb) {
            acc[dvb] = MFMA32(tr_frag(wl + MC_VIMG + dvb * 4096, 16 * s2 + 4 * h, 16 * s2 + 8 + 4 * h, lane), P0, acc[dvb]);
            if (TB == 1) acc[dvb] = MFMA32(tr_frag(wl + MC_VIMG + dvb * 4096, 32 + 16 * s2 + 4 * h, 32 + 16 * s2 + 8 + 4 * h, lane), P1, acc[dvb]); }
    }
    dsum += __shfl_xor(dsum, 32); qn += __shfl_xor(qn, 32);
    const float den = dsum + iw * qn, mt = ((const LAS float*)(wl + MC_T3))[32 * TB + ql];
    const float sc = 1.f / fmaxf(fabsf(den), __expf(-mt));
    float sum = 0.f;
#pragma unroll
    for (int dvb = 0; dvb < 2; ++dvb)
#pragma unroll
        for (int r = 0; r < 16; ++r) { const float v = acc[dvb][r] * sc; acc[dvb][r] = v; sum += v; }
    sum += __shfl_xor(sum, 32); const float mu = sum * (1.f / 64.f);
    float var = 0.f;
#pragma unroll
    for (int dvb = 0; dvb < 2; ++dvb)
#pragma unroll
        for (int r = 0; r < 16; ++r) { const float dlt = acc[dvb][r] - mu; var += dlt * dlt; }
    var += __shfl_xor(var, 32); const float rstd = rsqrtf(var * (1.f / 64.f) + EPS);
    bf16_t* op = L.mo + (size_t)(b * T + c * 64 + 32 * TB + ql) * 512 + hh * 64;
#pragma unroll
    for (int dvb = 0; dvb < 2; ++dvb)
#pragma unroll
        for (int gq = 0; gq < 4; ++gq) { const int dv = 32 * dvb + 8 * gq + 4 * h; const f32x4 ng = *(const LAS f32x4*)(wl + MC_T5 + dv * 4);
            const uint2 mg = mo[dvb][gq];
            const float y0 = (acc[dvb][4 * gq] - mu) * rstd * ng[0] * __uint_as_float(mg.x << 16), y1 = (acc[dvb][4 * gq + 1] - mu) * rstd * ng[1] * __uint_as_float(mg.x & 0xffff0000u);
            const float y2 = (acc[dvb][4 * gq + 2] - mu) * rstd * ng[2] * __uint_as_float(mg.y << 16), y3 = (acc[dvb][4 * gq + 3] - mu) * rstd * ng[3] * __uint_as_float(mg.y & 0xffff0000u);
            uint2 w; w.x = pkbf(y0, y1); w.y = pkbf(y2, y3); *(uint2*)(op + dv) = w; }
}
__device__ __forceinline__ void mlstm_C_mfma_unit(const P& p, const LB& L, int l, int u, LAS unsigned char* l3) {
    int tid_l = threadIdx.x; asm volatile("" : "+v"(tid_l)); const int tid = tid_l, lane = tid & 63, wave = tid >> 6, h = lane >> 5, ql = lane & 31;
    const int hg = u & 1, c = (u >> 1) & 31, b = u >> 6, hh = 4 * hg + (wave >> 1), tb = wave & 1, uh = (b * 32 + c) * 8 + hh, l128 = tid & 127;
    LAS unsigned char* wl = l3 + (wave >> 1) * MC_SLOT;
    const float* cw = p.conv_w + (size_t)l * 4 * 1024;
    bf16x8 Cf[2][4]; uint2 mo[2][4];
    {
        const bf16_t* st = L.state + (size_t)uh * 4096; const bf16_t* op = L.mo + (size_t)(b * T + c * 64 + 32 * tb + ql) * 512 + hh * 64;
#pragma unroll
        for (int dvb = 0; dvb < 2; ++dvb) {
#pragma unroll
            for (int ks = 0; ks < 4; ++ks) Cf[dvb][ks] = *(const bf16x8*)(st + (32 * dvb + ql) * 64 + 16 * ks + 8 * h);
#pragma unroll
            for (int gq = 0; gq < 4; ++gq) mo[dvb][gq] = *(const uint2*)(op + 32 * dvb + 8 * gq + 4 * h);
        }
    }
    __syncthreads();
    {
        u32x4 xq[5], xk[5], vv[4]; float cwv[4];
#pragma unroll
        for (int i = 0; i < 5; ++i) { const int idx = l128 + 128 * i, ic = idx < 67 * 8 ? idx : 67 * 8 - 1, row = ic >> 3, cc = ic & 7, t = c * 64 - 3 + row;
            const bf16_t* src = L.mqk + (size_t)(b * T + (t >= 0 ? t : 0)) * 1024 + hh * 64 + cc * 8; xq[i] = *(const u32x4*)src; xk[i] = *(const u32x4*)(src + 512); }
#pragma unroll
        for (int i = 0; i < 4; ++i) { const int s = (l128 >> 3) + 16 * i, cc = l128 & 7; vv[i] = *(const u32x4*)(L.mv + (size_t)(b * T + c * 64 + s) * 512 + hh * 64 + cc * 8); }
#pragma unroll
        for (int i = 0; i < 4; ++i) { const int e = l128 + 128 * i, tap = e >> 7, wch = e & 127; cwv[i] = cw[tap * 1024 + (wch >> 6) * 512 + hh * 64 + (wch & 63)]; }
#pragma unroll
        for (int i = 0; i < 5; ++i) { const int idx = l128 + 128 * i, row = idx >> 3, cc = idx & 7, t = c * 64 - 3 + row; const u32x4 z = (u32x4){0u, 0u, 0u, 0u};
            if (idx < 67 * 8) { *(LAS u32x4*)(wl + MC_XQ + row * 144 + cc * 16) = t >= 0 ? xq[i] : z; *(LAS u32x4*)(wl + MC_XK + row * 144 + cc * 16) = t >= 0 ? xk[i] : z; } }
#pragma unroll
        for (int i = 0; i < 4; ++i) { const int s = (l128 >> 3) + 16 * i, cc = l128 & 7; *(LAS u32x4*)(wl + MC_VIMG + (cc >> 2) * 4096 + s * 64 + (cc & 3) * 16) = vv[i]; }
#pragma unroll
        for (int i = 0; i < 4; ++i) ((LAS float*)(wl + MC_CW))[l128 + 128 * i] = cwv[i];
    }
    {
        float bcum, ig; mlstm_gates_wave(p, L, l, b, c, hh, lane, bcum, ig);
        const float a = ig - bcum; float v = a;
#pragma unroll
        for (int o = 1; o < 64; o <<= 1) { const float t = __shfl_up(v, o); if (lane >= o) v = fmaxf(v, t); }
        const float m_in = ws_f(p.ws, WS_MIN)[uh], Mt = fmaxf(v, m_in);
        if (tb == 1) { ((LAS float*)(wl + MC_T4))[lane] = ws_f(p.ws, WS_DN)[(size_t)uh * 64 + lane]; ((LAS float*)(wl + MC_T5))[lane] = p.norm_g[l * 512 + hh * 64 + lane]; }
        if (tb == 0) { ((LAS float*)(wl + MC_T0))[lane] = a; ((LAS float*)(wl + MC_T1))[lane] = Mt; ((LAS float*)(wl + MC_T2))[lane] = __expf(m_in - Mt); ((LAS float*)(wl + MC_T3))[lane] = bcum + Mt; }
    }
    __syncthreads();
    if (tb == 0) mlstm_C_block<0>(L, b, c, hh, lane, h, ql, wl, Cf, mo);
    else mlstm_C_block<1>(L, b, c, hh, lane, h, ql, wl, Cf, mo);
}

#define XB_TMO      128
#define XB_XCNT(j)  (256  + 64 * (j))
#define XB_XSUB(j)  (1280 + 64 * (j))
#define XB_XGEN(j)  (2304 + 64 * (j))
#define XB_TOP      3328
#define XB_TOPGEN   3392
#define XCD_BAR_WORDS 3456
#define XB_SPIN_CAP (1u << 18)

__device__ __forceinline__ unsigned xb_ld(unsigned* p)              { return __hip_atomic_load(p, __ATOMIC_RELAXED, __HIP_MEMORY_SCOPE_AGENT); }
__device__ __forceinline__ unsigned xb_add(unsigned* p, unsigned v) { return __hip_atomic_fetch_add(p, v, __ATOMIC_RELAXED, __HIP_MEMORY_SCOPE_AGENT); }
__device__ __forceinline__ unsigned xb_xcc_id() { return (unsigned)__builtin_amdgcn_s_getreg((3 << 11) | 20) & 0xFu; }
#define XB_SPIN(cond, bar) do { unsigned _sp = 0; while (cond) { __builtin_amdgcn_s_sleep(1); \
    if ((++_sp & 255u) == 0u) { if (xb_ld(&(bar)[XB_TMO])) break; if (_sp > XB_SPIN_CAP) { atomicAdd(&(bar)[XB_TMO], 1u); break; } } } } while (0)

struct XcdBarrier {
    unsigned* bar; unsigned x;
    volatile LAS unsigned* st;
};

__device__ __forceinline__ XcdBarrier xcd_barrier_post(unsigned* bar, volatile LAS unsigned* st) {
    XcdBarrier b; b.bar = bar; b.x = xb_xcc_id(); b.st = st;
    if (threadIdx.x == 0) (void)xb_add(&bar[XB_XCNT(b.x)], 1u);
    return b;
}
__device__ __forceinline__ void xcd_barrier_complete(unsigned* bar, unsigned x, unsigned& nloc, unsigned& nx) {
    const unsigned G = gridDim.x * gridDim.y * gridDim.z;
    unsigned sum, cnt, mine, sp = 0u;
    for (;;) {
        sum = 0u; cnt = 0u; mine = 0u;
#pragma unroll
        for (unsigned j = 0; j < 16; ++j) { const unsigned c = xb_ld(&bar[XB_XCNT(j)]); sum += c; cnt += (c > 0u) ? 1u : 0u; mine = (j == x) ? c : mine; }
        if (sum == G) break;
        __builtin_amdgcn_s_sleep(1);
        if ((++sp & 255u) == 0u) { if (xb_ld(&bar[XB_TMO])) break; if (sp > XB_SPIN_CAP) { atomicAdd(&bar[XB_TMO], 1u); break; } }
    }
    nloc = mine > 0u ? mine : 1u; nx = cnt > 0u ? cnt : 1u;
}

__device__ __forceinline__ void xcd_barrier(const XcdBarrier& b) {
    asm volatile("s_waitcnt vmcnt(0)" ::: "memory");
    __syncthreads();
    if (threadIdx.x == 0) {
        unsigned* bar = b.bar;
        __builtin_amdgcn_s_waitcnt(0);
        unsigned nloc = b.st[0], nx = b.st[1];
        if (nloc == 0u) { xcd_barrier_complete(bar, b.x, nloc, nx); b.st[0] = nloc; b.st[1] = nx; }
        const unsigned old = xb_add(&bar[XB_XSUB(b.x)], 1u);
        const unsigned gen = old / nloc;
        if (old + 1u == (gen + 1u) * nloc) {
            __builtin_amdgcn_fence(__ATOMIC_RELEASE, "agent");
            asm volatile("s_waitcnt vmcnt(0)" ::: "memory");
            const unsigned og = xb_add(&bar[XB_TOP], 1u);
            const unsigned tg = og / nx;
            if (og + 1u == (tg + 1u) * nx) xb_add(&bar[XB_TOPGEN], 1u);
            else XB_SPIN(xb_ld(&bar[XB_TOPGEN]) == tg, bar);
            __builtin_amdgcn_fence(__ATOMIC_ACQUIRE, "agent");
            xb_add(&bar[XB_XGEN(b.x)], 1u);
            asm volatile("s_waitcnt vmcnt(0)" ::: "memory");
        } else {
            XB_SPIN(xb_ld(&bar[XB_XGEN(b.x)]) == gen, bar);
            __builtin_amdgcn_fence(__ATOMIC_ACQUIRE, "agent");
            asm volatile("s_waitcnt vmcnt(0)" ::: "memory");
        }
    }
    __syncthreads();
}

__global__ void __launch_bounds__(512, 2) mk_fwd(P p) {
    extern __shared__ __attribute__((aligned(16))) unsigned char lds[];
    LAS unsigned char* l3 = (LAS unsigned char*)lds;
    float* fl = (float*)lds;
    const int G = gridDim.x, bx = blockIdx.x;
    if (threadIdx.x < 64) ((LAS unsigned*)(l3 + LDS_CTL))[threadIdx.x] = 0u;
    __syncthreads();
    (void)xcd_barrier_post((unsigned*)(p.ws + WS_BAR), (volatile LAS unsigned*)(l3 + LDS_CTL + 32));
#define PR_T0 (*(volatile LAS unsigned long long*)(l3 + LDS_CTL + 64))
#define PR_ACC (*(volatile LAS unsigned long long*)(l3 + LDS_CTL + 72))
#define PH_BEGIN(id) do { if ((PROBE_MASK >> (id)) & 1) { if (bx == 0 && threadIdx.x == 0) PR_T0 = __builtin_amdgcn_s_memrealtime(); } } while (0)
#define PH_END(id) do { if ((PROBE_MASK >> (id)) & 1) { if (bx == 0 && threadIdx.x == 0) PR_ACC = PR_ACC + (__builtin_amdgcn_s_memrealtime() - PR_T0); } } while (0)
#define GRID_BAR() do { XcdBarrier b_; b_.bar = (unsigned*)(p.ws + WS_BAR); b_.x = xb_xcc_id(); b_.st = (volatile LAS unsigned*)(l3 + LDS_CTL + 32); xcd_barrier(b_); } while (0)
#define WAVE_IDS() int tid_w = threadIdx.x; asm volatile("" : "+v"(tid_w)); const int lane = tid_w & 63, gw = bx * 8 + (tid_w >> 6), ngw = G * 8

        PH_BEGIN(0);
    {
        WAVE_IDS();
        convert_phase(p, bx, G, fl);
        rowstat_rows(p.x, M, layer_buf(p.ws, p.out, 0).xbin, ws_f(p.ws, WS_ROWSS), gw, ngw, lane);
        rowstat_rows(p.mem, MM, (bf16_t*)(p.ws + WS_MEMB), ws_f(p.ws, WS_ROWSS_MEM), gw, ngw, lane);
    }
    GRID_BAR();
        PH_END(0);

#pragma unroll 1
    for (int l = 0; l < 2; ++l) {
        PH_BEGIN(1);
        {
            const LB L = layer_buf(p.ws, p.out, l);
            pg8::Gemm g{L.xbin, L.win, M, 6656, D, (const bf16_t*)(p.ws + WS_MEMB)};
            SchedRounds S{G, bx, 6, 0, 1, 3};
            Unit u0, u3; S.next(0, u0); const bool has_tail = S.next(6, u3);
            fill_rstd_table(ws_f(p.ws, WS_ROWSS) + (size_t)(2 * l) * M * 16, u0.rm, (LAS float*)(l3 + LDS_RSTD0));
            if (has_tail) fill_rstd_table(u3.kind == 1 ? ws_f(p.ws, WS_ROWSS_MEM) : ws_f(p.ws, WS_ROWSS) + (size_t)(2 * l) * M * 16, u3.rm, (LAS float*)(l3 + LDS_RSTD1));
            __syncthreads();
            EpiProjMK E{L, (const LAS float*)(l3 + LDS_RSTD0), (const LAS float*)(l3 + LDS_RSTD1), u0.rm};
            pg8::gemm_phase<EpiProjMK, SchedRounds, true, true>(l3, g, S, E);
        }
        GRID_BAR();
        PH_END(1);
        PH_BEGIN(2);
        {
            const LB L = layer_buf(p.ws, p.out, l);
            PH_BEGIN(10); for (int u = bx; u < NB * 16 * 2; u += G) swa_mfma_unit(p, L, l, u, l3); PH_END(10);
            PH_BEGIN(11); for (int u = bx; u < NB * 4 * 8; u += G) xattn_mfma_unit(L, u, l3); PH_END(11);
            PH_BEGIN(12); for (int u = bx; u < NB * NCH; u += G) mlstm_A_mfma_unit(p, L, l, u, l3); PH_END(12);
        }
        GRID_BAR();
        PH_END(2);
        PH_BEGIN(3);
        {
            const LB L = layer_buf(p.ws, p.out, l);
            for (int u = bx; u < 256; u += G) mlstm_scan2_unit(p, L, u);
        }
        GRID_BAR();
        PH_END(3);
        PH_BEGIN(4);
        {
            const LB L = layer_buf(p.ws, p.out, l);
            for (int u = bx; u < NB * NCH * 2; u += G) mlstm_C_mfma_unit(p, L, l, u, l3);
        }
        GRID_BAR();
        PH_END(4);
        PH_BEGIN(6);
        {
            const LB L = layer_buf(p.ws, p.out, l);
            pg8::Gemm g{L.sq, L.wbr, 3 * M, 3 * D, 512, nullptr};
            SchedMerged S{G, bx};
            EpiMergedMK E{L.gates, L.merged};
            pg8::gemm_phase<EpiMergedMK, SchedMerged, true, true>(l3, g, S, E);
        }
        GRID_BAR();
        PH_END(6);
        PH_BEGIN(7);
        {
            const LB L = layer_buf(p.ws, p.out, l);
            pg8::Gemm g{L.merged, L.wout, M, D, D, nullptr};
            SchedRounds S{G, bx, 1, 0, 0, 99};
            EpiResidMK E{L.xbin, L.xbmid, ws_f(p.ws, WS_ROWSS) + (size_t)(2 * l + 1) * M * 16};
            pg8::gemm_phase<EpiResidMK, SchedRounds, true, true>(l3, g, S, E);
        }
        GRID_BAR();
        PH_END(7);
        PH_BEGIN(8);
        {
            const LB L = layer_buf(p.ws, p.out, l);
            pg8::Gemm g{L.xbmid, L.wff1, M, DFF, D, nullptr};
            SchedRounds S{G, bx, 4, 0, 0, 99};
            Unit u0; S.next(0, u0);
            fill_rstd_table(ws_f(p.ws, WS_ROWSS) + (size_t)(2 * l + 1) * M * 16, u0.rm, (LAS float*)(l3 + LDS_RSTD0));
            __syncthreads();
            EpiFF1MK E{L.hff, (const LAS float*)(l3 + LDS_RSTD0)};
            pg8::gemm_phase<EpiFF1MK, SchedRounds, true, true>(l3, g, S, E);
        }
        GRID_BAR();
        PH_END(8);
        PH_BEGIN(9);
        {
            const LB L = layer_buf(p.ws, p.out, l);
            pg8::Gemm g{L.hff, L.wff2, M, D, DFF, nullptr};
            SchedRounds S{G, bx, 1, 0, 0, 99};
            EpiResidMK E{L.xbmid, L.xbnext, ws_f(p.ws, WS_ROWSS) + (size_t)(2 * l + 2) * M * 16};
            pg8::gemm_phase<EpiResidMK, SchedRounds, true, true>(l3, g, S, E);
        }
        GRID_BAR();
        PH_END(9);
    }
    {
        WAVE_IDS();
        finalnorm_rows(layer_buf(p.ws, p.out, 1).xbnext, p.out, ws_f(p.ws, WS_ROWSS) + (size_t)4 * M * 16, p.g_final, gw, ngw, lane);
    }
    if (PROBE_MASK != 0 && bx == 0 && threadIdx.x == 0) { const unsigned long long te = __builtin_amdgcn_s_memrealtime(); const unsigned long long acc_ = PR_ACC; while (__builtin_amdgcn_s_memrealtime() - te < 10ull * acc_) __builtin_amdgcn_s_sleep(8); }
}
}

extern "C" void kernel_launch(void* const* d_in, const int* in_sizes, int n_in, void* d_out, int out_size, void* d_ws, size_t ws_size, hipStream_t stream) {
    static int grid = 0;
    if (grid == 0) {
        if (n_in != 20 || out_size != M * D || ws_size < WS_END) { fprintf(stderr, "kernel_launch: unexpected shapes (n_in %d out %d ws %zu)\n", n_in, out_size, ws_size); grid = -1; return; }
        int dev = 0, cus = 0, per_cu = 0;
        if (hipGetDevice(&dev) != hipSuccess || hipDeviceGetAttribute(&cus, hipDeviceAttributeMultiprocessorCount, dev) != hipSuccess) { fprintf(stderr, "kernel_launch: device query failed\n"); grid = -1; return; }
        if (hipFuncSetAttribute((const void*)mk_fwd, hipFuncAttributeMaxDynamicSharedMemorySize, LDS_BYTES) != hipSuccess) { fprintf(stderr, "kernel_launch: hipFuncSetAttribute failed\n"); grid = -1; return; }
        if (hipOccupancyMaxActiveBlocksPerMultiprocessor(&per_cu, (const void*)mk_fwd, 512, LDS_BYTES) != hipSuccess || per_cu < 1) { fprintf(stderr, "kernel_launch: occupancy query says %d blocks per CU\n", per_cu); grid = -1; return; }
        if (cus != 256) { fprintf(stderr, "kernel_launch: built for a 256-CU device (unit orders assume 256 workgroups); found %d CUs\n", cus); grid = -1; return; }
        grid = cus * (per_cu >= 1 ? 1 : 0);
    }
    if (grid < 0) return;
    P p{};
    const float** pf = (const float**)&p;
    for (int i = 0; i < 20; ++i) pf[i] = (const float*)d_in[i];
    p.out = (float*)d_out; p.ws = (unsigned char*)d_ws;
    if (hipMemsetAsync(d_ws, 0, WS_ZERO_BYTES, stream) != hipSuccess) { fprintf(stderr, "kernel_launch: memset failed\n"); return; }
    void* args[] = {&p};
    const hipError_t e = hipLaunchCooperativeKernel((const void*)mk_fwd, dim3(grid), dim3(512), args, LDS_BYTES, stream);
    if (e != hipSuccess) fprintf(stderr, "kernel_launch: cooperative launch failed: %s (grid %d)\n", hipGetErrorString(e), grid);
}
```

```cpp
#include <hip/hip_runtime.h>
#include <cstdio>
#include <cstdint>
#ifndef PROBE_MASK
#define PROBE_MASK 0
#endif

namespace pg8 {
#define PG8_LAS __attribute__((address_space(3)))
typedef unsigned short bf16_t;
typedef short bf16x8 __attribute__((ext_vector_type(8)));
typedef float f32x4 __attribute__((ext_vector_type(4)));
typedef unsigned u32x4 __attribute__((ext_vector_type(4)));
constexpr int BM = 256, BK = 64, HALF = 128, HTB = HALF * BK * 2  , STAGE_BYTES = 8 * HTB, NXCD = 8, WGM = 8;

__host__ __device__ __forceinline__ int lds_byte(int r, int c) { const int st = (r >> 4) * 2 + (c >> 5), rr = r & 15, cc = c & 31, ob = rr * 64 + cc * 2; return st * 1024 + (ob ^ (((ob >> 9) & 1) << 5)); }
__host__ __device__ __forceinline__ void stage_rc(int b, int& R, int& C) { const int st = b / 1024, sb = b % 1024, swz = sb ^ (((sb >> 9) & 1) << 5); R = (st >> 1) * 16 + swz / 64; C = (st & 1) * 32 + (swz % 64) / 2; }
__host__ __device__ __forceinline__ int perm32(int rho) { const int n = rho >> 4, i = rho & 15; return 8 * (i >> 2) + 4 * n + (i & 3); }
struct Unit { int pm, pn, rm, kind, asel; };
struct Gemm { const bf16_t* A; const bf16_t* Bt; int M, N, K; const bf16_t* A2; };
__device__ __forceinline__ unsigned cvt_pk_bf16(float lo, float hi) { unsigned r; asm volatile("v_cvt_pk_bf16_f32 %0, %1, %2" : "=v"(r) : "v"(lo), "v"(hi)); return r; }
template <class Epi, class Sched, bool ALIGN_EPI = false, bool SP2 = false>
__device__ __forceinline__ void gemm_phase(PG8_LAS unsigned char* lds, const Gemm g, const Sched& S, const Epi& E) {
    int tid_l = threadIdx.x; asm volatile("" : "+v"(tid_l));
    const int tid = tid_l, wid = __builtin_amdgcn_readfirstlane(tid >> 6), lane = tid & 63, wr = wid >> 2, wc = wid & 3, fr = lane & 15, fq = lane >> 4;
    const int K = g.K, nt = K / BK;
    unsigned voffA[2], voffB[2];
#pragma unroll
    for (int i = 0; i < 2; ++i) { int R, C; stage_rc(tid * 16 + i * 8192, R, C); const int Rb = Epi::PERM ? ((R & ~31) + perm32(R & 31)) : R;
        voffA[i] = (unsigned)(R * K + C) * 2u; voffB[i] = (unsigned)(Rb * K + C) * 2u; }
    const size_t kstep = (size_t)(BK * 2);
    const size_t hstep = (size_t)HALF * K * 2;
    const size_t tstep = 2 * hstep;
    const unsigned ldsw = (unsigned)wid * 1024u;
    const int aoff = lds_byte(wr * 64 + fr, fq * 8), boff = lds_byte(wc * 32 + fr, fq * 8);
#define PG8_SA(b, h) (((b) * 2 + (h)) * HTB)
#define PG8_SB(b, h) ((4 + (b) * 2 + (h)) * HTB)
#define PG8_STAGE(bufoff, gbase, voff) do { _Pragma("unroll") for (int _i = 0; _i < 2; ++_i) \
        __builtin_amdgcn_global_load_lds((const unsigned*)((const char*)(gbase) + (voff)[_i]), (PG8_LAS unsigned*)(lds + (bufoff) + ldsw + _i * 8192), 16, 0, 0); } while (0)
#define PG8_LDA(dst, b, h) do { _Pragma("unroll") for (int m = 0; m < 4; ++m) _Pragma("unroll") for (int k = 0; k < 2; ++k) dst[m][k] = *(const PG8_LAS bf16x8*)(lds + PG8_SA(b, h) + aoff + m * 2048 + k * 1024); } while (0)
#define PG8_LDB(dst, b, h) do { _Pragma("unroll") for (int n = 0; n < 2; ++n) _Pragma("unroll") for (int k = 0; k < 2; ++k) dst[n][k] = *(const PG8_LAS bf16x8*)(lds + PG8_SB(b, h) + boff + n * 2048 + k * 1024); } while (0)
#define PG8_MMA(ai, bj, At, Bt) do { __builtin_amdgcn_s_setprio(1); _Pragma("unroll") for (int m = 0; m < 4; ++m) _Pragma("unroll") for (int n = 0; n < 2; ++n) _Pragma("unroll") for (int k = 0; k < 2; ++k) \
        acc[ai][bj][m][n] = __builtin_amdgcn_mfma_f32_16x16x32_bf16(Bt[n][k], At[m][k], acc[ai][bj][m][n], 0, 0, 0); __builtin_amdgcn_s_setprio(0); } while (0)
#define PG8_WAIT_V(n) asm volatile("s_waitcnt vmcnt(" #n ")" ::: "memory")
#define PG8_WAIT_L(n) asm volatile("s_waitcnt lgkmcnt(" #n ")" ::: "memory")
#define PG8_BAR __builtin_amdgcn_s_barrier()
#define PG8_SCHED __builtin_amdgcn_sched_barrier(0)
    Unit cur, nxt; int ui = 0;
    if (!S.next(0, cur)) return;
    f32x4 acc[2][2][4][2];
#pragma unroll
    for (int a = 0; a < 2; ++a)
#pragma unroll
        for (int b = 0; b < 2; ++b)
#pragma unroll
            for (int m = 0; m < 4; ++m)
#pragma unroll
                for (int n = 0; n < 2; ++n) acc[a][b][m][n] = (f32x4){0.f, 0.f, 0.f, 0.f};
    bf16x8 At[4][2], B0[2][2], B1[2][2];
    const char* cA = (const char*)(cur.asel ? g.A2 : g.A) + (size_t)cur.pm * tstep; const char* cB = (const char*)g.Bt + (size_t)cur.pn * tstep;
    S.a_ready(cur);
    if constexpr (SP2) {
        PG8_STAGE(PG8_SB(0, 0), cB, voffB); PG8_STAGE(PG8_SB(0, 1), cB + hstep, voffB); PG8_STAGE(PG8_SA(0, 0), cA, voffA); PG8_STAGE(PG8_SA(0, 1), cA + hstep, voffA);
        if (wr == 1) PG8_BAR;
        PG8_WAIT_V(2); PG8_BAR;
        PG8_STAGE(PG8_SB(1, 0), cB + kstep, voffB); PG8_STAGE(PG8_SA(1, 0), cA + kstep, voffA); PG8_STAGE(PG8_SB(1, 1), cB + hstep + kstep, voffB);
        PG8_WAIT_V(6); PG8_BAR;
    } else {
        PG8_STAGE(PG8_SB(0, 0), cB, voffB); PG8_STAGE(PG8_SA(0, 0), cA, voffA); PG8_STAGE(PG8_SB(0, 1), cB + hstep, voffB); PG8_STAGE(PG8_SA(0, 1), cA + hstep, voffA);
        if (wr == 1) PG8_BAR;
        PG8_WAIT_V(4); PG8_BAR;
        PG8_STAGE(PG8_SB(1, 0), cB + kstep, voffB); PG8_STAGE(PG8_SA(1, 0), cA + kstep, voffA); PG8_STAGE(PG8_SB(1, 1), cB + hstep + kstep, voffB);
        PG8_WAIT_V(6); PG8_BAR;
    }
    for (;;) {
        const bool has_next = S.next(ui + 1, nxt);
        const char* nA = has_next ? (const char*)(nxt.asel ? g.A2 : g.A) + (size_t)nxt.pm * tstep : cA; const char* nB = has_next ? (const char*)g.Bt + (size_t)nxt.pn * tstep : cB;
        for (int t = 0; t < nt; t += 2) {
            const bool last = (t == nt - 2);
            const char* a1 = cA + (size_t)(t + 1) * kstep;
            const char* a2 = last ? nA : cA + (size_t)(t + 2) * kstep; const char* b2 = last ? nB : cB + (size_t)(t + 2) * kstep;
            const char* a3 = a2 + kstep; const char* b3 = b2 + kstep;
            if (last && has_next) S.a_ready(nxt);
            if constexpr (SP2) {
            PG8_LDB(B0, 0, 0); PG8_LDB(B1, 0, 1); PG8_SCHED; PG8_LDA(At, 0, 0); PG8_STAGE(PG8_SA(1, 1), a1 + hstep, voffA);
            PG8_WAIT_V(8); PG8_WAIT_L(0); PG8_BAR; PG8_MMA(0, 0, At, B0); PG8_MMA(0, 1, At, B1); PG8_BAR; PG8_SCHED;
            PG8_LDA(At, 0, 1); PG8_STAGE(PG8_SB(0, 0), b2, voffB); PG8_STAGE(PG8_SB(0, 1), b2 + hstep, voffB); PG8_STAGE(PG8_SA(0, 0), a2, voffA);
            PG8_WAIT_V(8); PG8_WAIT_L(0); PG8_BAR; PG8_MMA(1, 0, At, B0); PG8_MMA(1, 1, At, B1); PG8_BAR; PG8_SCHED;
            PG8_LDB(B0, 1, 0); PG8_LDB(B1, 1, 1); PG8_SCHED; PG8_LDA(At, 1, 0); PG8_STAGE(PG8_SA(0, 1), a2 + hstep, voffA);
            PG8_WAIT_V(8); PG8_WAIT_L(0); PG8_BAR; PG8_MMA(0, 0, At, B0); PG8_MMA(0, 1, At, B1); PG8_BAR; PG8_SCHED;
            PG8_LDA(At, 1, 1); PG8_STAGE(PG8_SB(1, 0), b3, voffB); PG8_STAGE(PG8_SB(1, 1), b3 + hstep, voffB); PG8_STAGE(PG8_SA(1, 0), a3, voffA);
            PG8_WAIT_V(8); PG8_WAIT_L(0); PG8_BAR; PG8_MMA(1, 0, At, B0); PG8_MMA(1, 1, At, B1); PG8_BAR; PG8_SCHED;
            } else {
            PG8_LDB(B0, 0, 0); PG8_SCHED; PG8_LDA(At, 0, 0); PG8_STAGE(PG8_SA(1, 1), a1 + hstep, voffA);
            PG8_WAIT_L(8); PG8_BAR; PG8_WAIT_L(0); PG8_MMA(0, 0, At, B0); PG8_BAR; PG8_SCHED;
            PG8_LDB(B1, 0, 1); PG8_STAGE(PG8_SB(0, 0), b2, voffB);
            PG8_BAR; PG8_WAIT_L(0); PG8_MMA(0, 1, At, B1); PG8_BAR;
            PG8_LDA(At, 0, 1); PG8_STAGE(PG8_SA(0, 0), a2, voffA);
            PG8_BAR; PG8_WAIT_L(0); PG8_MMA(1, 0, At, B0); PG8_BAR; PG8_SCHED;
            PG8_STAGE(PG8_SB(0, 1), b2 + hstep, voffB);
            PG8_WAIT_V(6); PG8_BAR; PG8_MMA(1, 1, At, B1); PG8_BAR;
            PG8_LDB(B0, 1, 0); PG8_SCHED; PG8_LDA(At, 1, 0); PG8_STAGE(PG8_SA(0, 1), a2 + hstep, voffA);
            PG8_WAIT_L(8); PG8_BAR; PG8_WAIT_L(0); PG8_MMA(0, 0, At, B0); PG8_BAR; PG8_SCHED;
            PG8_LDB(B1, 1, 1); PG8_STAGE(PG8_SB(1, 0), b3, voffB);
            PG8_BAR; PG8_WAIT_L(0); PG8_MMA(0, 1, At, B1); PG8_BAR;
            PG8_LDA(At, 1, 1); PG8_STAGE(PG8_SA(1, 0), a3, voffA);
            PG8_BAR; PG8_WAIT_L(0); PG8_MMA(1, 0, At, B0); PG8_BAR; PG8_SCHED;
            PG8_STAGE(PG8_SB(1, 1), b3 + hstep, voffB);
            PG8_WAIT_V(6); PG8_BAR; PG8_MMA(1, 1, At, B1); PG8_BAR;
            }
        }
        if constexpr (ALIGN_EPI) { if (wr == 0) PG8_BAR; }
        if constexpr (!Epi::AFTER_DRAIN) { E(acc, cur, wr, wc, fr, fq); S.done(cur); }
        const bool keep_acc = E.keep(cur);
        if (!has_next) break;
        if (!keep_acc) {
#pragma unroll
        for (int a = 0; a < 2; ++a)
#pragma unroll
            for (int b = 0; b < 2; ++b)
#pragma unroll
                for (int m = 0; m < 4; ++m)
#pragma unroll
                    for (int n = 0; n < 2; ++n) acc[a][b][m][n] = (f32x4){0.f, 0.f, 0.f, 0.f};
        }
        cur = nxt; cA = nA; cB = nB; ++ui;
        if constexpr (ALIGN_EPI) { if (wr == 1) PG8_BAR; }
    }
    PG8_WAIT_V(0);
    if constexpr (!ALIGN_EPI) { if (wr == 0) PG8_BAR; }
    PG8_BAR;
    if constexpr (Epi::AFTER_DRAIN) { E.fused(acc, cur, wr, wc, fr, fq, lds, wid, lane); S.done(cur); }
#undef PG8_SA
#undef PG8_SB
#undef PG8_STAGE
#undef PG8_LDA
#undef PG8_LDB
#undef PG8_MMA
#undef PG8_WAIT_V
#undef PG8_WAIT_L
#undef PG8_BAR
#undef PG8_SCHED
}
}

namespace {
using pg8::bf16_t; using pg8::f32x4; using pg8::u32x4; using pg8::Unit;
#define LAS __attribute__((address_space(3)))
constexpr int M = 16384, D = 1024, T = 2048, NB = 8, MEMLEN = 256, MM = NB * MEMLEN;
constexpr int INC = 6416, DFF = 4096, NCH = 32, NH = 8;
constexpr float EPS = 1e-6f;
constexpr size_t MiB = 1u << 20;
constexpr size_t WS_POOL_C = 77u << 20;
constexpr size_t WS_BAR = 0;
constexpr size_t WS_ROWSS = WS_POOL_C + 174 * (1u << 20);
constexpr size_t WS_ZERO_BYTES = 64 * 1024;
constexpr size_t WS_ROWSS_MEM = WS_POOL_C + 173 * (1u << 20);
constexpr size_t WS_G = 400 * 1024, WS_ML = 408 * 1024, WS_MIN = 416 * 1024;
constexpr size_t WS_DN = 512 * 1024;
constexpr size_t WS_WT = 1 * MiB;
constexpr size_t WT_WIN = 0, WT_WMEM = (size_t)6656 * D * 2, WT_WBR = WT_WMEM + (size_t)D * D * 2, WT_WOUT = WT_WBR + (size_t)3 * D * 512 * 2,
                 WT_FF1 = WT_WOUT + (size_t)D * D * 2, WT_FF2 = WT_FF1 + (size_t)DFF * D * 2, WT_LAYER = WT_FF2 + (size_t)D * DFF * 2;
constexpr size_t WS_MEMB = 73 * MiB, WS_POOL = 77 * MiB, WS_END = 256 * MiB;
static_assert(WS_WT + 2 * WT_LAYER <= WS_MEMB && WS_POOL_C == WS_POOL, "weights fit");
constexpr int LDS_RING = 131072, LDS_BYTES = 147456, LDS_CTL = LDS_BYTES - 256, LDS_RSTD0 = LDS_RING, LDS_RSTD1 = LDS_RING + 1024;

struct P {
    const float *x, *mem, *rel_bias, *g_mix, *w_in, *conv_w, *b_i, *b_f, *norm_g, *sinks, *g_mem, *w_mem_kv, *w_br0, *w_br1, *w_br2, *w_out, *g_ffn, *w_ff1, *w_ff2, *g_final;
    float* out; unsigned char* ws;
};
struct LB {
    bf16_t *xbin, *sq, *mo, *xq, *skv, *mqk, *mv, *memkv, *merged, *xbmid, *hff, *xbnext;
    unsigned char* gates;
    float* iff; bf16_t* state;
    const bf16_t *win, *wmem, *wbr, *wout, *wff1, *wff2;
};
__host__ __device__ inline LB layer_buf(unsigned char* ws, float* out, int l) {
    LB b; unsigned char* pool = ws + WS_POOL; unsigned char* breg = pool;
    b.xbin = (bf16_t*)out; b.xbmid = (bf16_t*)((unsigned char*)out + 32 * MiB); b.xbnext = l == 1 ? (bf16_t*)(pool + 128 * MiB) : (bf16_t*)out;
    b.merged = (bf16_t*)(pool + 48 * MiB); b.hff = (bf16_t*)pool;
    b.sq = (bf16_t*)breg; b.mo = (bf16_t*)(breg + 16 * MiB); b.xq = (bf16_t*)(breg + 32 * MiB);
    b.gates = pool + 125 * MiB;
    b.skv = (bf16_t*)(breg + 48 * MiB); b.mqk = (bf16_t*)(breg + 56 * MiB); b.mv = (bf16_t*)(breg + 88 * MiB);
    b.iff = (float*)(breg + 104 * MiB); b.memkv = (bf16_t*)(breg + 105 * MiB); b.state = (bf16_t*)(breg + 109 * MiB);
    unsigned char* wt = ws + WS_WT + (size_t)l * WT_LAYER;
    b.win = (const bf16_t*)(wt + WT_WIN); b.wmem = (const bf16_t*)(wt + WT_WMEM); b.wbr = (const bf16_t*)(wt + WT_WBR);
    b.wout = (const bf16_t*)(wt + WT_WOUT); b.wff1 = (const bf16_t*)(wt + WT_FF1); b.wff2 = (const bf16_t*)(wt + WT_FF2);
    return b;
}
__device__ __forceinline__ float* ws_f(unsigned char* ws, size_t off) { return (float*)(ws + off); }

__device__ __forceinline__ float bf2f(bf16_t h) { return __uint_as_float(((unsigned)h) << 16); }
__device__ __forceinline__ bf16_t f2bf(float f) { unsigned u = __float_as_uint(f); u = (u + 0x7fffu + ((u >> 16) & 1u)) >> 16; return (bf16_t)u; }
__device__ __forceinline__ unsigned pk2(float lo, float hi) { return (unsigned)f2bf(lo) | ((unsigned)f2bf(hi) << 16); }
__device__ __forceinline__ float sigmoidf_(float v) { return 1.f / (1.f + expf(-v)); }
__device__ __forceinline__ float fsigmoid(float v) { return __builtin_amdgcn_rcpf(1.f + __expf(-v)); }
__device__ __forceinline__ float wave_sum(float v) {
#pragma unroll
    for (int o = 1; o < 64; o <<= 1) v += __shfl_xor(v, o);
    return v;
}
__device__ __forceinline__ float wave_max(float v) {
#pragma unroll
    for (int o = 1; o < 64; o <<= 1) v = fmaxf(v, __shfl_xor(v, o));
    return v;
}
__device__ __forceinline__ void unpack8(const uint4 a, float (&f)[8]) {
    f[0] = __uint_as_float(a.x << 16); f[1] = __uint_as_float(a.x & 0xffff0000u); f[2] = __uint_as_float(a.y << 16); f[3] = __uint_as_float(a.y & 0xffff0000u);
    f[4] = __uint_as_float(a.z << 16); f[5] = __uint_as_float(a.z & 0xffff0000u); f[6] = __uint_as_float(a.w << 16); f[7] = __uint_as_float(a.w & 0xffff0000u);
}
__device__ const unsigned char T5_BUCKET[128] = {0, 1, 2, 3, 4, 5, 6, 7, 8, 9, 10, 11, 12, 13, 14, 15, 16, 16, 16, 17, 17, 18, 18, 18, 19, 19, 19, 20, 20, 20, 20, 21, 21, 21, 21, 22, 22, 22, 22, 22, 23, 23, 23, 23, 23, 23, 24, 24, 24, 24, 24, 24, 25, 25, 25, 25, 25, 25, 25, 26, 26, 26, 26, 26, 26, 26, 26, 27, 27, 27, 27, 27, 27, 27, 27, 27, 27, 28, 28, 28, 28, 28, 28, 28, 28, 28, 28, 29, 29, 29, 29, 29, 29, 29, 29, 29, 29, 29, 29, 30, 30, 30, 30, 30, 30, 30, 30, 30, 30, 30, 30, 30, 30, 31, 31, 31, 31, 31, 31, 31, 31, 31, 31, 31, 31, 31, 31, 31};

__device__ __forceinline__ float rstd_of(const float* rp, int row) {
    const f32x4* q = (const f32x4*)(rp + (size_t)row * 16); const f32x4 a = q[0], b = q[1], c = q[2], d = q[3];
    const float ss = ((a[0] + a[1]) + (a[2] + a[3])) + ((b[0] + b[1]) + (b[2] + b[3])) + (((c[0] + c[1]) + (c[2] + c[3])) + ((d[0] + d[1]) + (d[2] + d[3])));
    return rsqrtf(ss * (1.f / D) + EPS);
}
__device__ __forceinline__ void fill_rstd_table(const float* rp, int rm, LAS float* tab) {
    const int t = threadIdx.x; if (t < 256) tab[t] = rstd_of(rp, rm * 256 + t);
}
struct SchedRounds {
    int G, c, nfull, pn_base, tail, skip_at;
    __device__ __forceinline__ bool next(int i, Unit& u) const {
        const int L = i * G + c;
        if (L < nfull * 256) { const int r = L >> 8, w = L & 255, x = w & 7, j = w >> 3; u.pm = u.rm = 8 * x + (j & 7); u.pn = pn_base + 4 * r + (j >> 3) + (r >= skip_at ? 1 : 0); u.kind = 0; u.asel = 0; return true; }
        if (!tail) return false;
        const int t = L - nfull * 256;
        if (t < 64) { u.pm = u.rm = t; u.pn = 12; u.kind = 0; u.asel = 0; return true; }
        if (t < 128) { u.pm = u.rm = t - 64; u.pn = 25; u.kind = 0; u.asel = 0; return true; }
        if (t < 160) { const int q = t - 128; u.pm = u.rm = q >> 2; u.pn = 26 + (q & 3); u.kind = 1; u.asel = 1; return true; }
        return false;
    }
    __device__ __forceinline__ void a_ready(const Unit&) const {}
    __device__ __forceinline__ void done(const Unit&) const {}
};
struct SchedMerged {
    int G, c;
    __device__ __forceinline__ bool next(int i, Unit& u) const {
        const int tt = (i / 3) * G + c, seg = i % 3; if (tt >= 256) return false;
        const int x = tt & 7, j = tt >> 3; u.rm = 8 * x + (j & 7); u.pm = seg * 64 + u.rm; u.pn = seg * 4 + (j >> 3); u.kind = seg; u.asel = 0; return true;
    }
    __device__ __forceinline__ void a_ready(const Unit&) const {}
    __device__ __forceinline__ void done(const Unit&) const {}
};

__device__ __forceinline__ u32x4 pack8(f32x4 a, f32x4 b) { u32x4 w; w.x = pg8::cvt_pk_bf16(a[0], a[1]); w.y = pg8::cvt_pk_bf16(a[2], a[3]); w.z = pg8::cvt_pk_bf16(b[0], b[1]); w.w = pg8::cvt_pk_bf16(b[2], b[3]); return w; }
__device__ __forceinline__ f32x4 sig4(f32x4 v) { f32x4 r; r[0] = fsigmoid(v[0]); r[1] = fsigmoid(v[1]); r[2] = fsigmoid(v[2]); r[3] = fsigmoid(v[3]); return r; }
struct EpiProjMK {
    static constexpr bool PERM = true, AFTER_DRAIN = false;
    LB L; const LAS float* tab0; const LAS float* tab1; int rm0;
    __device__ __forceinline__ bool keep(const Unit&) const { return false; }
    __device__ __forceinline__ void operator()(f32x4 (&acc)[2][2][4][2], const Unit& u, int wr, int wc, int fr, int fq) const {
        const int rbase = u.rm * 256 + wr * 64 + fr, cin = wc * 32 + 8 * fq, rloc = wr * 64 + fr;
        const LAS float* rs = (u.kind == 0 && u.rm == rm0) ? tab0 : tab1; bf16_t* dst; int ld, coff; bool sig = false; const int tile = u.pn;
        if (u.kind == 1) { dst = L.memkv; ld = 1024; coff = (tile - 26) * 256; }
        else if (tile < 2) { dst = L.sq; ld = 512; coff = tile * 256; }
        else if (tile < 3) { dst = L.skv; ld = 256; coff = 0; }
        else if (tile < 7) { dst = L.mqk; ld = 1024; coff = (tile - 3) * 256; }
        else if (tile < 9) { dst = L.mv; ld = 512; coff = (tile - 7) * 256; }
        else if (tile < 11) { dst = L.mo; ld = 512; coff = (tile - 9) * 256; sig = true; }
        else if (tile < 13) { dst = L.xq; ld = 512; coff = (tile - 11) * 256; }
        else { dst = nullptr; ld = 0; coff = 0; }
#pragma unroll
        for (int ai = 0; ai < 2; ++ai)
#pragma unroll
            for (int m = 0; m < 4; ++m) {
                const int row = rbase + ai * 128 + m * 16; const float rstd = rs[rloc + ai * 128 + m * 16];
#pragma unroll
                for (int bj = 0; bj < 2; ++bj) {
                    if (dst == nullptr && tile < 25) {
                        const float nsc = rstd * -1.4426950408889634f; const f32x4 a0 = acc[ai][bj][m][0], a1 = acc[ai][bj][m][1]; uint2 w; w.x = 0u; w.y = 0u;
#pragma unroll
                        for (int j = 0; j < 4; ++j) {
                            w.x = __builtin_amdgcn_cvt_pk_u8_f32(floorf(__builtin_amdgcn_rcpf(1.f + __builtin_amdgcn_exp2f(a0[j] * nsc)) * 256.f), j, w.x);
                            w.y = __builtin_amdgcn_cvt_pk_u8_f32(floorf(__builtin_amdgcn_rcpf(1.f + __builtin_amdgcn_exp2f(a1[j] * nsc)) * 256.f), j, w.y); }
                        *(uint2*)(L.gates + (size_t)row * 3072 + (tile - 13) * 256 + bj * 128 + cin) = w; continue; }
                    f32x4 v0, v1;
                    if (sig) { const float nsc = rstd * -1.4426950408889634f; const f32x4 a0 = acc[ai][bj][m][0], a1 = acc[ai][bj][m][1];
#pragma unroll
                        for (int j = 0; j < 4; ++j) { v0[j] = __builtin_amdgcn_rcpf(1.f + __builtin_amdgcn_exp2f(a0[j] * nsc)); v1[j] = __builtin_amdgcn_rcpf(1.f + __builtin_amdgcn_exp2f(a1[j] * nsc)); } }
                    else { v0 = acc[ai][bj][m][0] * rstd; v1 = acc[ai][bj][m][1] * rstd; }
                    if (dst) *(u32x4*)((unsigned char*)dst + (unsigned)((row * ld + coff + bj * 128 + cin) * 2)) = pack8(v0, v1);
                    else if (bj == 0 && cin < 16) { *(f32x4*)(L.iff + (size_t)row * 16 + cin) = v0; *(f32x4*)(L.iff + (size_t)row * 16 + cin + 4) = v1; }
                }
            }
    }
};
struct EpiMergedMK {
    static constexpr bool PERM = true, AFTER_DRAIN = false;
    const unsigned char* gates; bf16_t* merged;
    __device__ __forceinline__ bool keep(const Unit& u) const { return u.kind < 2; }
    __device__ __forceinline__ static void deq8(uint2 w, float (&g)[8]) {
        g[0] = (float)(w.x & 255u) + 0.5f; g[1] = (float)((w.x >> 8) & 255u) + 0.5f; g[2] = (float)((w.x >> 16) & 255u) + 0.5f; g[3] = (float)(w.x >> 24) + 0.5f;
        g[4] = (float)(w.y & 255u) + 0.5f; g[5] = (float)((w.y >> 8) & 255u) + 0.5f; g[6] = (float)((w.y >> 16) & 255u) + 0.5f; g[7] = (float)(w.y >> 24) + 0.5f; }
    __device__ __forceinline__ void operator()(f32x4 (&acc)[2][2][4][2], const Unit& u, int wr, int wc, int fr, int fq) const {
        const int rbase = u.rm * 256 + wr * 64 + fr, col0 = (u.pn & 3) * 256 + wc * 32 + 8 * fq, seg = u.kind;
#pragma unroll
        for (int ai = 0; ai < 2; ++ai) {
            uint2 gs[4][2], gn[4][2];
#pragma unroll
            for (int m = 0; m < 4; ++m)
#pragma unroll
                for (int bj = 0; bj < 2; ++bj) { const unsigned char* gp = gates + (size_t)(rbase + ai * 128 + m * 16) * 3072 + seg * 1024 + col0 + bj * 128;
                    gs[m][bj] = *(const uint2*)gp; gn[m][bj] = seg < 2 ? *(const uint2*)(gp + 1024) : make_uint2(0u, 0u); }
#pragma unroll
            for (int m = 0; m < 4; ++m) {
                const int row = rbase + ai * 128 + m * 16;
#pragma unroll
                for (int bj = 0; bj < 2; ++bj) {
                    const int col = col0 + bj * 128;
                    float g[8]; deq8(gs[m][bj], g);
                    if (seg < 2) { float gd[8]; deq8(gn[m][bj], gd);
#pragma unroll
                        for (int j = 0; j < 8; ++j) g[j] = g[j] * __builtin_amdgcn_rcpf(gd[j]); }
                    else {
#pragma unroll
                        for (int j = 0; j < 8; ++j) g[j] *= (1.f / 256.f); }
                    f32x4 v0 = acc[ai][bj][m][0], v1 = acc[ai][bj][m][1];
                    v0[0] *= g[0]; v0[1] *= g[1]; v0[2] *= g[2]; v0[3] *= g[3]; v1[0] *= g[4]; v1[1] *= g[5]; v1[2] *= g[6]; v1[3] *= g[7];
                    acc[ai][bj][m][0] = v0; acc[ai][bj][m][1] = v1;
                    if (seg == 2) *(u32x4*)(merged + (size_t)row * D + col) = pack8(v0, v1);
                }
            }
            asm volatile("" ::: "memory");
        }
    }
};
struct EpiResidMK {
    static constexpr bool PERM = true, AFTER_DRAIN = false;
    const bf16_t* xold; bf16_t* xnew; float* rowss;
    __device__ __forceinline__ bool keep(const Unit&) const { return false; }
    __device__ __forceinline__ void operator()(f32x4 (&acc)[2][2][4][2], const Unit& u, int wr, int wc, int fr, int fq) const {
        const int rbase = u.rm * 256 + wr * 64 + fr, col0 = u.pn * 256 + wc * 32 + 8 * fq;
#pragma unroll
        for (int ai = 0; ai < 2; ++ai) {
            uint4 xo[4][2];
#pragma unroll
            for (int m = 0; m < 4; ++m)
#pragma unroll
                for (int bj = 0; bj < 2; ++bj) xo[m][bj] = *(const uint4*)(xold + (size_t)(rbase + ai * 128 + m * 16) * D + col0 + bj * 128);
#pragma unroll
            for (int m = 0; m < 4; ++m) {
                const int row = rbase + ai * 128 + m * 16; const size_t off = (size_t)row * D + col0; float ss = 0.f;
#pragma unroll
                for (int bj = 0; bj < 2; ++bj) {
                    float o[8]; unpack8(xo[m][bj], o);
                    f32x4 v0 = acc[ai][bj][m][0], v1 = acc[ai][bj][m][1];
                    v0[0] += o[0]; v0[1] += o[1]; v0[2] += o[2]; v0[3] += o[3]; v1[0] += o[4]; v1[1] += o[5]; v1[2] += o[6]; v1[3] += o[7];
                    const u32x4 w = pack8(v0, v1); *(u32x4*)(xnew + off + bj * 128) = w;
                    float r[8]; unpack8(__builtin_bit_cast(uint4, w), r);
#pragma unroll
                    for (int j = 0; j < 8; ++j) ss = fmaf(r[j], r[j], ss);
                }
                ss += __shfl_xor(ss, 16); ss += __shfl_xor(ss, 32);
                if (fq == 0) rowss[(size_t)row * 16 + (u.pn & 3) * 4 + wc] = ss;
            }
            asm volatile("" ::: "memory");
        }
    }
};
struct EpiFF1MK {
    static constexpr bool PERM = true, AFTER_DRAIN = false;
    bf16_t* h; const LAS float* tab0;
    __device__ __forceinline__ bool keep(const Unit&) const { return false; }
    __device__ __forceinline__ void operator()(f32x4 (&acc)[2][2][4][2], const Unit& u, int wr, int wc, int fr, int fq) const {
        const int rbase = u.rm * 256 + wr * 64 + fr, col0 = u.pn * 256 + wc * 32 + 8 * fq, rloc = wr * 64 + fr;
#pragma unroll
        for (int ai = 0; ai < 2; ++ai)
#pragma unroll
            for (int m = 0; m < 4; ++m) {
                const int row = rbase + ai * 128 + m * 16; const float rstd = tab0[rloc + ai * 128 + m * 16];
#pragma unroll
                for (int bj = 0; bj < 2; ++bj) {
                    f32x4 v0 = acc[ai][bj][m][0] * rstd, v1 = acc[ai][bj][m][1] * rstd;
#pragma unroll
                    for (int j = 0; j < 4; ++j) { v0[j] = fmaxf(v0[j], 0.f); v0[j] *= v0[j]; v1[j] = fmaxf(v1[j], 0.f); v1[j] *= v1[j]; }
                    *(u32x4*)((unsigned char*)h + (unsigned)((row * DFF + col0 + bj * 128) * 2)) = pack8(v0, v1);
                }
            }
    }
};

constexpr int CV_ITEMS_LAYER = 1152, CV_LD = 257;
struct CvItem { const float* src; const float* gain; bf16_t* dst; int ld, K, k0, ncols; float sc; };
__device__ __forceinline__ CvItem convert_decode(const P& p, int item) {
    CvItem c; const int l = item / CV_ITEMS_LAYER; int r = item % CV_ITEMS_LAYER;
    unsigned char* wt = p.ws + WS_WT + (size_t)l * WT_LAYER;
    const float* src; const float* gain = nullptr; int ld, col0, ncols, K; float sc = 1.f; bf16_t* dst;
    if (r < 416) {
        src = p.w_in + (size_t)l * D * INC; ld = INC; K = D; gain = p.g_mix + l * D; int dr;
        if (r < 32) { col0 = 0; ncols = 512; dr = 0; sc = 0.125f; }
        else if ((r -= 32) < 112) { col0 = 512; ncols = 1792; dr = 512; }
        else if ((r -= 112) < 32) { col0 = 2320; ncols = 512; dr = 2304; }
        else if ((r -= 32) < 32) { col0 = 2832; ncols = 512; dr = 2816; sc = 0.08838834764831845f; }
        else if ((r -= 32) < 192) { col0 = 3344; ncols = 3072; dr = 3328; }
        else { r -= 192; col0 = 2304; ncols = 16; dr = 6400; }
        dst = (bf16_t*)(wt + WT_WIN) + (size_t)dr * D;
    } else if ((r -= 416) < 64) { src = p.w_mem_kv + (size_t)l * D * 1024; ld = 1024; col0 = 0; ncols = 1024; K = D; gain = p.g_mem + l * D; dst = (bf16_t*)(wt + WT_WMEM); }
    else if ((r -= 64) < 96) { const int sg = r / 32; r -= sg * 32; src = (sg == 0 ? p.w_br0 : sg == 1 ? p.w_br1 : p.w_br2) + (size_t)l * 512 * 1024; ld = 1024; col0 = 0; ncols = 1024; K = 512; dst = (bf16_t*)(wt + WT_WBR) + (size_t)sg * 1024 * 512; }
    else if ((r -= 96) < 64) { src = p.w_out + (size_t)l * D * D; ld = 1024; col0 = 0; ncols = 1024; K = D; dst = (bf16_t*)(wt + WT_WOUT); }
    else if ((r -= 64) < 256) { src = p.w_ff1 + (size_t)l * D * DFF; ld = DFF; col0 = 0; ncols = DFF; K = D; gain = p.g_ffn + l * D; dst = (bf16_t*)(wt + WT_FF1); }
    else { r -= 256; src = p.w_ff2 + (size_t)l * DFF * D; ld = D; col0 = 0; ncols = D; K = DFF; dst = (bf16_t*)(wt + WT_FF2); }
    const int nnb = (ncols + 255) / 256, kb = r / nnb, nb = r % nnb, c0 = nb * 256;
    c.ncols = (ncols - c0) < 256 ? (ncols - c0) : 256; c.k0 = kb * 64; c.K = K; c.ld = ld; c.sc = sc; c.gain = gain;
    c.src = src + (size_t)c.k0 * ld + col0 + c0; c.dst = dst + (size_t)c0 * K + c.k0;
    return c;
}
__device__ __forceinline__ void convert_load(const CvItem& c, int tid, f32x4 (&v)[8]) {
    const int n4 = (tid & 63) * 4, kr = tid >> 6;
#pragma unroll
    for (int i = 0; i < 8; ++i) v[i] = n4 < c.ncols ? *(const f32x4*)(c.src + (size_t)(kr + 8 * i) * c.ld + n4) : (f32x4){0.f, 0.f, 0.f, 0.f};
}
__device__ __forceinline__ void convert_to_lds(const CvItem& c, int tid, const f32x4 (&v)[8], float* tile) {
    const int n4 = (tid & 63) * 4, kr = tid >> 6;
#pragma unroll
    for (int i = 0; i < 8; ++i) { const int kk = kr + 8 * i; const f32x4 w = v[i] * ((c.gain ? c.gain[c.k0 + kk] : 1.f) * c.sc);
        tile[kk * CV_LD + n4] = w[0]; tile[kk * CV_LD + n4 + 1] = w[1]; tile[kk * CV_LD + n4 + 2] = w[2]; tile[kk * CV_LD + n4 + 3] = w[3]; }
}
__device__ __forceinline__ void convert_store(const CvItem& c, int tid, const float* tile) {
    const int kc = tid & 7;
#pragma unroll
    for (int i = 0; i < 4; ++i) { const int n = (tid >> 3) + 64 * i; const float* tp = tile + (8 * kc) * CV_LD + n;
        u32x4 w; w.x = pk2(tp[0], tp[CV_LD]); w.y = pk2(tp[2 * CV_LD], tp[3 * CV_LD]); w.z = pk2(tp[4 * CV_LD], tp[5 * CV_LD]); w.w = pk2(tp[6 * CV_LD], tp[7 * CV_LD]);
        if (n < c.ncols) *(u32x4*)(c.dst + (size_t)n * c.K + 8 * kc) = w; }
}
__device__ __forceinline__ void convert_phase(const P& p, int bx, int G, float* tile) {
    int tid_l = threadIdx.x; asm volatile("" : "+v"(tid_l)); const int tid = tid_l;
    int it = bx; if (it >= 2 * CV_ITEMS_LAYER) return;
    CvItem c = convert_decode(p, it); f32x4 v[8]; convert_load(c, tid, v);
    for (;;) {
        convert_to_lds(c, tid, v, tile);
        const int nx = it + G; const bool more = nx < 2 * CV_ITEMS_LAYER; CvItem cn = c;
        if (more) { cn = convert_decode(p, nx); convert_load(cn, tid, v); }
        __syncthreads();
        convert_store(c, tid, tile);
        __syncthreads();
        if (!more) break;
        c = cn; it = nx;
    }
}
__device__ __forceinline__ void rowstat_rows(const float* src, int rows, bf16_t* xb, float* rowss, int gw, int ngw, int lane) {
    for (int r = gw; r < rows; r += 2 * ngw) {
        const int r1 = r + ngw; const bool two = r1 < rows;
        const float4* s0 = (const float4*)(src + (size_t)r * D); const float4* s1 = (const float4*)(src + (size_t)(two ? r1 : r) * D);
        float4 a[4], b[4];
#pragma unroll
        for (int j = 0; j < 4; ++j) { a[j] = s0[lane + 64 * j]; b[j] = s1[lane + 64 * j]; }
        float ssa = 0.f, ssb = 0.f;
#pragma unroll
        for (int j = 0; j < 4; ++j) { ssa += a[j].x * a[j].x + a[j].y * a[j].y + a[j].z * a[j].z + a[j].w * a[j].w; ssb += b[j].x * b[j].x + b[j].y * b[j].y + b[j].z * b[j].z + b[j].w * b[j].w;
            uint2 o; o.x = pk2(a[j].x, a[j].y); o.y = pk2(a[j].z, a[j].w); *(uint2*)(xb + (size_t)r * D + 4 * (lane + 64 * j)) = o;
            if (two) { uint2 o1; o1.x = pk2(b[j].x, b[j].y); o1.y = pk2(b[j].z, b[j].w); *(uint2*)(xb + (size_t)r1 * D + 4 * (lane + 64 * j)) = o1; } }
        ssa = wave_sum(ssa); ssb = wave_sum(ssb);
        if (lane < 16) { rowss[(size_t)r * 16 + lane] = lane == 0 ? ssa : 0.f; if (two) rowss[(size_t)r1 * 16 + lane] = lane == 0 ? ssb : 0.f; }
    }
}
__device__ __forceinline__ void finalnorm_rows(const bf16_t* xb, float* out, const float* rowss, const float* g, int gw, int ngw, int lane) {
    for (int r = gw; r < M; r += ngw) {
        const float rstd = rstd_of(rowss, r);
#pragma unroll
        for (int j = 0; j < 2; ++j) { float x[8]; unpack8(*(const uint4*)(xb + (size_t)r * D + 8 * (lane + 64 * j)), x);
            const float4 g0 = *(const float4*)(g + 8 * (lane + 64 * j)), g1 = *(const float4*)(g + 8 * (lane + 64 * j) + 4);
            float4 o0, o1; o0.x = x[0] * rstd * g0.x; o0.y = x[1] * rstd * g0.y; o0.z = x[2] * rstd * g0.z; o0.w = x[3] * rstd * g0.w;
            o1.x = x[4] * rstd * g1.x; o1.y = x[5] * rstd * g1.y; o1.z = x[6] * rstd * g1.z; o1.w = x[7] * rstd * g1.w;
            *(float4*)(out + (size_t)r * D + 8 * (lane + 64 * j)) = o0; *(float4*)(out + (size_t)r * D + 8 * (lane + 64 * j) + 4) = o1; }
    }
}

typedef short bf16x8 __attribute__((ext_vector_type(8)));
typedef short s16x4 __attribute__((ext_vector_type(4)));
typedef float f32x16 __attribute__((ext_vector_type(16)));
typedef float f32x2 __attribute__((ext_vector_type(2)));
typedef __bf16 bf16x2v __attribute__((ext_vector_type(2)));
#define MFMA32(a, b, c) __builtin_amdgcn_mfma_f32_32x32x16_bf16((a), (b), (c), 0, 0, 0)
__device__ __forceinline__ int crow(int reg, int h) { return (reg & 3) + 8 * (reg >> 2) + 4 * h; }
__device__ __forceinline__ unsigned pkbf(float a, float b) { return __builtin_bit_cast(unsigned, __builtin_convertvector((f32x2){a, b}, bf16x2v)); }
__device__ __forceinline__ bf16x8 pack_step(const f32x16& x, int s) {
    u32x4 p; p.x = pkbf(x[8 * s], x[8 * s + 1]); p.y = pkbf(x[8 * s + 2], x[8 * s + 3]); p.z = pkbf(x[8 * s + 4], x[8 * s + 5]); p.w = pkbf(x[8 * s + 6], x[8 * s + 7]);
    return __builtin_bit_cast(bf16x8, p);
}
__device__ __forceinline__ bf16x8 tr_frag(const LAS unsigned char* img, int row_lo, int row_hi, int lane) {
    const int i16 = lane & 15, q = i16 >> 2, p = i16 & 3, blk = (lane >> 4) & 1;
    const s16x4 lo = __builtin_amdgcn_ds_read_tr16_b64_v4i16((LAS s16x4*)(img + (row_lo + q) * 64 + 32 * blk + 8 * p));
    const s16x4 hi = __builtin_amdgcn_ds_read_tr16_b64_v4i16((LAS s16x4*)(img + (row_hi + q) * 64 + 32 * blk + 8 * p));
    return __builtin_shufflevector(lo, hi, 0, 1, 2, 3, 4, 5, 6, 7);
}

constexpr int SWA_KIMG = 0, SWA_VIMG = 256 * 144, SWA_TAB = SWA_VIMG + 2 * 16384;
__device__ __forceinline__ void swa_mfma_unit(const P& p, const LB& L, int l, int u, LAS unsigned char* l3) {
    int tid_l = threadIdx.x; asm volatile("" : "+v"(tid_l)); const int tid = tid_l, lane = tid & 63, wave = tid >> 6, h = lane >> 5, ql = lane & 31;
    const int hkv = u & 1, n = (u >> 1) & 15, b = u >> 5;
    __syncthreads();
#pragma unroll
    for (int i = 0; i < 4; ++i) {
        const int c = tid + 512 * i, row = c >> 3, cc = c & 7, t = 128 * (n - 1) + row;
        u32x4 kv = (u32x4){0u, 0u, 0u, 0u}, vv = (u32x4){0u, 0u, 0u, 0u};
        if (t >= 0) { const bf16_t* src = L.skv + (size_t)(b * T + t) * 256 + hkv * 64 + cc * 8; kv = *(const u32x4*)src; vv = *(const u32x4*)(src + 128); }
        *(LAS u32x4*)(l3 + SWA_KIMG + row * 144 + cc * 16) = kv;
        *(LAS u32x4*)(l3 + SWA_VIMG + (cc >> 2) * 16384 + row * 64 + (cc & 3) * 16) = vv;
    }
    for (int idx = tid; idx < 4 * 192; idx += 512) { const int g = idx / 192, e = idx % 192, dist = 159 - e;
        ((LAS float*)(l3 + SWA_TAB))[idx] = (dist >= 0 && dist < 128) ? p.rel_bias[(int)T5_BUCKET[dist] * 8 + hkv * 4 + g] : -1e30f; }
    __syncthreads();
    const int g = wave >> 1, half = wave & 1, hq = hkv * 4 + g;
    const float sink = p.sinks[l * 8 + hq];
    const LAS float* tab = (const LAS float*)(l3 + SWA_TAB) + g * 192 + 31 - ql;
#pragma unroll 1
    for (int sb = 0; sb < 2; ++sb) {
        const int r0 = 64 * half + 32 * sb, kb0 = 2 * half + sb;
        bf16_t* qptr = L.sq + (size_t)(b * T + 128 * n + r0 + ql) * 512 + hq * 64;
        bf16x8 Qf[4];
#pragma unroll
        for (int ks = 0; ks < 4; ++ks) Qf[ks] = *(const bf16x8*)(qptr + 16 * ks + 8 * h);
        f32x16 S[5];
#pragma unroll
        for (int i = 0; i < 5; ++i) {
#pragma unroll
            for (int r = 0; r < 16; ++r) S[i][r] = 0.f;
#pragma unroll
            for (int ks = 0; ks < 4; ++ks) { const bf16x8 Kf = *(const LAS bf16x8*)(l3 + SWA_KIMG + (32 * (kb0 + i) + ql) * 144 + 32 * ks + 16 * h); S[i] = MFMA32(Kf, Qf[ks], S[i]); }
        }
        float m = sink;
#pragma unroll
        for (int i = 0; i < 5; ++i)
#pragma unroll
            for (int r = 0; r < 16; ++r) { const int kk = 32 * i + crow(r, h); float sv = S[i][r] + tab[kk];
                if (n == 0 && 32 * kb0 + kk < 128) sv = -1e30f;
                S[i][r] = sv; m = fmaxf(m, sv); }
        m = fmaxf(m, __shfl_xor(m, 32));
        float lsum = 0.f;
#pragma unroll
        for (int i = 0; i < 5; ++i)
#pragma unroll
            for (int r = 0; r < 16; ++r) { const float pe = __expf(S[i][r] - m); S[i][r] = pe; lsum += pe; }
        lsum += __shfl_xor(lsum, 32);
        f32x16 O[2];
#pragma unroll
        for (int db = 0; db < 2; ++db)
#pragma unroll
            for (int r = 0; r < 16; ++r) O[db][r] = 0.f;
#pragma unroll
        for (int i = 0; i < 5; ++i)
#pragma unroll
            for (int s2 = 0; s2 < 2; ++s2) { const bf16x8 Pf = pack_step(S[i], s2); const int k0 = 32 * (kb0 + i) + 16 * s2;
#pragma unroll
                for (int db = 0; db < 2; ++db) { const bf16x8 Vf = tr_frag(l3 + SWA_VIMG + db * 16384, k0 + 4 * h, k0 + 8 + 4 * h, lane); O[db] = MFMA32(Vf, Pf, O[db]); } }
        const float inv = 1.f / (lsum + __expf(sink - m));
#pragma unroll
        for (int db = 0; db < 2; ++db)
#pragma unroll
            for (int gq = 0; gq < 4; ++gq) { uint2 w; w.x = pkbf(O[db][4 * gq] * inv, O[db][4 * gq + 1] * inv); w.y = pkbf(O[db][4 * gq + 2] * inv, O[db][4 * gq + 3] * inv);
                *(uint2*)(qptr + 32 * db + 8 * gq + 4 * h) = w; }
    }
}

constexpr int XA_KIMG = 0, XA_VIMG = 256 * 272;
__device__ __forceinline__ void xattn_mfma_unit(const LB& L, int u, LAS unsigned char* l3) {
    int tid_l = threadIdx.x; asm volatile("" : "+v"(tid_l)); const int tid = tid_l, lane = tid & 63, wave = tid >> 6, h = lane >> 5, ql = lane & 31;
    const int qb = u & 7, hx = (u >> 3) & 3, b = u >> 5;
    __syncthreads();
#pragma unroll
    for (int i = 0; i < 8; ++i) {
        const int c = tid + 512 * i, row = c >> 4, cc = c & 15;
        const bf16_t* src = L.memkv + (size_t)(b * MEMLEN + row) * 1024 + hx * 128 + cc * 8;
        const u32x4 kv = *(const u32x4*)src, vv = *(const u32x4*)(src + 512);
        *(LAS u32x4*)(l3 + XA_KIMG + row * 272 + cc * 16) = kv;
        *(LAS u32x4*)(l3 + XA_VIMG + (cc >> 2) * 16384 + row * 64 + (cc & 3) * 16) = vv;
    }
    bf16_t* qptr = L.xq + (size_t)(b * T + qb * 256 + wave * 32 + ql) * 512 + hx * 128;
    bf16x8 Qf[8];
#pragma unroll
    for (int ks = 0; ks < 8; ++ks) Qf[ks] = *(const bf16x8*)(qptr + 16 * ks + 8 * h);
    __syncthreads();
    f32x16 S[8];
    {
#pragma unroll
        for (int i = 0; i < 8; ++i) {
#pragma unroll
            for (int r = 0; r < 16; ++r) S[i][r] = 0.f;
#pragma unroll
            for (int ks = 0; ks < 8; ++ks) { const bf16x8 Kf = *(const LAS bf16x8*)(l3 + XA_KIMG + (32 * i + ql) * 272 + 32 * ks + 16 * h); S[i] = MFMA32(Kf, Qf[ks], S[i]); }
        }
    }
    float m = -1e30f;
#pragma unroll
    for (int i = 0; i < 8; ++i)
#pragma unroll
        for (int r = 0; r < 16; ++r) m = fmaxf(m, S[i][r]);
    m = fmaxf(m, __shfl_xor(m, 32));
    float lsum = 0.f;
#pragma unroll
    for (int i = 0; i < 8; ++i)
#pragma unroll
        for (int r = 0; r < 16; ++r) { const float pe = __expf(S[i][r] - m); S[i][r] = pe; lsum += pe; }
    lsum += __shfl_xor(lsum, 32);
    f32x16 O[4];
#pragma unroll
    for (int db = 0; db < 4; ++db)
#pragma unroll
        for (int r = 0; r < 16; ++r) O[db][r] = 0.f;
#pragma unroll
    for (int i = 0; i < 8; ++i)
#pragma unroll
        for (int s2 = 0; s2 < 2; ++s2) { const bf16x8 Pf = pack_step(S[i], s2); const int k0 = 32 * i + 16 * s2;
#pragma unroll
            for (int db = 0; db < 4; ++db) { const bf16x8 Vf = tr_frag(l3 + XA_VIMG + db * 16384, k0 + 4 * h, k0 + 8 + 4 * h, lane); O[db] = MFMA32(Vf, Pf, O[db]); } }
    const float inv = 1.f / lsum;
#pragma unroll
    for (int db = 0; db < 4; ++db)
#pragma unroll
        for (int gq = 0; gq < 4; ++gq) { uint2 w; w.x = pkbf(O[db][4 * gq] * inv, O[db][4 * gq + 1] * inv); w.y = pkbf(O[db][4 * gq + 2] * inv, O[db][4 * gq + 3] * inv);
            *(uint2*)(qptr + 32 * db + 8 * gq + 4 * h) = w; }
}


__device__ __forceinline__ float log_sigmoid_f(float x) { return x >= 0.f ? -__logf(1.f + __expf(-x)) : x - __logf(1.f + __expf(x)); }
__device__ __forceinline__ void mlstm_gates_load(const P& p, const LB& L, int l, int b, int c, int hh, int lane, float& iraw, float& fraw) {
    const size_t row = (size_t)b * T + c * 64 + lane;
    iraw = L.iff[row * 16 + hh] + p.b_i[l * 8 + hh]; fraw = L.iff[row * 16 + 8 + hh] + p.b_f[l * 8 + hh];
}
__device__ __forceinline__ void mlstm_gates_wave(float iraw, float fraw, int lane, float& bcum, float& ig) {
    ig = iraw;
    float v = log_sigmoid_f(fraw);
#pragma unroll
    for (int o = 1; o < 64; o <<= 1) { const float t = __shfl_up(v, o); if (lane >= o) v += t; }
    bcum = v;
}
constexpr int MA_SLOT = 18368, MA_XK = 0, MA_VIMG = 8704, MA_T0 = 16896;
__device__ __forceinline__ void mlstm_A_mfma_unit(const P& p, const LB& L, int l, int u, LAS unsigned char* l3) {
    int tid_l = threadIdx.x; asm volatile("" : "+v"(tid_l)); const int tid = tid_l, lane = tid & 63, hh = tid >> 6, h = lane >> 5, ql = lane & 31;
    const int c = u & 31, b = u >> 5, uh = u * 8 + hh;
    LAS unsigned char* wl = l3 + hh * MA_SLOT;
    const float* cw = p.conv_w + (size_t)l * 4 * 1024;
    float iraw, fraw; mlstm_gates_load(p, L, l, b, c, hh, lane, iraw, fraw);
    __syncthreads();
    {
        u32x4 xk[9], vv[8];
#pragma unroll
        for (int i = 0; i < 9; ++i) { const int idx = lane + 64 * i, ic = idx < 67 * 8 ? idx : 67 * 8 - 1, row = ic >> 3, cc = ic & 7, t = c * 64 - 3 + row;
            xk[i] = *(const u32x4*)(L.mqk + (size_t)(b * T + (t >= 0 ? t : 0)) * 1024 + 512 + hh * 64 + cc * 8); }
#pragma unroll
        for (int i = 0; i < 8; ++i) { const int s = (lane >> 3) + 8 * i, cc = lane & 7; vv[i] = *(const u32x4*)(L.mv + (size_t)(b * T + c * 64 + s) * 512 + hh * 64 + cc * 8); }
#pragma unroll
        for (int i = 0; i < 9; ++i) { const int idx = lane + 64 * i, row = idx >> 3, cc = idx & 7, t = c * 64 - 3 + row;
            if (idx < 67 * 8) *(LAS u32x4*)(wl + MA_XK + row * 128 + cc * 16) = t >= 0 ? xk[i] : (u32x4){0u, 0u, 0u, 0u}; }
#pragma unroll
        for (int i = 0; i < 8; ++i) { const int s = (lane >> 3) + 8 * i, cc = lane & 7; *(LAS u32x4*)(wl + MA_VIMG + (cc >> 2) * 4096 + s * 64 + (cc & 3) * 16) = vv[i]; }
    }
    float bcum, ig; mlstm_gates_wave(iraw, fraw, lane, bcum, ig);
    const float g = __shfl(bcum, 63), alog = g - bcum + ig, ml = wave_max(alog);
    ((LAS float*)(wl + MA_T0))[lane] = __expf(alog - ml);
    __syncthreads();
    f32x16 acc[2][2];
#pragma unroll
    for (int a = 0; a < 2; ++a)
#pragma unroll
        for (int d = 0; d < 2; ++d)
#pragma unroll
            for (int r = 0; r < 16; ++r) acc[a][d][r] = 0.f;
    float dnacc[2] = {0.f, 0.f};
    float cwr[2][4];
#pragma unroll
    for (int dkb = 0; dkb < 2; ++dkb)
#pragma unroll
        for (int tap = 0; tap < 4; ++tap) cwr[dkb][tap] = cw[tap * 1024 + 512 + hh * 64 + 32 * dkb + ql];
#pragma unroll
    for (int ks = 0; ks < 4; ++ks) {
        const int s0 = 16 * ks + 8 * h;
        const f32x4 we0 = *(const LAS f32x4*)(wl + MA_T0 + s0 * 4), we1 = *(const LAS f32x4*)(wl + MA_T0 + s0 * 4 + 16);
        const float we[8] = {we0[0], we0[1], we0[2], we0[3], we1[0], we1[1], we1[2], we1[3]};
        bf16x8 WKf[2];
#pragma unroll
        for (int dkb = 0; dkb < 2; ++dkb) {
            float x[11];
#pragma unroll
            for (int r = 0; r < 11; ++r) x[r] = bf2f(*(const LAS unsigned short*)(wl + MA_XK + (s0 + r) * 128 + (32 * dkb + ql) * 2));
            float wk[8];
#pragma unroll
            for (int j = 0; j < 8; ++j) { const float cv = fmaf(cwr[dkb][3], x[j + 3], fmaf(cwr[dkb][2], x[j + 2], fmaf(cwr[dkb][1], x[j + 1], cwr[dkb][0] * x[j])));
                wk[j] = cv * 0.125f * __builtin_amdgcn_rcpf(1.f + __expf(-cv)) * we[j]; dnacc[dkb] += wk[j]; }
            u32x4 w; w.x = pkbf(wk[0], wk[1]); w.y = pkbf(wk[2], wk[3]); w.z = pkbf(wk[4], wk[5]); w.w = pkbf(wk[6], wk[7]);
            WKf[dkb] = __builtin_bit_cast(bf16x8, w);
        }
#pragma unroll
        for (int dvb = 0; dvb < 2; ++dvb) { const bf16x8 Vf = tr_frag(wl + MA_VIMG + dvb * 4096, s0, s0 + 4, lane);
#pragma unroll
            for (int dkb = 0; dkb < 2; ++dkb) acc[dkb][dvb] = MFMA32(WKf[dkb], Vf, acc[dkb][dvb]); }
    }
    bf16_t* st = L.state + (size_t)uh * 4096;
#pragma unroll
    for (int dkb = 0; dkb < 2; ++dkb)
#pragma unroll
        for (int dvb = 0; dvb < 2; ++dvb)
#pragma unroll
            for (int gq = 0; gq < 4; ++gq) { uint2 w; w.x = pkbf(acc[dkb][dvb][4 * gq], acc[dkb][dvb][4 * gq + 1]); w.y = pkbf(acc[dkb][dvb][4 * gq + 2], acc[dkb][dvb][4 * gq + 3]);
                *(uint2*)(st + (32 * dvb + ql) * 64 + 32 * dkb + 8 * gq + 4 * h) = w; }
#pragma unroll
    for (int dkb = 0; dkb < 2; ++dkb) { const float t = dnacc[dkb] + __shfl_xor(dnacc[dkb], 32); if (h == 0) ws_f(p.ws, WS_DN)[(size_t)uh * 64 + 32 * dkb + ql] = t; }
    if (lane == 0) { ws_f(p.ws, WS_G)[uh] = g; ws_f(p.ws, WS_ML)[uh] = ml; }
}
__device__ __forceinline__ void mlstm_scan2_unit(const P& p, const LB& L, int u) {
    int tid_l = threadIdx.x; asm volatile("" : "+v"(tid_l)); const int tid = tid_l, bh = u >> 2, b = bh >> 3, hh = bh & 7, e = (u & 3) * 1024 + 2 * tid;
    const bool first = (u & 3) == 0; const bool do_n = first && tid < 64;
    float *G = ws_f(p.ws, WS_G), *ML = ws_f(p.ws, WS_ML), *MIN = ws_f(p.ws, WS_MIN), *DN = ws_f(p.ws, WS_DN);
    unsigned d[NCH]; float dn[NCH];
#pragma unroll
    for (int c = 0; c < NCH; ++c) { const int idx = (b * NCH + c) * 8 + hh; d[c] = *(const unsigned*)(L.state + (size_t)idx * 4096 + e); dn[c] = do_n ? DN[(size_t)idx * 64 + tid] : 0.f; }
    float m = 0.f, n = 0.f, C0 = 0.f, C1 = 0.f;
#pragma unroll
    for (int c = 0; c < NCH; ++c) { const int idx = (b * NCH + c) * 8 + hh; const float g = G[idx], ml = ML[idx], mn = fmaxf(g + m, ml), a = __expf(g + m - mn), sc = __expf(ml - mn);
        *(unsigned*)(L.state + (size_t)idx * 4096 + e) = pkbf(C0, C1);
        C0 = fmaf(C0, a, sc * __uint_as_float(d[c] << 16)); C1 = fmaf(C1, a, sc * __uint_as_float(d[c] & 0xffff0000u));
        if (do_n) { DN[(size_t)idx * 64 + tid] = n; n = a * n + sc * dn[c]; }
        if (first && tid == 0) MIN[idx] = m;
        m = mn; }
}
constexpr int MC_SLOT = 31232, MC_XQ = 0, MC_XK = 9728, MC_VIMG = 19456, MC_CW = 27648, MC_T0 = 29696, MC_T1 = 29952, MC_T2 = 30208, MC_T3 = 30464, MC_T4 = 30720  , MC_T5 = 30976  ;
__device__ __forceinline__ bf16x8 conv_frag_lds(const LAS unsigned char* img, int tok, int ch0, const LAS float* cwl, float scale) {
    float a[8] = {0.f, 0.f, 0.f, 0.f, 0.f, 0.f, 0.f, 0.f};
#pragma unroll
    for (int tap = 0; tap < 4; ++tap) {
        float xf[8]; unpack8(__builtin_bit_cast(uint4, *(const LAS u32x4*)(img + (tok + tap) * 144 + ch0 * 2)), xf);
        const f32x4 w0 = *(const LAS f32x4*)(cwl + tap * 128 + ch0), w1 = *(const LAS f32x4*)(cwl + tap * 128 + ch0 + 4);
        a[0] = fmaf(w0[0], xf[0], a[0]); a[1] = fmaf(w0[1], xf[1], a[1]); a[2] = fmaf(w0[2], xf[2], a[2]); a[3] = fmaf(w0[3], xf[3], a[3]);
        a[4] = fmaf(w1[0], xf[4], a[4]); a[5] = fmaf(w1[1], xf[5], a[5]); a[6] = fmaf(w1[2], xf[6], a[6]); a[7] = fmaf(w1[3], xf[7], a[7]);
    }
#pragma unroll
    for (int j = 0; j < 8; ++j) a[j] = a[j] * scale * __builtin_amdgcn_rcpf(1.f + __expf(-a[j]));
    u32x4 w; w.x = pkbf(a[0], a[1]); w.y = pkbf(a[2], a[3]); w.z = pkbf(a[4], a[5]); w.w = pkbf(a[6], a[7]);
    return __builtin_bit_cast(bf16x8, w);
}
template <int TB>
__device__ __forceinline__ void mlstm_C_block(const LB& L, int b, int c, int hh, int lane, int h, int ql, LAS unsigned char* wl, const bf16x8 (&Cf)[2][4], const uint2 (&mo)[2][4]) {
    const LAS float* cwl = (const LAS float*)(wl + MC_CW);
    bf16x8 Qf[4]; float qn = 0.f;
#pragma unroll
    for (int ks = 0; ks < 4; ++ks) { const int ch0 = 16 * ks + 8 * h;
        Qf[ks] = conv_frag_lds(wl + MC_XQ, 32 * TB + ql, ch0, cwl, 1.f);
        const f32x4 n0 = *(const LAS f32x4*)(wl + MC_T4 + ch0 * 4), n1 = *(const LAS f32x4*)(wl + MC_T4 + ch0 * 4 + 16);
        float qv[8]; unpack8(__builtin_bit_cast(uint4, Qf[ks]), qv);
#pragma unroll
        for (int j = 0; j < 4; ++j) { qn = fmaf(qv[j], n0[j], qn); qn = fmaf(qv[j + 4], n1[j], qn); } }
    f32x16 S0, S1;
#pragma unroll
    for (int r = 0; r < 16; ++r) { S0[r] = 0.f; S1[r] = 0.f; }
#pragma unroll
    for (int ks = 0; ks < 4; ++ks) { const int ch0 = 16 * ks + 8 * h;
        S0 = MFMA32(conv_frag_lds(wl + MC_XK, ql, ch0, cwl + 64, 0.125f), Qf[ks], S0);
        if (TB == 1) S1 = MFMA32(conv_frag_lds(wl + MC_XK, 32 + ql, ch0, cwl + 64, 0.125f), Qf[ks], S1); }
    const float Mt = ((const LAS float*)(wl + MC_T1))[32 * TB + ql];
    float dsum = 0.f;
#pragma unroll
    for (int gq = 0; gq < 4; ++gq) {
        const f32x4 a0 = *(const LAS f32x4*)(wl + MC_T0 + (8 * gq + 4 * h) * 4), a1 = *(const LAS f32x4*)(wl + MC_T0 + (32 + 8 * gq + 4 * h) * 4);
#pragma unroll
        for (int j = 0; j < 4; ++j) { const int r = 4 * gq + j, sl = 8 * gq + 4 * h + j;
            if (TB == 0) { const float v = sl <= ql ? S0[r] * __expf(a0[j] - Mt) : 0.f; S0[r] = v; dsum += v; }
            else { const float v0 = S0[r] * __expf(a0[j] - Mt); S0[r] = v0; const float v1 = sl <= ql ? S1[r] * __expf(a1[j] - Mt) : 0.f; S1[r] = v1; dsum += v0 + v1; } }
    }
    f32x16 acc[2];
#pragma unroll
    for (int d = 0; d < 2; ++d)
#pragma unroll
        for (int r = 0; r < 16; ++r) acc[d][r] = 0.f;
#pragma unroll
    for (int ks = 0; ks < 4; ++ks)
#pragma unroll
        for (int dvb = 0; dvb < 2; ++dvb) acc[dvb] = MFMA32(Cf[dvb][ks], Qf[ks], acc[dvb]);
    const float iw = ((const LAS float*)(wl + MC_T2))[32 * TB + ql];
#pragma unroll
    for (int dvb = 0; dvb < 2; ++dvb)
#pragma unroll
        for (int r = 0; r < 16; ++r) acc[dvb][r] *= iw;
#pragma unroll
    for (int s2 = 0; s2 < 2; ++s2) {
        const bf16x8 P0 = pack_step(S0, s2), P1 = pack_step(S1, s2);
#pragma unroll
        for (int dvb = 0; dvb < 2; ++dvb) {
            acc[dvb] = MFMA32(tr_frag(wl + MC_VIMG + dvb * 4096, 16 * s2 + 4 * h, 16 * s2 + 8 + 4 * h, lane), P0, acc[dvb]);
            if (TB == 1) acc[dvb] = MFMA32(tr_frag(wl + MC_VIMG + dvb * 4096, 32 + 16 * s2 + 4 * h, 32 + 16 * s2 + 8 + 4 * h, lane), P1, acc[dvb]); }
    }
    dsum += __shfl_xor(dsum, 32); qn += __shfl_xor(qn, 32);
    const float den = dsum + iw * qn, mt = ((const LAS float*)(wl + MC_T3))[32 * TB + ql];
    const float sc = 1.f / fmaxf(fabsf(den), __expf(-mt));
    float sum = 0.f;
#pragma unroll
    for (int dvb = 0; dvb < 2; ++dvb)
#pragma unroll
        for (int r = 0; r < 16; ++r) { const float v = acc[dvb][r] * sc; acc[dvb][r] = v; sum += v; }
    sum += __shfl_xor(sum, 32); const float mu = sum * (1.f / 64.f);
    float var = 0.f;
#pragma unroll
    for (int dvb = 0; dvb < 2; ++dvb)
#pragma unroll
        for (int r = 0; r < 16; ++r) { const float dlt = acc[dvb][r] - mu; var += dlt * dlt; }
    var += __shfl_xor(var, 32); const float rstd = rsqrtf(var * (1.f / 64.f) + EPS);
    bf16_t* op = L.mo + (size_t)(b * T + c * 64 + 32 * TB + ql) * 512 + hh * 64;
#pragma unroll
    for (int dvb = 0; dvb < 2; ++dvb)
#pragma unroll
        for (int gq = 0; gq < 4; ++gq) { const int dv = 32 * dvb + 8 * gq + 4 * h; const f32x4 ng = *(const LAS f32x4*)(wl + MC_T5 + dv * 4);
            const uint2 mg = mo[dvb][gq];
            const float y0 = (acc[dvb][4 * gq] - mu) * rstd * ng[0] * __uint_as_float(mg.x << 16), y1 = (acc[dvb][4 * gq + 1] - mu) * rstd * ng[1] * __uint_as_float(mg.x & 0xffff0000u);
            const float y2 = (acc[dvb][4 * gq + 2] - mu) * rstd * ng[2] * __uint_as_float(mg.y << 16), y3 = (acc[dvb][4 * gq + 3] - mu) * rstd * ng[3] * __uint_as_float(mg.y & 0xffff0000u);
            uint2 w; w.x = pkbf(y0, y1); w.y = pkbf(y2, y3); *(uint2*)(op + dv) = w; }
}
__device__ __forceinline__ void mlstm_C_mfma_unit(const P& p, const LB& L, int l, int u, LAS unsigned char* l3) {
    int tid_l = threadIdx.x; asm volatile("" : "+v"(tid_l)); const int tid = tid_l, lane = tid & 63, wave = tid >> 6, h = lane >> 5, ql = lane & 31;
    const int hg = u & 1, c = (u >> 1) & 31, b = u >> 6, hh = 4 * hg + (wave >> 1), tb = wave & 1, uh = (b * 32 + c) * 8 + hh, l128 = tid & 127;
    LAS unsigned char* wl = l3 + (wave >> 1) * MC_SLOT;
    const float* cw = p.conv_w + (size_t)l * 4 * 1024;
    bf16x8 Cf[2][4]; uint2 mo[2][4];
    float iraw, fraw; mlstm_gates_load(p, L, l, b, c, hh, lane, iraw, fraw);
    {
        const bf16_t* st = L.state + (size_t)uh * 4096; const bf16_t* op = L.mo + (size_t)(b * T + c * 64 + 32 * tb + ql) * 512 + hh * 64;
#pragma unroll
        for (int dvb = 0; dvb < 2; ++dvb) {
#pragma unroll
            for (int ks = 0; ks < 4; ++ks) Cf[dvb][ks] = *(const bf16x8*)(st + (32 * dvb + ql) * 64 + 16 * ks + 8 * h);
#pragma unroll
            for (int gq = 0; gq < 4; ++gq) mo[dvb][gq] = *(const uint2*)(op + 32 * dvb + 8 * gq + 4 * h);
        }
    }
    __syncthreads();
    {
        u32x4 xq[5], xk[5], vv[4]; float cwv[4];
#pragma unroll
        for (int i = 0; i < 5; ++i) { const int idx = l128 + 128 * i, ic = idx < 67 * 8 ? idx : 67 * 8 - 1, row = ic >> 3, cc = ic & 7, t = c * 64 - 3 + row;
            const bf16_t* src = L.mqk + (size_t)(b * T + (t >= 0 ? t : 0)) * 1024 + hh * 64 + cc * 8; xq[i] = *(const u32x4*)src; xk[i] = *(const u32x4*)(src + 512); }
#pragma unroll
        for (int i = 0; i < 4; ++i) { const int s = (l128 >> 3) + 16 * i, cc = l128 & 7; vv[i] = *(const u32x4*)(L.mv + (size_t)(b * T + c * 64 + s) * 512 + hh * 64 + cc * 8); }
#pragma unroll
        for (int i = 0; i < 4; ++i) { const int e = l128 + 128 * i, tap = e >> 7, wch = e & 127; cwv[i] = cw[tap * 1024 + (wch >> 6) * 512 + hh * 64 + (wch & 63)]; }
#pragma unroll
        for (int i = 0; i < 5; ++i) { const int idx = l128 + 128 * i, row = idx >> 3, cc = idx & 7, t = c * 64 - 3 + row; const u32x4 z = (u32x4){0u, 0u, 0u, 0u};
            if (idx < 67 * 8) { *(LAS u32x4*)(wl + MC_XQ + row * 144 + cc * 16) = t >= 0 ? xq[i] : z; *(LAS u32x4*)(wl + MC_XK + row * 144 + cc * 16) = t >= 0 ? xk[i] : z; } }
#pragma unroll
        for (int i = 0; i < 4; ++i) { const int s = (l128 >> 3) + 16 * i, cc = l128 & 7; *(LAS u32x4*)(wl + MC_VIMG + (cc >> 2) * 4096 + s * 64 + (cc & 3) * 16) = vv[i]; }
#pragma unroll
        for (int i = 0; i < 4; ++i) ((LAS float*)(wl + MC_CW))[l128 + 128 * i] = cwv[i];
    }
    {
        float bcum, ig; mlstm_gates_wave(iraw, fraw, lane, bcum, ig);
        const float a = ig - bcum; float v = a;
#pragma unroll
        for (int o = 1; o < 64; o <<= 1) { const float t = __shfl_up(v, o); if (lane >= o) v = fmaxf(v, t); }
        const float m_in = ws_f(p.ws, WS_MIN)[uh], Mt = fmaxf(v, m_in);
        if (tb == 1) { ((LAS float*)(wl + MC_T4))[lane] = ws_f(p.ws, WS_DN)[(size_t)uh * 64 + lane]; ((LAS float*)(wl + MC_T5))[lane] = p.norm_g[l * 512 + hh * 64 + lane]; }
        if (tb == 0) { ((LAS float*)(wl + MC_T0))[lane] = a; ((LAS float*)(wl + MC_T1))[lane] = Mt; ((LAS float*)(wl + MC_T2))[lane] = __expf(m_in - Mt); ((LAS float*)(wl + MC_T3))[lane] = bcum + Mt; }
    }
    __syncthreads();
    if (tb == 0) mlstm_C_block<0>(L, b, c, hh, lane, h, ql, wl, Cf, mo);
    else mlstm_C_block<1>(L, b, c, hh, lane, h, ql, wl, Cf, mo);
}

#define XB_TMO      128
#define XB_XCNT(j)  (256  + 64 * (j))
#define XB_XSUB(j)  (1280 + 64 * (j))
#define XB_XGEN(j)  (2304 + 64 * (j))
#define XB_TOP      3328
#define XB_TOPGEN   3392
#define XCD_BAR_WORDS 3456
#define XB_SPIN_CAP (1u << 18)

__device__ __forceinline__ unsigned xb_ld(unsigned* p)              { return __hip_atomic_load(p, __ATOMIC_RELAXED, __HIP_MEMORY_SCOPE_AGENT); }
__device__ __forceinline__ unsigned xb_add(unsigned* p, unsigned v) { return __hip_atomic_fetch_add(p, v, __ATOMIC_RELAXED, __HIP_MEMORY_SCOPE_AGENT); }
__device__ __forceinline__ unsigned xb_xcc_id() { return (unsigned)__builtin_amdgcn_s_getreg((3 << 11) | 20) & 0xFu; }
#define XB_SPIN(cond, bar) do { unsigned _sp = 0; while (cond) { __builtin_amdgcn_s_sleep(1); \
    if ((++_sp & 255u) == 0u) { if (xb_ld(&(bar)[XB_TMO])) break; if (_sp > XB_SPIN_CAP) { atomicAdd(&(bar)[XB_TMO], 1u); break; } } } } while (0)

struct XcdBarrier {
    unsigned* bar; unsigned x;
    volatile LAS unsigned* st;
};

__device__ __forceinline__ XcdBarrier xcd_barrier_post(unsigned* bar, volatile LAS unsigned* st) {
    XcdBarrier b; b.bar = bar; b.x = xb_xcc_id(); b.st = st;
    if (threadIdx.x == 0) (void)xb_add(&bar[XB_XCNT(b.x)], 1u);
    return b;
}
__device__ __forceinline__ void xcd_barrier_complete(unsigned* bar, unsigned x, unsigned& nloc, unsigned& nx) {
    const unsigned G = gridDim.x * gridDim.y * gridDim.z;
    unsigned sum, cnt, mine, sp = 0u;
    for (;;) {
        sum = 0u; cnt = 0u; mine = 0u;
#pragma unroll
        for (unsigned j = 0; j < 16; ++j) { const unsigned c = xb_ld(&bar[XB_XCNT(j)]); sum += c; cnt += (c > 0u) ? 1u : 0u; mine = (j == x) ? c : mine; }
        if (sum == G) break;
        __builtin_amdgcn_s_sleep(1);
        if ((++sp & 255u) == 0u) { if (xb_ld(&bar[XB_TMO])) break; if (sp > XB_SPIN_CAP) { atomicAdd(&bar[XB_TMO], 1u); break; } }
    }
    nloc = mine > 0u ? mine : 1u; nx = cnt > 0u ? cnt : 1u;
}

__device__ __forceinline__ void xcd_barrier(const XcdBarrier& b) {
    asm volatile("s_waitcnt vmcnt(0)" ::: "memory");
    __syncthreads();
    if (threadIdx.x == 0) {
        unsigned* bar = b.bar;
        __builtin_amdgcn_s_waitcnt(0);
        unsigned nloc = b.st[0], nx = b.st[1];
        if (nloc == 0u) { xcd_barrier_complete(bar, b.x, nloc, nx); b.st[0] = nloc; b.st[1] = nx; }
        const unsigned old = xb_add(&bar[XB_XSUB(b.x)], 1u);
        const unsigned gen = old / nloc;
        if (old + 1u == (gen + 1u) * nloc) {
            __builtin_amdgcn_fence(__ATOMIC_RELEASE, "agent");
            asm volatile("s_waitcnt vmcnt(0)" ::: "memory");
            const unsigned og = xb_add(&bar[XB_TOP], 1u);
            const unsigned tg = og / nx;
            if (og + 1u == (tg + 1u) * nx) xb_add(&bar[XB_TOPGEN], 1u);
            else XB_SPIN(xb_ld(&bar[XB_TOPGEN]) == tg, bar);
            __builtin_amdgcn_fence(__ATOMIC_ACQUIRE, "agent");
            xb_add(&bar[XB_XGEN(b.x)], 1u);
            asm volatile("s_waitcnt vmcnt(0)" ::: "memory");
        } else {
            XB_SPIN(xb_ld(&bar[XB_XGEN(b.x)]) == gen, bar);
            __builtin_amdgcn_fence(__ATOMIC_ACQUIRE, "agent");
            asm volatile("s_waitcnt vmcnt(0)" ::: "memory");
        }
    }
    __syncthreads();
}

__global__ void __launch_bounds__(512, 2) mk_fwd(P p) {
    extern __shared__ __attribute__((aligned(16))) unsigned char lds[];
    LAS unsigned char* l3 = (LAS unsigned char*)lds;
    float* fl = (float*)lds;
    const int G = gridDim.x, bx = blockIdx.x;
    if (threadIdx.x < 64) ((LAS unsigned*)(l3 + LDS_CTL))[threadIdx.x] = 0u;
    __syncthreads();
    (void)xcd_barrier_post((unsigned*)(p.ws + WS_BAR), (volatile LAS unsigned*)(l3 + LDS_CTL + 32));
#define PR_T0 (*(volatile LAS unsigned long long*)(l3 + LDS_CTL + 64))
#define PR_ACC (*(volatile LAS unsigned long long*)(l3 + LDS_CTL + 72))
#define PH_BEGIN(id) do { if ((PROBE_MASK >> (id)) & 1) { if (bx == 0 && threadIdx.x == 0) PR_T0 = __builtin_amdgcn_s_memrealtime(); } } while (0)
#define PH_END(id) do { if ((PROBE_MASK >> (id)) & 1) { if (bx == 0 && threadIdx.x == 0) PR_ACC = PR_ACC + (__builtin_amdgcn_s_memrealtime() - PR_T0); } } while (0)
#define GRID_BAR() do { XcdBarrier b_; b_.bar = (unsigned*)(p.ws + WS_BAR); b_.x = xb_xcc_id(); b_.st = (volatile LAS unsigned*)(l3 + LDS_CTL + 32); xcd_barrier(b_); } while (0)
#define WAVE_IDS() int tid_w = threadIdx.x; asm volatile("" : "+v"(tid_w)); const int lane = tid_w & 63, gw = bx * 8 + (tid_w >> 6), ngw = G * 8

        PH_BEGIN(0);
    {
        WAVE_IDS();
        convert_phase(p, bx, G, fl);
        rowstat_rows(p.x, M, layer_buf(p.ws, p.out, 0).xbin, ws_f(p.ws, WS_ROWSS), gw, ngw, lane);
        rowstat_rows(p.mem, MM, (bf16_t*)(p.ws + WS_MEMB), ws_f(p.ws, WS_ROWSS_MEM), gw, ngw, lane);
    }
    GRID_BAR();
        PH_END(0);

#pragma unroll 1
    for (int l = 0; l < 2; ++l) {
        PH_BEGIN(1);
        {
            const LB L = layer_buf(p.ws, p.out, l);
            pg8::Gemm g{L.xbin, L.win, M, 6656, D, (const bf16_t*)(p.ws + WS_MEMB)};
            SchedRounds S{G, bx, 6, 0, 1, 3};
            Unit u0, u3; S.next(0, u0); const bool has_tail = S.next(6, u3);
            fill_rstd_table(ws_f(p.ws, WS_ROWSS) + (size_t)(2 * l) * M * 16, u0.rm, (LAS float*)(l3 + LDS_RSTD0));
            if (has_tail) fill_rstd_table(u3.kind == 1 ? ws_f(p.ws, WS_ROWSS_MEM) : ws_f(p.ws, WS_ROWSS) + (size_t)(2 * l) * M * 16, u3.rm, (LAS float*)(l3 + LDS_RSTD1));
            __syncthreads();
            EpiProjMK E{L, (const LAS float*)(l3 + LDS_RSTD0), (const LAS float*)(l3 + LDS_RSTD1), u0.rm};
            pg8::gemm_phase<EpiProjMK, SchedRounds, true, true>(l3, g, S, E);
        }
        GRID_BAR();
        PH_END(1);
        PH_BEGIN(2);
        {
            const LB L = layer_buf(p.ws, p.out, l);
            PH_BEGIN(10); for (int u = bx; u < NB * 16 * 2; u += G) swa_mfma_unit(p, L, l, u, l3); PH_END(10);
            PH_BEGIN(11); for (int u = bx; u < NB * 4 * 8; u += G) xattn_mfma_unit(L, u, l3); PH_END(11);
            PH_BEGIN(12); for (int u = bx; u < NB * NCH; u += G) mlstm_A_mfma_unit(p, L, l, u, l3); PH_END(12);
        }
        GRID_BAR();
        PH_END(2);
        PH_BEGIN(3);
        {
            const LB L = layer_buf(p.ws, p.out, l);
            for (int u = bx; u < 256; u += G) mlstm_scan2_unit(p, L, u);
        }
        GRID_BAR();
        PH_END(3);
        PH_BEGIN(4);
        {
            const LB L = layer_buf(p.ws, p.out, l);
            for (int u = bx; u < NB * NCH * 2; u += G) mlstm_C_mfma_unit(p, L, l, u, l3);
        }
        GRID_BAR();
        PH_END(4);
        PH_BEGIN(6);
        {
            const LB L = layer_buf(p.ws, p.out, l);
            pg8::Gemm g{L.sq, L.wbr, 3 * M, 3 * D, 512, nullptr};
            SchedMerged S{G, bx};
            EpiMergedMK E{L.gates, L.merged};
            pg8::gemm_phase<EpiMergedMK, SchedMerged, true, true>(l3, g, S, E);
        }
        GRID_BAR();
        PH_END(6);
        PH_BEGIN(7);
        {
            const LB L = layer_buf(p.ws, p.out, l);
            pg8::Gemm g{L.merged, L.wout, M, D, D, nullptr};
            SchedRounds S{G, bx, 1, 0, 0, 99};
            EpiResidMK E{L.xbin, L.xbmid, ws_f(p.ws, WS_ROWSS) + (size_t)(2 * l + 1) * M * 16};
            pg8::gemm_phase<EpiResidMK, SchedRounds, true, true>(l3, g, S, E);
        }
        GRID_BAR();
        PH_END(7);
        PH_BEGIN(8);
        {
            const LB L = layer_buf(p.ws, p.out, l);
            pg8::Gemm g{L.xbmid, L.wff1, M, DFF, D, nullptr};
            SchedRounds S{G, bx, 4, 0, 0, 99};
            Unit u0; S.next(0, u0);
            fill_rstd_table(ws_f(p.ws, WS_ROWSS) + (size_t)(2 * l + 1) * M * 16, u0.rm, (LAS float*)(l3 + LDS_RSTD0));
            __syncthreads();
            EpiFF1MK E{L.hff, (const LAS float*)(l3 + LDS_RSTD0)};
            pg8::gemm_phase<EpiFF1MK, SchedRounds, true, true>(l3, g, S, E);
        }
        GRID_BAR();
        PH_END(8);
        PH_BEGIN(9);
        {
            const LB L = layer_buf(p.ws, p.out, l);
            pg8::Gemm g{L.hff, L.wff2, M, D, DFF, nullptr};
            SchedRounds S{G, bx, 1, 0, 0, 99};
            EpiResidMK E{L.xbmid, L.xbnext, ws_f(p.ws, WS_ROWSS) + (size_t)(2 * l + 2) * M * 16};
            pg8::gemm_phase<EpiResidMK, SchedRounds, true, true>(l3, g, S, E);
        }
        GRID_BAR();
        PH_END(9);
    }
    {
        WAVE_IDS();
        finalnorm_rows(layer_buf(p.ws, p.out, 1).xbnext, p.out, ws_f(p.ws, WS_ROWSS) + (size_t)4 * M * 16, p.g_final, gw, ngw, lane);
    }
    if (PROBE_MASK != 0 && bx == 0 && threadIdx.x == 0) { const unsigned long long te = __builtin_amdgcn_s_memrealtime(); const unsigned long long acc_ = PR_ACC; while (__builtin_amdgcn_s_memrealtime() - te < 10ull * acc_) __builtin_amdgcn_s_sleep(8); }
}
}

extern "C" void kernel_launch(void* const* d_in, const int* in_sizes, int n_in, void* d_out, int out_size, void* d_ws, size_t ws_size, hipStream_t stream) {
    static int grid = 0;
    if (grid == 0) {
        if (n_in != 20 || out_size != M * D || ws_size < WS_END) { fprintf(stderr, "kernel_launch: unexpected shapes (n_in %d out %d ws %zu)\n", n_in, out_size, ws_size); grid = -1; return; }
        int dev = 0, cus = 0, per_cu = 0;
        if (hipGetDevice(&dev) != hipSuccess || hipDeviceGetAttribute(&cus, hipDeviceAttributeMultiprocessorCount, dev) != hipSuccess) { fprintf(stderr, "kernel_launch: device query failed\n"); grid = -1; return; }
        if (hipFuncSetAttribute((const void*)mk_fwd, hipFuncAttributeMaxDynamicSharedMemorySize, LDS_BYTES) != hipSuccess) { fprintf(stderr, "kernel_launch: hipFuncSetAttribute failed\n"); grid = -1; return; }
        if (hipOccupancyMaxActiveBlocksPerMultiprocessor(&per_cu, (const void*)mk_fwd, 512, LDS_BYTES) != hipSuccess || per_cu < 1) { fprintf(stderr, "kernel_launch: occupancy query says %d blocks per CU\n", per_cu); grid = -1; return; }
        if (cus != 256) { fprintf(stderr, "kernel_launch: built for a 256-CU device (unit orders assume 256 workgroups); found %d CUs\n", cus); grid = -1; return; }
        grid = cus * (per_cu >= 1 ? 1 : 0);
    }
    if (grid < 0) return;
    P p{};
    const float** pf = (const float**)&p;
    for (int i = 0; i < 20; ++i) pf[i] = (const float*)d_in[i];
    p.out = (float*)d_out; p.ws = (unsigned char*)d_ws;
    if (hipMemsetAsync(d_ws, 0, WS_ZERO_BYTES, stream) != hipSuccess) { fprintf(stderr, "kernel_launch: memset failed\n"); return; }
    void* args[] = {&p};
    const hipError_t e = hipLaunchCooperativeKernel((const void*)mk_fwd, dim3(grid), dim3(512), args, LDS_BYTES, stream);
    if (e != hipSuccess) fprintf(stderr, "kernel_launch: cooperative launch failed: %s (grid %d)\n", hipGetErrorString(e), grid);
}
```

```cpp
#include <hip/hip_runtime.h>
#include <cstdio>
#include <cstdint>
#ifndef PROBE_MASK
#define PROBE_MASK 0
#endif

namespace pg8 {
#define PG8_LAS __attribute__((address_space(3)))
typedef unsigned short bf16_t;
typedef short bf16x8 __attribute__((ext_vector_type(8)));
typedef float f32x4 __attribute__((ext_vector_type(4)));
typedef unsigned u32x4 __attribute__((ext_vector_type(4)));
constexpr int BM = 256, BK = 64, HALF = 128, HTB = HALF * BK * 2  , STAGE_BYTES = 8 * HTB, NXCD = 8, WGM = 8;

__host__ __device__ __forceinline__ int lds_byte(int r, int c) { const int st = (r >> 4) * 2 + (c >> 5), rr = r & 15, cc = c & 31, ob = rr * 64 + cc * 2; return st * 1024 + (ob ^ (((ob >> 9) & 1) << 5)); }
__host__ __device__ __forceinline__ void stage_rc(int b, int& R, int& C) { const int st = b / 1024, sb = b % 1024, swz = sb ^ (((sb >> 9) & 1) << 5); R = (st >> 1) * 16 + swz / 64; C = (st & 1) * 32 + (swz % 64) / 2; }
__host__ __device__ __forceinline__ int perm32(int rho) { const int n = rho >> 4, i = rho & 15; return 8 * (i >> 2) + 4 * n + (i & 3); }
struct Unit { int pm, pn, rm, kind, asel; };
struct Gemm { const bf16_t* A; const bf16_t* Bt; int M, N, K; const bf16_t* A2; };
__device__ __forceinline__ unsigned cvt_pk_bf16(float lo, float hi) { unsigned r; asm volatile("v_cvt_pk_bf16_f32 %0, %1, %2" : "=v"(r) : "v"(lo), "v"(hi)); return r; }
template <class Epi, class Sched, bool ALIGN_EPI = false, bool SP2 = false>
__device__ __forceinline__ void gemm_phase(PG8_LAS unsigned char* lds, const Gemm g, const Sched& S, const Epi& E) {
    int tid_l = threadIdx.x; asm volatile("" : "+v"(tid_l));
    const int tid = tid_l, wid = __builtin_amdgcn_readfirstlane(tid >> 6), lane = tid & 63, wr = wid >> 2, wc = wid & 3, fr = lane & 15, fq = lane >> 4;
    const int K = g.K, nt = K / BK;
    unsigned voffA[2], voffB[2];
#pragma unroll
    for (int i = 0; i < 2; ++i) { int R, C; stage_rc(tid * 16 + i * 8192, R, C); const int Rb = Epi::PERM ? ((R & ~31) + perm32(R & 31)) : R;
        voffA[i] = (unsigned)(R * K + C) * 2u; voffB[i] = (unsigned)(Rb * K + C) * 2u; }
    const size_t kstep = (size_t)(BK * 2);
    const size_t hstep = (size_t)HALF * K * 2;
    const size_t tstep = 2 * hstep;
    const unsigned ldsw = (unsigned)wid * 1024u;
    const int aoff = lds_byte(wr * 64 + fr, fq * 8), boff = lds_byte(wc * 32 + fr, fq * 8);
#define PG8_SA(b, h) (((b) * 2 + (h)) * HTB)
#define PG8_SB(b, h) ((4 + (b) * 2 + (h)) * HTB)
#define PG8_STAGE(bufoff, gbase, voff) do { _Pragma("unroll") for (int _i = 0; _i < 2; ++_i) \
        __builtin_amdgcn_global_load_lds((const unsigned*)((const char*)(gbase) + (voff)[_i]), (PG8_LAS unsigned*)(lds + (bufoff) + ldsw + _i * 8192), 16, 0, 0); } while (0)
#define PG8_LDA(dst, b, h) do { _Pragma("unroll") for (int m = 0; m < 4; ++m) _Pragma("unroll") for (int k = 0; k < 2; ++k) dst[m][k] = *(const PG8_LAS bf16x8*)(lds + PG8_SA(b, h) + aoff + m * 2048 + k * 1024); } while (0)
#define PG8_LDB(dst, b, h) do { _Pragma("unroll") for (int n = 0; n < 2; ++n) _Pragma("unroll") for (int k = 0; k < 2; ++k) dst[n][k] = *(const PG8_LAS bf16x8*)(lds + PG8_SB(b, h) + boff + n * 2048 + k * 1024); } while (0)
#define PG8_MMA(ai, bj, At, Bt) do { __builtin_amdgcn_s_setprio(1); _Pragma("unroll") for (int m = 0; m < 4; ++m) _Pragma("unroll") for (int n = 0; n < 2; ++n) _Pragma("unroll") for (int k = 0; k < 2; ++k) \
        acc[ai][bj][m][n] = __builtin_amdgcn_mfma_f32_16x16x32_bf16(Bt[n][k], At[m][k], acc[ai][bj][m][n], 0, 0, 0); __builtin_amdgcn_s_setprio(0); } while (0)
#define PG8_WAIT_V(n) asm volatile("s_waitcnt vmcnt(" #n ")" ::: "memory")
#define PG8_WAIT_L(n) asm volatile("s_waitcnt lgkmcnt(" #n ")" ::: "memory")
#define PG8_BAR __builtin_amdgcn_s_barrier()
#define PG8_SCHED __builtin_amdgcn_sched_barrier(0)
    Unit cur, nxt; int ui = 0;
    if (!S.next(0, cur)) return;
    f32x4 acc[2][2][4][2];
#pragma unroll
    for (int a = 0; a < 2; ++a)
#pragma unroll
        for (int b = 0; b < 2; ++b)
#pragma unroll
            for (int m = 0; m < 4; ++m)
#pragma unroll
                for (int n = 0; n < 2; ++n) acc[a][b][m][n] = (f32x4){0.f, 0.f, 0.f, 0.f};
    bf16x8 At[4][2], B0[2][2], B1[2][2];
    const char* cA = (const char*)(cur.asel ? g.A2 : g.A) + (size_t)cur.pm * tstep; const char* cB = (const char*)g.Bt + (size_t)cur.pn * tstep;
    S.a_ready(cur);
    if constexpr (SP2) {
        PG8_STAGE(PG8_SB(0, 0), cB, voffB); PG8_STAGE(PG8_SB(0, 1), cB + hstep, voffB); PG8_STAGE(PG8_SA(0, 0), cA, voffA); PG8_STAGE(PG8_SA(0, 1), cA + hstep, voffA);
        if (wr == 1) PG8_BAR;
        PG8_WAIT_V(2); PG8_BAR;
        PG8_STAGE(PG8_SB(1, 0), cB + kstep, voffB); PG8_STAGE(PG8_SA(1, 0), cA + kstep, voffA); PG8_STAGE(PG8_SB(1, 1), cB + hstep + kstep, voffB);
        PG8_WAIT_V(6); PG8_BAR;
    } else {
        PG8_STAGE(PG8_SB(0, 0), cB, voffB); PG8_STAGE(PG8_SA(0, 0), cA, voffA); PG8_STAGE(PG8_SB(0, 1), cB + hstep, voffB); PG8_STAGE(PG8_SA(0, 1), cA + hstep, voffA);
        if (wr == 1) PG8_BAR;
        PG8_WAIT_V(4); PG8_BAR;
        PG8_STAGE(PG8_SB(1, 0), cB + kstep, voffB); PG8_STAGE(PG8_SA(1, 0), cA + kstep, voffA); PG8_STAGE(PG8_SB(1, 1), cB + hstep + kstep, voffB);
        PG8_WAIT_V(6); PG8_BAR;
    }
    for (;;) {
        const bool has_next = S.next(ui + 1, nxt);
        const char* nA = has_next ? (const char*)(nxt.asel ? g.A2 : g.A) + (size_t)nxt.pm * tstep : cA; const char* nB = has_next ? (const char*)g.Bt + (size_t)nxt.pn * tstep : cB;
        for (int t = 0; t < nt; t += 2) {
            const bool last = (t == nt - 2);
            const char* a1 = cA + (size_t)(t + 1) * kstep;
            const char* a2 = last ? nA : cA + (size_t)(t + 2) * kstep; const char* b2 = last ? nB : cB + (size_t)(t + 2) * kstep;
            const char* a3 = a2 + kstep; const char* b3 = b2 + kstep;
            if (last && has_next) S.a_ready(nxt);
            if constexpr (SP2) {
            PG8_LDB(B0, 0, 0); PG8_LDB(B1, 0, 1); PG8_SCHED; PG8_LDA(At, 0, 0); PG8_STAGE(PG8_SA(1, 1), a1 + hstep, voffA);
            PG8_WAIT_V(8); PG8_WAIT_L(0); PG8_BAR; PG8_MMA(0, 0, At, B0); PG8_MMA(0, 1, At, B1); PG8_BAR; PG8_SCHED;
            PG8_LDA(At, 0, 1); PG8_STAGE(PG8_SB(0, 0), b2, voffB); PG8_STAGE(PG8_SB(0, 1), b2 + hstep, voffB); PG8_STAGE(PG8_SA(0, 0), a2, voffA);
            PG8_WAIT_V(8); PG8_WAIT_L(0); PG8_BAR; PG8_MMA(1, 0, At, B0); PG8_MMA(1, 1, At, B1); PG8_BAR; PG8_SCHED;
            PG8_LDB(B0, 1, 0); PG8_LDB(B1, 1, 1); PG8_SCHED; PG8_LDA(At, 1, 0); PG8_STAGE(PG8_SA(0, 1), a2 + hstep, voffA);
            PG8_WAIT_V(8); PG8_WAIT_L(0); PG8_BAR; PG8_MMA(0, 0, At, B0); PG8_MMA(0, 1, At, B1); PG8_BAR; PG8_SCHED;
            PG8_LDA(At, 1, 1); PG8_STAGE(PG8_SB(1, 0), b3, voffB); PG8_STAGE(PG8_SB(1, 1), b3 + hstep, voffB); PG8_STAGE(PG8_SA(1, 0), a3, voffA);
            PG8_WAIT_V(8); PG8_WAIT_L(0); PG8_BAR; PG8_MMA(1, 0, At, B0); PG8_MMA(1, 1, At, B1); PG8_BAR; PG8_SCHED;
            } else {
            PG8_LDB(B0, 0, 0); PG8_SCHED; PG8_LDA(At, 0, 0); PG8_STAGE(PG8_SA(1, 1), a1 + hstep, voffA);
            PG8_WAIT_L(8); PG8_BAR; PG8_WAIT_L(0); PG8_MMA(0, 0, At, B0); PG8_BAR; PG8_SCHED;
            PG8_LDB(B1, 0, 1); PG8_STAGE(PG8_SB(0, 0), b2, voffB);
            PG8_BAR; PG8_WAIT_L(0); PG8_MMA(0, 1, At, B1); PG8_BAR;
            PG8_LDA(At, 0, 1); PG8_STAGE(PG8_SA(0, 0), a2, voffA);
            PG8_BAR; PG8_WAIT_L(0); PG8_MMA(1, 0, At, B0); PG8_BAR; PG8_SCHED;
            PG8_STAGE(PG8_SB(0, 1), b2 + hstep, voffB);
            PG8_WAIT_V(6); PG8_BAR; PG8_MMA(1, 1, At, B1); PG8_BAR;
            PG8_LDB(B0, 1, 0); PG8_SCHED; PG8_LDA(At, 1, 0); PG8_STAGE(PG8_SA(0, 1), a2 + hstep, voffA);
            PG8_WAIT_L(8); PG8_BAR; PG8_WAIT_L(0); PG8_MMA(0, 0, At, B0); PG8_BAR; PG8_SCHED;
            PG8_LDB(B1, 1, 1); PG8_STAGE(PG8_SB(1, 0), b3, voffB);
            PG8_BAR; PG8_WAIT_L(0); PG8_MMA(0, 1, At, B1); PG8_BAR;
            PG8_LDA(At, 1, 1); PG8_STAGE(PG8_SA(1, 0), a3, voffA);
            PG8_BAR; PG8_WAIT_L(0); PG8_MMA(1, 0, At, B0); PG8_BAR; PG8_SCHED;
            PG8_STAGE(PG8_SB(1, 1), b3 + hstep, voffB);
            PG8_WAIT_V(6); PG8_BAR; PG8_MMA(1, 1, At, B1); PG8_BAR;
            }
        }
        if constexpr (ALIGN_EPI) { if (wr == 0) PG8_BAR; }
        if constexpr (!Epi::AFTER_DRAIN) { E(acc, cur, wr, wc, fr, fq); S.done(cur); }
        const bool keep_acc = E.keep(cur);
        if (!has_next) break;
        if (!keep_acc) {
#pragma unroll
        for (int a = 0; a < 2; ++a)
#pragma unroll
            for (int b = 0; b < 2; ++b)
#pragma unroll
                for (int m = 0; m < 4; ++m)
#pragma unroll
                    for (int n = 0; n < 2; ++n) acc[a][b][m][n] = (f32x4){0.f, 0.f, 0.f, 0.f};
        }
        cur = nxt; cA = nA; cB = nB; ++ui;
        if constexpr (ALIGN_EPI) { if (wr == 1) PG8_BAR; }
    }
    PG8_WAIT_V(0);
    if constexpr (!ALIGN_EPI) { if (wr == 0) PG8_BAR; }
    PG8_BAR;
    if constexpr (Epi::AFTER_DRAIN) { E.fused(acc, cur, wr, wc, fr, fq, lds, wid, lane); S.done(cur); }
#undef PG8_SA
#undef PG8_SB
#undef PG8_STAGE
#undef PG8_LDA
#undef PG8_LDB
#undef PG8_MMA
#undef PG8_WAIT_V
#undef PG8_WAIT_L
#undef PG8_BAR
#undef PG8_SCHED
}
}

namespace {
using pg8::bf16_t; using pg8::f32x4; using pg8::u32x4; using pg8::Unit;
#define LAS __attribute__((address_space(3)))
constexpr int M = 16384, D = 1024, T = 2048, NB = 8, MEMLEN = 256, MM = NB * MEMLEN;
constexpr int INC = 6416, DFF = 4096, NCH = 32, NH = 8;
constexpr float EPS = 1e-6f;
constexpr size_t MiB = 1u << 20;
constexpr size_t WS_POOL_C = 77u << 20;
constexpr size_t WS_BAR = 0;
constexpr size_t WS_ROWSS = WS_POOL_C + 174 * (1u << 20);
constexpr size_t WS_ZERO_BYTES = 64 * 1024;
constexpr size_t WS_ROWSS_MEM = WS_POOL_C + 173 * (1u << 20);
constexpr size_t WS_G = 400 * 1024, WS_ML = 408 * 1024, WS_MIN = 416 * 1024;
constexpr size_t WS_DN = 512 * 1024;
constexpr size_t WS_WT = 1 * MiB;
constexpr size_t WT_WIN = 0, WT_WMEM = (size_t)6656 * D * 2, WT_WBR = WT_WMEM + (size_t)D * D * 2, WT_WOUT = WT_WBR + (size_t)3 * D * 512 * 2,
                 WT_FF1 = WT_WOUT + (size_t)D * D * 2, WT_FF2 = WT_FF1 + (size_t)DFF * D * 2, WT_LAYER = WT_FF2 + (size_t)D * DFF * 2;
constexpr size_t WS_MEMB = 73 * MiB, WS_POOL = 77 * MiB, WS_END = 256 * MiB;
static_assert(WS_WT + 2 * WT_LAYER <= WS_MEMB && WS_POOL_C == WS_POOL, "weights fit");
constexpr int LDS_RING = 131072, LDS_BYTES = 147456, LDS_CTL = LDS_BYTES - 256, LDS_RSTD0 = LDS_RING, LDS_RSTD1 = LDS_RING + 1024;

struct P {
    const float *x, *mem, *rel_bias, *g_mix, *w_in, *conv_w, *b_i, *b_f, *norm_g, *sinks, *g_mem, *w_mem_kv, *w_br0, *w_br1, *w_br2, *w_out, *g_ffn, *w_ff1, *w_ff2, *g_final;
    float* out; unsigned char* ws;
};
struct LB {
    bf16_t *xbin, *sq, *mo, *xq, *skv, *mqk, *mv, *memkv, *merged, *xbmid, *hff, *xbnext;
    unsigned char* gates;
    float* iff; bf16_t* state;
    const bf16_t *win, *wmem, *wbr, *wout, *wff1, *wff2;
};
__host__ __device__ inline LB layer_buf(unsigned char* ws, float* out, int l) {
    LB b; unsigned char* pool = ws + WS_POOL; unsigned char* breg = pool;
    b.xbin = (bf16_t*)out; b.xbmid = (bf16_t*)((unsigned char*)out + 32 * MiB); b.xbnext = l == 1 ? (bf16_t*)(pool + 128 * MiB) : (bf16_t*)out;
    b.merged = (bf16_t*)(pool + 48 * MiB); b.hff = (bf16_t*)pool;
    b.sq = (bf16_t*)breg; b.mo = (bf16_t*)(breg + 16 * MiB); b.xq = (bf16_t*)(breg + 32 * MiB);
    b.gates = pool + 125 * MiB;
    b.skv = (bf16_t*)(breg + 48 * MiB); b.mqk = (bf16_t*)(breg + 56 * MiB); b.mv = (bf16_t*)(breg + 88 * MiB);
    b.iff = (float*)(breg + 104 * MiB); b.memkv = (bf16_t*)(breg + 105 * MiB); b.state = (bf16_t*)(breg + 109 * MiB);
    unsigned char* wt = ws + WS_WT + (size_t)l * WT_LAYER;
    b.win = (const bf16_t*)(wt + WT_WIN); b.wmem = (const bf16_t*)(wt + WT_WMEM); b.wbr = (const bf16_t*)(wt + WT_WBR);
    b.wout = (const bf16_t*)(wt + WT_WOUT); b.wff1 = (const bf16_t*)(wt + WT_FF1); b.wff2 = (const bf16_t*)(wt + WT_FF2);
    return b;
}
__device__ __forceinline__ float* ws_f(unsigned char* ws, size_t off) { return (float*)(ws + off); }

__device__ __forceinline__ float bf2f(bf16_t h) { return __uint_as_float(((unsigned)h) << 16); }
__device__ __forceinline__ bf16_t f2bf(float f) { unsigned u = __float_as_uint(f); u = (u + 0x7fffu + ((u >> 16) & 1u)) >> 16; return (bf16_t)u; }
__device__ __forceinline__ unsigned pk2(float lo, float hi) { return (unsigned)f2bf(lo) | ((unsigned)f2bf(hi) << 16); }
__device__ __forceinline__ float sigmoidf_(float v) { return 1.f / (1.f + expf(-v)); }
__device__ __forceinline__ float fsigmoid(float v) { return __builtin_amdgcn_rcpf(1.f + __expf(-v)); }
__device__ __forceinline__ float wave_sum(float v) {
#pragma unroll
    for (int o = 1; o < 64; o <<= 1) v += __shfl_xor(v, o);
    return v;
}
__device__ __forceinline__ float wave_max(float v) {
#pragma unroll
    for (int o = 1; o < 64; o <<= 1) v = fmaxf(v, __shfl_xor(v, o));
    return v;
}
__device__ __forceinline__ void unpack8(const uint4 a, float (&f)[8]) {
    f[0] = __uint_as_float(a.x << 16); f[1] = __uint_as_float(a.x & 0xffff0000u); f[2] = __uint_as_float(a.y << 16); f[3] = __uint_as_float(a.y & 0xffff0000u);
    f[4] = __uint_as_float(a.z << 16); f[5] = __uint_as_float(a.z & 0xffff0000u); f[6] = __uint_as_float(a.w << 16); f[7] = __uint_as_float(a.w & 0xffff0000u);
}
__device__ const unsigned char T5_BUCKET[128] = {0, 1, 2, 3, 4, 5, 6, 7, 8, 9, 10, 11, 12, 13, 14, 15, 16, 16, 16, 17, 17, 18, 18, 18, 19, 19, 19, 20, 20, 20, 20, 21, 21, 21, 21, 22, 22, 22, 22, 22, 23, 23, 23, 23, 23, 23, 24, 24, 24, 24, 24, 24, 25, 25, 25, 25, 25, 25, 25, 26, 26, 26, 26, 26, 26, 26, 26, 27, 27, 27, 27, 27, 27, 27, 27, 27, 27, 28, 28, 28, 28, 28, 28, 28, 28, 28, 28, 29, 29, 29, 29, 29, 29, 29, 29, 29, 29, 29, 29, 30, 30, 30, 30, 30, 30, 30, 30, 30, 30, 30, 30, 30, 30, 31, 31, 31, 31, 31, 31, 31, 31, 31, 31, 31, 31, 31, 31, 31};

__device__ __forceinline__ float rstd_of(const float* rp, int row) {
    const f32x4* q = (const f32x4*)(rp + (size_t)row * 16); const f32x4 a = q[0], b = q[1], c = q[2], d = q[3];
    const float ss = ((a[0] + a[1]) + (a[2] + a[3])) + ((b[0] + b[1]) + (b[2] + b[3])) + (((c[0] + c[1]) + (c[2] + c[3])) + ((d[0] + d[1]) + (d[2] + d[3])));
    return rsqrtf(ss * (1.f / D) + EPS);
}
__device__ __forceinline__ void fill_rstd_table(const float* rp, int rm, LAS float* tab) {
    const int t = threadIdx.x; if (t < 256) tab[t] = rstd_of(rp, rm * 256 + t);
}
struct SchedRounds {
    int G, c, nfull, pn_base, tail, skip_at;
    __device__ __forceinline__ bool next(int i, Unit& u) const {
        const int L = i * G + c;
        if (L < nfull * 256) { const int r = L >> 8, w = L & 255, x = w & 7, j = w >> 3; u.pm = u.rm = 8 * x + (j & 7); u.pn = pn_base + 4 * r + (j >> 3) + (r >= skip_at ? 1 : 0); u.kind = 0; u.asel = 0; return true; }
        if (!tail) return false;
        const int t = L - nfull * 256;
        if (t < 64) { u.pm = u.rm = t; u.pn = 12; u.kind = 0; u.asel = 0; return true; }
        if (t < 128) { u.pm = u.rm = t - 64; u.pn = 25; u.kind = 0; u.asel = 0; return true; }
        if (t < 160) { const int q = t - 128; u.pm = u.rm = q >> 2; u.pn = 26 + (q & 3); u.kind = 1; u.asel = 1; return true; }
        return false;
    }
    __device__ __forceinline__ void a_ready(const Unit&) const {}
    __device__ __forceinline__ void done(const Unit&) const {}
};
struct SchedMerged {
    int G, c;
    __device__ __forceinline__ bool next(int i, Unit& u) const {
        const int tt = (i / 3) * G + c, seg = i % 3; if (tt >= 256) return false;
        const int x = tt & 7, j = tt >> 3; u.rm = 8 * x + (j & 7); u.pm = seg * 64 + u.rm; u.pn = seg * 4 + (j >> 3); u.kind = seg; u.asel = 0; return true;
    }
    __device__ __forceinline__ void a_ready(const Unit&) const {}
    __device__ __forceinline__ void done(const Unit&) const {}
};

__device__ __forceinline__ u32x4 pack8(f32x4 a, f32x4 b) { u32x4 w; w.x = pg8::cvt_pk_bf16(a[0], a[1]); w.y = pg8::cvt_pk_bf16(a[2], a[3]); w.z = pg8::cvt_pk_bf16(b[0], b[1]); w.w = pg8::cvt_pk_bf16(b[2], b[3]); return w; }
__device__ __forceinline__ f32x4 sig4(f32x4 v) { f32x4 r; r[0] = fsigmoid(v[0]); r[1] = fsigmoid(v[1]); r[2] = fsigmoid(v[2]); r[3] = fsigmoid(v[3]); return r; }
struct EpiProjMK {
    static constexpr bool PERM = true, AFTER_DRAIN = false;
    LB L; const LAS float* tab0; const LAS float* tab1; int rm0;
    __device__ __forceinline__ bool keep(const Unit&) const { return false; }
    __device__ __forceinline__ void operator()(f32x4 (&acc)[2][2][4][2], const Unit& u, int wr, int wc, int fr, int fq) const {
        const int rbase = u.rm * 256 + wr * 64 + fr, cin = wc * 32 + 8 * fq, rloc = wr * 64 + fr;
        const LAS float* rs = (u.kind == 0 && u.rm == rm0) ? tab0 : tab1; bf16_t* dst; int ld, coff; bool sig = false; const int tile = u.pn;
        if (u.kind == 1) { dst = L.memkv; ld = 1024; coff = (tile - 26) * 256; }
        else if (tile < 2) { dst = L.sq; ld = 512; coff = tile * 256; }
        else if (tile < 3) { dst = L.skv; ld = 256; coff = 0; }
        else if (tile < 7) { dst = L.mqk; ld = 1024; coff = (tile - 3) * 256; }
        else if (tile < 9) { dst = L.mv; ld = 512; coff = (tile - 7) * 256; }
        else if (tile < 11) { dst = L.mo; ld = 512; coff = (tile - 9) * 256; sig = true; }
        else if (tile < 13) { dst = L.xq; ld = 512; coff = (tile - 11) * 256; }
        else { dst = nullptr; ld = 0; coff = 0; }
#pragma unroll
        for (int ai = 0; ai < 2; ++ai)
#pragma unroll
            for (int m = 0; m < 4; ++m) {
                const int row = rbase + ai * 128 + m * 16; const float rstd = rs[rloc + ai * 128 + m * 16];
#pragma unroll
                for (int bj = 0; bj < 2; ++bj) {
                    if (dst == nullptr && tile < 25) {
                        const float nsc = rstd * -1.4426950408889634f; const f32x4 a0 = acc[ai][bj][m][0], a1 = acc[ai][bj][m][1]; uint2 w; w.x = 0u; w.y = 0u;
#pragma unroll
                        for (int j = 0; j < 4; ++j) {
                            w.x = __builtin_amdgcn_cvt_pk_u8_f32(floorf(__builtin_amdgcn_rcpf(1.f + __builtin_amdgcn_exp2f(a0[j] * nsc)) * 256.f), j, w.x);
                            w.y = __builtin_amdgcn_cvt_pk_u8_f32(floorf(__builtin_amdgcn_rcpf(1.f + __builtin_amdgcn_exp2f(a1[j] * nsc)) * 256.f), j, w.y); }
                        *(uint2*)(L.gates + (size_t)row * 3072 + (tile - 13) * 256 + bj * 128 + cin) = w; continue; }
                    f32x4 v0, v1;
                    if (sig) { const float nsc = rstd * -1.4426950408889634f; const f32x4 a0 = acc[ai][bj][m][0], a1 = acc[ai][bj][m][1];
#pragma unroll
                        for (int j = 0; j < 4; ++j) { v0[j] = __builtin_amdgcn_rcpf(1.f + __builtin_amdgcn_exp2f(a0[j] * nsc)); v1[j] = __builtin_amdgcn_rcpf(1.f + __builtin_amdgcn_exp2f(a1[j] * nsc)); } }
                    else { v0 = acc[ai][bj][m][0] * rstd; v1 = acc[ai][bj][m][1] * rstd; }
                    if (dst) *(u32x4*)((unsigned char*)dst + (unsigned)((row * ld + coff + bj * 128 + cin) * 2)) = pack8(v0, v1);
                    else if (bj == 0 && cin < 16) { *(f32x4*)(L.iff + (size_t)row * 16 + cin) = v0; *(f32x4*)(L.iff + (size_t)row * 16 + cin + 4) = v1; }
                }
            }
    }
};
struct EpiMergedMK {
    static constexpr bool PERM = true, AFTER_DRAIN = false;
    const unsigned char* gates; bf16_t* merged;
    __device__ __forceinline__ bool keep(const Unit& u) const { return u.kind < 2; }
    __device__ __forceinline__ static void deq8(uint2 w, float (&g)[8]) {
        g[0] = (float)(w.x & 255u) + 0.5f; g[1] = (float)((w.x >> 8) & 255u) + 0.5f; g[2] = (float)((w.x >> 16) & 255u) + 0.5f; g[3] = (float)(w.x >> 24) + 0.5f;
        g[4] = (float)(w.y & 255u) + 0.5f; g[5] = (float)((w.y >> 8) & 255u) + 0.5f; g[6] = (float)((w.y >> 16) & 255u) + 0.5f; g[7] = (float)(w.y >> 24) + 0.5f; }
    __device__ __forceinline__ void operator()(f32x4 (&acc)[2][2][4][2], const Unit& u, int wr, int wc, int fr, int fq) const {
        const int rbase = u.rm * 256 + wr * 64 + fr, col0 = (u.pn & 3) * 256 + wc * 32 + 8 * fq, seg = u.kind;
#pragma unroll
        for (int ai = 0; ai < 2; ++ai) {
            uint2 gs[4][2], gn[4][2];
#pragma unroll
            for (int m = 0; m < 4; ++m)
#pragma unroll
                for (int bj = 0; bj < 2; ++bj) { const unsigned char* gp = gates + (size_t)(rbase + ai * 128 + m * 16) * 3072 + seg * 1024 + col0 + bj * 128;
                    gs[m][bj] = *(const uint2*)gp; gn[m][bj] = seg < 2 ? *(const uint2*)(gp + 1024) : make_uint2(0u, 0u); }
#pragma unroll
            for (int m = 0; m < 4; ++m) {
                const int row = rbase + ai * 128 + m * 16;
#pragma unroll
                for (int bj = 0; bj < 2; ++bj) {
                    const int col = col0 + bj * 128;
                    float g[8]; deq8(gs[m][bj], g);
                    if (seg < 2) { float gd[8]; deq8(gn[m][bj], gd);
#pragma unroll
                        for (int j = 0; j < 8; ++j) g[j] = g[j] * __builtin_amdgcn_rcpf(gd[j]); }
                    else {
#pragma unroll
                        for (int j = 0; j < 8; ++j) g[j] *= (1.f / 256.f); }
                    f32x4 v0 = acc[ai][bj][m][0], v1 = acc[ai][bj][m][1];
                    v0[0] *= g[0]; v0[1] *= g[1]; v0[2] *= g[2]; v0[3] *= g[3]; v1[0] *= g[4]; v1[1] *= g[5]; v1[2] *= g[6]; v1[3] *= g[7];
                    acc[ai][bj][m][0] = v0; acc[ai][bj][m][1] = v1;
                    if (seg == 2) *(u32x4*)(merged + (size_t)row * D + col) = pack8(v0, v1);
                }
            }
            asm volatile("" ::: "memory");
        }
    }
};
struct EpiResidMK {
    static constexpr bool PERM = true, AFTER_DRAIN = false;
    const bf16_t* xold; bf16_t* xnew; float* rowss;
    __device__ __forceinline__ bool keep(const Unit&) const { return false; }
    __device__ __forceinline__ void operator()(f32x4 (&acc)[2][2][4][2], const Unit& u, int wr, int wc, int fr, int fq) const {
        const int rbase = u.rm * 256 + wr * 64 + fr, col0 = u.pn * 256 + wc * 32 + 8 * fq;
#pragma unroll
        for (int ai = 0; ai < 2; ++ai) {
            uint4 xo[4][2];
#pragma unroll
            for (int m = 0; m < 4; ++m)
#pragma unroll
                for (int bj = 0; bj < 2; ++bj) xo[m][bj] = *(const uint4*)(xold + (size_t)(rbase + ai * 128 + m * 16) * D + col0 + bj * 128);
#pragma unroll
            for (int m = 0; m < 4; ++m) {
                const int row = rbase + ai * 128 + m * 16; const size_t off = (size_t)row * D + col0; float ss = 0.f;
#pragma unroll
                for (int bj = 0; bj < 2; ++bj) {
                    float o[8]; unpack8(xo[m][bj], o);
                    f32x4 v0 = acc[ai][bj][m][0], v1 = acc[ai][bj][m][1];
                    v0[0] += o[0]; v0[1] += o[1]; v0[2] += o[2]; v0[3] += o[3]; v1[0] += o[4]; v1[1] += o[5]; v1[2] += o[6]; v1[3] += o[7];
                    const u32x4 w = pack8(v0, v1); *(u32x4*)(xnew + off + bj * 128) = w;
                    float r[8]; unpack8(__builtin_bit_cast(uint4, w), r);
#pragma unroll
                    for (int j = 0; j < 8; ++j) ss = fmaf(r[j], r[j], ss);
                }
                ss += __shfl_xor(ss, 16); ss += __shfl_xor(ss, 32);
                if (fq == 0) rowss[(size_t)row * 16 + (u.pn & 3) * 4 + wc] = ss;
            }
            asm volatile("" ::: "memory");
        }
    }
};
struct EpiFF1MK {
    static constexpr bool PERM = true, AFTER_DRAIN = false;
    bf16_t* h; const LAS float* tab0;
    __device__ __forceinline__ bool keep(const Unit&) const { return false; }
    __device__ __forceinline__ void operator()(f32x4 (&acc)[2][2][4][2], const Unit& u, int wr, int wc, int fr, int fq) const {
        const int rbase = u.rm * 256 + wr * 64 + fr, col0 = u.pn * 256 + wc * 32 + 8 * fq, rloc = wr * 64 + fr;
#pragma unroll
        for (int ai = 0; ai < 2; ++ai)
#pragma unroll
            for (int m = 0; m < 4; ++m) {
                const int row = rbase + ai * 128 + m * 16; const float rstd = tab0[rloc + ai * 128 + m * 16];
#pragma unroll
                for (int bj = 0; bj < 2; ++bj) {
                    f32x4 v0 = acc[ai][bj][m][0] * rstd, v1 = acc[ai][bj][m][1] * rstd;
#pragma unroll
                    for (int j = 0; j < 4; ++j) { v0[j] = fmaxf(v0[j], 0.f); v0[j] *= v0[j]; v1[j] = fmaxf(v1[j], 0.f); v1[j] *= v1[j]; }
                    *(u32x4*)((unsigned char*)h + (unsigned)((row * DFF + col0 + bj * 128) * 2)) = pack8(v0, v1);
                }
            }
    }
};

constexpr int CV_ITEMS_LAYER = 1152, CV_LD = 257;
struct CvItem { const float* src; const float* gain; bf16_t* dst; int ld, K, k0, ncols; float sc; };
__device__ __forceinline__ CvItem convert_decode(const P& p, int item) {
    CvItem c; const int l = item / CV_ITEMS_LAYER; int r = item % CV_ITEMS_LAYER;
    unsigned char* wt = p.ws + WS_WT + (size_t)l * WT_LAYER;
    const float* src; const float* gain = nullptr; int ld, col0, ncols, K; float sc = 1.f; bf16_t* dst;
    if (r < 416) {
        src = p.w_in + (size_t)l * D * INC; ld = INC; K = D; gain = p.g_mix + l * D; int dr;
        if (r < 32) { col0 = 0; ncols = 512; dr = 0; sc = 0.125f; }
        else if ((r -= 32) < 112) { col0 = 512; ncols = 1792; dr = 512; }
        else if ((r -= 112) < 32) { col0 = 2320; ncols = 512; dr = 2304; }
        else if ((r -= 32) < 32) { col0 = 2832; ncols = 512; dr = 2816; sc = 0.08838834764831845f; }
        else if ((r -= 32) < 192) { col0 = 3344; ncols = 3072; dr = 3328; }
        else { r -= 192; col0 = 2304; ncols = 16; dr = 6400; }
        dst = (bf16_t*)(wt + WT_WIN) + (size_t)dr * D;
    } else if ((r -= 416) < 64) { src = p.w_mem_kv + (size_t)l * D * 1024; ld = 1024; col0 = 0; ncols = 1024; K = D; gain = p.g_mem + l * D; dst = (bf16_t*)(wt + WT_WMEM); }
    else if ((r -= 64) < 96) { const int sg = r / 32; r -= sg * 32; src = (sg == 0 ? p.w_br0 : sg == 1 ? p.w_br1 : p.w_br2) + (size_t)l * 512 * 1024; ld = 1024; col0 = 0; ncols = 1024; K = 512; dst = (bf16_t*)(wt + WT_WBR) + (size_t)sg * 1024 * 512; }
    else if ((r -= 96) < 64) { src = p.w_out + (size_t)l * D * D; ld = 1024; col0 = 0; ncols = 1024; K = D; dst = (bf16_t*)(wt + WT_WOUT); }
    else if ((r -= 64) < 256) { src = p.w_ff1 + (size_t)l * D * DFF; ld = DFF; col0 = 0; ncols = DFF; K = D; gain = p.g_ffn + l * D; dst = (bf16_t*)(wt + WT_FF1); }
    else { r -= 256; src = p.w_ff2 + (size_t)l * DFF * D; ld = D; col0 = 0; ncols = D; K = DFF; dst = (bf16_t*)(wt + WT_FF2); }
    const int nnb = (ncols + 255) / 256, kb = r / nnb, nb = r % nnb, c0 = nb * 256;
    c.ncols = (ncols - c0) < 256 ? (ncols - c0) : 256; c.k0 = kb * 64; c.K = K; c.ld = ld; c.sc = sc; c.gain = gain;
    c.src = src + (size_t)c.k0 * ld + col0 + c0; c.dst = dst + (size_t)c0 * K + c.k0;
    return c;
}
__device__ __forceinline__ void convert_load(const CvItem& c, int tid, f32x4 (&v)[8]) {
    const int n4 = (tid & 63) * 4, kr = tid >> 6;
#pragma unroll
    for (int i = 0; i < 8; ++i) v[i] = n4 < c.ncols ? *(const f32x4*)(c.src + (size_t)(kr + 8 * i) * c.ld + n4) : (f32x4){0.f, 0.f, 0.f, 0.f};
}
__device__ __forceinline__ void convert_to_lds(const CvItem& c, int tid, const f32x4 (&v)[8], float* tile) {
    const int n4 = (tid & 63) * 4, kr = tid >> 6;
#pragma unroll
    for (int i = 0; i < 8; ++i) { const int kk = kr + 8 * i; const f32x4 w = v[i] * ((c.gain ? c.gain[c.k0 + kk] : 1.f) * c.sc);
        tile[kk * CV_LD + n4] = w[0]; tile[kk * CV_LD + n4 + 1] = w[1]; tile[kk * CV_LD + n4 + 2] = w[2]; tile[kk * CV_LD + n4 + 3] = w[3]; }
}
__device__ __forceinline__ void convert_store(const CvItem& c, int tid, const float* tile) {
    const int kc = tid & 7;
#pragma unroll
    for (int i = 0; i < 4; ++i) { const int n = (tid >> 3) + 64 * i; const float* tp = tile + (8 * kc) * CV_LD + n;
        u32x4 w; w.x = pk2(tp[0], tp[CV_LD]); w.y = pk2(tp[2 * CV_LD], tp[3 * CV_LD]); w.z = pk2(tp[4 * CV_LD], tp[5 * CV_LD]); w.w = pk2(tp[6 * CV_LD], tp[7 * CV_LD]);
        if (n < c.ncols) *(u32x4*)(c.dst + (size_t)n * c.K + 8 * kc) = w; }
}
__device__ __forceinline__ void convert_phase(const P& p, int bx, int G, float* tile) {
    int tid_l = threadIdx.x; asm volatile("" : "+v"(tid_l)); const int tid = tid_l;
    int it = bx; if (it >= 2 * CV_ITEMS_LAYER) return;
    CvItem c = convert_decode(p, it); f32x4 v[8]; convert_load(c, tid, v);
    for (;;) {
        convert_to_lds(c, tid, v, tile);
        const int nx = it + G; const bool more = nx < 2 * CV_ITEMS_LAYER; CvItem cn = c;
        if (more) { cn = convert_decode(p, nx); convert_load(cn, tid, v); }
        __syncthreads();
        convert_store(c, tid, tile);
        __syncthreads();
        if (!more) break;
        c = cn; it = nx;
    }
}
__device__ __forceinline__ void rowstat_rows(const float* src, int rows, bf16_t* xb, float* rowss, int gw, int ngw, int lane) {
    for (int r = gw; r < rows; r += 2 * ngw) {
        const int r1 = r + ngw; const bool two = r1 < rows;
        const float4* s0 = (const float4*)(src + (size_t)r * D); const float4* s1 = (const float4*)(src + (size_t)(two ? r1 : r) * D);
        float4 a[4], b[4];
#pragma unroll
        for (int j = 0; j < 4; ++j) { a[j] = s0[lane + 64 * j]; b[j] = s1[lane + 64 * j]; }
        float ssa = 0.f, ssb = 0.f;
#pragma unroll
        for (int j = 0; j < 4; ++j) { ssa += a[j].x * a[j].x + a[j].y * a[j].y + a[j].z * a[j].z + a[j].w * a[j].w; ssb += b[j].x * b[j].x + b[j].y * b[j].y + b[j].z * b[j].z + b[j].w * b[j].w;
            uint2 o; o.x = pk2(a[j].x, a[j].y); o.y = pk2(a[j].z, a[j].w); *(uint2*)(xb + (size_t)r * D + 4 * (lane + 64 * j)) = o;
            if (two) { uint2 o1; o1.x = pk2(b[j].x, b[j].y); o1.y = pk2(b[j].z, b[j].w); *(uint2*)(xb + (size_t)r1 * D + 4 * (lane + 64 * j)) = o1; } }
        ssa = wave_sum(ssa); ssb = wave_sum(ssb);
        if (lane < 16) { rowss[(size_t)r * 16 + lane] = lane == 0 ? ssa : 0.f; if (two) rowss[(size_t)r1 * 16 + lane] = lane == 0 ? ssb : 0.f; }
    }
}
__device__ __forceinline__ void finalnorm_rows(const bf16_t* xb, float* out, const float* rowss, const float* g, int gw, int ngw, int lane) {
    for (int r = gw; r < M; r += ngw) {
        const float rstd = rstd_of(rowss, r);
#pragma unroll
        for (int j = 0; j < 2; ++j) { float x[8]; unpack8(*(const uint4*)(xb + (size_t)r * D + 8 * (lane + 64 * j)), x);
            const float4 g0 = *(const float4*)(g + 8 * (lane + 64 * j)), g1 = *(const float4*)(g + 8 * (lane + 64 * j) + 4);
            float4 o0, o1; o0.x = x[0] * rstd * g0.x; o0.y = x[1] * rstd * g0.y; o0.z = x[2] * rstd * g0.z; o0.w = x[3] * rstd * g0.w;
            o1.x = x[4] * rstd * g1.x; o1.y = x[5] * rstd * g1.y; o1.z = x[6] * rstd * g1.z; o1.w = x[7] * rstd * g1.w;
            *(float4*)(out + (size_t)r * D + 8 * (lane + 64 * j)) = o0; *(float4*)(out + (size_t)r * D + 8 * (lane + 64 * j) + 4) = o1; }
    }
}

typedef short bf16x8 __attribute__((ext_vector_type(8)));
typedef short s16x4 __attribute__((ext_vector_type(4)));
typedef float f32x16 __attribute__((ext_vector_type(16)));
typedef float f32x2 __attribute__((ext_vector_type(2)));
typedef __bf16 bf16x2v __attribute__((ext_vector_type(2)));
#define MFMA32(a, b, c) __builtin_amdgcn_mfma_f32_32x32x16_bf16((a), (b), (c), 0, 0, 0)
__device__ __forceinline__ int crow(int reg, int h) { return (reg & 3) + 8 * (reg >> 2) + 4 * h; }
__device__ __forceinline__ unsigned pkbf(float a, float b) { return __builtin_bit_cast(unsigned, __builtin_convertvector((f32x2){a, b}, bf16x2v)); }
__device__ __forceinline__ bf16x8 pack_step(const f32x16& x, int s) {
    u32x4 p; p.x = pkbf(x[8 * s], x[8 * s + 1]); p.y = pkbf(x[8 * s + 2], x[8 * s + 3]); p.z = pkbf(x[8 * s + 4], x[8 * s + 5]); p.w = pkbf(x[8 * s + 6], x[8 * s + 7]);
    return __builtin_bit_cast(bf16x8, p);
}
__device__ __forceinline__ bf16x8 tr_frag(const LAS unsigned char* img, int row_lo, int row_hi, int lane) {
    const int i16 = lane & 15, q = i16 >> 2, p = i16 & 3, blk = (lane >> 4) & 1;
    const s16x4 lo = __builtin_amdgcn_ds_read_tr16_b64_v4i16((LAS s16x4*)(img + (row_lo + q) * 64 + 32 * blk + 8 * p));
    const s16x4 hi = __builtin_amdgcn_ds_read_tr16_b64_v4i16((LAS s16x4*)(img + (row_hi + q) * 64 + 32 * blk + 8 * p));
    return __builtin_shufflevector(lo, hi, 0, 1, 2, 3, 4, 5, 6, 7);
}

constexpr int SWA_KIMG = 0, SWA_VIMG = 256 * 144, SWA_TAB = SWA_VIMG + 2 * 16384;
__device__ __forceinline__ void swa_mfma_unit(const P& p, const LB& L, int l, int u, LAS unsigned char* l3) {
    int tid_l = threadIdx.x; asm volatile("" : "+v"(tid_l)); const int tid = tid_l, lane = tid & 63, wave = tid >> 6, h = lane >> 5, ql = lane & 31;
    const int hkv = u & 1, n = (u >> 1) & 15, b = u >> 5;
    __syncthreads();
#pragma unroll
    for (int i = 0; i < 4; ++i) {
        const int c = tid + 512 * i, row = c >> 3, cc = c & 7, t = 128 * (n - 1) + row;
        u32x4 kv = (u32x4){0u, 0u, 0u, 0u}, vv = (u32x4){0u, 0u, 0u, 0u};
        if (t >= 0) { const bf16_t* src = L.skv + (size_t)(b * T + t) * 256 + hkv * 64 + cc * 8; kv = *(const u32x4*)src; vv = *(const u32x4*)(src + 128); }
        *(LAS u32x4*)(l3 + SWA_KIMG + row * 144 + cc * 16) = kv;
        *(LAS u32x4*)(l3 + SWA_VIMG + (cc >> 2) * 16384 + row * 64 + (cc & 3) * 16) = vv;
    }
    for (int idx = tid; idx < 4 * 192; idx += 512) { const int g = idx / 192, e = idx % 192, dist = 159 - e;
        ((LAS float*)(l3 + SWA_TAB))[idx] = (dist >= 0 && dist < 128) ? p.rel_bias[(int)T5_BUCKET[dist] * 8 + hkv * 4 + g] : -1e30f; }
    __syncthreads();
    const int g = wave >> 1, half = wave & 1, hq = hkv * 4 + g;
    const float sink = p.sinks[l * 8 + hq];
    const LAS float* tab = (const LAS float*)(l3 + SWA_TAB) + g * 192 + 31 - ql;
#pragma unroll 1
    for (int sb = 0; sb < 2; ++sb) {
        const int r0 = 64 * half + 32 * sb, kb0 = 2 * half + sb;
        bf16_t* qptr = L.sq + (size_t)(b * T + 128 * n + r0 + ql) * 512 + hq * 64;
        bf16x8 Qf[4];
#pragma unroll
        for (int ks = 0; ks < 4; ++ks) Qf[ks] = *(const bf16x8*)(qptr + 16 * ks + 8 * h);
        f32x16 S[5];
#pragma unroll
        for (int i = 0; i < 5; ++i) {
#pragma unroll
            for (int r = 0; r < 16; ++r) S[i][r] = 0.f;
#pragma unroll
            for (int ks = 0; ks < 4; ++ks) { const bf16x8 Kf = *(const LAS bf16x8*)(l3 + SWA_KIMG + (32 * (kb0 + i) + ql) * 144 + 32 * ks + 16 * h); S[i] = MFMA32(Kf, Qf[ks], S[i]); }
        }
        float m = sink;
#pragma unroll
        for (int i = 0; i < 5; ++i)
#pragma unroll
            for (int r = 0; r < 16; ++r) { const int kk = 32 * i + crow(r, h); float sv = S[i][r] + tab[kk];
                if (n == 0 && 32 * kb0 + kk < 128) sv = -1e30f;
                S[i][r] = sv; m = fmaxf(m, sv); }
        m = fmaxf(m, __shfl_xor(m, 32));
        float lsum = 0.f;
#pragma unroll
        for (int i = 0; i < 5; ++i)
#pragma unroll
            for (int r = 0; r < 16; ++r) { const float pe = __expf(S[i][r] - m); S[i][r] = pe; lsum += pe; }
        lsum += __shfl_xor(lsum, 32);
        f32x16 O[2];
#pragma unroll
        for (int db = 0; db < 2; ++db)
#pragma unroll
            for (int r = 0; r < 16; ++r) O[db][r] = 0.f;
#pragma unroll
        for (int i = 0; i < 5; ++i)
#pragma unroll
            for (int s2 = 0; s2 < 2; ++s2) { const bf16x8 Pf = pack_step(S[i], s2); const int k0 = 32 * (kb0 + i) + 16 * s2;
#pragma unroll
                for (int db = 0; db < 2; ++db) { const bf16x8 Vf = tr_frag(l3 + SWA_VIMG + db * 16384, k0 + 4 * h, k0 + 8 + 4 * h, lane); O[db] = MFMA32(Vf, Pf, O[db]); } }
        const float inv = 1.f / (lsum + __expf(sink - m));
#pragma unroll
        for (int db = 0; db < 2; ++db)
#pragma unroll
            for (int gq = 0; gq < 4; ++gq) { uint2 w; w.x = pkbf(O[db][4 * gq] * inv, O[db][4 * gq + 1] * inv); w.y = pkbf(O[db][4 * gq + 2] * inv, O[db][4 * gq + 3] * inv);
                *(uint2*)(qptr + 32 * db + 8 * gq + 4 * h) = w; }
    }
}

constexpr int XA_KIMG = 0, XA_VIMG = 256 * 272;
__device__ __forceinline__ void xattn_mfma_unit(const LB& L, int u, LAS unsigned char* l3) {
    int tid_l = threadIdx.x; asm volatile("" : "+v"(tid_l)); const int tid = tid_l, lane = tid & 63, wave = tid >> 6, h = lane >> 5, ql = lane & 31;
    const int qb = u & 7, hx = (u >> 3) & 3, b = u >> 5;
    __syncthreads();
#pragma unroll
    for (int i = 0; i < 8; ++i) {
        const int c = tid + 512 * i, row = c >> 4, cc = c & 15;
        const bf16_t* src = L.memkv + (size_t)(b * MEMLEN + row) * 1024 + hx * 128 + cc * 8;
        const u32x4 kv = *(const u32x4*)src, vv = *(const u32x4*)(src + 512);
        *(LAS u32x4*)(l3 + XA_KIMG + row * 272 + cc * 16) = kv;
        *(LAS u32x4*)(l3 + XA_VIMG + (cc >> 2) * 16384 + row * 64 + (cc & 3) * 16) = vv;
    }
    bf16_t* qptr = L.xq + (size_t)(b * T + qb * 256 + wave * 32 + ql) * 512 + hx * 128;
    bf16x8 Qf[8];
#pragma unroll
    for (int ks = 0; ks < 8; ++ks) Qf[ks] = *(const bf16x8*)(qptr + 16 * ks + 8 * h);
    __syncthreads();
    f32x16 S[8];
    {
#pragma unroll
        for (int i = 0; i < 8; ++i) {
#pragma unroll
            for (int r = 0; r < 16; ++r) S[i][r] = 0.f;
#pragma unroll
            for (int ks = 0; ks < 8; ++ks) { const bf16x8 Kf = *(const LAS bf16x8*)(l3 + XA_KIMG + (32 * i + ql) * 272 + 32 * ks + 16 * h); S[i] = MFMA32(Kf, Qf[ks], S[i]); }
        }
    }
    float m = -1e30f;
#pragma unroll
    for (int i = 0; i < 8; ++i)
#pragma unroll
        for (int r = 0; r < 16; ++r) m = fmaxf(m, S[i][r]);
    m = fmaxf(m, __shfl_xor(m, 32));
    float lsum = 0.f;
#pragma unroll
    for (int i = 0; i < 8; ++i)
#pragma unroll
        for (int r = 0; r < 16; ++r) { const float pe = __expf(S[i][r] - m); S[i][r] = pe; lsum += pe; }
    lsum += __shfl_xor(lsum, 32);
    f32x16 O[4];
#pragma unroll
    for (int db = 0; db < 4; ++db)
#pragma unroll
        for (int r = 0; r < 16; ++r) O[db][r] = 0.f;
#pragma unroll
    for (int i = 0; i < 8; ++i)
#pragma unroll
        for (int s2 = 0; s2 < 2; ++s2) { const bf16x8 Pf = pack_step(S[i], s2); const int k0 = 32 * i + 16 * s2;
#pragma unroll
            for (int db = 0; db < 4; ++db) { const bf16x8 Vf = tr_frag(l3 + XA_VIMG + db * 16384, k0 + 4 * h, k0 + 8 + 4 * h, lane); O[db] = MFMA32(Vf, Pf, O[db]); } }
    const float inv = 1.f / lsum;
#pragma unroll
    for (int db = 0; db < 4; ++db)
#pragma unroll
        for (int gq = 0; gq < 4; ++gq) { uint2 w; w.x = pkbf(O[db][4 * gq] * inv, O[db][4 * gq + 1] * inv); w.y = pkbf(O[db][4 * gq + 2] * inv, O[db][4 * gq + 3] * inv);
            *(uint2*)(qptr + 32 * db + 8 * gq + 4 * h) = w; }
}


__device__ __forceinline__ float log_sigmoid_f(float x) { return x >= 0.f ? -__logf(1.f + __expf(-x)) : x - __logf(1.f + __expf(x)); }
__device__ __forceinline__ void mlstm_gates_load(const P& p, const LB& L, int l, int b, int c, int hh, int lane, float& iraw, float& fraw) {
    const size_t row = (size_t)b * T + c * 64 + lane;
    iraw = L.iff[row * 16 + hh] + p.b_i[l * 8 + hh]; fraw = L.iff[row * 16 + 8 + hh] + p.b_f[l * 8 + hh];
}
__device__ __forceinline__ void mlstm_gates_wave(float iraw, float fraw, int lane, float& bcum, float& ig) {
    ig = iraw;
    float v = log_sigmoid_f(fraw);
#pragma unroll
    for (int o = 1; o < 64; o <<= 1) { const float t = __shfl_up(v, o); if (lane >= o) v += t; }
    bcum = v;
}
constexpr int MA_SLOT = 18368, MA_XK = 0, MA_VIMG = 8704, MA_T0 = 16896;
__device__ __forceinline__ void mlstm_A_mfma_unit(const P& p, const LB& L, int l, int u, LAS unsigned char* l3) {
    int tid_l = threadIdx.x; asm volatile("" : "+v"(tid_l)); const int tid = tid_l, lane = tid & 63, hh = tid >> 6, h = lane >> 5, ql = lane & 31;
    const int c = u & 31, b = u >> 5, uh = u * 8 + hh;
    LAS unsigned char* wl = l3 + hh * MA_SLOT;
    const float* cw = p.conv_w + (size_t)l * 4 * 1024;
    float iraw, fraw; mlstm_gates_load(p, L, l, b, c, hh, lane, iraw, fraw);
    __syncthreads();
    {
        u32x4 xk[9], vv[8];
#pragma unroll
        for (int i = 0; i < 9; ++i) { const int idx = lane + 64 * i, ic = idx < 67 * 8 ? idx : 67 * 8 - 1, row = ic >> 3, cc = ic & 7, t = c * 64 - 3 + row;
            xk[i] = *(const u32x4*)(L.mqk + (size_t)(b * T + (t >= 0 ? t : 0)) * 1024 + 512 + hh * 64 + cc * 8); }
#pragma unroll
        for (int i = 0; i < 8; ++i) { const int s = (lane >> 3) + 8 * i, cc = lane & 7; vv[i] = *(const u32x4*)(L.mv + (size_t)(b * T + c * 64 + s) * 512 + hh * 64 + cc * 8); }
#pragma unroll
        for (int i = 0; i < 9; ++i) { const int idx = lane + 64 * i, row = idx >> 3, cc = idx & 7, t = c * 64 - 3 + row;
            if (idx < 67 * 8) *(LAS u32x4*)(wl + MA_XK + row * 128 + cc * 16) = t >= 0 ? xk[i] : (u32x4){0u, 0u, 0u, 0u}; }
#pragma unroll
        for (int i = 0; i < 8; ++i) { const int s = (lane >> 3) + 8 * i, cc = lane & 7; *(LAS u32x4*)(wl + MA_VIMG + (cc >> 2) * 4096 + s * 64 + (cc & 3) * 16) = vv[i]; }
    }
    float bcum, ig; mlstm_gates_wave(iraw, fraw, lane, bcum, ig);
    const float g = __shfl(bcum, 63), alog = g - bcum + ig, ml = wave_max(alog);
    ((LAS float*)(wl + MA_T0))[lane] = __expf(alog - ml);
    __syncthreads();
    f32x16 acc[2][2];
#pragma unroll
    for (int a = 0; a < 2; ++a)
#pragma unroll
        for (int d = 0; d < 2; ++d)
#pragma unroll
            for (int r = 0; r < 16; ++r) acc[a][d][r] = 0.f;
    float dnacc[2] = {0.f, 0.f};
    float cwr[2][4];
#pragma unroll
    for (int dkb = 0; dkb < 2; ++dkb)
#pragma unroll
        for (int tap = 0; tap < 4; ++tap) cwr[dkb][tap] = cw[tap * 1024 + 512 + hh * 64 + 32 * dkb + ql];
#pragma unroll
    for (int ks = 0; ks < 4; ++ks) {
        const int s0 = 16 * ks + 8 * h;
        const f32x4 we0 = *(const LAS f32x4*)(wl + MA_T0 + s0 * 4), we1 = *(const LAS f32x4*)(wl + MA_T0 + s0 * 4 + 16);
        const float we[8] = {we0[0], we0[1], we0[2], we0[3], we1[0], we1[1], we1[2], we1[3]};
        bf16x8 WKf[2];
#pragma unroll
        for (int dkb = 0; dkb < 2; ++dkb) {
            float x[11];
#pragma unroll
            for (int r = 0; r < 11; ++r) x[r] = bf2f(*(const LAS unsigned short*)(wl + MA_XK + (s0 + r) * 128 + (32 * dkb + ql) * 2));
            float wk[8];
#pragma unroll
            for (int j = 0; j < 8; ++j) { const float cv = fmaf(cwr[dkb][3], x[j + 3], fmaf(cwr[dkb][2], x[j + 2], fmaf(cwr[dkb][1], x[j + 1], cwr[dkb][0] * x[j])));
                wk[j] = cv * 0.125f * __builtin_amdgcn_rcpf(1.f + __expf(-cv)) * we[j]; dnacc[dkb] += wk[j]; }
            u32x4 w; w.x = pkbf(wk[0], wk[1]); w.y = pkbf(wk[2], wk[3]); w.z = pkbf(wk[4], wk[5]); w.w = pkbf(wk[6], wk[7]);
            WKf[dkb] = __builtin_bit_cast(bf16x8, w);
        }
#pragma unroll
        for (int dvb = 0; dvb < 2; ++dvb) { const bf16x8 Vf = tr_frag(wl + MA_VIMG + dvb * 4096, s0, s0 + 4, lane);
#pragma unroll
            for (int dkb = 0; dkb < 2; ++dkb) acc[dkb][dvb] = MFMA32(WKf[dkb], Vf, acc[dkb][dvb]); }
    }
    bf16_t* st = L.state + (size_t)uh * 4096;
#pragma unroll
    for (int dkb = 0; dkb < 2; ++dkb)
#pragma unroll
        for (int dvb = 0; dvb < 2; ++dvb)
#pragma unroll
            for (int gq = 0; gq < 4; ++gq) { uint2 w; w.x = pkbf(acc[dkb][dvb][4 * gq], acc[dkb][dvb][4 * gq + 1]); w.y = pkbf(acc[dkb][dvb][4 * gq + 2], acc[dkb][dvb][4 * gq + 3]);
                *(uint2*)(st + (32 * dvb + ql) * 64 + 32 * dkb + 8 * gq + 4 * h) = w; }
#pragma unroll
    for (int dkb = 0; dkb < 2; ++dkb) { const float t = dnacc[dkb] + __shfl_xor(dnacc[dkb], 32); if (h == 0) ws_f(p.ws, WS_DN)[(size_t)uh * 64 + 32 * dkb + ql] = t; }
    if (lane == 0) { ws_f(p.ws, WS_G)[uh] = g; ws_f(p.ws, WS_ML)[uh] = ml; }
}
__device__ __forceinline__ void mlstm_scan2_unit(const P& p, const LB& L, int u) {
    int tid_l = threadIdx.x; asm volatile("" : "+v"(tid_l)); const int tid = tid_l, bh = u >> 2, b = bh >> 3, hh = bh & 7, e = (u & 3) * 1024 + 2 * tid;
    const bool first = (u & 3) == 0; const bool do_n = first && tid < 64;
    float *G = ws_f(p.ws, WS_G), *ML = ws_f(p.ws, WS_ML), *MIN = ws_f(p.ws, WS_MIN), *DN = ws_f(p.ws, WS_DN);
    unsigned d[NCH]; float dn[NCH];
#pragma unroll
    for (int c = 0; c < NCH; ++c) { const int idx = (b * NCH + c) * 8 + hh; d[c] = *(const unsigned*)(L.state + (size_t)idx * 4096 + e); dn[c] = do_n ? DN[(size_t)idx * 64 + tid] : 0.f; }
    float m = 0.f, n = 0.f, C0 = 0.f, C1 = 0.f;
#pragma unroll
    for (int c = 0; c < NCH; ++c) { const int idx = (b * NCH + c) * 8 + hh; const float g = G[idx], ml = ML[idx], mn = fmaxf(g + m, ml), a = __expf(g + m - mn), sc = __expf(ml - mn);
        *(unsigned*)(L.state + (size_t)idx * 4096 + e) = pkbf(C0, C1);
        C0 = fmaf(C0, a, sc * __uint_as_float(d[c] << 16)); C1 = fmaf(C1, a, sc * __uint_as_float(d[c] & 0xffff0000u));
        if (do_n) { DN[(size_t)idx * 64 + tid] = n; n = a * n + sc * dn[c]; }
        if (first && tid == 0) MIN[idx] = m;
        m = mn; }
}
constexpr int MC_SLOT = 31232, MC_XQ = 0, MC_XK = 9728, MC_VIMG = 19456, MC_CW = 27648, MC_T0 = 29696, MC_T1 = 29952, MC_T2 = 30208, MC_T3 = 30464, MC_T4 = 30720  , MC_T5 = 30976  ;
__device__ __forceinline__ bf16x8 conv_frag_lds(const LAS unsigned char* img, int tok, int ch0, const LAS float* cwl, float scale) {
    float a[8] = {0.f, 0.f, 0.f, 0.f, 0.f, 0.f, 0.f, 0.f};
#pragma unroll
    for (int tap = 0; tap < 4; ++tap) {
        float xf[8]; unpack8(__builtin_bit_cast(uint4, *(const LAS u32x4*)(img + (tok + tap) * 144 + ch0 * 2)), xf);
        const f32x4 w0 = *(const LAS f32x4*)(cwl + tap * 128 + ch0), w1 = *(const LAS f32x4*)(cwl + tap * 128 + ch0 + 4);
        a[0] = fmaf(w0[0], xf[0], a[0]); a[1] = fmaf(w0[1], xf[1], a[1]); a[2] = fmaf(w0[2], xf[2], a[2]); a[3] = fmaf(w0[3], xf[3], a[3]);
        a[4] = fmaf(w1[0], xf[4], a[4]); a[5] = fmaf(w1[1], xf[5], a[5]); a[6] = fmaf(w1[2], xf[6], a[6]); a[7] = fmaf(w1[3], xf[7], a[7]);
    }
#pragma unroll
    for (int j = 0; j < 8; ++j) a[j] = a[j] * scale * __builtin_amdgcn_rcpf(1.f + __expf(-a[j]));
    u32x4 w; w.x = pkbf(a[0], a[1]); w.y = pkbf(a[2], a[3]); w.z = pkbf(a[4], a[5]); w.w = pkbf(a[6], a[7]);
    return __builtin_bit_cast(bf16x8, w);
}
template <int TB>
__device__ __forceinline__ void mlstm_C_block(const LB& L, int b, int c, int hh, int lane, int h, int ql, LAS unsigned char* wl, const bf16x8 (&Cf)[2][4], const uint2 (&mo)[2][4]) {
    const LAS float* cwl = (const LAS float*)(wl + MC_CW);
    bf16x8 Qf[4]; float qn = 0.f;
#pragma unroll
    for (int ks = 0; ks < 4; ++ks) { const int ch0 = 16 * ks + 8 * h;
        Qf[ks] = conv_frag_lds(wl + MC_XQ, 32 * TB + ql, ch0, cwl, 1.f);
        const f32x4 n0 = *(const LAS f32x4*)(wl + MC_T4 + ch0 * 4), n1 = *(const LAS f32x4*)(wl + MC_T4 + ch0 * 4 + 16);
        float qv[8]; unpack8(__builtin_bit_cast(uint4, Qf[ks]), qv);
#pragma unroll
        for (int j = 0; j < 4; ++j) { qn = fmaf(qv[j], n0[j], qn); qn = fmaf(qv[j + 4], n1[j], qn); } }
    f32x16 S0, S1;
#pragma unroll
    for (int r = 0; r < 16; ++r) { S0[r] = 0.f; S1[r] = 0.f; }
#pragma unroll
    for (int ks = 0; ks < 4; ++ks) { const int ch0 = 16 * ks + 8 * h;
        S0 = MFMA32(conv_frag_lds(wl + MC_XK, ql, ch0, cwl + 64, 0.125f), Qf[ks], S0);
        if (TB == 1) S1 = MFMA32(conv_frag_lds(wl + MC_XK, 32 + ql, ch0, cwl + 64, 0.125f), Qf[ks], S1); }
    const float Mt = ((const LAS float*)(wl + MC_T1))[32 * TB + ql];
    float dsum = 0.f;
#pragma unroll
    for (int gq = 0; gq < 4; ++gq) {
        const f32x4 a0 = *(const LAS f32x4*)(wl + MC_T0 + (8 * gq + 4 * h) * 4), a1 = *(const LAS f32x4*)(wl + MC_T0 + (32 + 8 * gq + 4 * h) * 4);
#pragma unroll
        for (int j = 0; j < 4; ++j) { const int r = 4 * gq + j, sl = 8 * gq + 4 * h + j;
            if (TB == 0) { const float v = sl <= ql ? S0[r] * __expf(a0[j] - Mt) : 0.f; S0[r] = v; dsum += v; }
            else { const float v0 = S0[r] * __expf(a0[j] - Mt); S0[r] = v0; const float v1 = sl <= ql ? S1[r] * __expf(a1[j] - Mt) : 0.f; S1[r] = v1; dsum += v0 + v1; } }
    }
    f32x16 acc[2];
#pragma unroll
    for (int d = 0; d < 2; ++d)
#pragma unroll
        for (int r = 0; r < 16; ++r) acc[d][r] = 0.f;
#pragma unroll
    for (int ks = 0; ks < 4; ++ks)
#pragma unroll
        for (int dvb = 0; dvb < 2; ++dvb) acc[dvb] = MFMA32(Cf[dvb][ks], Qf[ks], acc[dvb]);
    const float iw = ((const LAS float*)(wl + MC_T2))[32 * TB + ql];
#pragma unroll
    for (int dvb = 0; dvb < 2; ++dvb)
#pragma unroll
        for (int r = 0; r < 16; ++r) acc[dvb][r] *= iw;
#pragma unroll
    for (int s2 = 0; s2 < 2; ++s2) {
        const bf16x8 P0 = pack_step(S0, s2), P1 = pack_step(S1, s2);
#pragma unroll
        for (int dvb = 0; dvb < 2; ++dvb) {
            acc[dvb] = MFMA32(tr_frag(wl + MC_VIMG + dvb * 4096, 16 * s2 + 4 * h, 16 * s2 + 8 + 4 * h, lane), P0, acc[dvb]);
            if (TB == 1) acc[dvb] = MFMA32(tr_frag(wl + MC_VIMG + dvb * 4096, 32 + 16 * s2 + 4 * h, 32 + 16 * s2 + 8 + 4 * h, lane), P1, acc[dvb]); }
    }
    dsum += __shfl_xor(dsum, 32); qn += __shfl_xor(qn, 32);
    const float den = dsum + iw * qn, mt = ((const LAS float*)(wl + MC_T3))[32 * TB + ql];
    const float sc = 1.f / fmaxf(fabsf(den), __expf(-mt));
    float sum = 0.f;
#pragma unroll
    for (int dvb = 0; dvb < 2; ++dvb)
#pragma unroll
        for (int r = 0; r < 16; ++r) { const float v = acc[dvb][r] * sc; acc[dvb][r] = v; sum += v; }
    sum += __shfl_xor(sum, 32); const float mu = sum * (1.f / 64.f);
    float var = 0.f;
#pragma unroll
    for (int dvb = 0; dvb < 2; ++dvb)
#pragma unroll
        for (int r = 0; r < 16; ++r) { const float dlt = acc[dvb][r] - mu; var += dlt * dlt; }
    var += __shfl_xor(var, 32); const float rstd = rsqrtf(var * (1.f / 64.f) + EPS);
    bf16_t* op = L.mo + (size_t)(b * T + c * 64 + 32 * TB + ql) * 512 + hh * 64;
#pragma unroll
    for (int dvb = 0; dvb < 2; ++dvb)
#pragma unroll
        for (int gq = 0; gq < 4; ++gq) { const int dv = 32 * dvb + 8 * gq + 4 * h; const f32x4 ng = *(const LAS f32x4*)(wl + MC_T5 + dv * 4);
            const uint2 mg = mo[dvb][gq];
            const float y0 = (acc[dvb][4 * gq] - mu) * rstd * ng[0] * __uint_as_float(mg.x << 16), y1 = (acc[dvb][4 * gq + 1] - mu) * rstd * ng[1] * __uint_as_float(mg.x & 0xffff0000u);
            const float y2 = (acc[dvb][4 * gq + 2] - mu) * rstd * ng[2] * __uint_as_float(mg.y << 16), y3 = (acc[dvb][4 * gq + 3] - mu) * rstd * ng[3] * __uint_as_float(mg.y & 0xffff0000u);
            uint2 w; w.x = pkbf(y0, y1); w.y = pkbf(y2, y3); *(uint2*)(op + dv) = w; }
}
__device__ __forceinline__ void mlstm_C_mfma_unit(const P& p, const LB& L, int l, int u, LAS unsigned char* l3) {
    int tid_l = threadIdx.x; asm volatile("" : "+v"(tid_l)); const int tid = tid_l, lane = tid & 63, wave = tid >> 6, h = lane >> 5, ql = lane & 31;
    const int hg = u & 1, c = (u >> 1) & 31, b = u >> 6, hh = 4 * hg + (wave >> 1), tb = wave & 1, uh = (b * 32 + c) * 8 + hh, l128 = tid & 127;
    LAS unsigned char* wl = l3 + (wave >> 1) * MC_SLOT;
    const float* cw = p.conv_w + (size_t)l * 4 * 1024;
    bf16x8 Cf[2][4]; uint2 mo[2][4];
    float iraw, fraw; mlstm_gates_load(p, L, l, b, c, hh, lane, iraw, fraw);
    {
        const bf16_t* st = L.state + (size_t)uh * 4096; const bf16_t* op = L.mo + (size_t)(b * T + c * 64 + 32 * tb + ql) * 512 + hh * 64;
#pragma unroll
        for (int dvb = 0; dvb < 2; ++dvb) {
#pragma unroll
            for (int ks = 0; ks < 4; ++ks) Cf[dvb][ks] = *(const bf16x8*)(st + (32 * dvb + ql) * 64 + 16 * ks + 8 * h);
#pragma unroll
            for (int gq = 0; gq < 4; ++gq) mo[dvb][gq] = *(const uint2*)(op + 32 * dvb + 8 * gq + 4 * h);
        }
    }
    __syncthreads();
    {
        u32x4 xq[5], xk[5], vv[4]; float cwv[4];
#pragma unroll
        for (int i = 0; i < 5; ++i) { const int idx = l128 + 128 * i, ic = idx < 67 * 8 ? idx : 67 * 8 - 1, row = ic >> 3, cc = ic & 7, t = c * 64 - 3 + row;
            const bf16_t* src = L.mqk + (size_t)(b * T + (t >= 0 ? t : 0)) * 1024 + hh * 64 + cc * 8; xq[i] = *(const u32x4*)src; xk[i] = *(const u32x4*)(src + 512); }
#pragma unroll
        for (int i = 0; i < 4; ++i) { const int s = (l128 >> 3) + 16 * i, cc = l128 & 7; vv[i] = *(const u32x4*)(L.mv + (size_t)(b * T + c * 64 + s) * 512 + hh * 64 + cc * 8); }
#pragma unroll
        for (int i = 0; i < 4; ++i) { const int e = l128 + 128 * i, tap = e >> 7, wch = e & 127; cwv[i] = cw[tap * 1024 + (wch >> 6) * 512 + hh * 64 + (wch & 63)]; }
#pragma unroll
        for (int i = 0; i < 5; ++i) { const int idx = l128 + 128 * i, row = idx >> 3, cc = idx & 7, t = c * 64 - 3 + row; const u32x4 z = (u32x4){0u, 0u, 0u, 0u};
            if (idx < 67 * 8) { *(LAS u32x4*)(wl + MC_XQ + row * 144 + cc * 16) = t >= 0 ? xq[i] : z; *(LAS u32x4*)(wl + MC_XK + row * 144 + cc * 16) = t >= 0 ? xk[i] : z; } }
#pragma unroll
        for (int i = 0; i < 4; ++i) { const int s = (l128 >> 3) + 16 * i, cc = l128 & 7; *(LAS u32x4*)(wl + MC_VIMG + (cc >> 2) * 4096 + s * 64 + (cc & 3) * 16) = vv[i]; }
#pragma unroll
        for (int i = 0; i < 4; ++i) ((LAS float*)(wl + MC_CW))[l128 + 128 * i] = cwv[i];
    }
    {
        float bcum, ig; mlstm_gates_wave(iraw, fraw, lane, bcum, ig);
        const float a = ig - bcum; float v = a;
#pragma unroll
        for (int o = 1; o < 64; o <<= 1) { const float t = __shfl_up(v, o); if (lane >= o) v = fmaxf(v, t); }
        const float m_in = ws_f(p.ws, WS_MIN)[uh], Mt = fmaxf(v, m_in);
        if (tb == 1) { ((LAS float*)(wl + MC_T4))[lane] = ws_f(p.ws, WS_DN)[(size_t)uh * 64 + lane]; ((LAS float*)(wl + MC_T5))[lane] = p.norm_g[l * 512 + hh * 64 + lane]; }
        if (tb == 0) { ((LAS float*)(wl + MC_T0))[lane] = a; ((LAS float*)(wl + MC_T1))[lane] = Mt; ((LAS float*)(wl + MC_T2))[lane] = __expf(m_in - Mt); ((LAS float*)(wl + MC_T3))[lane] = bcum + Mt; }
    }
    __syncthreads();
    if (tb == 0) mlstm_C_block<0>(L, b, c, hh, lane, h, ql, wl, Cf, mo);
    else mlstm_C_block<1>(L, b, c, hh, lane, h, ql, wl, Cf, mo);
}

#define XB_TMO      128
#define XB_XCNT(j)  (256  + 64 * (j))
#define XB_XSUB(j)  (1280 + 64 * (j))
#define XB_XGEN(j)  (2304 + 64 * (j))
#define XB_TOP      3328
#define XB_TOPGEN   3392
#define XCD_BAR_WORDS 3456
#define XB_SPIN_CAP (1u << 18)

__device__ __forceinline__ unsigned xb_ld(unsigned* p)              { return __hip_atomic_load(p, __ATOMIC_RELAXED, __HIP_MEMORY_SCOPE_AGENT); }
__device__ __forceinline__ unsigned xb_add(unsigned* p, unsigned v) { return __hip_atomic_fetch_add(p, v, __ATOMIC_RELAXED, __HIP_MEMORY_SCOPE_AGENT); }
__device__ __forceinline__ unsigned xb_xcc_id() { return (unsigned)__builtin_amdgcn_s_getreg((3 << 11) | 20) & 0xFu; }
#define XB_SPIN(cond, bar) do { unsigned _sp = 0; while (cond) { __builtin_amdgcn_s_sleep(1); \
    if ((++_sp & 255u) == 0u) { if (xb_ld(&(bar)[XB_TMO])) break; if (_sp > XB_SPIN_CAP) { atomicAdd(&(bar)[XB_TMO], 1u); break; } } } } while (0)

struct XcdBarrier {
    unsigned* bar; unsigned x;
    volatile LAS unsigned* st;
};

__device__ __forceinline__ XcdBarrier xcd_barrier_post(unsigned* bar, volatile LAS unsigned* st) {
    XcdBarrier b; b.bar = bar; b.x = xb_xcc_id(); b.st = st;
    if (threadIdx.x == 0) (void)xb_add(&bar[XB_XCNT(b.x)], 1u);
    return b;
}
__device__ __forceinline__ void xcd_barrier_complete(unsigned* bar, unsigned x, unsigned& nloc, unsigned& nx) {
    const unsigned G = gridDim.x * gridDim.y * gridDim.z;
    unsigned sum, cnt, mine, sp = 0u;
    for (;;) {
        sum = 0u; cnt = 0u; mine = 0u;
#pragma unroll
        for (unsigned j = 0; j < 16; ++j) { const unsigned c = xb_ld(&bar[XB_XCNT(j)]); sum += c; cnt += (c > 0u) ? 1u : 0u; mine = (j == x) ? c : mine; }
        if (sum == G) break;
        __builtin_amdgcn_s_sleep(1);
        if ((++sp & 255u) == 0u) { if (xb_ld(&bar[XB_TMO])) break; if (sp > XB_SPIN_CAP) { atomicAdd(&bar[XB_TMO], 1u); break; } }
    }
    nloc = mine > 0u ? mine : 1u; nx = cnt > 0u ? cnt : 1u;
}

__device__ __forceinline__ void xcd_barrier(const XcdBarrier& b) {
    asm volatile("s_waitcnt vmcnt(0)" ::: "memory");
    __syncthreads();
    if (threadIdx.x == 0) {
        unsigned* bar = b.bar;
        __builtin_amdgcn_s_waitcnt(0);
        unsigned nloc = b.st[0], nx = b.st[1];
        if (nloc == 0u) { xcd_barrier_complete(bar, b.x, nloc, nx); b.st[0] = nloc; b.st[1] = nx; }
        const unsigned old = xb_add(&bar[XB_XSUB(b.x)], 1u);
        const unsigned gen = old / nloc;
        if (old + 1u == (gen + 1u) * nloc) {
            __builtin_amdgcn_fence(__ATOMIC_RELEASE, "agent");
            asm volatile("s_waitcnt vmcnt(0)" ::: "memory");
            const unsigned og = xb_add(&bar[XB_TOP], 1u);
            const unsigned tg = og / nx;
            if (og + 1u == (tg + 1u) * nx) xb_add(&bar[XB_TOPGEN], 1u);
            else XB_SPIN(xb_ld(&bar[XB_TOPGEN]) == tg, bar);
            __builtin_amdgcn_fence(__ATOMIC_ACQUIRE, "agent");
            xb_add(&bar[XB_XGEN(b.x)], 1u);
            asm volatile("s_waitcnt vmcnt(0)" ::: "memory");
        } else {
            XB_SPIN(xb_ld(&bar[XB_XGEN(b.x)]) == gen, bar);
            __builtin_amdgcn_fence(__ATOMIC_ACQUIRE, "agent");
            asm volatile("s_waitcnt vmcnt(0)" ::: "memory");
        }
    }
    __syncthreads();
}

__global__ void __launch_bounds__(512, 2) mk_fwd(P p) {
    extern __shared__ __attribute__((aligned(16))) unsigned char lds[];
    LAS unsigned char* l3 = (LAS unsigned char*)lds;
    float* fl = (float*)lds;
    const int G = gridDim.x, bx = blockIdx.x;
    if (threadIdx.x < 64) ((LAS unsigned*)(l3 + LDS_CTL))[threadIdx.x] = 0u;
    __syncthreads();
    (void)xcd_barrier_post((unsigned*)(p.ws + WS_BAR), (volatile LAS unsigned*)(l3 + LDS_CTL + 32));
#define PR_T0 (*(volatile LAS unsigned long long*)(l3 + LDS_CTL + 64))
#define PR_ACC (*(volatile LAS unsigned long long*)(l3 + LDS_CTL + 72))
#define PH_BEGIN(id) do { if ((PROBE_MASK >> (id)) & 1) { if (bx == 0 && threadIdx.x == 0) PR_T0 = __builtin_amdgcn_s_memrealtime(); } } while (0)
#define PH_END(id) do { if ((PROBE_MASK >> (id)) & 1) { if (bx == 0 && threadIdx.x == 0) PR_ACC = PR_ACC + (__builtin_amdgcn_s_memrealtime() - PR_T0); } } while (0)
#define GRID_BAR() do { XcdBarrier b_; b_.bar = (unsigned*)(p.ws + WS_BAR); b_.x = xb_xcc_id(); b_.st = (volatile LAS unsigned*)(l3 + LDS_CTL + 32); xcd_barrier(b_); } while (0)
#define WAVE_IDS() int tid_w = threadIdx.x; asm volatile("" : "+v"(tid_w)); const int lane = tid_w & 63, gw = bx * 8 + (tid_w >> 6), ngw = G * 8

        PH_BEGIN(0);
    {
        WAVE_IDS();
        convert_phase(p, bx, G, fl);
        rowstat_rows(p.x, M, layer_buf(p.ws, p.out, 0).xbin, ws_f(p.ws, WS_ROWSS), gw, ngw, lane);
        rowstat_rows(p.mem, MM, (bf16_t*)(p.ws + WS_MEMB), ws_f(p.ws, WS_ROWSS_MEM), gw, ngw, lane);
    }
    GRID_BAR();
        PH_END(0);

#pragma unroll 1
    for (int l = 0; l < 2; ++l) {
        PH_BEGIN(1);
        {
            const LB L = layer_buf(p.ws, p.out, l);
            pg8::Gemm g{L.xbin, L.win, M, 6656, D, (const bf16_t*)(p.ws + WS_MEMB)};
            SchedRounds S{G, bx, 6, 0, 1, 3};
            Unit u0, u3; S.next(0, u0); const bool has_tail = S.next(6, u3);
            fill_rstd_table(ws_f(p.ws, WS_ROWSS) + (size_t)(2 * l) * M * 16, u0.rm, (LAS float*)(l3 + LDS_RSTD0));
            if (has_tail) fill_rstd_table(u3.kind == 1 ? ws_f(p.ws, WS_ROWSS_MEM) : ws_f(p.ws, WS_ROWSS) + (size_t)(2 * l) * M * 16, u3.rm, (LAS float*)(l3 + LDS_RSTD1));
            __syncthreads();
            EpiProjMK E{L, (const LAS float*)(l3 + LDS_RSTD0), (const LAS float*)(l3 + LDS_RSTD1), u0.rm};
            pg8::gemm_phase<EpiProjMK, SchedRounds, true, true>(l3, g, S, E);
        }
        GRID_BAR();
        PH_END(1);
        PH_BEGIN(2);
        {
            const LB L = layer_buf(p.ws, p.out, l);
            PH_BEGIN(10); for (int u = bx; u < NB * 16 * 2; u += G) swa_mfma_unit(p, L, l, u, l3); PH_END(10);
            PH_BEGIN(11); xattn_mfma_unit(L, ((bx & 7) * 4 + (bx >> 6)) * 8 + ((bx >> 3) & 7), l3); PH_END(11);
            PH_BEGIN(12); for (int u = bx; u < NB * NCH; u += G) mlstm_A_mfma_unit(p, L, l, u, l3); PH_END(12);
        }
        GRID_BAR();
        PH_END(2);
        PH_BEGIN(3);
        {
            const LB L = layer_buf(p.ws, p.out, l);
            for (int u = bx; u < 256; u += G) mlstm_scan2_unit(p, L, u);
        }
        GRID_BAR();
        PH_END(3);
        PH_BEGIN(4);
        {
            const LB L = layer_buf(p.ws, p.out, l);
            for (int u = bx; u < NB * NCH * 2; u += G) mlstm_C_mfma_unit(p, L, l, u, l3);
        }
        GRID_BAR();
        PH_END(4);
        PH_BEGIN(6);
        {
            const LB L = layer_buf(p.ws, p.out, l);
            pg8::Gemm g{L.sq, L.wbr, 3 * M, 3 * D, 512, nullptr};
            SchedMerged S{G, bx};
            EpiMergedMK E{L.gates, L.merged};
            pg8::gemm_phase<EpiMergedMK, SchedMerged, true, true>(l3, g, S, E);
        }
        GRID_BAR();
        PH_END(6);
        PH_BEGIN(7);
        {
            const LB L = layer_buf(p.ws, p.out, l);
            pg8::Gemm g{L.merged, L.wout, M, D, D, nullptr};
            SchedRounds S{G, bx, 1, 0, 0, 99};
            EpiResidMK E{L.xbin, L.xbmid, ws_f(p.ws, WS_ROWSS) + (size_t)(2 * l + 1) * M * 16};
            pg8::gemm_phase<EpiResidMK, SchedRounds, true, true>(l3, g, S, E);
        }
        GRID_BAR();
        PH_END(7);
        PH_BEGIN(8);
        {
            const LB L = layer_buf(p.ws, p.out, l);
            pg8::Gemm g{L.xbmid, L.wff1, M, DFF, D, nullptr};
            SchedRounds S{G, bx, 4, 0, 0, 99};
            Unit u0; S.next(0, u0);
            fill_rstd_table(ws_f(p.ws, WS_ROWSS) + (size_t)(2 * l + 1) * M * 16, u0.rm, (LAS float*)(l3 + LDS_RSTD0));
            __syncthreads();
            EpiFF1MK E{L.hff, (const LAS float*)(l3 + LDS_RSTD0)};
            pg8::gemm_phase<EpiFF1MK, SchedRounds, true, true>(l3, g, S, E);
        }
        GRID_BAR();
        PH_END(8);
        PH_BEGIN(9);
        {
            const LB L = layer_buf(p.ws, p.out, l);
            pg8::Gemm g{L.hff, L.wff2, M, D, DFF, nullptr};
            SchedRounds S{G, bx, 1, 0, 0, 99};
            EpiResidMK E{L.xbmid, L.xbnext, ws_f(p.ws, WS_ROWSS) + (size_t)(2 * l + 2) * M * 16};
            pg8::gemm_phase<EpiResidMK, SchedRounds, true, true>(l3, g, S, E);
        }
        GRID_BAR();
        PH_END(9);
    }
    {
        WAVE_IDS();
        finalnorm_rows(layer_buf(p.ws, p.out, 1).xbnext, p.out, ws_f(p.ws, WS_ROWSS) + (size_t)4 * M * 16, p.g_final, gw, ngw, lane);
    }
    if (PROBE_MASK != 0 && bx == 0 && threadIdx.x == 0) { const unsigned long long te = __builtin_amdgcn_s_memrealtime(); const unsigned long long acc_ = PR_ACC; while (__builtin_amdgcn_s_memrealtime() - te < 10ull * acc_) __builtin_amdgcn_s_sleep(8); }
}
}

extern "C" void kernel_launch(void* const* d_in, const int* in_sizes, int n_in, void* d_out, int out_size, void* d_ws, size_t ws_size, hipStream_t stream) {
    static int grid = 0;
    if (grid == 0) {
        if (n_in != 20 || out_size != M * D || ws_size < WS_END) { fprintf(stderr, "kernel_launch: unexpected shapes (n_in %d out %d ws %zu)\n", n_in, out_size, ws_size); grid = -1; return; }
        int dev = 0, cus = 0, per_cu = 0;
        if (hipGetDevice(&dev) != hipSuccess || hipDeviceGetAttribute(&cus, hipDeviceAttributeMultiprocessorCount, dev) != hipSuccess) { fprintf(stderr, "kernel_launch: device query failed\n"); grid = -1; return; }
        if (hipFuncSetAttribute((const void*)mk_fwd, hipFuncAttributeMaxDynamicSharedMemorySize, LDS_BYTES) != hipSuccess) { fprintf(stderr, "kernel_launch: hipFuncSetAttribute failed\n"); grid = -1; return; }
        if (hipOccupancyMaxActiveBlocksPerMultiprocessor(&per_cu, (const void*)mk_fwd, 512, LDS_BYTES) != hipSuccess || per_cu < 1) { fprintf(stderr, "kernel_launch: occupancy query says %d blocks per CU\n", per_cu); grid = -1; return; }
        if (cus != 256) { fprintf(stderr, "kernel_launch: built for a 256-CU device (unit orders assume 256 workgroups); found %d CUs\n", cus); grid = -1; return; }
        grid = cus * (per_cu >= 1 ? 1 : 0);
    }
    if (grid < 0) return;
    P p{};
    const float** pf = (const float**)&p;
    for (int i = 0; i < 20; ++i) pf[i] = (const float*)d_in[i];
    p.out = (float*)d_out; p.ws = (unsigned char*)d_ws;
    if (hipMemsetAsync(d_ws, 0, WS_ZERO_BYTES, stream) != hipSuccess) { fprintf(stderr, "kernel_launch: memset failed\n"); return; }
    void* args[] = {&p};
    const hipError_t e = hipLaunchCooperativeKernel((const void*)mk_fwd, dim3(grid), dim3(512), args, LDS_BYTES, stream);
    if (e != hipSuccess) fprintf(stderr, "kernel_launch: cooperative launch failed: %s (grid %d)\n", hipGetErrorString(e), grid);
}
```
